# Optimizing an MI355X kernel written in HIP

```python
import jax, jax.numpy as jnp
from jax import lax
import numpy as np

D_MODEL = 1024
BATCH = 8
SEQ = 2048
DEPTH = 2
DEC_BATCH = 128
DEC_SEQ = 1
PAST_LEN = 16384
PAGE_SIZE = 128

N_EVEN = (DEPTH + 1) // 2
N_ODD = DEPTH // 2
CONV_CH = D_MODEL // 2
CONV_K = 31
DN_HEAD_DIM = 128
DN_HEADS = (D_MODEL // 2) // DN_HEAD_DIM
DN_WIDTH = DN_HEADS * DN_HEAD_DIM
QKV_CH = 3 * DN_WIDTH
SC_K = 4
DN_CHUNK = 64
EVEN_IN = 3 * CONV_CH + QKV_CH + DN_WIDTH + 2 * DN_HEADS
EVEN_MIX = CONV_CH + DN_WIDTH
EVEN_SPLITS = (CONV_CH, 2 * CONV_CH, 3 * CONV_CH, 3 * CONV_CH + QKV_CH,
               3 * CONV_CH + QKV_CH + DN_WIDTH, 3 * CONV_CH + QKV_CH + DN_WIDTH + DN_HEADS)
POOL_WINDOWS = (2, 4, 8, 16)
POOL_WIDTH = D_MODEL
POOL_GROUP = POOL_WIDTH // len(POOL_WINDOWS)
POOL_BUF = max(POOL_WINDOWS) - 1
N_MEM = 256
XA_HEADS = 4
XA_HEAD_DIM = D_MODEL // XA_HEADS
XA_WIDTH = XA_HEADS * XA_HEAD_DIM
EPS = 1e-6

kernel_name = 'hybrid_conformer_deltanet_pool_decoder_step'


def rms_norm(x, g):
    xf = x.astype(jnp.float32)
    y = xf * lax.rsqrt(jnp.mean(xf * xf, axis=-1, keepdims=True) + EPS)
    return y.astype(x.dtype) * g.astype(x.dtype)


def layer_norm(x, g, b):
    xf = x.astype(jnp.float32)
    xc = xf - jnp.mean(xf, axis=-1, keepdims=True)
    y = xc * lax.rsqrt(jnp.mean(xc * xc, axis=-1, keepdims=True) + EPS)
    return y.astype(x.dtype) * g.astype(x.dtype) + b.astype(x.dtype)


def l2_normalize(x):
    return x * lax.rsqrt(jnp.sum(x * x, axis=-1, keepdims=True) + EPS)


def causal_depthwise_conv(x, buf, w):
    k_len, ch = w.shape
    xp = jnp.concatenate([buf.astype(x.dtype), x], axis=1)
    y = lax.conv_general_dilated(xp, w.astype(x.dtype)[:, None, :], window_strides=(1,), padding='VALID',
                                 dimension_numbers=('NWC', 'WIO', 'NWC'), feature_group_count=ch)
    return y, xp[:, xp.shape[1] - (k_len - 1):]


def gated_delta_chunked(q, k, v, g, beta, s0):
    b, t, h, dk = q.shape
    dv = v.shape[-1]
    c = DN_CHUNK
    n = t // c

    def blocks(a):
        return jnp.moveaxis(a.reshape((b, n, c, h) + a.shape[3:]), 3, 1)

    q, k, v, g, beta = blocks(q * dk ** -0.5), blocks(k), blocks(v), blocks(g), blocks(beta)
    gc = jnp.cumsum(g, axis=-1)
    incl = jnp.tril(jnp.ones((c, c), dtype=bool))
    strict = jnp.tril(jnp.ones((c, c), dtype=bool), -1)
    diff = gc[..., :, None] - gc[..., None, :]
    decay = jnp.where(incl, jnp.exp(jnp.where(incl, diff, 0.0)), 0.0)
    kb = k * beta[..., None]
    a_low = jnp.where(strict, jnp.einsum('bhnid,bhnjd->bhnij', kb, k) * decay, 0.0)
    rhs = jnp.concatenate([v * beta[..., None], kb * jnp.exp(gc)[..., None]], axis=-1)
    sol = lax.linalg.triangular_solve(a_low + jnp.eye(c, dtype=a_low.dtype), rhs, left_side=True,
                                      lower=True, unit_diagonal=True)
    u, w = sol[..., :dv], sol[..., dv:]
    qk = jnp.where(incl, jnp.einsum('bhnid,bhnjd->bhnij', q, k) * decay, 0.0)
    q_dec = q * jnp.exp(gc)[..., None]
    k_dec = k * jnp.exp(gc[..., -1:] - gc)[..., None]
    g_last = jnp.exp(gc[..., -1])

    def step(s, xs):
        u_n, w_n, qd_n, kd_n, qk_n, gl_n = xs
        v_new = u_n - jnp.einsum('bhcd,bhde->bhce', w_n, s)
        o_n = jnp.einsum('bhcd,bhde->bhce', qd_n, s) + jnp.einsum('bhcj,bhje->bhce', qk_n, v_new)
        s = s * gl_n[..., None, None] + jnp.einsum('bhcd,bhce->bhde', kd_n, v_new)
        return s, o_n

    xs = tuple(jnp.moveaxis(a, 2, 0) for a in (u, w, q_dec, k_dec, qk, g_last))
    s_fin, o = lax.scan(step, s0, xs)
    o = jnp.transpose(o, (1, 0, 3, 2, 4)).reshape(b, t, h, dv)
    return o, s_fin


def gated_delta_recurrent(q, k, v, g, beta, s0):
    q = q * q.shape[-1] ** -0.5

    def step(s, xs):
        q_t, k_t, v_t, g_t, b_t = xs
        s = s * jnp.exp(g_t)[..., None, None]
        v_new = (v_t - jnp.einsum('bhd,bhde->bhe', k_t, s)) * b_t[..., None]
        s = s + jnp.einsum('bhd,bhe->bhde', k_t, v_new)
        return s, jnp.einsum('bhd,bhde->bhe', q_t, s)

    xs = tuple(jnp.moveaxis(a, 1, 0) for a in (q, k, v, g, beta))
    s_fin, o = lax.scan(step, s0, xs)
    return jnp.moveaxis(o, 0, 1), s_fin


def even_mixer(h, conv_buf, qkv_buf, s0, w_in, dw_w, dw_b, ln_g, ln_b, sc_w, a_log, dt_bias, dn_g, w_out,
               recurrent):
    b, t, _ = h.shape
    p = h @ w_in
    glu_val, glu_gate, gate_a, qkv, z, beta_l, a_l = jnp.split(p, EVEN_SPLITS, axis=-1)
    c, conv_buf_new = causal_depthwise_conv(glu_val * jax.nn.sigmoid(glu_gate), conv_buf, dw_w)
    c = jax.nn.silu(layer_norm(c + dw_b.astype(c.dtype), ln_g, ln_b))
    a_out = c * jax.nn.silu(gate_a)
    qkv_c, qkv_buf_new = causal_depthwise_conv(qkv, qkv_buf, sc_w)
    qkv_c = jax.nn.silu(qkv_c).astype(jnp.float32).reshape(b, t, 3, DN_HEADS, DN_HEAD_DIM)
    q = l2_normalize(qkv_c[:, :, 0])
    k = l2_normalize(qkv_c[:, :, 1])
    v = qkv_c[:, :, 2]
    beta = jax.nn.sigmoid(beta_l.astype(jnp.float32))
    g = -jnp.exp(a_log.astype(jnp.float32)) * jax.nn.softplus(a_l.astype(jnp.float32) + dt_bias.astype(jnp.float32))
    delta = gated_delta_recurrent if recurrent else gated_delta_chunked
    o, s_new = delta(q, k, v, g, beta, s0.astype(jnp.float32))
    o = rms_norm(o, dn_g) * jax.nn.silu(z.astype(jnp.float32).reshape(b, t, DN_HEADS, DN_HEAD_DIM))
    b_out = o.reshape(b, t, DN_WIDTH).astype(h.dtype)
    y = jnp.concatenate([a_out, b_out], axis=-1) @ w_out
    return y, conv_buf_new, qkv_buf_new, s_new.astype(s0.dtype)


def causal_multiscale_pool(u, buf, start_pos):
    b, t, ch = u.shape
    up = jnp.concatenate([buf.astype(u.dtype), u], axis=1)
    cs = jnp.cumsum(up.astype(jnp.float32), axis=1)
    cs = jnp.concatenate([jnp.zeros((b, 1, ch), jnp.float32), cs], axis=1)
    pos = start_pos + jnp.arange(t)
    end = cs[:, POOL_BUF + 1:POOL_BUF + 1 + t]
    means = []
    for gi, win in enumerate(POOL_WINDOWS):
        sl = slice(gi * POOL_GROUP, (gi + 1) * POOL_GROUP)
        begin = cs[:, POOL_BUF + 1 - win:POOL_BUF + 1 - win + t, sl]
        cnt = jnp.minimum(pos + 1, win).astype(jnp.float32)
        means.append((end[..., sl] - begin) / cnt[None, :, None])
    pooled = jnp.concatenate(means, axis=-1) - u.astype(jnp.float32)
    return pooled.astype(u.dtype), up[:, up.shape[1] - POOL_BUF:]


def odd_mixer(h, pool_buf, w_in, w_pool, b_pool, scale, w_out, start_pos):
    b, t, _ = h.shape
    u, gate = jnp.split(h @ w_in, 2, axis=-1)
    pooled, buf_new = causal_multiscale_pool(u, pool_buf, start_pos)
    z = jnp.einsum('btgc,gcd->btgd', pooled.reshape(b, t, len(POOL_WINDOWS), POOL_GROUP), w_pool) + b_pool
    z = z.reshape(b, t, POOL_WIDTH) * scale * jax.nn.silu(gate)
    return z @ w_out, buf_new


def memory_cross_attention(h, mk, mv, wq, wo):
    b, t, _ = h.shape
    q = (h @ wq).reshape(b, t, XA_HEADS, XA_HEAD_DIM)
    s = jnp.einsum('bthd,bmhd->bhtm', q, mk.astype(q.dtype)).astype(jnp.float32) * XA_HEAD_DIM ** -0.5
    pr = jax.nn.softmax(s, axis=-1).astype(q.dtype)
    o = jnp.einsum('bhtm,bmhd->bthd', pr, mv.astype(q.dtype)).reshape(b, t, XA_WIDTH)
    return o @ wo


def trunk(x, conv_bufs, qkv_bufs, dn_states, pool_bufs, mem_k, mem_v, prm, start_pos, recurrent):
    new_conv, new_qkv, new_dn, new_pool = [], [], [], []
    for l in range(DEPTH):
        h = rms_norm(x, prm['norm_mix'][l])
        if l % 2 == 0:
            e = l // 2
            y, cb, qb, st = even_mixer(h, conv_bufs[e], qkv_bufs[e], dn_states[e], prm['w_in_even'][e],
                                       prm['dw_w'][e], prm['dw_b'][e], prm['ln_a_g'][e], prm['ln_a_b'][e],
                                       prm['sc_w'][e], prm['a_log'][e], prm['dt_bias'][e],
                                       prm['dn_norm_g'][e], prm['w_out_even'][e], recurrent)
            new_conv.append(cb)
            new_qkv.append(qb)
            new_dn.append(st)
        else:
            o = l // 2
            y, pb = odd_mixer(h, pool_bufs[o], prm['w_in_odd'][o], prm['w_pool'][o], prm['b_pool'][o],
                              prm['pool_scale'][o], prm['w_out_odd'][o], start_pos)
            new_pool.append(pb)
        x = x + y
        h = rms_norm(x, prm['norm_xattn'][l])
        x = x + memory_cross_attention(h, mem_k[l], mem_v[l], prm['w_xq'][l], prm['w_xo'][l])
    y = rms_norm(x, prm['norm_final'])
    return y, jnp.stack(new_conv), jnp.stack(new_qkv), jnp.stack(new_dn), jnp.stack(new_pool)


def setup_inputs(seed: int = 0) -> dict:
    key = jax.random.key(seed)
    ks = jax.random.split(key, 40)

    def nrm(k, shape, scale):
        return jax.random.normal(k, shape, jnp.float32) * scale

    dt = jnp.exp(jax.random.uniform(ks[20], (N_EVEN, DN_HEADS), jnp.float32, np.log(1e-3), np.log(1e-1)))
    return {
        'x_prompt': nrm(ks[0], (BATCH, SEQ, D_MODEL), 1.0),
        'x_sample': nrm(ks[1], (DEC_BATCH, DEC_SEQ, D_MODEL), 1.0),
        'state_conv_a': nrm(ks[2], (N_EVEN, DEC_BATCH, CONV_K - 1, CONV_CH), 0.5),
        'state_qkv_conv': nrm(ks[3], (N_EVEN, DEC_BATCH, SC_K - 1, QKV_CH), 1.0),
        'state_delta': nrm(ks[4], (N_EVEN, DEC_BATCH, DN_HEADS, DN_HEAD_DIM, DN_HEAD_DIM), 0.1),
        'state_pool': nrm(ks[5], (N_ODD, DEC_BATCH, POOL_BUF, POOL_WIDTH), 1.0),
        'cache_mem_k': nrm(ks[6], (DEPTH, DEC_BATCH, N_MEM, XA_HEADS, XA_HEAD_DIM), 1.0),
        'cache_mem_v': nrm(ks[7], (DEPTH, DEC_BATCH, N_MEM, XA_HEADS, XA_HEAD_DIM), 1.0),
        'mem_prompt': nrm(ks[8], (BATCH, N_MEM, D_MODEL), 1.0),
        'norm_mix': 1.0 + nrm(ks[9], (DEPTH, D_MODEL), 0.02),
        'norm_xattn': 1.0 + nrm(ks[10], (DEPTH, D_MODEL), 0.02),
        'norm_final': 1.0 + nrm(ks[11], (D_MODEL,), 0.02),
        'w_in_even': nrm(ks[12], (N_EVEN, D_MODEL, EVEN_IN), D_MODEL ** -0.5),
        'w_out_even': nrm(ks[13], (N_EVEN, EVEN_MIX, D_MODEL), EVEN_MIX ** -0.5),
        'dw_w': nrm(ks[14], (N_EVEN, CONV_K, CONV_CH), CONV_K ** -0.5),
        'dw_b': nrm(ks[15], (N_EVEN, CONV_CH), 0.02),
        'ln_a_g': 1.0 + nrm(ks[16], (N_EVEN, CONV_CH), 0.02),
        'ln_a_b': nrm(ks[17], (N_EVEN, CONV_CH), 0.02),
        'sc_w': nrm(ks[18], (N_EVEN, SC_K, QKV_CH), SC_K ** -0.5),
        'a_log': jnp.log(jax.random.uniform(ks[19], (N_EVEN, DN_HEADS), jnp.float32, 1.0, 16.0)),
        'dt_bias': dt + jnp.log(-jnp.expm1(-dt)),
        'dn_norm_g': 1.0 + nrm(ks[21], (N_EVEN, DN_HEAD_DIM), 0.02),
        'w_in_odd': nrm(ks[22], (N_ODD, D_MODEL, 2 * POOL_WIDTH), D_MODEL ** -0.5),
        'w_pool': nrm(ks[23], (N_ODD, len(POOL_WINDOWS), POOL_GROUP, POOL_GROUP), POOL_GROUP ** -0.5),
        'b_pool': nrm(ks[24], (N_ODD, len(POOL_WINDOWS), POOL_GROUP), 0.02),
        'pool_scale': 1.0 + nrm(ks[25], (N_ODD, POOL_WIDTH), 0.02),
        'w_out_odd': nrm(ks[26], (N_ODD, POOL_WIDTH, D_MODEL), POOL_WIDTH ** -0.5),
        'w_xq': nrm(ks[27], (DEPTH, D_MODEL, XA_WIDTH), D_MODEL ** -0.5),
        'w_xk': nrm(ks[28], (DEPTH, D_MODEL, XA_WIDTH), D_MODEL ** -0.5),
        'w_xv': nrm(ks[29], (DEPTH, D_MODEL, XA_WIDTH), D_MODEL ** -0.5),
        'w_xo': nrm(ks[30], (DEPTH, XA_WIDTH, D_MODEL), XA_WIDTH ** -0.5),
    }


def reference(x_prompt, x_sample, state_conv_a, state_qkv_conv, state_delta, state_pool, cache_mem_k,
              cache_mem_v, mem_prompt, norm_mix, norm_xattn, norm_final, w_in_even, w_out_even, dw_w, dw_b,
              ln_a_g, ln_a_b, sc_w, a_log, dt_bias, dn_norm_g, w_in_odd, w_pool, b_pool, pool_scale,
              w_out_odd, w_xq, w_xk, w_xv, w_xo):
    prm = {'norm_mix': norm_mix, 'norm_xattn': norm_xattn, 'norm_final': norm_final,
           'w_in_even': w_in_even, 'w_out_even': w_out_even, 'dw_w': dw_w, 'dw_b': dw_b,
           'ln_a_g': ln_a_g, 'ln_a_b': ln_a_b, 'sc_w': sc_w, 'a_log': a_log, 'dt_bias': dt_bias,
           'dn_norm_g': dn_norm_g, 'w_in_odd': w_in_odd, 'w_pool': w_pool, 'b_pool': b_pool,
           'pool_scale': pool_scale, 'w_out_odd': w_out_odd, 'w_xq': w_xq, 'w_xo': w_xo}
    bp = x_prompt.shape[0]
    new_mem_k_p = jnp.einsum('bmd,lde->lbme', mem_prompt, w_xk).reshape(DEPTH, bp, N_MEM, XA_HEADS, XA_HEAD_DIM)
    new_mem_v_p = jnp.einsum('bmd,lde->lbme', mem_prompt, w_xv).reshape(DEPTH, bp, N_MEM, XA_HEADS, XA_HEAD_DIM)
    conv0 = jnp.zeros((N_EVEN, bp, CONV_K - 1, CONV_CH), x_prompt.dtype)
    qkv0 = jnp.zeros((N_EVEN, bp, SC_K - 1, QKV_CH), x_prompt.dtype)
    dn0 = jnp.zeros((N_EVEN, bp, DN_HEADS, DN_HEAD_DIM, DN_HEAD_DIM), state_delta.dtype)
    pool0 = jnp.zeros((N_ODD, bp, POOL_BUF, POOL_WIDTH), x_prompt.dtype)
    y_prompt, new_conv_a_p, new_qkv_conv_p, new_delta_p, new_pool_p = trunk(
        x_prompt, conv0, qkv0, dn0, pool0, new_mem_k_p, new_mem_v_p, prm, 0, False)
    y_sample, new_conv_a_s, new_qkv_conv_s, new_delta_s, new_pool_s = trunk(
        x_sample, state_conv_a, state_qkv_conv, state_delta, state_pool, cache_mem_k, cache_mem_v, prm,
        PAST_LEN, True)
    return (y_prompt, y_sample, new_conv_a_p, new_qkv_conv_p, new_delta_p, new_pool_p, new_mem_k_p,
            new_mem_v_p, new_conv_a_s, new_qkv_conv_s, new_delta_s, new_pool_s)
```

```cpp
#include <hip/hip_runtime.h>
#include <hip/hip_cooperative_groups.h>
#include <cstdio>
namespace cg = cooperative_groups;

#define DI __device__ __forceinline__
typedef unsigned short bfr;
using bf16x8 = __attribute__((ext_vector_type(8))) short;
using f32x16 = __attribute__((ext_vector_type(16))) float;
typedef __bf16 bf2_t __attribute__((ext_vector_type(2)));
typedef float fl2_t __attribute__((ext_vector_type(2)));
typedef unsigned u32x4 __attribute__((ext_vector_type(4)));
#define MFMA32(a, b, c) __builtin_amdgcn_mfma_f32_32x32x16_bf16((a), (b), (c), 0, 0, 0)

constexpr int NROW = 16512;
constexpr int NPR = 16384;
constexpr int DM = 1024;
constexpr int EIN = 3592, EINP = 3584;
constexpr float EPSF = 1e-6f;

constexpr size_t O_Y = 0;
constexpr size_t O_CONVP = 16777216 + 131072;
constexpr size_t O_QKVP = O_CONVP + 122880;
constexpr size_t O_DELTAP = O_QKVP + 36864;
constexpr size_t O_POOLP = O_DELTAP + 524288;
constexpr size_t O_MEMK = O_POOLP + 122880;
constexpr size_t O_MEMV = O_MEMK + 4194304;
constexpr size_t O_CONVS = O_MEMV + 4194304;
constexpr size_t O_QKVS = O_CONVS + 1966080;
constexpr size_t O_DELTAS = O_QKVS + 589824;
constexpr size_t O_POOLS = O_DELTAS + 8388608;

struct Params {
  const float *x_prompt, *x_sample, *state_conv_a, *state_qkv_conv, *state_delta, *state_pool, *cache_k, *cache_v, *mem_prompt;
  const float *norm_mix, *norm_xattn, *norm_final, *w_in_even, *w_out_even, *dw_w, *dw_b, *ln_a_g, *ln_a_b, *sc_w, *a_log,
      *dt_bias, *dn_norm_g, *w_in_odd, *w_pool, *b_pool, *pool_scale, *w_out_odd, *w_xq, *w_xk, *w_xv, *w_xo;
  float* out;
  float *X, *QKV, *BGR, *BG, *CONV, *ODN, *U, *GL;
  bfr *H, *PB, *MIX, *ACT2, *ACT3, *KB, *VT, *MPB;
  bfr *WtInE, *WtOutE, *WtInO, *WtPool, *WtOutO, *WtXq, *WtXk, *WtXv, *WtXo;
  uint4 *WN, *QD, *KD, *QKF;
  int phase_lo, phase_hi;
};

DI unsigned pack2(float a, float b) {
  fl2_t f = {a, b};
  bf2_t r = __builtin_convertvector(f, bf2_t);
  return __builtin_bit_cast(unsigned, r);
}
DI bfr f2bf(float a) { return (bfr)(pack2(a, 0.f) & 0xffffu); }
DI float bf2f(bfr u) { return __uint_as_float(((unsigned)u) << 16); }
DI float bflo(unsigned u) { return __uint_as_float(u << 16); }
DI float bfhi(unsigned u) { return __uint_as_float(u & 0xffff0000u); }
DI float sigmoidf_(float x) { return 1.0f / (1.0f + __expf(-x)); }
DI float siluf_(float x) { return x / (1.0f + __expf(-x)); }
DI float wave_sum(float v) {
#pragma unroll
  for (int o = 32; o >= 1; o >>= 1) v += __shfl_xor(v, o);
  return v;
}
DI float wave_max(float v) {
#pragma unroll
  for (int o = 32; o >= 1; o >>= 1) v = fmaxf(v, __shfl_xor(v, o));
  return v;
}
DI int crow(int reg, int h) { return (reg & 3) + 8 * (reg >> 2) + 4 * h; }
DI bf16x8 pack8(const f32x16& x, int s) {
  uint4 p;
  p.x = pack2(x[8 * s + 0], x[8 * s + 1]);
  p.y = pack2(x[8 * s + 2], x[8 * s + 3]);
  p.z = pack2(x[8 * s + 4], x[8 * s + 5]);
  p.w = pack2(x[8 * s + 6], x[8 * s + 7]);
  return __builtin_bit_cast(bf16x8, p);
}
DI bf16x8 ldfrag(const uint4* p) { uint4 v = *p; return __builtin_bit_cast(bf16x8, v); }

template <class Epi>
DI void gemm_tile(const bfr* __restrict__ A, int lda, const bfr* __restrict__ Bt, int ldb, int K, int m0, int n0, char* smem, Epi epi) {
  bfr* As = (bfr*)smem;
  bfr* Bs = As + 128 * 72;
  const int tid = threadIdx.x, lane = tid & 63, wid = tid >> 6, wr = wid >> 1, wc = wid & 1;
  const int r = lane & 31, hl = lane >> 5;
  f32x16 acc[2][2];
#pragma unroll
  for (int i = 0; i < 2; ++i)
#pragma unroll
    for (int j = 0; j < 2; ++j)
#pragma unroll
      for (int q = 0; q < 16; ++q) acc[i][j][q] = 0.f;
  u32x4 ra[4], rb[4];
  const int nk = K >> 6;
  const bfr* Ab = A + (size_t)m0 * lda;
  const bfr* Bb = Bt + (size_t)n0 * ldb;
#pragma unroll
  for (int i = 0; i < 4; ++i) {
    int chunk = tid + i * 256, row = chunk >> 3, c8 = chunk & 7;
    ra[i] = *(const u32x4*)(Ab + (size_t)row * lda + c8 * 8);
    rb[i] = *(const u32x4*)(Bb + (size_t)row * ldb + c8 * 8);
  }
  for (int kt = 0; kt < nk; ++kt) {
    __syncthreads();
#pragma unroll
    for (int i = 0; i < 4; ++i) {
      int chunk = tid + i * 256, row = chunk >> 3, c8 = chunk & 7;
      *(u32x4*)(As + row * 72 + c8 * 8) = ra[i];
      *(u32x4*)(Bs + row * 72 + c8 * 8) = rb[i];
    }
    __syncthreads();
    if (kt + 1 < nk) {
#pragma unroll
      for (int i = 0; i < 4; ++i) {
        int chunk = tid + i * 256, row = chunk >> 3, c8 = chunk & 7;
        ra[i] = *(const u32x4*)(Ab + (size_t)row * lda + (kt + 1) * 64 + c8 * 8);
        rb[i] = *(const u32x4*)(Bb + (size_t)row * ldb + (kt + 1) * 64 + c8 * 8);
      }
    }
#pragma unroll
    for (int ks = 0; ks < 4; ++ks) {
      bf16x8 af[2], bfg[2];
#pragma unroll
      for (int i = 0; i < 2; ++i) {
        af[i] = *(const bf16x8*)(As + (wr * 64 + i * 32 + r) * 72 + ks * 16 + hl * 8);
        bfg[i] = *(const bf16x8*)(Bs + (wc * 64 + i * 32 + r) * 72 + ks * 16 + hl * 8);
      }
#pragma unroll
      for (int i = 0; i < 2; ++i)
#pragma unroll
        for (int j = 0; j < 2; ++j) acc[i][j] = MFMA32(af[i], bfg[j], acc[i][j]);
    }
  }
#pragma unroll
  for (int i = 0; i < 2; ++i)
#pragma unroll
    for (int j = 0; j < 2; ++j)
#pragma unroll
      for (int q = 0; q < 16; ++q) {
        int row = m0 + wr * 64 + i * 32 + crow(q, hl);
        int col = n0 + wc * 64 + j * 32 + r;
        epi(row, col, acc[i][j][q]);
      }
  __syncthreads();
}

DI void transpose_tile(const float* __restrict__ W, int ldw, bfr* __restrict__ Wt, int ldt, int k0, int n0, float* sm) {
  const int tid = threadIdx.x;
#pragma unroll
  for (int i = 0; i < 16; ++i) {
    int idx = tid + i * 256, kk = idx >> 6, nn = idx & 63;
    sm[kk * 65 + nn] = W[(size_t)(k0 + kk) * ldw + n0 + nn];
  }
  __syncthreads();
#pragma unroll
  for (int i = 0; i < 8; ++i) {
    int idx = tid + i * 256, nn = idx >> 5, kp = idx & 31;
    float a = sm[(2 * kp) * 65 + nn], b = sm[(2 * kp + 1) * 65 + nn];
    *(unsigned*)(Wt + (size_t)(n0 + nn) * ldt + k0 + 2 * kp) = pack2(a, b);
  }
  __syncthreads();
}

DI void phase_prep(const Params& p, char* smem) {
  float* sm = (float*)smem;
  for (int t = blockIdx.x; t < 4032; t += gridDim.x) {
    if (t < 896) {
      int kt = t / 56, nt = t % 56;
      transpose_tile(p.w_in_even, EIN, p.WtInE, 1024, kt * 64, nt * 64, sm);
    } else if (t < 1152) {
      int u = t - 896;
      transpose_tile(p.w_out_even, 1024, p.WtOutE, 1024, (u >> 4) * 64, (u & 15) * 64, sm);
    } else if (t < 1664) {
      int u = t - 1152;
      transpose_tile(p.w_in_odd, 2048, p.WtInO, 1024, (u >> 5) * 64, (u & 31) * 64, sm);
    } else if (t < 1728) {
      int u = t - 1664, g = u >> 4, v = u & 15;
      transpose_tile(p.w_pool + (size_t)g * 65536, 256, p.WtPool + (size_t)g * 65536, 256, (v >> 2) * 64, (v & 3) * 64, sm);
    } else if (t < 1984) {
      int u = t - 1728;
      transpose_tile(p.w_out_odd, 1024, p.WtOutO, 1024, (u >> 4) * 64, (u & 15) * 64, sm);
    } else {
      int u = t - 1984, m = u >> 8, v = u & 255;
      int which = m >> 1, l = m & 1;
      const float* src = (which == 0 ? p.w_xq : which == 1 ? p.w_xk : which == 2 ? p.w_xv : p.w_xo) + (size_t)l * 1048576;
      bfr* dst = (which == 0 ? p.WtXq : which == 1 ? p.WtXk : which == 2 ? p.WtXv : p.WtXo) + (size_t)l * 1048576;
      transpose_tile(src, 1024, dst, 1024, (v >> 4) * 64, (v & 15) * 64, sm);
    }
  }
  {
    const int n4 = 2048 * 1024 / 4;
    for (int i = blockIdx.x * 256 + threadIdx.x; i < n4; i += gridDim.x * 256) {
      float4 v = ((const float4*)p.mem_prompt)[i];
      uint2 o;
      o.x = pack2(v.x, v.y);
      o.y = pack2(v.z, v.w);
      ((uint2*)p.MPB)[i] = o;
    }
  }
  {
    const int lane = threadIdx.x & 63, wid = threadIdx.x >> 6;
    for (int row = blockIdx.x * 4 + wid; row < NROW; row += gridDim.x * 4) {
      const float* xr = row < NPR ? p.x_prompt + (size_t)row * DM : p.x_sample + (size_t)(row - NPR) * DM;
      float4 v[4];
      float ss = 0.f;
#pragma unroll
      for (int j = 0; j < 4; ++j) {
        v[j] = ((const float4*)xr)[j * 64 + lane];
        ss += v[j].x * v[j].x + v[j].y * v[j].y + v[j].z * v[j].z + v[j].w * v[j].w;
        ((float4*)(p.X + (size_t)row * DM))[j * 64 + lane] = v[j];
      }
      ss = wave_sum(ss);
      float inv = rsqrtf(ss * (1.0f / 1024.0f) + EPSF);
      float part[8];
#pragma unroll
      for (int c = 0; c < 8; ++c) part[c] = 0.f;
#pragma unroll
      for (int j = 0; j < 4; ++j) {
        float4 g = ((const float4*)p.norm_mix)[j * 64 + lane];
        float hv[4] = {v[j].x * inv * g.x, v[j].y * inv * g.y, v[j].z * inv * g.z, v[j].w * inv * g.w};
        uint2 o;
        o.x = pack2(hv[0], hv[1]);
        o.y = pack2(hv[2], hv[3]);
        ((uint2*)(p.H + (size_t)row * DM))[j * 64 + lane] = o;
        int k0 = (j * 64 + lane) * 4;
#pragma unroll
        for (int i = 0; i < 4; ++i) {
          const float4* wp = (const float4*)(p.w_in_even + (size_t)(k0 + i) * EIN + EINP);
          float4 w0 = wp[0], w1 = wp[1];
          part[0] += hv[i] * w0.x; part[1] += hv[i] * w0.y; part[2] += hv[i] * w0.z; part[3] += hv[i] * w0.w;
          part[4] += hv[i] * w1.x; part[5] += hv[i] * w1.y; part[6] += hv[i] * w1.z; part[7] += hv[i] * w1.w;
        }
      }
#pragma unroll
      for (int c = 0; c < 8; ++c) part[c] = wave_sum(part[c]);
      if (lane == 0) {
        float4 a = {part[0], part[1], part[2], part[3]}, b = {part[4], part[5], part[6], part[7]};
        ((float4*)(p.BGR + (size_t)row * 8))[0] = a;
        ((float4*)(p.BGR + (size_t)row * 8))[1] = b;
      }
    }
  }
}

DI void phase_rmsnorm(const Params& p, const float* g) {
  const int lane = threadIdx.x & 63, wid = threadIdx.x >> 6;
  for (int row = blockIdx.x * 4 + wid; row < NROW; row += gridDim.x * 4) {
    const float* xr = p.X + (size_t)row * DM;
    float4 v[4];
    float ss = 0.f;
#pragma unroll
    for (int j = 0; j < 4; ++j) {
      v[j] = ((const float4*)xr)[j * 64 + lane];
      ss += v[j].x * v[j].x + v[j].y * v[j].y + v[j].z * v[j].z + v[j].w * v[j].w;
    }
    ss = wave_sum(ss);
    float inv = rsqrtf(ss * (1.0f / 1024.0f) + EPSF);
#pragma unroll
    for (int j = 0; j < 4; ++j) {
      float4 gg = ((const float4*)g)[j * 64 + lane];
      uint2 o;
      o.x = pack2(v[j].x * inv * gg.x, v[j].y * inv * gg.y);
      o.y = pack2(v[j].z * inv * gg.z, v[j].w * inv * gg.w);
      ((uint2*)(p.H + (size_t)row * DM))[j * 64 + lane] = o;
    }
  }
}

DI void phase_final_norm(const Params& p) {
  const int lane = threadIdx.x & 63, wid = threadIdx.x >> 6;
  for (int row = blockIdx.x * 4 + wid; row < NROW; row += gridDim.x * 4) {
    const float* xr = p.X + (size_t)row * DM;
    float4 v[4];
    float ss = 0.f;
#pragma unroll
    for (int j = 0; j < 4; ++j) {
      v[j] = ((const float4*)xr)[j * 64 + lane];
      ss += v[j].x * v[j].x + v[j].y * v[j].y + v[j].z * v[j].z + v[j].w * v[j].w;
    }
    ss = wave_sum(ss);
    float inv = rsqrtf(ss * (1.0f / 1024.0f) + EPSF);
#pragma unroll
    for (int j = 0; j < 4; ++j) {
      float4 gg = ((const float4*)p.norm_final)[j * 64 + lane];
      float4 o = {v[j].x * inv * gg.x, v[j].y * inv * gg.y, v[j].z * inv * gg.z, v[j].w * inv * gg.w};
      ((float4*)(p.out + O_Y + (size_t)row * DM))[j * 64 + lane] = o;
    }
  }
}

DI void phase_gemm_in_even(const Params& p, char* smem) {
  const int NT1 = 129 * 28, NT2 = 4 * 128;
  for (int t = blockIdx.x; t < NT1 + NT2; t += gridDim.x) {
    if (t < NT1) {
      int mt = t / 28, nt = t % 28;
      bfr* PB = p.PB;
      gemm_tile(p.H, 1024, p.WtInE, 1024, 1024, mt * 128, nt * 128, smem,
                [=](int row, int col, float v) { PB[(size_t)row * EINP + col] = f2bf(v); });
    } else {
      int u = t - NT1, gsel = u >> 7, v = u & 127, mt = v >> 3, nt = v & 7;
      int isv = gsel >> 1, l = gsel & 1;
      if (!isv) {
        float* o = p.out + O_MEMK + (size_t)l * 2097152;
        bfr* kb = p.KB + (size_t)l * 2097152;
        gemm_tile(p.MPB, 1024, p.WtXk + (size_t)l * 1048576, 1024, 1024, mt * 128, nt * 128, smem,
                  [=](int row, int col, float v) {
                    o[(size_t)row * 1024 + col] = v;
                    kb[(size_t)row * 1024 + col] = f2bf(v);
                  });
      } else {
        float* o = p.out + O_MEMV + (size_t)l * 2097152;
        bfr* vt = p.VT + (size_t)l * 2097152;
        gemm_tile(p.MPB, 1024, p.WtXv + (size_t)l * 1048576, 1024, 1024, mt * 128, nt * 128, smem,
                  [=](int row, int col, float v) {
                    o[(size_t)row * 1024 + col] = v;
                    int b = row >> 8, mem = row & 255, h = col >> 8, dim = col & 255;
                    int ks = mem >> 4, ml = mem & 15, hl2 = (ml >> 2) & 1, j = ((ml >> 3) << 2) | (ml & 3);
                    int dt = dim >> 5, rr = dim & 31;
                    size_t off = ((((size_t)(b * 4 + h) * 8 + dt) * 16 + ks) * 64 + hl2 * 32 + rr) * 8 + j;
                    vt[off] = f2bf(v);
                  });
      }
    }
  }
}

DI void qkv_token(const Params& p, int row, int lane) {
  const bool is_p = row < NPR;
  const int t = row & 2047, b = row >> 11, s = row - NPR;
#pragma unroll 1
  for (int grp = 0; grp < 12; ++grp) {
    const int ch = grp * 128 + lane * 2;
    float x0[4], x1[4];
#pragma unroll
    for (int j = 0; j < 4; ++j) {
      x0[j] = 0.f; x1[j] = 0.f;
      if (is_p) {
        if (t - 3 + j >= 0) {
          unsigned u = *(const unsigned*)(p.PB + (size_t)(row - 3 + j) * EINP + 1536 + ch);
          x0[j] = bflo(u); x1[j] = bfhi(u);
        }
      } else {
        if (j < 3) {
          float2 f = *(const float2*)(p.state_qkv_conv + ((size_t)s * 3 + j) * 1536 + ch);
          x0[j] = f.x; x1[j] = f.y;
        } else {
          unsigned u = *(const unsigned*)(p.PB + (size_t)row * EINP + 1536 + ch);
          x0[j] = bflo(u); x1[j] = bfhi(u);
        }
      }
    }
    float a0 = 0.f, a1 = 0.f;
#pragma unroll
    for (int j = 0; j < 4; ++j) {
      float2 w = *(const float2*)(p.sc_w + (size_t)j * 1536 + ch);
      a0 += w.x * x0[j]; a1 += w.y * x1[j];
    }
    float y0 = siluf_(a0), y1 = siluf_(a1);
    if (grp < 8) {
      float ss = wave_sum(y0 * y0 + y1 * y1);
      float inv = rsqrtf(ss + EPSF);
      if (grp < 4) inv *= 0.08838834764831845f;
      y0 *= inv; y1 *= inv;
    }
    float2 o = {y0, y1};
    *(float2*)(p.QKV + (size_t)row * 1536 + ch) = o;
    if (is_p) {
      if (t >= 2045) {
        float2 c = {x0[3], x1[3]};
        *(float2*)(p.out + O_QKVP + ((size_t)b * 3 + (t - 2045)) * 1536 + ch) = c;
      }
    } else {
      float2 c0 = {x0[1], x1[1]}, c1 = {x0[2], x1[2]}, c2 = {x0[3], x1[3]};
      *(float2*)(p.out + O_QKVS + ((size_t)s * 3 + 0) * 1536 + ch) = c0;
      *(float2*)(p.out + O_QKVS + ((size_t)s * 3 + 1) * 1536 + ch) = c1;
      *(float2*)(p.out + O_QKVS + ((size_t)s * 3 + 2) * 1536 + ch) = c2;
    }
  }
  if (lane < 4) {
    float bl = p.BGR[(size_t)row * 8 + lane], al = p.BGR[(size_t)row * 8 + 4 + lane];
    float beta = sigmoidf_(bl);
    float xx = al + p.dt_bias[lane];
    float sp = xx > 20.f ? xx : log1pf(__expf(xx));
    float g = -__expf(p.a_log[lane]) * sp;
    p.BG[(size_t)row * 8 + lane] = beta;
    p.BG[(size_t)row * 8 + 4 + lane] = g;
  }
}

DI void conv_a_prompt_item(const Params& p, int item, float* sm) {
  const int half = item & 1, tile = (item >> 1) & 63, b = item >> 7;
  const int tid = threadIdx.x, c = half * 256 + tid, t0 = tile * 32;
#pragma unroll 2
  for (int i = 0; i < 62; ++i) {
    int tt = t0 - 30 + i;
    float gl = 0.f;
    if (tt >= 0) {
      size_t row = (size_t)b * 2048 + tt;
      float val = bf2f(p.PB[row * EINP + c]);
      float gate = bf2f(p.PB[row * EINP + 512 + c]);
      gl = val * sigmoidf_(gate);
    }
    sm[i * 256 + tid] = gl;
  }
  float w[31];
#pragma unroll
  for (int j = 0; j < 31; ++j) w[j] = p.dw_w[j * 512 + c];
  const float bias = p.dw_b[c];
#pragma unroll 1
  for (int o = 0; o < 32; ++o) {
    float acc = bias;
#pragma unroll
    for (int j = 0; j < 31; ++j) acc += w[j] * sm[(o + j) * 256 + tid];
    p.CONV[((size_t)b * 2048 + t0 + o) * 512 + c] = acc;
  }
  if (tile == 63) {
#pragma unroll 1
    for (int j = 0; j < 30; ++j) p.out[O_CONVP + ((size_t)b * 30 + j) * 512 + c] = sm[(32 + j) * 256 + tid];
  }
  __syncthreads();
}

DI void conv_a_sample_item(const Params& p, int s) {
  const int tid = threadIdx.x;
  const size_t row = NPR + s;
#pragma unroll
  for (int cc = 0; cc < 2; ++cc) {
    int c = tid + cc * 256;
    float val = bf2f(p.PB[row * EINP + c]);
    float gate = bf2f(p.PB[row * EINP + 512 + c]);
    float gl = val * sigmoidf_(gate);
    float acc = p.dw_b[c] + p.dw_w[30 * 512 + c] * gl;
#pragma unroll 6
    for (int j = 0; j < 30; ++j) {
      float st = p.state_conv_a[((size_t)s * 30 + j) * 512 + c];
      acc += p.dw_w[j * 512 + c] * st;
      if (j >= 1) p.out[O_CONVS + ((size_t)s * 30 + j - 1) * 512 + c] = st;
    }
    p.out[O_CONVS + ((size_t)s * 30 + 29) * 512 + c] = gl;
    p.CONV[row * 512 + c] = acc;
  }
}

DI void phase_even_pointwise(const Params& p, char* smem) {
  const int lane = threadIdx.x & 63, wid = threadIdx.x >> 6;
  for (int it = blockIdx.x; it < 1024 + 128; it += gridDim.x) {
    if (it < 1024) conv_a_prompt_item(p, it, (float*)smem);
    else conv_a_sample_item(p, it - 1024);
  }
  for (int row = blockIdx.x * 4 + wid; row < NROW; row += gridDim.x * 4) qkv_token(p, row, lane);
}

DI void chunk_prep(const Params& p, int item, char* smem) {
  const int tid = threadIdx.x, lane = tid & 63, wid = tid >> 6, r = lane & 31, hl = lane >> 5;
  const int n = item & 31, hh = (item >> 5) & 3, b = item >> 7;
  const size_t row0 = (size_t)b * 2048 + n * 64;
  float* gcs = (float*)smem;
  float* betas = gcs + 64;
  float* egs = betas + 64;
  float* kscale = egs + 64;
  bfr* qs = (bfr*)(smem + 1024);
  bfr* ks_ = qs + 64 * 136;
  float* Am = (float*)(smem + 1024 + 2 * 64 * 136 * 2);
  bfr* wsb = qs;
  if (tid < 64) {
    float beta = p.BG[(row0 + tid) * 8 + hh];
    float g = p.BG[(row0 + tid) * 8 + 4 + hh];
    float v = g;
#pragma unroll
    for (int off = 1; off < 64; off <<= 1) {
      float t = __shfl_up(v, off);
      if (lane >= off) v += t;
    }
    float gl = __shfl(v, 63);
    gcs[tid] = v;
    betas[tid] = beta;
    egs[tid] = __expf(v);
    kscale[tid] = __expf(gl - v);
    if (tid == 63) p.GL[item] = __expf(gl);
  }
#pragma unroll
  for (int i = 0; i < 8; ++i) {
    int idx = tid + i * 256, row = idx >> 5, c4 = idx & 31;
    float4 q = *(const float4*)(p.QKV + (row0 + row) * 1536 + hh * 128 + c4 * 4);
    float4 k = *(const float4*)(p.QKV + (row0 + row) * 1536 + 512 + hh * 128 + c4 * 4);
    uint2 qo, ko;
    qo.x = pack2(q.x, q.y); qo.y = pack2(q.z, q.w);
    ko.x = pack2(k.x, k.y); ko.y = pack2(k.z, k.w);
    *(uint2*)(qs + row * 136 + c4 * 4) = qo;
    *(uint2*)(ks_ + row * 136 + c4 * 4) = ko;
  }
  __syncthreads();
  {
    const int mi = wid >> 1, ni = wid & 1;
    f32x16 akk, aqk;
#pragma unroll
    for (int q = 0; q < 16; ++q) { akk[q] = 0.f; aqk[q] = 0.f; }
#pragma unroll
    for (int ks = 0; ks < 8; ++ks) {
      bf16x8 ka = *(const bf16x8*)(ks_ + (mi * 32 + r) * 136 + ks * 16 + hl * 8);
      bf16x8 qa = *(const bf16x8*)(qs + (mi * 32 + r) * 136 + ks * 16 + hl * 8);
      bf16x8 kb = *(const bf16x8*)(ks_ + (ni * 32 + r) * 136 + ks * 16 + hl * 8);
      akk = MFMA32(ka, kb, akk);
      aqk = MFMA32(qa, kb, aqk);
    }
    bfr* qkf = (bfr*)(p.QKF + (size_t)item * 512);
#pragma unroll
    for (int q = 0; q < 16; ++q) {
      int i = mi * 32 + crow(q, hl), j = ni * 32 + r;
      float dec = (i >= j) ? __expf(gcs[i] - gcs[j]) : 0.f;
      Am[i * 68 + j] = (i > j) ? akk[q] * betas[i] * dec : 0.f;
      float qv = (i >= j) ? aqk[q] * dec : 0.f;
      int ksj = j >> 4, jl = j & 15, h2 = (jl >> 2) & 1, jj = ((jl >> 3) << 2) | (jl & 3);
      qkf[((mi * 4 + ksj) * 64 + h2 * 32 + (i & 31)) * 8 + jj] = f2bf(qv);
    }
  }
  {
    uint4* QD = p.QD + (size_t)item * 1024;
#pragma unroll
    for (int i = 0; i < 4; ++i) {
      int idx = tid + i * 256, f = idx >> 6, ln = idx & 63, mt = f >> 3, ks = f & 7, m = ln & 31, h2 = ln >> 5;
      int ri = mt * 32 + m, d0 = ks * 16 + h2 * 4;
      float sc = egs[ri];
      const float* src = p.QKV + (row0 + ri) * 1536 + hh * 128 + d0;
      float4 a = *(const float4*)src, c = *(const float4*)(src + 8);
      uint4 o;
      o.x = pack2(a.x * sc, a.y * sc); o.y = pack2(a.z * sc, a.w * sc);
      o.z = pack2(c.x * sc, c.y * sc); o.w = pack2(c.z * sc, c.w * sc);
      QD[f * 64 + ln] = o;
    }
    uint4* KD = p.KD + (size_t)item * 1024;
#pragma unroll
    for (int i = 0; i < 4; ++i) {
      int idx = tid + i * 256, f = idx >> 6, ln = idx & 63, mt = f >> 2, ks = f & 3, m = ln & 31, h2 = ln >> 5;
      int d = mt * 32 + m;
      float vals[8];
#pragma unroll
      for (int j = 0; j < 8; ++j) {
        int c = ks * 16 + 8 * (j >> 2) + 4 * h2 + (j & 3);
        vals[j] = p.QKV[(row0 + c) * 1536 + 512 + hh * 128 + d] * kscale[c];
      }
      uint4 o;
      o.x = pack2(vals[0], vals[1]); o.y = pack2(vals[2], vals[3]);
      o.z = pack2(vals[4], vals[5]); o.w = pack2(vals[6], vals[7]);
      KD[f * 64 + ln] = o;
    }
  }
  __syncthreads();
  {
    const int c = tid;
    const float* src = (c < 128) ? (p.QKV + row0 * 1536 + 1024 + hh * 128 + c) : (p.QKV + row0 * 1536 + 512 + hh * 128 + (c - 128));
    float sol[64];
#pragma unroll
    for (int i = 0; i < 64; ++i) {
      float rhs = src[(size_t)i * 1536] * betas[i];
      if (c >= 128) rhs *= egs[i];
      float acc = rhs;
#pragma unroll
      for (int j = 0; j < i; ++j) acc -= Am[i * 68 + j] * sol[j];
      sol[i] = acc;
    }
    if (c < 128) {
      float* U = p.U + (size_t)item * 8192;
#pragma unroll
      for (int i = 0; i < 64; ++i) U[i * 128 + c] = sol[i];
    } else {
#pragma unroll
      for (int i = 0; i < 64; ++i) wsb[i * 136 + (c - 128)] = f2bf(-sol[i]);
    }
  }
  __syncthreads();
  {
    uint4* WN = p.WN + (size_t)item * 1024;
#pragma unroll
    for (int i = 0; i < 4; ++i) {
      int idx = tid + i * 256, f = idx >> 6, ln = idx & 63, mt = f >> 3, ks = f & 7, m = ln & 31, h2 = ln >> 5;
      int ri = mt * 32 + m, d0 = ks * 16 + h2 * 4;
      uint2 a = *(const uint2*)(wsb + ri * 136 + d0), c = *(const uint2*)(wsb + ri * 136 + d0 + 8);
      uint4 o = {a.x, a.y, c.x, c.y};
      WN[f * 64 + ln] = o;
    }
  }
  __syncthreads();
}

DI void branch_a_final_row(const Params& p, int row, int lane) {
  const float* cr = p.CONV + (size_t)row * 512;
  float4 v[2];
  float s = 0.f;
#pragma unroll
  for (int j = 0; j < 2; ++j) {
    v[j] = ((const float4*)cr)[j * 64 + lane];
    s += v[j].x + v[j].y + v[j].z + v[j].w;
  }
  float mean = wave_sum(s) * (1.0f / 512.0f);
  float vs = 0.f;
#pragma unroll
  for (int j = 0; j < 2; ++j) {
    v[j].x -= mean; v[j].y -= mean; v[j].z -= mean; v[j].w -= mean;
    vs += v[j].x * v[j].x + v[j].y * v[j].y + v[j].z * v[j].z + v[j].w * v[j].w;
  }
  float inv = rsqrtf(wave_sum(vs) * (1.0f / 512.0f) + EPSF);
#pragma unroll
  for (int j = 0; j < 2; ++j) {
    int c = (j * 64 + lane) * 4;
    float4 g = *(const float4*)(p.ln_a_g + c), bb = *(const float4*)(p.ln_a_b + c);
    uint2 gu = *(const uint2*)(p.PB + (size_t)row * EINP + 1024 + c);
    float y0 = siluf_(v[j].x * inv * g.x + bb.x) * siluf_(bflo(gu.x));
    float y1 = siluf_(v[j].y * inv * g.y + bb.y) * siluf_(bfhi(gu.x));
    float y2 = siluf_(v[j].z * inv * g.z + bb.z) * siluf_(bflo(gu.y));
    float y3 = siluf_(v[j].w * inv * g.w + bb.w) * siluf_(bfhi(gu.y));
    uint2 o;
    o.x = pack2(y0, y1); o.y = pack2(y2, y3);
    *(uint2*)(p.MIX + (size_t)row * 1024 + c) = o;
  }
}

DI void delta_sample_item(const Params& p, int item, char* smem) {
  const int s = item >> 2, hh = item & 3, tid = threadIdx.x;
  const size_t row = NPR + s;
  float* ksm = (float*)smem;
  float* qsm = ksm + 128;
  float* part = qsm + 128;
  if (tid < 128) ksm[tid] = p.QKV[row * 1536 + 512 + hh * 128 + tid];
  else qsm[tid - 128] = p.QKV[row * 1536 + hh * 128 + (tid - 128)];
  const float beta = p.BG[row * 8 + hh], a = __expf(p.BG[row * 8 + 4 + hh]);
  __syncthreads();
  const int e = tid & 127, half = tid >> 7, d0 = half * 64;
  const float* S0 = p.state_delta + (((size_t)s * 4 + hh) * 128 + d0) * 128 + e;
  float* So = p.out + O_DELTAS + (((size_t)s * 4 + hh) * 128 + d0) * 128 + e;
  float Sr[64];
  float ksum = 0.f;
#pragma unroll
  for (int i = 0; i < 64; ++i) {
    Sr[i] = S0[(size_t)i * 128] * a;
    ksum += ksm[d0 + i] * Sr[i];
  }
  part[half * 128 + e] = ksum;
  __syncthreads();
  const float kS = part[e] + part[128 + e];
  const float v = p.QKV[row * 1536 + 1024 + hh * 128 + e];
  const float vnew = (v - kS) * beta;
  float oo = 0.f;
#pragma unroll
  for (int i = 0; i < 64; ++i) {
    Sr[i] += ksm[d0 + i] * vnew;
    So[(size_t)i * 128] = Sr[i];
    oo += qsm[d0 + i] * Sr[i];
  }
  __syncthreads();
  part[half * 128 + e] = oo;
  __syncthreads();
  if (half == 0) p.ODN[row * 512 + hh * 128 + e] = part[e] + part[128 + e];
  __syncthreads();
}

DI void phase_chunk_prep(const Params& p, char* smem) {
  const int lane = threadIdx.x & 63, wid = threadIdx.x >> 6;
  for (int it = blockIdx.x; it < 1024 + 512; it += gridDim.x) {
    if (it < 1024) chunk_prep(p, it, smem);
    else delta_sample_item(p, it - 1024, smem);
  }
  for (int row = blockIdx.x * 4 + wid; row < NROW; row += gridDim.x * 4) branch_a_final_row(p, row, lane);
}

DI void scan_item(const Params& p, int item) {
  const int tid = threadIdx.x, lane = tid & 63, es = tid >> 6, r = lane & 31, hl = lane >> 5;
  const int b = item >> 2, hh = item & 3;
  f32x16 S[4];
#pragma unroll
  for (int d = 0; d < 4; ++d)
#pragma unroll
    for (int q = 0; q < 16; ++q) S[d][q] = 0.f;
#pragma unroll 1
  for (int n = 0; n < 32; ++n) {
    const int chunk = item * 32 + n;
    const uint4* WN = p.WN + (size_t)chunk * 1024 + lane;
    const uint4* QD = p.QD + (size_t)chunk * 1024 + lane;
    const uint4* KD = p.KD + (size_t)chunk * 1024 + lane;
    const uint4* QK = p.QKF + (size_t)chunk * 512 + lane;
    const float* U = p.U + (size_t)chunk * 8192 + es * 32 + r;
    const float gl = p.GL[chunk];
    bf16x8 Sb[4][2];
#pragma unroll
    for (int d = 0; d < 4; ++d) { Sb[d][0] = pack8(S[d], 0); Sb[d][1] = pack8(S[d], 1); }
    f32x16 vn[2], o[2];
#pragma unroll
    for (int ct = 0; ct < 2; ++ct)
#pragma unroll
      for (int q = 0; q < 16; ++q) { vn[ct][q] = U[(ct * 32 + crow(q, hl)) * 128]; o[ct][q] = 0.f; }
#pragma unroll
    for (int ct = 0; ct < 2; ++ct)
#pragma unroll
      for (int ks = 0; ks < 8; ++ks) {
        bf16x8 aw = ldfrag(WN + (ct * 8 + ks) * 64);
        bf16x8 aq = ldfrag(QD + (ct * 8 + ks) * 64);
        vn[ct] = MFMA32(aw, Sb[ks >> 1][ks & 1], vn[ct]);
        o[ct] = MFMA32(aq, Sb[ks >> 1][ks & 1], o[ct]);
      }
    bf16x8 Vb[2][2];
#pragma unroll
    for (int ct = 0; ct < 2; ++ct) { Vb[ct][0] = pack8(vn[ct], 0); Vb[ct][1] = pack8(vn[ct], 1); }
#pragma unroll
    for (int ct = 0; ct < 2; ++ct)
#pragma unroll
      for (int ks = 0; ks < 4; ++ks) {
        bf16x8 a = ldfrag(QK + (ct * 4 + ks) * 64);
        o[ct] = MFMA32(a, Vb[ks >> 1][ks & 1], o[ct]);
      }
#pragma unroll
    for (int d = 0; d < 4; ++d) {
#pragma unroll
      for (int q = 0; q < 16; ++q) S[d][q] *= gl;
#pragma unroll
      for (int ks = 0; ks < 4; ++ks) {
        bf16x8 a = ldfrag(KD + (d * 4 + ks) * 64);
        S[d] = MFMA32(a, Vb[ks >> 1][ks & 1], S[d]);
      }
    }
    float* od = p.ODN + ((size_t)b * 2048 + n * 64) * 512 + hh * 128 + es * 32 + r;
#pragma unroll
    for (int ct = 0; ct < 2; ++ct)
#pragma unroll
      for (int q = 0; q < 16; ++q) od[(size_t)(ct * 32 + crow(q, hl)) * 512] = o[ct][q];
  }
  float* so = p.out + O_DELTAP + ((size_t)(b * 4 + hh) * 128) * 128 + es * 32 + r;
#pragma unroll
  for (int d = 0; d < 4; ++d)
#pragma unroll
    for (int q = 0; q < 16; ++q) so[(size_t)(d * 32 + crow(q, hl)) * 128] = S[d][q];
}

DI void phase_delta_post(const Params& p) {
  const int lane = threadIdx.x & 63, wid = threadIdx.x >> 6;
  for (int row = blockIdx.x * 4 + wid; row < NROW; row += gridDim.x * 4) {
#pragma unroll
    for (int hh = 0; hh < 4; ++hh) {
      int ch = hh * 128 + lane * 2;
      float2 o = *(const float2*)(p.ODN + (size_t)row * 512 + ch);
      float ss = wave_sum(o.x * o.x + o.y * o.y);
      float inv = rsqrtf(ss * (1.0f / 128.0f) + EPSF);
      float2 g = *(const float2*)(p.dn_norm_g + lane * 2);
      unsigned zu = *(const unsigned*)(p.PB + (size_t)row * EINP + 3072 + ch);
      float y0 = o.x * inv * g.x * siluf_(bflo(zu));
      float y1 = o.y * inv * g.y * siluf_(bfhi(zu));
      *(unsigned*)(p.MIX + (size_t)row * 1024 + 512 + ch) = pack2(y0, y1);
    }
  }
}

DI void phase_gemm_resid(const Params& p, const bfr* A, const bfr* Wt, char* smem) {
  float* X = p.X;
  for (int t = blockIdx.x; t < 129 * 8; t += gridDim.x) {
    int mt = t >> 3, nt = t & 7;
    gemm_tile(A, 1024, Wt, 1024, 1024, mt * 128, nt * 128, smem,
              [=](int row, int col, float v) { X[(size_t)row * 1024 + col] += v; });
  }
}
DI void phase_gemm_bf16out(const Params& p, const bfr* A, const bfr* Wt, bfr* C, int N, char* smem) {
  const int ntn = N >> 7;
  for (int t = blockIdx.x; t < 129 * ntn; t += gridDim.x) {
    int mt = t / ntn, nt = t % ntn;
    gemm_tile(A, 1024, Wt, 1024, 1024, mt * 128, nt * 128, smem,
              [=](int row, int col, float v) { C[(size_t)row * N + col] = f2bf(v); });
  }
}

DI void attn_prompt_wave(const Params& p, int l, int b, int hh, int tt, bfr* Obuf) {
  const int lane = threadIdx.x & 63, r = lane & 31, hl = lane >> 5;
  const size_t row0 = (size_t)b * 2048 + tt * 32;
  const bfr* Qp = p.ACT2 + (row0 + r) * 1024 + hh * 256 + hl * 8;
  const bfr* Kp = p.KB + (size_t)l * 2097152 + ((size_t)b * 256 + r) * 1024 + hh * 256 + hl * 8;
  f32x16 st[8];
#pragma unroll
  for (int m = 0; m < 8; ++m)
#pragma unroll
    for (int q = 0; q < 16; ++q) st[m][q] = 0.f;
#pragma unroll 2
  for (int ks = 0; ks < 16; ++ks) {
    bf16x8 qf = *(const bf16x8*)(Qp + ks * 16);
#pragma unroll
    for (int m = 0; m < 8; ++m) {
      bf16x8 kf = *(const bf16x8*)(Kp + (size_t)m * 32 * 1024 + ks * 16);
      st[m] = MFMA32(kf, qf, st[m]);
    }
  }
  float mx = -3.0e38f;
#pragma unroll
  for (int m = 0; m < 8; ++m)
#pragma unroll
    for (int q = 0; q < 16; ++q) mx = fmaxf(mx, st[m][q]);
  mx = fmaxf(mx, __shfl_xor(mx, 32));
  float sum = 0.f;
#pragma unroll
  for (int m = 0; m < 8; ++m)
#pragma unroll
    for (int q = 0; q < 16; ++q) {
      float e = __expf((st[m][q] - mx) * 0.0625f);
      st[m][q] = e;
      sum += e;
    }
  sum += __shfl_xor(sum, 32);
  const float inv = 1.0f / sum;
  bf16x8 pb[8][2];
#pragma unroll
  for (int m = 0; m < 8; ++m) { pb[m][0] = pack8(st[m], 0); pb[m][1] = pack8(st[m], 1); }
  const uint4* VT = (const uint4*)(p.VT + (size_t)l * 2097152) + ((size_t)(b * 4 + hh) * 8) * 16 * 64 + lane;
  bfr* Op = Obuf + (row0 + r) * 1024 + hh * 256;
#pragma unroll 1
  for (int half = 0; half < 2; ++half) {
    f32x16 o[4];
#pragma unroll
    for (int d = 0; d < 4; ++d)
#pragma unroll
      for (int q = 0; q < 16; ++q) o[d][q] = 0.f;
#pragma unroll
    for (int ks = 0; ks < 16; ++ks) {
#pragma unroll
      for (int d = 0; d < 4; ++d) {
        bf16x8 vf = ldfrag(VT + ((size_t)(half * 4 + d) * 16 + ks) * 64);
        o[d] = MFMA32(vf, pb[ks >> 1][ks & 1], o[d]);
      }
    }
#pragma unroll
    for (int d = 0; d < 4; ++d)
#pragma unroll
      for (int g4 = 0; g4 < 4; ++g4) {
        int dim = (half * 4 + d) * 32 + 8 * g4 + 4 * hl;
        uint2 ov;
        ov.x = pack2(o[d][g4 * 4 + 0] * inv, o[d][g4 * 4 + 1] * inv);
        ov.y = pack2(o[d][g4 * 4 + 2] * inv, o[d][g4 * 4 + 3] * inv);
        *(uint2*)(Op + dim) = ov;
      }
  }
}

DI void attn_sample_item(const Params& p, int l, int item, char* smem, bfr* Obuf) {
  const int s = item >> 2, hh = item & 3, tid = threadIdx.x, lane = tid & 63, wid = tid >> 6;
  float* qsm = (float*)smem;
  float* sc = qsm + 256;
  float* red = sc + 256;
  const size_t row = NPR + s;
  qsm[tid] = bf2f(p.ACT2[row * 1024 + hh * 256 + tid]);
  __syncthreads();
  const int grp = lane >> 4, l16 = lane & 15;
  float4 q4[4];
#pragma unroll
  for (int j = 0; j < 4; ++j) q4[j] = ((const float4*)qsm)[j * 16 + l16];
  const float* Kb = p.cache_k + ((((size_t)l * 128 + s) * 256) * 4 + hh) * 256;
  const float* Vb = p.cache_v + ((((size_t)l * 128 + s) * 256) * 4 + hh) * 256;
#pragma unroll 4
  for (int ps = 0; ps < 16; ++ps) {
    int mem = wid * 64 + ps * 4 + grp;
    const float4* kr = (const float4*)(Kb + (size_t)mem * 1024);
    float d = 0.f;
#pragma unroll
    for (int j = 0; j < 4; ++j) {
      float4 k4 = kr[j * 16 + l16];
      d += k4.x * q4[j].x + k4.y * q4[j].y + k4.z * q4[j].z + k4.w * q4[j].w;
    }
    d += __shfl_xor(d, 8);
    d += __shfl_xor(d, 4);
    d += __shfl_xor(d, 2);
    d += __shfl_xor(d, 1);
    if (l16 == 0) sc[mem] = d * 0.0625f;
  }
  __syncthreads();
  float sv = sc[tid];
  float m = wave_max(sv);
  if (lane == 0) red[wid] = m;
  __syncthreads();
  m = fmaxf(fmaxf(red[0], red[1]), fmaxf(red[2], red[3]));
  float e = __expf(sv - m);
  float sm_ = wave_sum(e);
  if (lane == 0) red[4 + wid] = sm_;
  sc[tid] = e;
  __syncthreads();
  const float inv = 1.0f / (red[4] + red[5] + red[6] + red[7]);
  float acc = 0.f;
#pragma unroll 8
  for (int mem = 0; mem < 256; ++mem) acc += sc[mem] * Vb[(size_t)mem * 1024 + tid];
  Obuf[row * 1024 + hh * 256 + tid] = f2bf(acc * inv);
  __syncthreads();
}

DI void phase_attn(const Params& p, int l, char* smem) {
  bfr* Obuf = p.ACT3;
  for (int it = blockIdx.x; it < 1024; it += gridDim.x) {
    if (it < 512) {
      attn_sample_item(p, l, it, smem, Obuf);
    } else {
      int u = it - 512, tt4 = u & 15, hh = (u >> 4) & 3, b = u >> 6;
      attn_prompt_wave(p, l, b, hh, tt4 * 4 + (threadIdx.x >> 6), Obuf);
    }
  }
}

DI void phase_pool(const Params& p) {
  const bfr* P2 = p.PB;
  for (int idx = blockIdx.x * 256 + threadIdx.x; idx < NROW * 512; idx += gridDim.x * 256) {
    const int row = idx >> 9, c = (idx & 511) * 2;
    const int gi = c >> 8, win = 2 << gi;
    unsigned uu = *(const unsigned*)(P2 + (size_t)row * 2048 + c);
    const float u0 = bflo(uu), u1 = bfhi(uu);
    float s0 = u0, s1 = u1, cnt;
    if (row < NPR) {
      const int t = row & 2047, b = row >> 11;
      const int n = min(t + 1, win);
      cnt = (float)n;
      for (int j = 1; j < n; ++j) {
        unsigned w = *(const unsigned*)(P2 + (size_t)(row - j) * 2048 + c);
        s0 += bflo(w); s1 += bfhi(w);
      }
      if (t >= 2033) {
        float2 o = {u0, u1};
        *(float2*)(p.out + O_POOLP + ((size_t)b * 15 + (t - 2033)) * 1024 + c) = o;
      }
    } else {
      const int s = row - NPR;
      cnt = (float)win;
      const float* sp = p.state_pool + (size_t)s * 15 * 1024 + c;
      for (int j = 1; j < win; ++j) {
        float2 w = *(const float2*)(sp + (size_t)(15 - j) * 1024);
        s0 += w.x; s1 += w.y;
      }
      float* op = p.out + O_POOLS + (size_t)s * 15 * 1024 + c;
      for (int j = 0; j < 14; ++j) *(float2*)(op + (size_t)j * 1024) = *(const float2*)(sp + (size_t)(j + 1) * 1024);
      float2 o = {u0, u1};
      *(float2*)(op + (size_t)14 * 1024) = o;
    }
    *(unsigned*)(p.MIX + (size_t)row * 1024 + c) = pack2(s0 / cnt - u0, s1 / cnt - u1);
  }
}

DI void phase_gemm_pool(const Params& p, char* smem) {
  const bfr* P2 = p.PB;
  bfr* Z = p.ACT3;
  for (int t = blockIdx.x; t < 129 * 8; t += gridDim.x) {
    int mt = t >> 3, g = (t >> 1) & 3, nt = t & 1;
    const float* bp = p.b_pool + g * 256;
    const float* sc = p.pool_scale + g * 256;
    gemm_tile(p.MIX + g * 256, 1024, p.WtPool + (size_t)g * 65536, 256, 256, mt * 128, nt * 128, smem,
              [=](int row, int col, float v) {
                float gate = bf2f(P2[(size_t)row * 2048 + 1024 + g * 256 + col]);
                float z = (v + bp[col]) * sc[col] * siluf_(gate);
                Z[(size_t)row * 1024 + g * 256 + col] = f2bf(z);
              });
  }
}

#ifndef ONLY_PHASE
#define ONLY_PHASE -1
#endif
#define PON(n) (ONLY_PHASE < 0 || ONLY_PHASE == (n))
__global__ void __launch_bounds__(256, 2) mega(Params p) {
  __shared__ __attribute__((aligned(16))) char smem[65536];
  cg::grid_group grid = cg::this_grid();
#define RUN(n, call) do { if (PON(n) && p.phase_lo <= (n) && (n) <= p.phase_hi) { call; } if (p.phase_lo <= (n) && (n) < p.phase_hi) grid.sync(); } while (0)
  RUN(0, phase_prep(p, smem));
  RUN(1, phase_gemm_in_even(p, smem));
  RUN(2, phase_even_pointwise(p, smem));
  RUN(3, phase_chunk_prep(p, smem));
  RUN(4, for (int it = blockIdx.x; it < 32; it += gridDim.x) scan_item(p, it));
  RUN(5, phase_delta_post(p));
  RUN(6, phase_gemm_resid(p, p.MIX, p.WtOutE, smem));
  RUN(7, phase_rmsnorm(p, p.norm_xattn));
  RUN(8, phase_gemm_bf16out(p, p.H, p.WtXq, p.ACT2, 1024, smem));
  RUN(9, phase_attn(p, 0, smem));
  RUN(10, phase_gemm_resid(p, p.ACT3, p.WtXo, smem));
  RUN(11, phase_rmsnorm(p, p.norm_mix + 1024));
  RUN(12, phase_gemm_bf16out(p, p.H, p.WtInO, p.PB, 2048, smem));
  RUN(13, phase_pool(p));
  RUN(14, phase_gemm_pool(p, smem));
  RUN(15, phase_gemm_resid(p, p.ACT3, p.WtOutO, smem));
  RUN(16, phase_rmsnorm(p, p.norm_xattn + 1024));
  RUN(17, phase_gemm_bf16out(p, p.H, p.WtXq + 1048576, p.ACT2, 1024, smem));
  RUN(18, phase_attn(p, 1, smem));
  RUN(19, phase_gemm_resid(p, p.ACT3, p.WtXo + 1048576, smem));
  RUN(20, phase_final_norm(p));
}

extern "C" void kernel_launch(void* const* d_in, const int* in_sizes, int n_in, void* d_out, int out_size, void* d_ws,
                              size_t ws_size, hipStream_t stream) {
  static int grid_blocks = 0;
  if (!grid_blocks) {
    int dev = 0, cus = 0, per_cu = 0;
    hipGetDevice(&dev);
    hipDeviceGetAttribute(&cus, hipDeviceAttributeMultiprocessorCount, dev);
    hipOccupancyMaxActiveBlocksPerMultiprocessor(&per_cu, mega, 256, 0);
    if (per_cu < 1) per_cu = 1;
    if (per_cu > 2) per_cu = 2;
    grid_blocks = cus * per_cu;
  }
  Params p{};
  const float** ins = (const float**)&p.x_prompt;
  for (int i = 0; i < 31; ++i) ins[i] = (const float*)d_in[i];
  p.out = (float*)d_out;
  char* w = (char*)d_ws;
  size_t off = 0;
  auto take = [&](size_t bytes) { char* r = w + off; off += (bytes + 255) & ~(size_t)255; return r; };
  p.X = (float*)take((size_t)NROW * 1024 * 4);
  p.QKV = (float*)take((size_t)NROW * 1536 * 4);
  p.BGR = (float*)take((size_t)NROW * 8 * 4);
  p.BG = (float*)take((size_t)NROW * 8 * 4);
  p.CONV = (float*)take((size_t)NROW * 512 * 4);
  p.ODN = (float*)take((size_t)NROW * 512 * 4);
  p.U = (float*)take((size_t)1024 * 8192 * 4);
  p.GL = (float*)take(4096);
  p.H = (bfr*)take((size_t)NROW * 1024 * 2);
  p.PB = (bfr*)take((size_t)NROW * 3584 * 2);
  p.MIX = (bfr*)take((size_t)NROW * 1024 * 2);
  p.ACT2 = (bfr*)take((size_t)NROW * 1024 * 2);
  p.ACT3 = (bfr*)take((size_t)NROW * 1024 * 2);
  p.KB = (bfr*)take((size_t)2 * 2048 * 1024 * 2);
  p.VT = (bfr*)take((size_t)2 * 2048 * 1024 * 2);
  p.MPB = (bfr*)take((size_t)2048 * 1024 * 2);
  p.WtInE = (bfr*)take((size_t)3584 * 1024 * 2);
  p.WtOutE = (bfr*)take((size_t)1024 * 1024 * 2);
  p.WtInO = (bfr*)take((size_t)2048 * 1024 * 2);
  p.WtPool = (bfr*)take((size_t)4 * 256 * 256 * 2);
  p.WtOutO = (bfr*)take((size_t)1024 * 1024 * 2);
  p.WtXq = (bfr*)take((size_t)2 * 1024 * 1024 * 2);
  p.WtXk = (bfr*)take((size_t)2 * 1024 * 1024 * 2);
  p.WtXv = (bfr*)take((size_t)2 * 1024 * 1024 * 2);
  p.WtXo = (bfr*)take((size_t)2 * 1024 * 1024 * 2);
  p.WN = (uint4*)take((size_t)1024 * 1024 * 16);
  p.QD = (uint4*)take((size_t)1024 * 1024 * 16);
  p.KD = (uint4*)take((size_t)1024 * 1024 * 16);
  p.QKF = (uint4*)take((size_t)1024 * 512 * 16);
  if (off > ws_size) {
    fprintf(stderr, "kernel_launch: workspace too small: need %zu have %zu\n", off, ws_size);
    return;
  }
  p.phase_lo = 0;
  p.phase_hi = 20;
  void* args[] = {&p};
  hipError_t e = hipLaunchCooperativeKernel((void*)mega, dim3(grid_blocks), dim3(256), args, 0, stream);
  if (e != hipSuccess) fprintf(stderr, "cooperative launch failed: %s (grid %d)\n", hipGetErrorString(e), grid_blocks);
}
```

```cpp
#include <hip/hip_runtime.h>
#include <hip/hip_cooperative_groups.h>
#include <cstdio>
namespace cg = cooperative_groups;

#define DI __device__ __forceinline__
typedef unsigned short bfr;
using bf16x8 = __attribute__((ext_vector_type(8))) short;
using f32x16 = __attribute__((ext_vector_type(16))) float;
typedef __bf16 bf2_t __attribute__((ext_vector_type(2)));
typedef float fl2_t __attribute__((ext_vector_type(2)));
typedef unsigned u32x4 __attribute__((ext_vector_type(4)));
#define MFMA32(a, b, c) __builtin_amdgcn_mfma_f32_32x32x16_bf16((a), (b), (c), 0, 0, 0)

constexpr int NROW = 16512;
constexpr int NPR = 16384;
constexpr int DM = 1024;
constexpr int EIN = 3592, EINP = 3584;
constexpr float EPSF = 1e-6f;

constexpr size_t O_Y = 0;
constexpr size_t O_CONVP = 16777216 + 131072;
constexpr size_t O_QKVP = O_CONVP + 122880;
constexpr size_t O_DELTAP = O_QKVP + 36864;
constexpr size_t O_POOLP = O_DELTAP + 524288;
constexpr size_t O_MEMK = O_POOLP + 122880;
constexpr size_t O_MEMV = O_MEMK + 4194304;
constexpr size_t O_CONVS = O_MEMV + 4194304;
constexpr size_t O_QKVS = O_CONVS + 1966080;
constexpr size_t O_DELTAS = O_QKVS + 589824;
constexpr size_t O_POOLS = O_DELTAS + 8388608;

struct Params {
  const float *x_prompt, *x_sample, *state_conv_a, *state_qkv_conv, *state_delta, *state_pool, *cache_k, *cache_v, *mem_prompt;
  const float *norm_mix, *norm_xattn, *norm_final, *w_in_even, *w_out_even, *dw_w, *dw_b, *ln_a_g, *ln_a_b, *sc_w, *a_log,
      *dt_bias, *dn_norm_g, *w_in_odd, *w_pool, *b_pool, *pool_scale, *w_out_odd, *w_xq, *w_xk, *w_xv, *w_xo;
  float* out;
  float *X, *QKV, *BGR, *BG, *CONV, *ODN, *U, *GL;
  bfr *H, *PB, *MIX, *ACT2, *ACT3, *KB, *VT, *MPB;
  bfr *WtInE, *WtOutE, *WtInO, *WtPool, *WtOutO, *WtXq, *WtXk, *WtXv, *WtXo;
  uint4 *WN, *QD, *KD, *QKF;
  unsigned* bar;
  int phase_lo, phase_hi;
};

DI unsigned pack2(float a, float b) {
  fl2_t f = {a, b};
  bf2_t r = __builtin_convertvector(f, bf2_t);
  return __builtin_bit_cast(unsigned, r);
}
DI bfr f2bf(float a) { return (bfr)(pack2(a, 0.f) & 0xffffu); }
DI float bf2f(bfr u) { return __uint_as_float(((unsigned)u) << 16); }
DI float bflo(unsigned u) { return __uint_as_float(u << 16); }
DI float bfhi(unsigned u) { return __uint_as_float(u & 0xffff0000u); }
DI float sigmoidf_(float x) { return 1.0f / (1.0f + __expf(-x)); }
DI float siluf_(float x) { return x / (1.0f + __expf(-x)); }
DI float wave_sum(float v) {
#pragma unroll
  for (int o = 32; o >= 1; o >>= 1) v += __shfl_xor(v, o);
  return v;
}
DI float wave_max(float v) {
#pragma unroll
  for (int o = 32; o >= 1; o >>= 1) v = fmaxf(v, __shfl_xor(v, o));
  return v;
}
DI int crow(int reg, int h) { return (reg & 3) + 8 * (reg >> 2) + 4 * h; }
DI bf16x8 pack8(const f32x16& x, int s) {
  uint4 p;
  p.x = pack2(x[8 * s + 0], x[8 * s + 1]);
  p.y = pack2(x[8 * s + 2], x[8 * s + 3]);
  p.z = pack2(x[8 * s + 4], x[8 * s + 5]);
  p.w = pack2(x[8 * s + 6], x[8 * s + 7]);
  return __builtin_bit_cast(bf16x8, p);
}
DI bf16x8 ldfrag(const uint4* p) { uint4 v = *p; return __builtin_bit_cast(bf16x8, v); }


#define XB_TMO      128
#define XB_XCNT(j)  (256  + 64 * (j))
#define XB_XSUB(j)  (1280 + 64 * (j))
#define XB_XGEN(j)  (2304 + 64 * (j))
#define XB_TOP      3328
#define XB_TOPGEN   3392
#define XCD_BAR_WORDS 3456
#define XB_SPIN_CAP (1u << 18)
#define LAS __attribute__((address_space(3)))
DI unsigned xb_ld(unsigned* p) { return __hip_atomic_load(p, __ATOMIC_RELAXED, __HIP_MEMORY_SCOPE_AGENT); }
DI unsigned xb_add(unsigned* p, unsigned v) { return __hip_atomic_fetch_add(p, v, __ATOMIC_RELAXED, __HIP_MEMORY_SCOPE_AGENT); }
DI unsigned xb_xcc_id() { return (unsigned)__builtin_amdgcn_s_getreg((3 << 11) | 20) & 0xFu; }
#define XB_SPIN(cond, bar) do { unsigned _sp = 0; while (cond) { __builtin_amdgcn_s_sleep(1); \
    if ((++_sp & 255u) == 0u) { if (xb_ld(&(bar)[XB_TMO])) break; if (_sp > XB_SPIN_CAP) { atomicAdd(&(bar)[XB_TMO], 1u); break; } } } } while (0)
struct XcdBarrier { unsigned* bar; unsigned x; volatile LAS unsigned* st; };
DI XcdBarrier xcd_barrier_post(unsigned* bar, volatile LAS unsigned* st) {
  XcdBarrier b; b.bar = bar; b.x = xb_xcc_id(); b.st = st;
  if (threadIdx.x == 0) (void)xb_add(&bar[XB_XCNT(b.x)], 1u);
  return b;
}
DI void xcd_barrier_complete(unsigned* bar, unsigned x, unsigned& nloc, unsigned& nx) {
  const unsigned G = gridDim.x * gridDim.y * gridDim.z;
  unsigned sum, cnt, mine, sp = 0u;
  for (;;) {
    sum = 0u; cnt = 0u; mine = 0u;
#pragma unroll
    for (unsigned j = 0; j < 16; ++j) { const unsigned c = xb_ld(&bar[XB_XCNT(j)]); sum += c; cnt += (c > 0u) ? 1u : 0u; mine = (j == x) ? c : mine; }
    if (sum == G) break;
    __builtin_amdgcn_s_sleep(1);
    if ((++sp & 255u) == 0u) { if (xb_ld(&bar[XB_TMO])) break; if (sp > XB_SPIN_CAP) { atomicAdd(&bar[XB_TMO], 1u); break; } }
  }
  nloc = mine > 0u ? mine : 1u; nx = cnt > 0u ? cnt : 1u;
}
DI void xcd_barrier(const XcdBarrier& b) {
  asm volatile("s_waitcnt vmcnt(0)" ::: "memory");
  __syncthreads();
  if (threadIdx.x == 0) {
    unsigned* bar = b.bar;
    __builtin_amdgcn_s_waitcnt(0);
    unsigned nloc = b.st[0], nx = b.st[1];
    if (nloc == 0u) { xcd_barrier_complete(bar, b.x, nloc, nx); b.st[0] = nloc; b.st[1] = nx; }
    const unsigned old = xb_add(&bar[XB_XSUB(b.x)], 1u);
    const unsigned gen = old / nloc;
    if (old + 1u == (gen + 1u) * nloc) {
      __builtin_amdgcn_fence(__ATOMIC_RELEASE, "agent");
      asm volatile("s_waitcnt vmcnt(0)" ::: "memory");
      const unsigned og = xb_add(&bar[XB_TOP], 1u);
      const unsigned tg = og / nx;
      if (og + 1u == (tg + 1u) * nx) xb_add(&bar[XB_TOPGEN], 1u);
      else XB_SPIN(xb_ld(&bar[XB_TOPGEN]) == tg, bar);
      __builtin_amdgcn_fence(__ATOMIC_ACQUIRE, "agent");
      xb_add(&bar[XB_XGEN(b.x)], 1u);
      asm volatile("s_waitcnt vmcnt(0)" ::: "memory");
    } else {
      XB_SPIN(xb_ld(&bar[XB_XGEN(b.x)]) == gen, bar);
      __builtin_amdgcn_fence(__ATOMIC_ACQUIRE, "agent");
      asm volatile("s_waitcnt vmcnt(0)" ::: "memory");
    }
  }
  __syncthreads();
}

template <class Epi>
DI void gemm_tile(const bfr* __restrict__ A, int lda, const bfr* __restrict__ Bt, int ldb, int K, int m0, int n0, char* smem, Epi epi) {
  bfr* As = (bfr*)smem;
  bfr* Bs = As + 128 * 72;
  const int tid = threadIdx.x, lane = tid & 63, wid = tid >> 6, wr = wid >> 1, wc = wid & 1;
  const int r = lane & 31, hl = lane >> 5;
  f32x16 acc[2][2];
#pragma unroll
  for (int i = 0; i < 2; ++i)
#pragma unroll
    for (int j = 0; j < 2; ++j)
#pragma unroll
      for (int q = 0; q < 16; ++q) acc[i][j][q] = 0.f;
  u32x4 ra[4], rb[4];
  const int nk = K >> 6;
  const bfr* Ab = A + (size_t)m0 * lda;
  const bfr* Bb = Bt + (size_t)n0 * ldb;
#pragma unroll
  for (int i = 0; i < 4; ++i) {
    int chunk = tid + i * 256, row = chunk >> 3, c8 = chunk & 7;
    ra[i] = *(const u32x4*)(Ab + (size_t)row * lda + c8 * 8);
    rb[i] = *(const u32x4*)(Bb + (size_t)row * ldb + c8 * 8);
  }
  for (int kt = 0; kt < nk; ++kt) {
    __syncthreads();
#pragma unroll
    for (int i = 0; i < 4; ++i) {
      int chunk = tid + i * 256, row = chunk >> 3, c8 = chunk & 7;
      *(u32x4*)(As + row * 72 + c8 * 8) = ra[i];
      *(u32x4*)(Bs + row * 72 + c8 * 8) = rb[i];
    }
    __syncthreads();
    if (kt + 1 < nk) {
#pragma unroll
      for (int i = 0; i < 4; ++i) {
        int chunk = tid + i * 256, row = chunk >> 3, c8 = chunk & 7;
        ra[i] = *(const u32x4*)(Ab + (size_t)row * lda + (kt + 1) * 64 + c8 * 8);
        rb[i] = *(const u32x4*)(Bb + (size_t)row * ldb + (kt + 1) * 64 + c8 * 8);
      }
    }
#pragma unroll
    for (int ks = 0; ks < 4; ++ks) {
      bf16x8 af[2], bfg[2];
#pragma unroll
      for (int i = 0; i < 2; ++i) {
        af[i] = *(const bf16x8*)(As + (wr * 64 + i * 32 + r) * 72 + ks * 16 + hl * 8);
        bfg[i] = *(const bf16x8*)(Bs + (wc * 64 + i * 32 + r) * 72 + ks * 16 + hl * 8);
      }
#pragma unroll
      for (int i = 0; i < 2; ++i)
#pragma unroll
        for (int j = 0; j < 2; ++j) acc[i][j] = MFMA32(af[i], bfg[j], acc[i][j]);
    }
  }
#pragma unroll
  for (int i = 0; i < 2; ++i)
#pragma unroll
    for (int j = 0; j < 2; ++j)
#pragma unroll
      for (int q = 0; q < 16; ++q) {
        int row = m0 + wr * 64 + i * 32 + crow(q, hl);
        int col = n0 + wc * 64 + j * 32 + r;
        epi(row, col, acc[i][j][q]);
      }
  __syncthreads();
}

DI void transpose_tile(const float* __restrict__ W, int ldw, bfr* __restrict__ Wt, int ldt, int k0, int n0, float* sm, int nvalid = 1 << 30) {
  const int tid = threadIdx.x;
#pragma unroll
  for (int i = 0; i < 16; ++i) {
    int idx = tid + i * 256, kk = idx >> 6, nn = idx & 63;
    sm[kk * 65 + nn] = (n0 + nn < nvalid) ? W[(size_t)(k0 + kk) * ldw + n0 + nn] : 0.f;
  }
  __syncthreads();
#pragma unroll
  for (int i = 0; i < 8; ++i) {
    int idx = tid + i * 256, nn = idx >> 5, kp = idx & 31;
    float a = sm[(2 * kp) * 65 + nn], b = sm[(2 * kp + 1) * 65 + nn];
    *(unsigned*)(Wt + (size_t)(n0 + nn) * ldt + k0 + 2 * kp) = pack2(a, b);
  }
  __syncthreads();
}

DI void phase_prep(const Params& p, char* smem) {
  float* sm = (float*)smem;
  for (int tt = blockIdx.x; tt < 4032 + 32; tt += gridDim.x) {
    int t = tt - 32;
    if (tt < 928) {
      int kt = tt / 58, nt = tt % 58;
      transpose_tile(p.w_in_even, EIN, p.WtInE, 1024, kt * 64, nt * 64, sm, EIN);
    } else if (t < 1152) {
      int u = t - 896;
      transpose_tile(p.w_out_even, 1024, p.WtOutE, 1024, (u >> 4) * 64, (u & 15) * 64, sm);
    } else if (t < 1664) {
      int u = t - 1152;
      transpose_tile(p.w_in_odd, 2048, p.WtInO, 1024, (u >> 5) * 64, (u & 31) * 64, sm);
    } else if (t < 1728) {
      int u = t - 1664, g = u >> 4, v = u & 15;
      transpose_tile(p.w_pool + (size_t)g * 65536, 256, p.WtPool + (size_t)g * 65536, 256, (v >> 2) * 64, (v & 3) * 64, sm);
    } else if (t < 1984) {
      int u = t - 1728;
      transpose_tile(p.w_out_odd, 1024, p.WtOutO, 1024, (u >> 4) * 64, (u & 15) * 64, sm);
    } else {
      int u = t - 1984, m = u >> 8, v = u & 255;
      int which = m >> 1, l = m & 1;
      const float* src = (which == 0 ? p.w_xq : which == 1 ? p.w_xk : which == 2 ? p.w_xv : p.w_xo) + (size_t)l * 1048576;
      bfr* dst = (which == 0 ? p.WtXq : which == 1 ? p.WtXk : which == 2 ? p.WtXv : p.WtXo) + (size_t)l * 1048576;
      transpose_tile(src, 1024, dst, 1024, (v >> 4) * 64, (v & 15) * 64, sm);
    }
  }
  {
    const int n4 = 2048 * 1024 / 4;
    for (int i = blockIdx.x * 256 + threadIdx.x; i < n4; i += gridDim.x * 256) {
      float4 v = ((const float4*)p.mem_prompt)[i];
      uint2 o;
      o.x = pack2(v.x, v.y);
      o.y = pack2(v.z, v.w);
      ((uint2*)p.MPB)[i] = o;
    }
  }
  {
    const int lane = threadIdx.x & 63, wid = threadIdx.x >> 6;
    for (int row = blockIdx.x * 4 + wid; row < NROW; row += gridDim.x * 4) {
      const float* xr = row < NPR ? p.x_prompt + (size_t)row * DM : p.x_sample + (size_t)(row - NPR) * DM;
      float4 v[4];
      float ss = 0.f;
#pragma unroll
      for (int j = 0; j < 4; ++j) {
        v[j] = ((const float4*)xr)[j * 64 + lane];
        ss += v[j].x * v[j].x + v[j].y * v[j].y + v[j].z * v[j].z + v[j].w * v[j].w;
      }
      ss = wave_sum(ss);
      float inv = rsqrtf(ss * (1.0f / 1024.0f) + EPSF);
#pragma unroll
      for (int j = 0; j < 4; ++j) {
        float4 g = ((const float4*)p.norm_mix)[j * 64 + lane];
        uint2 o;
        o.x = pack2(v[j].x * inv * g.x, v[j].y * inv * g.y);
        o.y = pack2(v[j].z * inv * g.z, v[j].w * inv * g.w);
        ((uint2*)(p.H + (size_t)row * DM))[j * 64 + lane] = o;
      }
    }
  }
}

DI void phase_rmsnorm(const Params& p, const float* g) {
  const int lane = threadIdx.x & 63, wid = threadIdx.x >> 6;
  for (int row = blockIdx.x * 4 + wid; row < NROW; row += gridDim.x * 4) {
    const float* xr = p.X + (size_t)row * DM;
    float4 v[4];
    float ss = 0.f;
#pragma unroll
    for (int j = 0; j < 4; ++j) {
      v[j] = ((const float4*)xr)[j * 64 + lane];
      ss += v[j].x * v[j].x + v[j].y * v[j].y + v[j].z * v[j].z + v[j].w * v[j].w;
    }
    ss = wave_sum(ss);
    float inv = rsqrtf(ss * (1.0f / 1024.0f) + EPSF);
#pragma unroll
    for (int j = 0; j < 4; ++j) {
      float4 gg = ((const float4*)g)[j * 64 + lane];
      uint2 o;
      o.x = pack2(v[j].x * inv * gg.x, v[j].y * inv * gg.y);
      o.y = pack2(v[j].z * inv * gg.z, v[j].w * inv * gg.w);
      ((uint2*)(p.H + (size_t)row * DM))[j * 64 + lane] = o;
    }
  }
}

DI void phase_final_norm(const Params& p) {
  const int lane = threadIdx.x & 63, wid = threadIdx.x >> 6;
  for (int row = blockIdx.x * 4 + wid; row < NROW; row += gridDim.x * 4) {
    const float* xr = p.X + (size_t)row * DM;
    float4 v[4];
    float ss = 0.f;
#pragma unroll
    for (int j = 0; j < 4; ++j) {
      v[j] = ((const float4*)xr)[j * 64 + lane];
      ss += v[j].x * v[j].x + v[j].y * v[j].y + v[j].z * v[j].z + v[j].w * v[j].w;
    }
    ss = wave_sum(ss);
    float inv = rsqrtf(ss * (1.0f / 1024.0f) + EPSF);
#pragma unroll
    for (int j = 0; j < 4; ++j) {
      float4 gg = ((const float4*)p.norm_final)[j * 64 + lane];
      float4 o = {v[j].x * inv * gg.x, v[j].y * inv * gg.y, v[j].z * inv * gg.z, v[j].w * inv * gg.w};
      ((float4*)(p.out + O_Y + (size_t)row * DM))[j * 64 + lane] = o;
    }
  }
}

DI void phase_gemm_in_even(const Params& p, char* smem) {
  const int NT1 = 129 * 29, NT2 = 4 * 128;
  for (int t = blockIdx.x; t < NT1 + NT2; t += gridDim.x) {
    if (t < NT1) {
      int mt = t / 29, nt = t % 29;
      bfr* PB = p.PB;
      float* BGR = p.BGR;
      if (nt < 28)
        gemm_tile(p.H, 1024, p.WtInE, 1024, 1024, mt * 128, nt * 128, smem,
                  [=](int row, int col, float v) { PB[(size_t)row * EINP + col] = f2bf(v); });
      else
        gemm_tile(p.H, 1024, p.WtInE, 1024, 1024, mt * 128, nt * 128, smem,
                  [=](int row, int col, float v) { if (col < EIN) BGR[(size_t)row * 8 + (col - EINP)] = v; });
    } else {
      int u = t - NT1, gsel = u >> 7, v = u & 127, mt = v >> 3, nt = v & 7;
      int isv = gsel >> 1, l = gsel & 1;
      if (!isv) {
        float* o = p.out + O_MEMK + (size_t)l * 2097152;
        bfr* kb = p.KB + (size_t)l * 2097152;
        gemm_tile(p.MPB, 1024, p.WtXk + (size_t)l * 1048576, 1024, 1024, mt * 128, nt * 128, smem,
                  [=](int row, int col, float v) {
                    o[(size_t)row * 1024 + col] = v;
                    kb[(size_t)row * 1024 + col] = f2bf(v);
                  });
      } else {
        float* o = p.out + O_MEMV + (size_t)l * 2097152;
        bfr* vt = p.VT + (size_t)l * 2097152;
        gemm_tile(p.MPB, 1024, p.WtXv + (size_t)l * 1048576, 1024, 1024, mt * 128, nt * 128, smem,
                  [=](int row, int col, float v) {
                    o[(size_t)row * 1024 + col] = v;
                    int b = row >> 8, mem = row & 255, h = col >> 8, dim = col & 255;
                    int ks = mem >> 4, ml = mem & 15, hl2 = (ml >> 2) & 1, j = ((ml >> 3) << 2) | (ml & 3);
                    int dt = dim >> 5, rr = dim & 31;
                    size_t off = ((((size_t)(b * 4 + h) * 8 + dt) * 16 + ks) * 64 + hl2 * 32 + rr) * 8 + j;
                    vt[off] = f2bf(v);
                  });
      }
    }
  }
}

DI void qkv_token(const Params& p, int row, int lane) {
  const bool is_p = row < NPR;
  const int t = row & 2047, b = row >> 11, s = row - NPR;
#pragma unroll 6
  for (int grp = 0; grp < 12; ++grp) {
    const int ch = grp * 128 + lane * 2;
    float x0[4], x1[4];
#pragma unroll
    for (int j = 0; j < 4; ++j) {
      x0[j] = 0.f; x1[j] = 0.f;
      if (is_p) {
        if (t - 3 + j >= 0) {
          unsigned u = *(const unsigned*)(p.PB + (size_t)(row - 3 + j) * EINP + 1536 + ch);
          x0[j] = bflo(u); x1[j] = bfhi(u);
        }
      } else {
        if (j < 3) {
          float2 f = *(const float2*)(p.state_qkv_conv + ((size_t)s * 3 + j) * 1536 + ch);
          x0[j] = f.x; x1[j] = f.y;
        } else {
          unsigned u = *(const unsigned*)(p.PB + (size_t)row * EINP + 1536 + ch);
          x0[j] = bflo(u); x1[j] = bfhi(u);
        }
      }
    }
    float a0 = 0.f, a1 = 0.f;
#pragma unroll
    for (int j = 0; j < 4; ++j) {
      float2 w = *(const float2*)(p.sc_w + (size_t)j * 1536 + ch);
      a0 += w.x * x0[j]; a1 += w.y * x1[j];
    }
    float y0 = siluf_(a0), y1 = siluf_(a1);
    if (grp < 8) {
      float ss = wave_sum(y0 * y0 + y1 * y1);
      float inv = rsqrtf(ss + EPSF);
      if (grp < 4) inv *= 0.08838834764831845f;
      y0 *= inv; y1 *= inv;
    }
    float2 o = {y0, y1};
    *(float2*)(p.QKV + (size_t)row * 1536 + ch) = o;
    if (is_p) {
      if (t >= 2045) {
        float2 c = {x0[3], x1[3]};
        *(float2*)(p.out + O_QKVP + ((size_t)b * 3 + (t - 2045)) * 1536 + ch) = c;
      }
    } else {
      float2 c0 = {x0[1], x1[1]}, c1 = {x0[2], x1[2]}, c2 = {x0[3], x1[3]};
      *(float2*)(p.out + O_QKVS + ((size_t)s * 3 + 0) * 1536 + ch) = c0;
      *(float2*)(p.out + O_QKVS + ((size_t)s * 3 + 1) * 1536 + ch) = c1;
      *(float2*)(p.out + O_QKVS + ((size_t)s * 3 + 2) * 1536 + ch) = c2;
    }
  }
  if (lane < 4) {
    float bl = p.BGR[(size_t)row * 8 + lane], al = p.BGR[(size_t)row * 8 + 4 + lane];
    float beta = sigmoidf_(bl);
    float xx = al + p.dt_bias[lane];
    float sp = xx > 20.f ? xx : log1pf(__expf(xx));
    float g = -__expf(p.a_log[lane]) * sp;
    p.BG[(size_t)row * 8 + lane] = beta;
    p.BG[(size_t)row * 8 + 4 + lane] = g;
  }
}

DI void conv_a_prompt_item(const Params& p, int item, float* sm) {
  const int half = item & 1, tile = (item >> 1) & 63, b = item >> 7;
  const int tid = threadIdx.x, c = half * 256 + tid, t0 = tile * 32;
#pragma unroll 31
  for (int i = 0; i < 62; ++i) {
    int tt = t0 - 30 + i;
    float gl = 0.f;
    if (tt >= 0) {
      size_t row = (size_t)b * 2048 + tt;
      float val = bf2f(p.PB[row * EINP + c]);
      float gate = bf2f(p.PB[row * EINP + 512 + c]);
      gl = val * sigmoidf_(gate);
    }
    sm[i * 256 + tid] = gl;
  }
  float w[31];
#pragma unroll
  for (int j = 0; j < 31; ++j) w[j] = p.dw_w[j * 512 + c];
  const float bias = p.dw_b[c];
#pragma unroll 1
  for (int o = 0; o < 32; ++o) {
    float acc = bias;
#pragma unroll
    for (int j = 0; j < 31; ++j) acc += w[j] * sm[(o + j) * 256 + tid];
    p.CONV[((size_t)b * 2048 + t0 + o) * 512 + c] = acc;
  }
  if (tile == 63) {
#pragma unroll 1
    for (int j = 0; j < 30; ++j) p.out[O_CONVP + ((size_t)b * 30 + j) * 512 + c] = sm[(32 + j) * 256 + tid];
  }
  __syncthreads();
}

DI void conv_a_sample_item(const Params& p, int s) {
  const int tid = threadIdx.x;
  const size_t row = NPR + s;
#pragma unroll
  for (int cc = 0; cc < 2; ++cc) {
    int c = tid + cc * 256;
    float val = bf2f(p.PB[row * EINP + c]);
    float gate = bf2f(p.PB[row * EINP + 512 + c]);
    float gl = val * sigmoidf_(gate);
    float acc = p.dw_b[c] + p.dw_w[30 * 512 + c] * gl;
#pragma unroll 6
    for (int j = 0; j < 30; ++j) {
      float st = p.state_conv_a[((size_t)s * 30 + j) * 512 + c];
      acc += p.dw_w[j * 512 + c] * st;
      if (j >= 1) p.out[O_CONVS + ((size_t)s * 30 + j - 1) * 512 + c] = st;
    }
    p.out[O_CONVS + ((size_t)s * 30 + 29) * 512 + c] = gl;
    p.CONV[row * 512 + c] = acc;
  }
}

DI void phase_even_pointwise(const Params& p, char* smem) {
  const int lane = threadIdx.x & 63, wid = threadIdx.x >> 6;
  for (int it = blockIdx.x; it < 1024 + 128; it += gridDim.x) {
    if (it < 1024) conv_a_prompt_item(p, it, (float*)smem);
    else conv_a_sample_item(p, it - 1024);
  }
  for (int row = blockIdx.x * 4 + wid; row < NROW; row += gridDim.x * 4) qkv_token(p, row, lane);
}

DI void chunk_prep(const Params& p, int item, char* smem) {
  const int tid = threadIdx.x, lane = tid & 63, wid = tid >> 6, r = lane & 31, hl = lane >> 5;
  const int n = item & 31, hh = (item >> 5) & 3, b = item >> 7;
  const size_t row0 = (size_t)b * 2048 + n * 64;
  float* gcs = (float*)smem;
  float* betas = gcs + 64;
  float* egs = betas + 64;
  float* kscale = egs + 64;
  bfr* qs = (bfr*)(smem + 1024);
  bfr* ks_ = qs + 64 * 136;
  float* Am = (float*)(smem + 1024 + 2 * 64 * 136 * 2);
  bfr* wsb = qs;
  if (tid < 64) {
    float beta = p.BG[(row0 + tid) * 8 + hh];
    float g = p.BG[(row0 + tid) * 8 + 4 + hh];
    float v = g;
#pragma unroll
    for (int off = 1; off < 64; off <<= 1) {
      float t = __shfl_up(v, off);
      if (lane >= off) v += t;
    }
    float gl = __shfl(v, 63);
    gcs[tid] = v;
    betas[tid] = beta;
    egs[tid] = __expf(v);
    kscale[tid] = __expf(gl - v);
    if (tid == 63) p.GL[item] = __expf(gl);
  }
#pragma unroll
  for (int i = 0; i < 8; ++i) {
    int idx = tid + i * 256, row = idx >> 5, c4 = idx & 31;
    float4 q = *(const float4*)(p.QKV + (row0 + row) * 1536 + hh * 128 + c4 * 4);
    float4 k = *(const float4*)(p.QKV + (row0 + row) * 1536 + 512 + hh * 128 + c4 * 4);
    uint2 qo, ko;
    qo.x = pack2(q.x, q.y); qo.y = pack2(q.z, q.w);
    ko.x = pack2(k.x, k.y); ko.y = pack2(k.z, k.w);
    *(uint2*)(qs + row * 136 + c4 * 4) = qo;
    *(uint2*)(ks_ + row * 136 + c4 * 4) = ko;
  }
  __syncthreads();
  {
    const int mi = wid >> 1, ni = wid & 1;
    f32x16 akk, aqk;
#pragma unroll
    for (int q = 0; q < 16; ++q) { akk[q] = 0.f; aqk[q] = 0.f; }
#pragma unroll
    for (int ks = 0; ks < 8; ++ks) {
      bf16x8 ka = *(const bf16x8*)(ks_ + (mi * 32 + r) * 136 + ks * 16 + hl * 8);
      bf16x8 qa = *(const bf16x8*)(qs + (mi * 32 + r) * 136 + ks * 16 + hl * 8);
      bf16x8 kb = *(const bf16x8*)(ks_ + (ni * 32 + r) * 136 + ks * 16 + hl * 8);
      akk = MFMA32(ka, kb, akk);
      aqk = MFMA32(qa, kb, aqk);
    }
    bfr* qkf = (bfr*)(p.QKF + (size_t)item * 512);
#pragma unroll
    for (int q = 0; q < 16; ++q) {
      int i = mi * 32 + crow(q, hl), j = ni * 32 + r;
      float dec = (i >= j) ? __expf(gcs[i] - gcs[j]) : 0.f;
      Am[i * 68 + j] = (i > j) ? akk[q] * betas[i] * dec : 0.f;
      float qv = (i >= j) ? aqk[q] * dec : 0.f;
      int ksj = j >> 4, jl = j & 15, h2 = (jl >> 2) & 1, jj = ((jl >> 3) << 2) | (jl & 3);
      qkf[((mi * 4 + ksj) * 64 + h2 * 32 + (i & 31)) * 8 + jj] = f2bf(qv);
    }
  }
  {
    uint4* QD = p.QD + (size_t)item * 1024;
#pragma unroll
    for (int i = 0; i < 4; ++i) {
      int idx = tid + i * 256, f = idx >> 6, ln = idx & 63, mt = f >> 3, ks = f & 7, m = ln & 31, h2 = ln >> 5;
      int ri = mt * 32 + m, d0 = ks * 16 + h2 * 4;
      float sc = egs[ri];
      const float* src = p.QKV + (row0 + ri) * 1536 + hh * 128 + d0;
      float4 a = *(const float4*)src, c = *(const float4*)(src + 8);
      uint4 o;
      o.x = pack2(a.x * sc, a.y * sc); o.y = pack2(a.z * sc, a.w * sc);
      o.z = pack2(c.x * sc, c.y * sc); o.w = pack2(c.z * sc, c.w * sc);
      QD[f * 64 + ln] = o;
    }
    uint4* KD = p.KD + (size_t)item * 1024;
#pragma unroll
    for (int i = 0; i < 4; ++i) {
      int idx = tid + i * 256, f = idx >> 6, ln = idx & 63, mt = f >> 2, ks = f & 3, m = ln & 31, h2 = ln >> 5;
      int d = mt * 32 + m;
      float vals[8];
#pragma unroll
      for (int j = 0; j < 8; ++j) {
        int c = ks * 16 + 8 * (j >> 2) + 4 * h2 + (j & 3);
        vals[j] = p.QKV[(row0 + c) * 1536 + 512 + hh * 128 + d] * kscale[c];
      }
      uint4 o;
      o.x = pack2(vals[0], vals[1]); o.y = pack2(vals[2], vals[3]);
      o.z = pack2(vals[4], vals[5]); o.w = pack2(vals[6], vals[7]);
      KD[f * 64 + ln] = o;
    }
  }
  __syncthreads();
  {
    const int c = tid;
    const float* src = (c < 128) ? (p.QKV + row0 * 1536 + 1024 + hh * 128 + c) : (p.QKV + row0 * 1536 + 512 + hh * 128 + (c - 128));
    float sol[64];
#pragma unroll
    for (int i = 0; i < 64; ++i) {
      float rhs = src[(size_t)i * 1536] * betas[i];
      if (c >= 128) rhs *= egs[i];
      float acc = rhs;
#pragma unroll
      for (int j = 0; j < i; ++j) acc -= Am[i * 68 + j] * sol[j];
      sol[i] = acc;
    }
    if (c < 128) {
      float* U = p.U + (size_t)item * 8192;
#pragma unroll
      for (int i = 0; i < 64; ++i) U[i * 128 + c] = sol[i];
    } else {
#pragma unroll
      for (int i = 0; i < 64; ++i) wsb[i * 136 + (c - 128)] = f2bf(-sol[i]);
    }
  }
  __syncthreads();
  {
    uint4* WN = p.WN + (size_t)item * 1024;
#pragma unroll
    for (int i = 0; i < 4; ++i) {
      int idx = tid + i * 256, f = idx >> 6, ln = idx & 63, mt = f >> 3, ks = f & 7, m = ln & 31, h2 = ln >> 5;
      int ri = mt * 32 + m, d0 = ks * 16 + h2 * 4;
      uint2 a = *(const uint2*)(wsb + ri * 136 + d0), c = *(const uint2*)(wsb + ri * 136 + d0 + 8);
      uint4 o = {a.x, a.y, c.x, c.y};
      WN[f * 64 + ln] = o;
    }
  }
  __syncthreads();
}

DI void branch_a_final_row(const Params& p, int row, int lane) {
  const float* cr = p.CONV + (size_t)row * 512;
  float4 v[2];
  float s = 0.f;
#pragma unroll
  for (int j = 0; j < 2; ++j) {
    v[j] = ((const float4*)cr)[j * 64 + lane];
    s += v[j].x + v[j].y + v[j].z + v[j].w;
  }
  float mean = wave_sum(s) * (1.0f / 512.0f);
  float vs = 0.f;
#pragma unroll
  for (int j = 0; j < 2; ++j) {
    v[j].x -= mean; v[j].y -= mean; v[j].z -= mean; v[j].w -= mean;
    vs += v[j].x * v[j].x + v[j].y * v[j].y + v[j].z * v[j].z + v[j].w * v[j].w;
  }
  float inv = rsqrtf(wave_sum(vs) * (1.0f / 512.0f) + EPSF);
#pragma unroll
  for (int j = 0; j < 2; ++j) {
    int c = (j * 64 + lane) * 4;
    float4 g = *(const float4*)(p.ln_a_g + c), bb = *(const float4*)(p.ln_a_b + c);
    uint2 gu = *(const uint2*)(p.PB + (size_t)row * EINP + 1024 + c);
    float y0 = siluf_(v[j].x * inv * g.x + bb.x) * siluf_(bflo(gu.x));
    float y1 = siluf_(v[j].y * inv * g.y + bb.y) * siluf_(bfhi(gu.x));
    float y2 = siluf_(v[j].z * inv * g.z + bb.z) * siluf_(bflo(gu.y));
    float y3 = siluf_(v[j].w * inv * g.w + bb.w) * siluf_(bfhi(gu.y));
    uint2 o;
    o.x = pack2(y0, y1); o.y = pack2(y2, y3);
    *(uint2*)(p.MIX + (size_t)row * 1024 + c) = o;
  }
}

DI void delta_sample_item(const Params& p, int item, char* smem) {
  const int s = item >> 2, hh = item & 3, tid = threadIdx.x;
  const size_t row = NPR + s;
  float* ksm = (float*)smem;
  float* qsm = ksm + 128;
  float* part = qsm + 128;
  if (tid < 128) ksm[tid] = p.QKV[row * 1536 + 512 + hh * 128 + tid];
  else qsm[tid - 128] = p.QKV[row * 1536 + hh * 128 + (tid - 128)];
  const float beta = p.BG[row * 8 + hh], a = __expf(p.BG[row * 8 + 4 + hh]);
  __syncthreads();
  const int e = tid & 127, half = tid >> 7, d0 = half * 64;
  const float* S0 = p.state_delta + (((size_t)s * 4 + hh) * 128 + d0) * 128 + e;
  float* So = p.out + O_DELTAS + (((size_t)s * 4 + hh) * 128 + d0) * 128 + e;
  float Sr[64];
  float ksum = 0.f;
#pragma unroll
  for (int i = 0; i < 64; ++i) {
    Sr[i] = S0[(size_t)i * 128] * a;
    ksum += ksm[d0 + i] * Sr[i];
  }
  part[half * 128 + e] = ksum;
  __syncthreads();
  const float kS = part[e] + part[128 + e];
  const float v = p.QKV[row * 1536 + 1024 + hh * 128 + e];
  const float vnew = (v - kS) * beta;
  float oo = 0.f;
#pragma unroll
  for (int i = 0; i < 64; ++i) {
    Sr[i] += ksm[d0 + i] * vnew;
    So[(size_t)i * 128] = Sr[i];
    oo += qsm[d0 + i] * Sr[i];
  }
  __syncthreads();
  part[half * 128 + e] = oo;
  __syncthreads();
  if (half == 0) p.ODN[row * 512 + hh * 128 + e] = part[e] + part[128 + e];
  __syncthreads();
}

DI void phase_chunk_prep(const Params& p, char* smem) {
  const int lane = threadIdx.x & 63, wid = threadIdx.x >> 6;
  for (int it = blockIdx.x; it < 1024 + 512; it += gridDim.x) {
    if (it < 1024) chunk_prep(p, it, smem);
    else delta_sample_item(p, it - 1024, smem);
  }
  for (int row = blockIdx.x * 4 + wid; row < NROW; row += gridDim.x * 4) branch_a_final_row(p, row, lane);
}

DI void scan_item(const Params& p, int item) {
  const int tid = threadIdx.x, lane = tid & 63, es = tid >> 6, r = lane & 31, hl = lane >> 5;
  const int b = item >> 2, hh = item & 3;
  f32x16 S[4];
#pragma unroll
  for (int d = 0; d < 4; ++d)
#pragma unroll
    for (int q = 0; q < 16; ++q) S[d][q] = 0.f;
#pragma unroll 1
  for (int n = 0; n < 32; ++n) {
    const int chunk = item * 32 + n;
    const uint4* WN = p.WN + (size_t)chunk * 1024 + lane;
    const uint4* QD = p.QD + (size_t)chunk * 1024 + lane;
    const uint4* KD = p.KD + (size_t)chunk * 1024 + lane;
    const uint4* QK = p.QKF + (size_t)chunk * 512 + lane;
    const float* U = p.U + (size_t)chunk * 8192 + es * 32 + r;
    const float gl = p.GL[chunk];
    bf16x8 Sb[4][2];
#pragma unroll
    for (int d = 0; d < 4; ++d) { Sb[d][0] = pack8(S[d], 0); Sb[d][1] = pack8(S[d], 1); }
    f32x16 vn[2], o[2];
#pragma unroll
    for (int ct = 0; ct < 2; ++ct)
#pragma unroll
      for (int q = 0; q < 16; ++q) { vn[ct][q] = U[(ct * 32 + crow(q, hl)) * 128]; o[ct][q] = 0.f; }
#pragma unroll
    for (int ct = 0; ct < 2; ++ct)
#pragma unroll
      for (int ks = 0; ks < 8; ++ks) {
        bf16x8 aw = ldfrag(WN + (ct * 8 + ks) * 64);
        bf16x8 aq = ldfrag(QD + (ct * 8 + ks) * 64);
        vn[ct] = MFMA32(aw, Sb[ks >> 1][ks & 1], vn[ct]);
        o[ct] = MFMA32(aq, Sb[ks >> 1][ks & 1], o[ct]);
      }
    bf16x8 Vb[2][2];
#pragma unroll
    for (int ct = 0; ct < 2; ++ct) { Vb[ct][0] = pack8(vn[ct], 0); Vb[ct][1] = pack8(vn[ct], 1); }
#pragma unroll
    for (int ct = 0; ct < 2; ++ct)
#pragma unroll
      for (int ks = 0; ks < 4; ++ks) {
        bf16x8 a = ldfrag(QK + (ct * 4 + ks) * 64);
        o[ct] = MFMA32(a, Vb[ks >> 1][ks & 1], o[ct]);
      }
#pragma unroll
    for (int d = 0; d < 4; ++d) {
#pragma unroll
      for (int q = 0; q < 16; ++q) S[d][q] *= gl;
#pragma unroll
      for (int ks = 0; ks < 4; ++ks) {
        bf16x8 a = ldfrag(KD + (d * 4 + ks) * 64);
        S[d] = MFMA32(a, Vb[ks >> 1][ks & 1], S[d]);
      }
    }
    float* od = p.ODN + ((size_t)b * 2048 + n * 64) * 512 + hh * 128 + es * 32 + r;
#pragma unroll
    for (int ct = 0; ct < 2; ++ct)
#pragma unroll
      for (int q = 0; q < 16; ++q) od[(size_t)(ct * 32 + crow(q, hl)) * 512] = o[ct][q];
  }
  float* so = p.out + O_DELTAP + ((size_t)(b * 4 + hh) * 128) * 128 + es * 32 + r;
#pragma unroll
  for (int d = 0; d < 4; ++d)
#pragma unroll
    for (int q = 0; q < 16; ++q) so[(size_t)(d * 32 + crow(q, hl)) * 128] = S[d][q];
}

DI void phase_delta_post(const Params& p) {
  const int lane = threadIdx.x & 63, wid = threadIdx.x >> 6;
  for (int row = blockIdx.x * 4 + wid; row < NROW; row += gridDim.x * 4) {
#pragma unroll
    for (int hh = 0; hh < 4; ++hh) {
      int ch = hh * 128 + lane * 2;
      float2 o = *(const float2*)(p.ODN + (size_t)row * 512 + ch);
      float ss = wave_sum(o.x * o.x + o.y * o.y);
      float inv = rsqrtf(ss * (1.0f / 128.0f) + EPSF);
      float2 g = *(const float2*)(p.dn_norm_g + lane * 2);
      unsigned zu = *(const unsigned*)(p.PB + (size_t)row * EINP + 3072 + ch);
      float y0 = o.x * inv * g.x * siluf_(bflo(zu));
      float y1 = o.y * inv * g.y * siluf_(bfhi(zu));
      *(unsigned*)(p.MIX + (size_t)row * 1024 + 512 + ch) = pack2(y0, y1);
    }
  }
}

template <bool FIRST>
DI void phase_gemm_resid(const Params& p, const bfr* A, const bfr* Wt, char* smem) {
  float* X = p.X;
  const float* xp = p.x_prompt;
  const float* xs = p.x_sample;
  for (int t = blockIdx.x; t < 129 * 8; t += gridDim.x) {
    int mt = t >> 3, nt = t & 7;
    gemm_tile(A, 1024, Wt, 1024, 1024, mt * 128, nt * 128, smem,
              [=](int row, int col, float v) {
                size_t o = (size_t)row * 1024 + col;
                if (FIRST) X[o] = (row < NPR ? xp[o] : xs[o - (size_t)NPR * 1024]) + v;
                else X[o] += v;
              });
  }
}
DI void phase_gemm_bf16out(const Params& p, const bfr* A, const bfr* Wt, bfr* C, int N, char* smem) {
  const int ntn = N >> 7;
  for (int t = blockIdx.x; t < 129 * ntn; t += gridDim.x) {
    int mt = t / ntn, nt = t % ntn;
    gemm_tile(A, 1024, Wt, 1024, 1024, mt * 128, nt * 128, smem,
              [=](int row, int col, float v) { C[(size_t)row * N + col] = f2bf(v); });
  }
}

DI void attn_prompt_wave(const Params& p, int l, int b, int hh, int tt, bfr* Obuf) {
  const int lane = threadIdx.x & 63, r = lane & 31, hl = lane >> 5;
  const size_t row0 = (size_t)b * 2048 + tt * 32;
  const bfr* Qp = p.ACT2 + (row0 + r) * 1024 + hh * 256 + hl * 8;
  const bfr* Kp = p.KB + (size_t)l * 2097152 + ((size_t)b * 256 + r) * 1024 + hh * 256 + hl * 8;
  f32x16 st[8];
#pragma unroll
  for (int m = 0; m < 8; ++m)
#pragma unroll
    for (int q = 0; q < 16; ++q) st[m][q] = 0.f;
#pragma unroll 2
  for (int ks = 0; ks < 16; ++ks) {
    bf16x8 qf = *(const bf16x8*)(Qp + ks * 16);
#pragma unroll
    for (int m = 0; m < 8; ++m) {
      bf16x8 kf = *(const bf16x8*)(Kp + (size_t)m * 32 * 1024 + ks * 16);
      st[m] = MFMA32(kf, qf, st[m]);
    }
  }
  float mx = -3.0e38f;
#pragma unroll
  for (int m = 0; m < 8; ++m)
#pragma unroll
    for (int q = 0; q < 16; ++q) mx = fmaxf(mx, st[m][q]);
  mx = fmaxf(mx, __shfl_xor(mx, 32));
  float sum = 0.f;
#pragma unroll
  for (int m = 0; m < 8; ++m)
#pragma unroll
    for (int q = 0; q < 16; ++q) {
      float e = __expf((st[m][q] - mx) * 0.0625f);
      st[m][q] = e;
      sum += e;
    }
  sum += __shfl_xor(sum, 32);
  const float inv = 1.0f / sum;
  bf16x8 pb[8][2];
#pragma unroll
  for (int m = 0; m < 8; ++m) { pb[m][0] = pack8(st[m], 0); pb[m][1] = pack8(st[m], 1); }
  const uint4* VT = (const uint4*)(p.VT + (size_t)l * 2097152) + ((size_t)(b * 4 + hh) * 8) * 16 * 64 + lane;
  bfr* Op = Obuf + (row0 + r) * 1024 + hh * 256;
#pragma unroll 1
  for (int half = 0; half < 2; ++half) {
    f32x16 o[4];
#pragma unroll
    for (int d = 0; d < 4; ++d)
#pragma unroll
      for (int q = 0; q < 16; ++q) o[d][q] = 0.f;
#pragma unroll
    for (int ks = 0; ks < 16; ++ks) {
#pragma unroll
      for (int d = 0; d < 4; ++d) {
        bf16x8 vf = ldfrag(VT + ((size_t)(half * 4 + d) * 16 + ks) * 64);
        o[d] = MFMA32(vf, pb[ks >> 1][ks & 1], o[d]);
      }
    }
#pragma unroll
    for (int d = 0; d < 4; ++d)
#pragma unroll
      for (int g4 = 0; g4 < 4; ++g4) {
        int dim = (half * 4 + d) * 32 + 8 * g4 + 4 * hl;
        uint2 ov;
        ov.x = pack2(o[d][g4 * 4 + 0] * inv, o[d][g4 * 4 + 1] * inv);
        ov.y = pack2(o[d][g4 * 4 + 2] * inv, o[d][g4 * 4 + 3] * inv);
        *(uint2*)(Op + dim) = ov;
      }
  }
}

DI void attn_sample_item(const Params& p, int l, int item, char* smem, bfr* Obuf) {
  const int s = item >> 2, hh = item & 3, tid = threadIdx.x, lane = tid & 63, wid = tid >> 6;
  float* qsm = (float*)smem;
  float* sc = qsm + 256;
  float* red = sc + 256;
  const size_t row = NPR + s;
  qsm[tid] = bf2f(p.ACT2[row * 1024 + hh * 256 + tid]);
  __syncthreads();
  const int grp = lane >> 4, l16 = lane & 15;
  float4 q4[4];
#pragma unroll
  for (int j = 0; j < 4; ++j) q4[j] = ((const float4*)qsm)[j * 16 + l16];
  const float* Kb = p.cache_k + ((((size_t)l * 128 + s) * 256) * 4 + hh) * 256;
  const float* Vb = p.cache_v + ((((size_t)l * 128 + s) * 256) * 4 + hh) * 256;
#pragma unroll 4
  for (int ps = 0; ps < 16; ++ps) {
    int mem = wid * 64 + ps * 4 + grp;
    const float4* kr = (const float4*)(Kb + (size_t)mem * 1024);
    float d = 0.f;
#pragma unroll
    for (int j = 0; j < 4; ++j) {
      float4 k4 = kr[j * 16 + l16];
      d += k4.x * q4[j].x + k4.y * q4[j].y + k4.z * q4[j].z + k4.w * q4[j].w;
    }
    d += __shfl_xor(d, 8);
    d += __shfl_xor(d, 4);
    d += __shfl_xor(d, 2);
    d += __shfl_xor(d, 1);
    if (l16 == 0) sc[mem] = d * 0.0625f;
  }
  __syncthreads();
  float sv = sc[tid];
  float m = wave_max(sv);
  if (lane == 0) red[wid] = m;
  __syncthreads();
  m = fmaxf(fmaxf(red[0], red[1]), fmaxf(red[2], red[3]));
  float e = __expf(sv - m);
  float sm_ = wave_sum(e);
  if (lane == 0) red[4 + wid] = sm_;
  sc[tid] = e;
  __syncthreads();
  const float inv = 1.0f / (red[4] + red[5] + red[6] + red[7]);
  float acc = 0.f;
#pragma unroll 8
  for (int mem = 0; mem < 256; ++mem) acc += sc[mem] * Vb[(size_t)mem * 1024 + tid];
  Obuf[row * 1024 + hh * 256 + tid] = f2bf(acc * inv);
  __syncthreads();
}

DI void phase_attn(const Params& p, int l, char* smem) {
  bfr* Obuf = p.ACT3;
  for (int it = blockIdx.x; it < 1024; it += gridDim.x) {
    if (it < 512) {
      attn_sample_item(p, l, it, smem, Obuf);
    } else {
      int u = it - 512, tt4 = u & 15, hh = (u >> 4) & 3, b = u >> 6;
      attn_prompt_wave(p, l, b, hh, tt4 * 4 + (threadIdx.x >> 6), Obuf);
    }
  }
}

DI void phase_pool(const Params& p) {
  const bfr* P2 = p.PB;
  for (int idx = blockIdx.x * 256 + threadIdx.x; idx < NROW * 512; idx += gridDim.x * 256) {
    const int row = idx >> 9, c = (idx & 511) * 2;
    const int gi = c >> 8, win = 2 << gi;
    unsigned uu = *(const unsigned*)(P2 + (size_t)row * 2048 + c);
    const float u0 = bflo(uu), u1 = bfhi(uu);
    float s0 = u0, s1 = u1, cnt;
    if (row < NPR) {
      const int t = row & 2047, b = row >> 11;
      const int n = min(t + 1, win);
      cnt = (float)n;
      for (int j = 1; j < n; ++j) {
        unsigned w = *(const unsigned*)(P2 + (size_t)(row - j) * 2048 + c);
        s0 += bflo(w); s1 += bfhi(w);
      }
      if (t >= 2033) {
        float2 o = {u0, u1};
        *(float2*)(p.out + O_POOLP + ((size_t)b * 15 + (t - 2033)) * 1024 + c) = o;
      }
    } else {
      const int s = row - NPR;
      cnt = (float)win;
      const float* sp = p.state_pool + (size_t)s * 15 * 1024 + c;
      for (int j = 1; j < win; ++j) {
        float2 w = *(const float2*)(sp + (size_t)(15 - j) * 1024);
        s0 += w.x; s1 += w.y;
      }
      float* op = p.out + O_POOLS + (size_t)s * 15 * 1024 + c;
      for (int j = 0; j < 14; ++j) *(float2*)(op + (size_t)j * 1024) = *(const float2*)(sp + (size_t)(j + 1) * 1024);
      float2 o = {u0, u1};
      *(float2*)(op + (size_t)14 * 1024) = o;
    }
    *(unsigned*)(p.MIX + (size_t)row * 1024 + c) = pack2(s0 / cnt - u0, s1 / cnt - u1);
  }
}

DI void phase_gemm_pool(const Params& p, char* smem) {
  const bfr* P2 = p.PB;
  bfr* Z = p.ACT3;
  for (int t = blockIdx.x; t < 129 * 8; t += gridDim.x) {
    int mt = t >> 3, g = (t >> 1) & 3, nt = t & 1;
    const float* bp = p.b_pool + g * 256;
    const float* sc = p.pool_scale + g * 256;
    gemm_tile(p.MIX + g * 256, 1024, p.WtPool + (size_t)g * 65536, 256, 256, mt * 128, nt * 128, smem,
              [=](int row, int col, float v) {
                float gate = bf2f(P2[(size_t)row * 2048 + 1024 + g * 256 + col]);
                float z = (v + bp[col]) * sc[col] * siluf_(gate);
                Z[(size_t)row * 1024 + g * 256 + col] = f2bf(z);
              });
  }
}

#ifndef ONLY_PHASE
#define ONLY_PHASE -1
#endif
#define PON(n) (ONLY_PHASE < 0 || ONLY_PHASE == (n))
__global__ void __launch_bounds__(256, 2) mega(Params p) {
  __shared__ __attribute__((aligned(16))) char smem[65536];
  cg::grid_group grid = cg::this_grid();
  if (p.phase_lo < -1000) grid.sync();
  volatile LAS unsigned* xst = (volatile LAS unsigned*)(smem + 65520);
  if (threadIdx.x < 4) xst[threadIdx.x] = 0u;
  __syncthreads();
  XcdBarrier xb = xcd_barrier_post(p.bar, xst);
#ifndef DUPMASK
#define DUPMASK 0
#endif
#define RUN(n, call) do { if (PON(n) && p.phase_lo <= (n) && (n) <= p.phase_hi) { call; if ((DUPMASK >> (n)) & 1) { xcd_barrier(xb); call; } } if (p.phase_lo <= (n) && (n) < p.phase_hi) xcd_barrier(xb); } while (0)
  RUN(0, phase_prep(p, smem));
  RUN(1, phase_gemm_in_even(p, smem));
  RUN(2, phase_even_pointwise(p, smem));
  RUN(3, phase_chunk_prep(p, smem));
  RUN(4, for (int it = blockIdx.x; it < 32; it += gridDim.x) scan_item(p, it));
  RUN(5, phase_delta_post(p));
  RUN(6, phase_gemm_resid<true>(p, p.MIX, p.WtOutE, smem));
  RUN(7, phase_rmsnorm(p, p.norm_xattn));
  RUN(8, phase_gemm_bf16out(p, p.H, p.WtXq, p.ACT2, 1024, smem));
  RUN(9, phase_attn(p, 0, smem));
  RUN(10, phase_gemm_resid<false>(p, p.ACT3, p.WtXo, smem));
  RUN(11, phase_rmsnorm(p, p.norm_mix + 1024));
  RUN(12, phase_gemm_bf16out(p, p.H, p.WtInO, p.PB, 2048, smem));
  RUN(13, phase_pool(p));
  RUN(14, phase_gemm_pool(p, smem));
  RUN(15, phase_gemm_resid<false>(p, p.ACT3, p.WtOutO, smem));
  RUN(16, phase_rmsnorm(p, p.norm_xattn + 1024));
  RUN(17, phase_gemm_bf16out(p, p.H, p.WtXq + 1048576, p.ACT2, 1024, smem));
  RUN(18, phase_attn(p, 1, smem));
  RUN(19, phase_gemm_resid<false>(p, p.ACT3, p.WtXo + 1048576, smem));
  RUN(20, phase_final_norm(p));
}

extern "C" void kernel_launch(void* const* d_in, const int* in_sizes, int n_in, void* d_out, int out_size, void* d_ws,
                              size_t ws_size, hipStream_t stream) {
  static int grid_blocks = 0;
  if (!grid_blocks) {
    int dev = 0, cus = 0, per_cu = 0;
    hipGetDevice(&dev);
    hipDeviceGetAttribute(&cus, hipDeviceAttributeMultiprocessorCount, dev);
    hipOccupancyMaxActiveBlocksPerMultiprocessor(&per_cu, mega, 256, 0);
    if (per_cu < 1) per_cu = 1;
    if (per_cu > 2) per_cu = 2;
    grid_blocks = cus * per_cu;
  }
  Params p{};
  const float** ins = (const float**)&p.x_prompt;
  for (int i = 0; i < 31; ++i) ins[i] = (const float*)d_in[i];
  p.out = (float*)d_out;
  char* w = (char*)d_ws;
  size_t off = 0;
  auto take = [&](size_t bytes) { char* r = w + off; off += (bytes + 255) & ~(size_t)255; return r; };
  p.X = (float*)take((size_t)NROW * 1024 * 4);
  p.QKV = (float*)take((size_t)NROW * 1536 * 4);
  p.BGR = (float*)take((size_t)NROW * 8 * 4);
  p.BG = (float*)take((size_t)NROW * 8 * 4);
  p.CONV = (float*)take((size_t)NROW * 512 * 4);
  p.ODN = (float*)take((size_t)NROW * 512 * 4);
  p.U = (float*)take((size_t)1024 * 8192 * 4);
  p.GL = (float*)take(4096);
  p.H = (bfr*)take((size_t)NROW * 1024 * 2);
  p.PB = (bfr*)take((size_t)NROW * 3584 * 2);
  p.MIX = (bfr*)take((size_t)NROW * 1024 * 2);
  p.ACT2 = (bfr*)take((size_t)NROW * 1024 * 2);
  p.ACT3 = (bfr*)take((size_t)NROW * 1024 * 2);
  p.KB = (bfr*)take((size_t)2 * 2048 * 1024 * 2);
  p.VT = (bfr*)take((size_t)2 * 2048 * 1024 * 2);
  p.MPB = (bfr*)take((size_t)2048 * 1024 * 2);
  p.WtInE = (bfr*)take((size_t)3712 * 1024 * 2);
  p.WtOutE = (bfr*)take((size_t)1024 * 1024 * 2);
  p.WtInO = (bfr*)take((size_t)2048 * 1024 * 2);
  p.WtPool = (bfr*)take((size_t)4 * 256 * 256 * 2);
  p.WtOutO = (bfr*)take((size_t)1024 * 1024 * 2);
  p.WtXq = (bfr*)take((size_t)2 * 1024 * 1024 * 2);
  p.WtXk = (bfr*)take((size_t)2 * 1024 * 1024 * 2);
  p.WtXv = (bfr*)take((size_t)2 * 1024 * 1024 * 2);
  p.WtXo = (bfr*)take((size_t)2 * 1024 * 1024 * 2);
  p.WN = (uint4*)take((size_t)1024 * 1024 * 16);
  p.QD = (uint4*)take((size_t)1024 * 1024 * 16);
  p.KD = (uint4*)take((size_t)1024 * 1024 * 16);
  p.QKF = (uint4*)take((size_t)1024 * 512 * 16);
  p.bar = (unsigned*)take((size_t)XCD_BAR_WORDS * 4);
  if (off > ws_size) {
    fprintf(stderr, "kernel_launch: workspace too small: need %zu have %zu\n", off, ws_size);
    return;
  }
  p.phase_lo = 0;
  p.phase_hi = 20;
  if (hipMemsetAsync(p.bar, 0, (size_t)XCD_BAR_WORDS * 4, stream) != hipSuccess) { fprintf(stderr, "memset failed\n"); return; }
  void* args[] = {&p};
  hipError_t e = hipLaunchCooperativeKernel((void*)mega, dim3(grid_blocks), dim3(256), args, 0, stream);
  if (e != hipSuccess) fprintf(stderr, "cooperative launch failed: %s (grid %d)\n", hipGetErrorString(e), grid_blocks);
}
```

```cpp
#include <hip/hip_runtime.h>
#include <hip/hip_cooperative_groups.h>
#include <cstdio>
namespace cg = cooperative_groups;

#define DI __device__ __forceinline__
typedef unsigned short bfr;
using bf16x8 = __attribute__((ext_vector_type(8))) short;
using f32x16 = __attribute__((ext_vector_type(16))) float;
typedef __bf16 bf2_t __attribute__((ext_vector_type(2)));
typedef float fl2_t __attribute__((ext_vector_type(2)));
typedef unsigned u32x4 __attribute__((ext_vector_type(4)));
#define MFMA32(a, b, c) __builtin_amdgcn_mfma_f32_32x32x16_bf16((a), (b), (c), 0, 0, 0)

constexpr int NROW = 16512;
constexpr int NPR = 16384;
constexpr int DM = 1024;
constexpr int EIN = 3592, EINP = 3584;
constexpr float EPSF = 1e-6f;

constexpr size_t O_Y = 0;
constexpr size_t O_CONVP = 16777216 + 131072;
constexpr size_t O_QKVP = O_CONVP + 122880;
constexpr size_t O_DELTAP = O_QKVP + 36864;
constexpr size_t O_POOLP = O_DELTAP + 524288;
constexpr size_t O_MEMK = O_POOLP + 122880;
constexpr size_t O_MEMV = O_MEMK + 4194304;
constexpr size_t O_CONVS = O_MEMV + 4194304;
constexpr size_t O_QKVS = O_CONVS + 1966080;
constexpr size_t O_DELTAS = O_QKVS + 589824;
constexpr size_t O_POOLS = O_DELTAS + 8388608;

struct Params {
  const float *x_prompt, *x_sample, *state_conv_a, *state_qkv_conv, *state_delta, *state_pool, *cache_k, *cache_v, *mem_prompt;
  const float *norm_mix, *norm_xattn, *norm_final, *w_in_even, *w_out_even, *dw_w, *dw_b, *ln_a_g, *ln_a_b, *sc_w, *a_log,
      *dt_bias, *dn_norm_g, *w_in_odd, *w_pool, *b_pool, *pool_scale, *w_out_odd, *w_xq, *w_xk, *w_xv, *w_xo;
  float* out;
  float *X, *QKV, *BGR, *BG, *CONV, *ODN, *U, *GL, *SS;
  bfr *H, *PB, *MIX, *ACT2, *ACT3, *KB, *VT, *MPB;
  bfr *WtInE, *WtOutE, *WtInO, *WtPool, *WtOutO, *WtXq, *WtXk, *WtXv, *WtXo;
  uint4 *WN, *QD, *KD, *QKF;
  unsigned* bar;
  int phase_lo, phase_hi;
};

DI unsigned pack2(float a, float b) {
  fl2_t f = {a, b};
  bf2_t r = __builtin_convertvector(f, bf2_t);
  return __builtin_bit_cast(unsigned, r);
}
DI bfr f2bf(float a) { return (bfr)(pack2(a, 0.f) & 0xffffu); }
DI float bf2f(bfr u) { return __uint_as_float(((unsigned)u) << 16); }
DI float bflo(unsigned u) { return __uint_as_float(u << 16); }
DI float bfhi(unsigned u) { return __uint_as_float(u & 0xffff0000u); }
DI float sigmoidf_(float x) { return 1.0f / (1.0f + __expf(-x)); }
DI float siluf_(float x) { return x / (1.0f + __expf(-x)); }
DI float wave_sum(float v) {
#pragma unroll
  for (int o = 32; o >= 1; o >>= 1) v += __shfl_xor(v, o);
  return v;
}
DI float wave_max(float v) {
#pragma unroll
  for (int o = 32; o >= 1; o >>= 1) v = fmaxf(v, __shfl_xor(v, o));
  return v;
}
DI int crow(int reg, int h) { return (reg & 3) + 8 * (reg >> 2) + 4 * h; }
DI bf16x8 pack8(const f32x16& x, int s) {
  uint4 p;
  p.x = pack2(x[8 * s + 0], x[8 * s + 1]);
  p.y = pack2(x[8 * s + 2], x[8 * s + 3]);
  p.z = pack2(x[8 * s + 4], x[8 * s + 5]);
  p.w = pack2(x[8 * s + 6], x[8 * s + 7]);
  return __builtin_bit_cast(bf16x8, p);
}
DI bf16x8 ldfrag(const uint4* p) { uint4 v = *p; return __builtin_bit_cast(bf16x8, v); }


#define XB_TMO      128
#define XB_XCNT(j)  (256  + 64 * (j))
#define XB_XSUB(j)  (1280 + 64 * (j))
#define XB_XGEN(j)  (2304 + 64 * (j))
#define XB_TOP      3328
#define XB_TOPGEN   3392
#define XCD_BAR_WORDS 3456
#define XB_SPIN_CAP (1u << 18)
#define LAS __attribute__((address_space(3)))
DI unsigned xb_ld(unsigned* p) { return __hip_atomic_load(p, __ATOMIC_RELAXED, __HIP_MEMORY_SCOPE_AGENT); }
DI unsigned xb_add(unsigned* p, unsigned v) { return __hip_atomic_fetch_add(p, v, __ATOMIC_RELAXED, __HIP_MEMORY_SCOPE_AGENT); }
DI unsigned xb_xcc_id() { return (unsigned)__builtin_amdgcn_s_getreg((3 << 11) | 20) & 0xFu; }
#define XB_SPIN(cond, bar) do { unsigned _sp = 0; while (cond) { __builtin_amdgcn_s_sleep(1); \
    if ((++_sp & 255u) == 0u) { if (xb_ld(&(bar)[XB_TMO])) break; if (_sp > XB_SPIN_CAP) { atomicAdd(&(bar)[XB_TMO], 1u); break; } } } } while (0)
struct XcdBarrier { unsigned* bar; unsigned x; volatile LAS unsigned* st; };
DI XcdBarrier xcd_barrier_post(unsigned* bar, volatile LAS unsigned* st) {
  XcdBarrier b; b.bar = bar; b.x = xb_xcc_id(); b.st = st;
  if (threadIdx.x == 0) (void)xb_add(&bar[XB_XCNT(b.x)], 1u);
  return b;
}
DI void xcd_barrier_complete(unsigned* bar, unsigned x, unsigned& nloc, unsigned& nx) {
  const unsigned G = gridDim.x * gridDim.y * gridDim.z;
  unsigned sum, cnt, mine, sp = 0u;
  for (;;) {
    sum = 0u; cnt = 0u; mine = 0u;
#pragma unroll
    for (unsigned j = 0; j < 16; ++j) { const unsigned c = xb_ld(&bar[XB_XCNT(j)]); sum += c; cnt += (c > 0u) ? 1u : 0u; mine = (j == x) ? c : mine; }
    if (sum == G) break;
    __builtin_amdgcn_s_sleep(1);
    if ((++sp & 255u) == 0u) { if (xb_ld(&bar[XB_TMO])) break; if (sp > XB_SPIN_CAP) { atomicAdd(&bar[XB_TMO], 1u); break; } }
  }
  nloc = mine > 0u ? mine : 1u; nx = cnt > 0u ? cnt : 1u;
}
DI void xcd_barrier(const XcdBarrier& b) {
  asm volatile("s_waitcnt vmcnt(0)" ::: "memory");
  __syncthreads();
  if (threadIdx.x == 0) {
    unsigned* bar = b.bar;
    __builtin_amdgcn_s_waitcnt(0);
    unsigned nloc = b.st[0], nx = b.st[1];
    if (nloc == 0u) { xcd_barrier_complete(bar, b.x, nloc, nx); b.st[0] = nloc; b.st[1] = nx; }
    const unsigned old = xb_add(&bar[XB_XSUB(b.x)], 1u);
    const unsigned gen = old / nloc;
    if (old + 1u == (gen + 1u) * nloc) {
      __builtin_amdgcn_fence(__ATOMIC_RELEASE, "agent");
      asm volatile("s_waitcnt vmcnt(0)" ::: "memory");
      const unsigned og = xb_add(&bar[XB_TOP], 1u);
      const unsigned tg = og / nx;
      if (og + 1u == (tg + 1u) * nx) xb_add(&bar[XB_TOPGEN], 1u);
      else XB_SPIN(xb_ld(&bar[XB_TOPGEN]) == tg, bar);
      __builtin_amdgcn_fence(__ATOMIC_ACQUIRE, "agent");
      xb_add(&bar[XB_XGEN(b.x)], 1u);
      asm volatile("s_waitcnt vmcnt(0)" ::: "memory");
    } else {
      XB_SPIN(xb_ld(&bar[XB_XGEN(b.x)]) == gen, bar);
      __builtin_amdgcn_fence(__ATOMIC_ACQUIRE, "agent");
      asm volatile("s_waitcnt vmcnt(0)" ::: "memory");
    }
  }
  __syncthreads();
}

DI void gemm_mainloop(const bfr* __restrict__ A, int lda, const bfr* __restrict__ Bt, int ldb, int K, int m0, int n0, char* smem, f32x16 (&acc)[2][2]) {
  bfr* As = (bfr*)smem;
  bfr* Bs = As + 128 * 72;
  const int tid = threadIdx.x, lane = tid & 63, wid = tid >> 6, wr = wid >> 1, wc = wid & 1;
  const int r = lane & 31, hl = lane >> 5;
#pragma unroll
  for (int i = 0; i < 2; ++i)
#pragma unroll
    for (int j = 0; j < 2; ++j)
#pragma unroll
      for (int q = 0; q < 16; ++q) acc[i][j][q] = 0.f;
  u32x4 ra[4], rb[4];
  const int nk = K >> 6;
  const bfr* Ab = A + (size_t)m0 * lda;
  const bfr* Bb = Bt + (size_t)n0 * ldb;
#pragma unroll
  for (int i = 0; i < 4; ++i) {
    int chunk = tid + i * 256, row = chunk >> 3, c8 = chunk & 7;
    ra[i] = *(const u32x4*)(Ab + (size_t)row * lda + c8 * 8);
    rb[i] = *(const u32x4*)(Bb + (size_t)row * ldb + c8 * 8);
  }
  for (int kt = 0; kt < nk; ++kt) {
    __syncthreads();
#pragma unroll
    for (int i = 0; i < 4; ++i) {
      int chunk = tid + i * 256, row = chunk >> 3, c8 = chunk & 7;
      *(u32x4*)(As + row * 72 + c8 * 8) = ra[i];
      *(u32x4*)(Bs + row * 72 + c8 * 8) = rb[i];
    }
    __syncthreads();
    if (kt + 1 < nk) {
#pragma unroll
      for (int i = 0; i < 4; ++i) {
        int chunk = tid + i * 256, row = chunk >> 3, c8 = chunk & 7;
        ra[i] = *(const u32x4*)(Ab + (size_t)row * lda + (kt + 1) * 64 + c8 * 8);
        rb[i] = *(const u32x4*)(Bb + (size_t)row * ldb + (kt + 1) * 64 + c8 * 8);
      }
    }
#pragma unroll
    for (int ks = 0; ks < 4; ++ks) {
      bf16x8 af[2], bfg[2];
#pragma unroll
      for (int i = 0; i < 2; ++i) {
        af[i] = *(const bf16x8*)(As + (wr * 64 + i * 32 + r) * 72 + ks * 16 + hl * 8);
        bfg[i] = *(const bf16x8*)(Bs + (wc * 64 + i * 32 + r) * 72 + ks * 16 + hl * 8);
      }
#pragma unroll
      for (int i = 0; i < 2; ++i)
#pragma unroll
        for (int j = 0; j < 2; ++j) acc[i][j] = MFMA32(af[i], bfg[j], acc[i][j]);
    }
  }
}

template <class Epi>
DI void gemm_tile(const bfr* __restrict__ A, int lda, const bfr* __restrict__ Bt, int ldb, int K, int m0, int n0, char* smem, Epi epi) {
  f32x16 acc[2][2];
  gemm_mainloop(A, lda, Bt, ldb, K, m0, n0, smem, acc);
  const int lane = threadIdx.x & 63, wid = threadIdx.x >> 6, wr = wid >> 1, wc = wid & 1, r = lane & 31, hl = lane >> 5;
#pragma unroll
  for (int i = 0; i < 2; ++i)
#pragma unroll
    for (int j = 0; j < 2; ++j)
#pragma unroll
      for (int q = 0; q < 16; ++q) {
        int row = m0 + wr * 64 + i * 32 + crow(q, hl);
        int col = n0 + wc * 64 + j * 32 + r;
        epi(row, col, acc[i][j][q]);
      }
  __syncthreads();
}
template <class Epi, class RowF>
DI void gemm_tile_rs(const bfr* __restrict__ A, int lda, const bfr* __restrict__ Bt, int ldb, int K, int m0, int n0, char* smem, Epi epi, RowF rowf) {
  f32x16 acc[2][2];
  gemm_mainloop(A, lda, Bt, ldb, K, m0, n0, smem, acc);
  const int lane = threadIdx.x & 63, wid = threadIdx.x >> 6, wr = wid >> 1, wc = wid & 1, r = lane & 31, hl = lane >> 5;
#pragma unroll
  for (int i = 0; i < 2; ++i)
#pragma unroll
    for (int q = 0; q < 16; ++q) {
      int row = m0 + wr * 64 + i * 32 + crow(q, hl);
      float rs = 0.f;
#pragma unroll
      for (int j = 0; j < 2; ++j) {
        int col = n0 + wc * 64 + j * 32 + r;
        float v = epi(row, col, acc[i][j][q]);
        rs += v * v;
      }
      rs += __shfl_xor(rs, 16);
      rs += __shfl_xor(rs, 8);
      rs += __shfl_xor(rs, 4);
      rs += __shfl_xor(rs, 2);
      rs += __shfl_xor(rs, 1);
      if (r == 0) rowf(row, rs);
    }
  __syncthreads();
}

template <bool RS, class Epi, class RowF>
DI void gemm_sample(const bfr* __restrict__ A, int lda, const bfr* __restrict__ Bt, int ldb, int K, int N, char* smem, Epi epi, RowF rowf) {
  const int tid = threadIdx.x, lane = tid & 63, wid = tid >> 6, r = lane & 31, hl = lane >> 5;
  float* red = (float*)smem;
  const int nun = 4 * (N >> 5);
  for (int u = blockIdx.x; u < nun; u += gridDim.x) {
    const int mu = u & 3, nu = u >> 2;
    const int kq = K >> 2, k0 = wid * kq;
    const bfr* ap = A + (size_t)(NPR + mu * 32 + r) * lda + k0 + hl * 8;
    const bfr* bp = Bt + (size_t)(nu * 32 + r) * ldb + k0 + hl * 8;
    f32x16 acc;
#pragma unroll
    for (int q = 0; q < 16; ++q) acc[q] = 0.f;
    if (K == 1024) {
#pragma unroll
      for (int ks = 0; ks < 16; ++ks) {
        bf16x8 af = *(const bf16x8*)(ap + ks * 16);
        bf16x8 bf = *(const bf16x8*)(bp + ks * 16);
        acc = MFMA32(af, bf, acc);
      }
    } else {
      for (int ks = 0; ks < (kq >> 4); ++ks) {
        bf16x8 af = *(const bf16x8*)(ap + ks * 16);
        bf16x8 bf = *(const bf16x8*)(bp + ks * 16);
        acc = MFMA32(af, bf, acc);
      }
    }
#pragma unroll
    for (int q = 0; q < 16; ++q) red[(wid * 16 + q) * 64 + lane] = acc[q];
    __syncthreads();
#pragma unroll
    for (int e = 0; e < 4; ++e) {
      const int q = wid + e * 4;
      const float v = red[q * 64 + lane] + red[(16 + q) * 64 + lane] + red[(32 + q) * 64 + lane] + red[(48 + q) * 64 + lane];
      const int row = NPR + mu * 32 + crow(q, hl), col = nu * 32 + r;
      float x = epi(row, col, v);
      if (RS) {
        float s2 = x * x;
        s2 += __shfl_xor(s2, 16);
        s2 += __shfl_xor(s2, 8);
        s2 += __shfl_xor(s2, 4);
        s2 += __shfl_xor(s2, 2);
        s2 += __shfl_xor(s2, 1);
        if (r == 0) rowf(row, s2);
      }
    }
    __syncthreads();
  }
}

DI void transpose_tile(const float* __restrict__ W, int ldw, bfr* __restrict__ Wt, int ldt, int k0, int n0, float* sm, int nvalid = 1 << 30) {
  const int tid = threadIdx.x;
#pragma unroll
  for (int i = 0; i < 16; ++i) {
    int idx = tid + i * 256, kk = idx >> 6, nn = idx & 63;
    sm[kk * 65 + nn] = (n0 + nn < nvalid) ? W[(size_t)(k0 + kk) * ldw + n0 + nn] : 0.f;
  }
  __syncthreads();
#pragma unroll
  for (int i = 0; i < 8; ++i) {
    int idx = tid + i * 256, nn = idx >> 5, kp = idx & 31;
    float a = sm[(2 * kp) * 65 + nn], b = sm[(2 * kp + 1) * 65 + nn];
    *(unsigned*)(Wt + (size_t)(n0 + nn) * ldt + k0 + 2 * kp) = pack2(a, b);
  }
  __syncthreads();
}

DI void phase_prep(const Params& p, char* smem) {
  float* sm = (float*)smem;
  for (int tt = blockIdx.x; tt < 4032 + 32; tt += gridDim.x) {
    int t = tt - 32;
    if (tt < 928) {
      int kt = tt / 58, nt = tt % 58;
      transpose_tile(p.w_in_even, EIN, p.WtInE, 1024, kt * 64, nt * 64, sm, EIN);
    } else if (t < 1152) {
      int u = t - 896;
      transpose_tile(p.w_out_even, 1024, p.WtOutE, 1024, (u >> 4) * 64, (u & 15) * 64, sm);
    } else if (t < 1664) {
      int u = t - 1152;
      transpose_tile(p.w_in_odd, 2048, p.WtInO, 1024, (u >> 5) * 64, (u & 31) * 64, sm);
    } else if (t < 1728) {
      int u = t - 1664, g = u >> 4, v = u & 15;
      transpose_tile(p.w_pool + (size_t)g * 65536, 256, p.WtPool + (size_t)g * 65536, 256, (v >> 2) * 64, (v & 3) * 64, sm);
    } else if (t < 1984) {
      int u = t - 1728;
      transpose_tile(p.w_out_odd, 1024, p.WtOutO, 1024, (u >> 4) * 64, (u & 15) * 64, sm);
    } else {
      int u = t - 1984, m = u >> 8, v = u & 255;
      int which = m >> 1, l = m & 1;
      const float* src = (which == 0 ? p.w_xq : which == 1 ? p.w_xk : which == 2 ? p.w_xv : p.w_xo) + (size_t)l * 1048576;
      bfr* dst = (which == 0 ? p.WtXq : which == 1 ? p.WtXk : which == 2 ? p.WtXv : p.WtXo) + (size_t)l * 1048576;
      transpose_tile(src, 1024, dst, 1024, (v >> 4) * 64, (v & 15) * 64, sm);
    }
  }
  {
    for (int i = blockIdx.x * 256 + threadIdx.x; i < 4 * NROW; i += gridDim.x * 256) p.SS[i] = 0.f;
    const int n4 = 2048 * 1024 / 4;
    for (int i = blockIdx.x * 256 + threadIdx.x; i < n4; i += gridDim.x * 256) {
      float4 v = ((const float4*)p.mem_prompt)[i];
      uint2 o;
      o.x = pack2(v.x, v.y);
      o.y = pack2(v.z, v.w);
      ((uint2*)p.MPB)[i] = o;
    }
  }
  {
    const int lane = threadIdx.x & 63, wid = threadIdx.x >> 6;
    float* wT = (float*)smem;
    for (int i = threadIdx.x; i < 2048; i += 256) {
      const int k = i >> 1, hf = i & 1;
      float4 w = *(const float4*)(p.w_in_even + (size_t)k * EIN + EINP + hf * 4);
      wT[(hf * 4 + 0) * 1024 + k] = w.x; wT[(hf * 4 + 1) * 1024 + k] = w.y;
      wT[(hf * 4 + 2) * 1024 + k] = w.z; wT[(hf * 4 + 3) * 1024 + k] = w.w;
    }
    __syncthreads();
    for (int row = blockIdx.x * 4 + wid; row < NROW; row += gridDim.x * 4) {
      const float* xr = row < NPR ? p.x_prompt + (size_t)row * DM : p.x_sample + (size_t)(row - NPR) * DM;
      float4 v[4];
      float ss = 0.f;
#pragma unroll
      for (int j = 0; j < 4; ++j) {
        v[j] = ((const float4*)xr)[j * 64 + lane];
        ss += v[j].x * v[j].x + v[j].y * v[j].y + v[j].z * v[j].z + v[j].w * v[j].w;
      }
      ss = wave_sum(ss);
      float inv = rsqrtf(ss * (1.0f / 1024.0f) + EPSF);
      float part[8];
#pragma unroll
      for (int c = 0; c < 8; ++c) part[c] = 0.f;
#pragma unroll
      for (int j = 0; j < 4; ++j) {
        float4 g = ((const float4*)p.norm_mix)[j * 64 + lane];
        uint2 o;
        const float h0 = v[j].x * inv * g.x, h1 = v[j].y * inv * g.y, h2 = v[j].z * inv * g.z, h3 = v[j].w * inv * g.w;
        o.x = pack2(h0, h1);
        o.y = pack2(h2, h3);
        ((uint2*)(p.H + (size_t)row * DM))[j * 64 + lane] = o;
#pragma unroll
        for (int c = 0; c < 8; ++c) {
          float4 w = ((const float4*)(wT + c * 1024))[j * 64 + lane];
          part[c] += h0 * w.x + h1 * w.y + h2 * w.z + h3 * w.w;
        }
      }
#pragma unroll
      for (int c = 0; c < 8; ++c) part[c] = wave_sum(part[c]);
      if (lane == 0) {
        float4 a = {part[0], part[1], part[2], part[3]}, b = {part[4], part[5], part[6], part[7]};
        ((float4*)(p.BGR + (size_t)row * 8))[0] = a;
        ((float4*)(p.BGR + (size_t)row * 8))[1] = b;
      }
    }
    __syncthreads();
  }
}

DI void phase_rmsnorm(const Params& p, const float* g) {
  const int lane = threadIdx.x & 63, wid = threadIdx.x >> 6;
  for (int row = blockIdx.x * 4 + wid; row < NROW; row += gridDim.x * 4) {
    const float* xr = p.X + (size_t)row * DM;
    float4 v[4];
    float ss = 0.f;
#pragma unroll
    for (int j = 0; j < 4; ++j) {
      v[j] = ((const float4*)xr)[j * 64 + lane];
      ss += v[j].x * v[j].x + v[j].y * v[j].y + v[j].z * v[j].z + v[j].w * v[j].w;
    }
    ss = wave_sum(ss);
    float inv = rsqrtf(ss * (1.0f / 1024.0f) + EPSF);
#pragma unroll
    for (int j = 0; j < 4; ++j) {
      float4 gg = ((const float4*)g)[j * 64 + lane];
      uint2 o;
      o.x = pack2(v[j].x * inv * gg.x, v[j].y * inv * gg.y);
      o.y = pack2(v[j].z * inv * gg.z, v[j].w * inv * gg.w);
      ((uint2*)(p.H + (size_t)row * DM))[j * 64 + lane] = o;
    }
  }
}

DI void phase_final_norm(const Params& p) {
  const float* ss = p.SS + 3 * NROW;
  for (int i = blockIdx.x * 256 + threadIdx.x; i < NROW * 256; i += gridDim.x * 256) {
    const int row = i >> 8, c4 = i & 255;
    float4 v = ((const float4*)p.X)[i];
    float4 g = ((const float4*)p.norm_final)[c4];
    const float inv = rsqrtf(ss[row] * (1.0f / 1024.0f) + EPSF);
    float4 o = {v.x * inv * g.x, v.y * inv * g.y, v.z * inv * g.z, v.w * inv * g.w};
    ((float4*)(p.out + O_Y))[i] = o;
  }
}

DI void phase_gemm_in_even(const Params& p, char* smem) {
  const int NT1 = 128 * 28, NT2 = 4 * 128;
  {
    bfr* PB = p.PB;
    gemm_sample<false>(p.H, 1024, p.WtInE, 1024, 1024, EINP, smem,
                       [=](int row, int col, float v) -> float { PB[(size_t)row * EINP + col] = f2bf(v); return 0.f; },
                       [=](int, float) {});
  }
  for (int t = blockIdx.x; t < NT1 + NT2; t += gridDim.x) {
    if (t < NT1) {
      int mt = t / 28, nt = t % 28;
      bfr* PB = p.PB;
      gemm_tile(p.H, 1024, p.WtInE, 1024, 1024, mt * 128, nt * 128, smem,
                [=](int row, int col, float v) { PB[(size_t)row * EINP + col] = f2bf(v); });
    } else {
      int u = t - NT1, gsel = u >> 7, v = u & 127, mt = v >> 3, nt = v & 7;
      int isv = gsel >> 1, l = gsel & 1;
      if (!isv) {
        float* o = p.out + O_MEMK + (size_t)l * 2097152;
        bfr* kb = p.KB + (size_t)l * 2097152;
        gemm_tile(p.MPB, 1024, p.WtXk + (size_t)l * 1048576, 1024, 1024, mt * 128, nt * 128, smem,
                  [=](int row, int col, float v) {
                    o[(size_t)row * 1024 + col] = v;
                    kb[(size_t)row * 1024 + col] = f2bf(v);
                  });
      } else {
        float* o = p.out + O_MEMV + (size_t)l * 2097152;
        bfr* vt = p.VT + (size_t)l * 2097152;
        gemm_tile(p.MPB, 1024, p.WtXv + (size_t)l * 1048576, 1024, 1024, mt * 128, nt * 128, smem,
                  [=](int row, int col, float v) {
                    o[(size_t)row * 1024 + col] = v;
                    int b = row >> 8, mem = row & 255, h = col >> 8, dim = col & 255;
                    int ks = mem >> 4, ml = mem & 15, hl2 = (ml >> 2) & 1, j = ((ml >> 3) << 2) | (ml & 3);
                    int dt = dim >> 5, rr = dim & 31;
                    size_t off = ((((size_t)(b * 4 + h) * 8 + dt) * 16 + ks) * 64 + hl2 * 32 + rr) * 8 + j;
                    vt[off] = f2bf(v);
                  });
      }
    }
  }
}

template <bool IS_P, bool EDGE>
DI void qkv_token(const Params& p, int row, int lane) {
  const int t = row & 2047, b = row >> 11, s = row - NPR;
#pragma unroll 6
  for (int grp = 0; grp < 12; ++grp) {
    const int ch = grp * 128 + lane * 2;
    float x0[4], x1[4];
    if (IS_P) {
      unsigned u[4];
#pragma unroll
      for (int j = 0; j < 4; ++j) {
        const int rc = (!EDGE || t - 3 + j >= 0) ? (row - 3 + j) : row;
        u[j] = *(const unsigned*)(p.PB + (size_t)rc * EINP + 1536 + ch);
      }
#pragma unroll
      for (int j = 0; j < 4; ++j) {
        const bool ok = (!EDGE || t - 3 + j >= 0);
        x0[j] = ok ? bflo(u[j]) : 0.f;
        x1[j] = ok ? bfhi(u[j]) : 0.f;
      }
    } else {
#pragma unroll
      for (int j = 0; j < 3; ++j) {
        float2 f = *(const float2*)(p.state_qkv_conv + ((size_t)s * 3 + j) * 1536 + ch);
        x0[j] = f.x; x1[j] = f.y;
      }
      unsigned u = *(const unsigned*)(p.PB + (size_t)row * EINP + 1536 + ch);
      x0[3] = bflo(u); x1[3] = bfhi(u);
    }
    float a0 = 0.f, a1 = 0.f;
#pragma unroll
    for (int j = 0; j < 4; ++j) {
      float2 w = *(const float2*)(p.sc_w + (size_t)j * 1536 + ch);
      a0 += w.x * x0[j]; a1 += w.y * x1[j];
    }
    float y0 = siluf_(a0), y1 = siluf_(a1);
    if (grp < 8) {
      float ss = wave_sum(y0 * y0 + y1 * y1);
      float inv = rsqrtf(ss + EPSF);
      if (grp < 4) inv *= 0.08838834764831845f;
      y0 *= inv; y1 *= inv;
    }
    float2 o = {y0, y1};
    *(float2*)(p.QKV + (size_t)row * 1536 + ch) = o;
    if (IS_P) {
      if (t >= 2045) {
        float2 c = {x0[3], x1[3]};
        *(float2*)(p.out + O_QKVP + ((size_t)b * 3 + (t - 2045)) * 1536 + ch) = c;
      }
    } else {
      float2 c0 = {x0[1], x1[1]}, c1 = {x0[2], x1[2]}, c2 = {x0[3], x1[3]};
      *(float2*)(p.out + O_QKVS + ((size_t)s * 3 + 0) * 1536 + ch) = c0;
      *(float2*)(p.out + O_QKVS + ((size_t)s * 3 + 1) * 1536 + ch) = c1;
      *(float2*)(p.out + O_QKVS + ((size_t)s * 3 + 2) * 1536 + ch) = c2;
    }
  }
  if (lane < 4) {
    float bl = p.BGR[(size_t)row * 8 + lane], al = p.BGR[(size_t)row * 8 + 4 + lane];
    float beta = sigmoidf_(bl);
    float xx = al + p.dt_bias[lane];
    float sp = xx > 20.f ? xx : log1pf(__expf(xx));
    float g = -__expf(p.a_log[lane]) * sp;
    p.BG[(size_t)row * 8 + lane] = beta;
    p.BG[(size_t)row * 8 + 4 + lane] = g;
  }
}

DI void conv_a_prompt_item(const Params& p, int item, float* sm) {
  const int half = item & 1, tile = (item >> 1) & 63, b = item >> 7;
  const int tid = threadIdx.x, c = half * 256 + tid, t0 = tile * 32;
  if (tile > 0) {
#pragma unroll
    for (int i = 0; i < 30; ++i) {
      const size_t row = (size_t)b * 2048 + (t0 - 30 + i);
      const float val = bf2f(p.PB[row * EINP + c]);
      const float gate = bf2f(p.PB[row * EINP + 512 + c]);
      sm[i * 256 + tid] = val * sigmoidf_(gate);
    }
  } else {
#pragma unroll
    for (int i = 0; i < 30; ++i) sm[i * 256 + tid] = 0.f;
  }
#pragma unroll
  for (int i = 30; i < 62; ++i) {
    const size_t row = (size_t)b * 2048 + (t0 - 30 + i);
    const float val = bf2f(p.PB[row * EINP + c]);
    const float gate = bf2f(p.PB[row * EINP + 512 + c]);
    sm[i * 256 + tid] = val * sigmoidf_(gate);
  }
  float w[31];
#pragma unroll
  for (int j = 0; j < 31; ++j) w[j] = p.dw_w[j * 512 + c];
  const float bias = p.dw_b[c];
#pragma unroll 1
  for (int o = 0; o < 32; ++o) {
    float acc = bias;
#pragma unroll
    for (int j = 0; j < 31; ++j) acc += w[j] * sm[(o + j) * 256 + tid];
    p.CONV[((size_t)b * 2048 + t0 + o) * 512 + c] = acc;
  }
  if (tile == 63) {
#pragma unroll 1
    for (int j = 0; j < 30; ++j) p.out[O_CONVP + ((size_t)b * 30 + j) * 512 + c] = sm[(32 + j) * 256 + tid];
  }
  __syncthreads();
}

DI void conv_a_sample_item(const Params& p, int s) {
  const int tid = threadIdx.x;
  const size_t row = NPR + s;
#pragma unroll
  for (int cc = 0; cc < 2; ++cc) {
    int c = tid + cc * 256;
    float val = bf2f(p.PB[row * EINP + c]);
    float gate = bf2f(p.PB[row * EINP + 512 + c]);
    float gl = val * sigmoidf_(gate);
    float acc = p.dw_b[c] + p.dw_w[30 * 512 + c] * gl;
#pragma unroll 6
    for (int j = 0; j < 30; ++j) {
      float st = p.state_conv_a[((size_t)s * 30 + j) * 512 + c];
      acc += p.dw_w[j * 512 + c] * st;
      if (j >= 1) p.out[O_CONVS + ((size_t)s * 30 + j - 1) * 512 + c] = st;
    }
    p.out[O_CONVS + ((size_t)s * 30 + 29) * 512 + c] = gl;
    p.CONV[row * 512 + c] = acc;
  }
}

DI void phase_even_pw_conv(const Params& p, char* smem) {
  for (int it = blockIdx.x; it < 1024 + 128; it += gridDim.x) {
    if (it < 1024) conv_a_prompt_item(p, it, (float*)smem);
    else conv_a_sample_item(p, it - 1024);
  }
}
DI void phase_even_pw_qkv(const Params& p) {
  const int lane = threadIdx.x & 63, wid = threadIdx.x >> 6;
  for (int row = blockIdx.x * 4 + wid; row < NPR; row += gridDim.x * 4) {
    if ((row & 2047) >= 3) qkv_token<true, false>(p, row, lane);
    else qkv_token<true, true>(p, row, lane);
  }
  for (int row = NPR + blockIdx.x * 4 + wid; row < NROW; row += gridDim.x * 4) qkv_token<false, false>(p, row, lane);
}
DI void phase_even_pointwise(const Params& p, char* smem) {
  phase_even_pw_conv(p, smem);
  phase_even_pw_qkv(p);
}

DI void chunk_prep(const Params& p, int item, char* smem) {
  const int tid = threadIdx.x, lane = tid & 63, wid = tid >> 6, r = lane & 31, hl = lane >> 5;
  const int n = item & 31, hh = (item >> 5) & 3, b = item >> 7;
  const size_t row0 = (size_t)b * 2048 + n * 64;
  float* gcs = (float*)smem;
  float* betas = gcs + 64;
  float* egs = betas + 64;
  float* kscale = egs + 64;
  bfr* qs = (bfr*)(smem + 1024);
  bfr* ks_ = qs + 64 * 136;
  float* Am = (float*)(smem + 1024 + 2 * 64 * 136 * 2);
  bfr* wsb = qs;
  if (tid < 64) {
    float beta = p.BG[(row0 + tid) * 8 + hh];
    float g = p.BG[(row0 + tid) * 8 + 4 + hh];
    float v = g;
#pragma unroll
    for (int off = 1; off < 64; off <<= 1) {
      float t = __shfl_up(v, off);
      if (lane >= off) v += t;
    }
    float gl = __shfl(v, 63);
    gcs[tid] = v;
    betas[tid] = beta;
    egs[tid] = __expf(v);
    kscale[tid] = __expf(gl - v);
    if (tid == 63) p.GL[item] = __expf(gl);
  }
#pragma unroll
  for (int i = 0; i < 8; ++i) {
    int idx = tid + i * 256, row = idx >> 5, c4 = idx & 31;
    float4 q = *(const float4*)(p.QKV + (row0 + row) * 1536 + hh * 128 + c4 * 4);
    float4 k = *(const float4*)(p.QKV + (row0 + row) * 1536 + 512 + hh * 128 + c4 * 4);
    uint2 qo, ko;
    qo.x = pack2(q.x, q.y); qo.y = pack2(q.z, q.w);
    ko.x = pack2(k.x, k.y); ko.y = pack2(k.z, k.w);
    *(uint2*)(qs + row * 136 + c4 * 4) = qo;
    *(uint2*)(ks_ + row * 136 + c4 * 4) = ko;
  }
  __syncthreads();
  {
    const int mi = wid >> 1, ni = wid & 1;
    f32x16 akk, aqk;
#pragma unroll
    for (int q = 0; q < 16; ++q) { akk[q] = 0.f; aqk[q] = 0.f; }
#pragma unroll
    for (int ks = 0; ks < 8; ++ks) {
      bf16x8 ka = *(const bf16x8*)(ks_ + (mi * 32 + r) * 136 + ks * 16 + hl * 8);
      bf16x8 qa = *(const bf16x8*)(qs + (mi * 32 + r) * 136 + ks * 16 + hl * 8);
      bf16x8 kb = *(const bf16x8*)(ks_ + (ni * 32 + r) * 136 + ks * 16 + hl * 8);
      akk = MFMA32(ka, kb, akk);
      aqk = MFMA32(qa, kb, aqk);
    }
    bfr* qkf = (bfr*)(p.QKF + (size_t)item * 512);
#pragma unroll
    for (int q = 0; q < 16; ++q) {
      int i = mi * 32 + crow(q, hl), j = ni * 32 + r;
      float dec = (i >= j) ? __expf(gcs[i] - gcs[j]) : 0.f;
      Am[i * 68 + j] = (i > j) ? akk[q] * betas[i] * dec : 0.f;
      float qv = (i >= j) ? aqk[q] * dec : 0.f;
      int ksj = j >> 4, jl = j & 15, h2 = (jl >> 2) & 1, jj = ((jl >> 3) << 2) | (jl & 3);
      qkf[((mi * 4 + ksj) * 64 + h2 * 32 + (i & 31)) * 8 + jj] = f2bf(qv);
    }
  }
  {
    uint4* QD = p.QD + (size_t)item * 1024;
#pragma unroll
    for (int i = 0; i < 4; ++i) {
      int idx = tid + i * 256, f = idx >> 6, ln = idx & 63, mt = f >> 3, ks = f & 7, m = ln & 31, h2 = ln >> 5;
      int ri = mt * 32 + m, d0 = ks * 16 + h2 * 4;
      float sc = egs[ri];
      const float* src = p.QKV + (row0 + ri) * 1536 + hh * 128 + d0;
      float4 a = *(const float4*)src, c = *(const float4*)(src + 8);
      uint4 o;
      o.x = pack2(a.x * sc, a.y * sc); o.y = pack2(a.z * sc, a.w * sc);
      o.z = pack2(c.x * sc, c.y * sc); o.w = pack2(c.z * sc, c.w * sc);
      QD[f * 64 + ln] = o;
    }
    uint4* KD = p.KD + (size_t)item * 1024;
#pragma unroll
    for (int i = 0; i < 4; ++i) {
      int idx = tid + i * 256, f = idx >> 6, ln = idx & 63, mt = f >> 2, ks = f & 3, m = ln & 31, h2 = ln >> 5;
      int d = mt * 32 + m;
      float vals[8];
#pragma unroll
      for (int j = 0; j < 8; ++j) {
        int c = ks * 16 + 8 * (j >> 2) + 4 * h2 + (j & 3);
        vals[j] = p.QKV[(row0 + c) * 1536 + 512 + hh * 128 + d] * kscale[c];
      }
      uint4 o;
      o.x = pack2(vals[0], vals[1]); o.y = pack2(vals[2], vals[3]);
      o.z = pack2(vals[4], vals[5]); o.w = pack2(vals[6], vals[7]);
      KD[f * 64 + ln] = o;
    }
  }
  __syncthreads();
  {
    const int c = tid;
    const float* src = (c < 128) ? (p.QKV + row0 * 1536 + 1024 + hh * 128 + c) : (p.QKV + row0 * 1536 + 512 + hh * 128 + (c - 128));
    float sol[64];
#pragma unroll
    for (int i = 0; i < 64; ++i) {
      float rhs = src[(size_t)i * 1536] * betas[i];
      if (c >= 128) rhs *= egs[i];
      float acc = rhs;
#pragma unroll
      for (int j = 0; j < i; ++j) acc -= Am[i * 68 + j] * sol[j];
      sol[i] = acc;
    }
    if (c < 128) {
      float* U = p.U + (size_t)item * 8192;
#pragma unroll
      for (int i = 0; i < 64; ++i) U[i * 128 + c] = sol[i];
    } else {
#pragma unroll
      for (int i = 0; i < 64; ++i) wsb[i * 136 + (c - 128)] = f2bf(-sol[i]);
    }
  }
  __syncthreads();
  {
    uint4* WN = p.WN + (size_t)item * 1024;
#pragma unroll
    for (int i = 0; i < 4; ++i) {
      int idx = tid + i * 256, f = idx >> 6, ln = idx & 63, mt = f >> 3, ks = f & 7, m = ln & 31, h2 = ln >> 5;
      int ri = mt * 32 + m, d0 = ks * 16 + h2 * 4;
      uint2 a = *(const uint2*)(wsb + ri * 136 + d0), c = *(const uint2*)(wsb + ri * 136 + d0 + 8);
      uint4 o = {a.x, a.y, c.x, c.y};
      WN[f * 64 + ln] = o;
    }
  }
  __syncthreads();
}

DI void branch_a_final_row(const Params& p, int row, int lane) {
  const float* cr = p.CONV + (size_t)row * 512;
  float4 v[2];
  float s = 0.f;
#pragma unroll
  for (int j = 0; j < 2; ++j) {
    v[j] = ((const float4*)cr)[j * 64 + lane];
    s += v[j].x + v[j].y + v[j].z + v[j].w;
  }
  float mean = wave_sum(s) * (1.0f / 512.0f);
  float vs = 0.f;
#pragma unroll
  for (int j = 0; j < 2; ++j) {
    v[j].x -= mean; v[j].y -= mean; v[j].z -= mean; v[j].w -= mean;
    vs += v[j].x * v[j].x + v[j].y * v[j].y + v[j].z * v[j].z + v[j].w * v[j].w;
  }
  float inv = rsqrtf(wave_sum(vs) * (1.0f / 512.0f) + EPSF);
#pragma unroll
  for (int j = 0; j < 2; ++j) {
    int c = (j * 64 + lane) * 4;
    float4 g = *(const float4*)(p.ln_a_g + c), bb = *(const float4*)(p.ln_a_b + c);
    uint2 gu = *(const uint2*)(p.PB + (size_t)row * EINP + 1024 + c);
    float y0 = siluf_(v[j].x * inv * g.x + bb.x) * siluf_(bflo(gu.x));
    float y1 = siluf_(v[j].y * inv * g.y + bb.y) * siluf_(bfhi(gu.x));
    float y2 = siluf_(v[j].z * inv * g.z + bb.z) * siluf_(bflo(gu.y));
    float y3 = siluf_(v[j].w * inv * g.w + bb.w) * siluf_(bfhi(gu.y));
    uint2 o;
    o.x = pack2(y0, y1); o.y = pack2(y2, y3);
    *(uint2*)(p.MIX + (size_t)row * 1024 + c) = o;
  }
}

DI void delta_sample_item(const Params& p, int item, char* smem) {
  const int s = item >> 2, hh = item & 3, tid = threadIdx.x;
  const size_t row = NPR + s;
  float* ksm = (float*)smem;
  float* qsm = ksm + 128;
  float* part = qsm + 128;
  if (tid < 128) ksm[tid] = p.QKV[row * 1536 + 512 + hh * 128 + tid];
  else qsm[tid - 128] = p.QKV[row * 1536 + hh * 128 + (tid - 128)];
  const float beta = p.BG[row * 8 + hh], a = __expf(p.BG[row * 8 + 4 + hh]);
  __syncthreads();
  const int e = tid & 127, half = tid >> 7, d0 = half * 64;
  const float* S0 = p.state_delta + (((size_t)s * 4 + hh) * 128 + d0) * 128 + e;
  float* So = p.out + O_DELTAS + (((size_t)s * 4 + hh) * 128 + d0) * 128 + e;
  float Sr[64];
  float ksum = 0.f;
#pragma unroll
  for (int i = 0; i < 64; ++i) {
    Sr[i] = S0[(size_t)i * 128] * a;
    ksum += ksm[d0 + i] * Sr[i];
  }
  part[half * 128 + e] = ksum;
  __syncthreads();
  const float kS = part[e] + part[128 + e];
  const float v = p.QKV[row * 1536 + 1024 + hh * 128 + e];
  const float vnew = (v - kS) * beta;
  float oo = 0.f;
#pragma unroll
  for (int i = 0; i < 64; ++i) {
    Sr[i] += ksm[d0 + i] * vnew;
    So[(size_t)i * 128] = Sr[i];
    oo += qsm[d0 + i] * Sr[i];
  }
  __syncthreads();
  part[half * 128 + e] = oo;
  __syncthreads();
  if (half == 0) p.ODN[row * 512 + hh * 128 + e] = part[e] + part[128 + e];
  __syncthreads();
}

DI void phase_chunk_prep(const Params& p, char* smem) {
  for (int it = blockIdx.x; it < 1024; it += gridDim.x) chunk_prep(p, it, smem);
}

DI void scan_item(const Params& p, int item, char* smem) {
  const int tid = threadIdx.x, lane = tid & 63, es = tid >> 6, r = lane & 31, hl = lane >> 5;
  const int b = item >> 2, hh = item & 3;
  u32x4* bufA = (u32x4*)smem;
  u32x4* bufB = (u32x4*)(smem + 32768);
  const u32x4* gWN = (const u32x4*)p.WN + (size_t)item * 32 * 1024;
  const u32x4* gQD = (const u32x4*)p.QD + (size_t)item * 32 * 1024;
  const u32x4* gKD = (const u32x4*)p.KD + (size_t)item * 32 * 1024;
  const u32x4* gQK = (const u32x4*)p.QKF + (size_t)item * 32 * 512;
  const float* gU = p.U + (size_t)item * 32 * 8192;
  const int uo = hl * 4 * 128 + es * 32 + r;
  const int oo = hl * 4 * 512 + es * 32 + r;
#define GLDS(gp, lp) __builtin_amdgcn_global_load_lds((const unsigned*)(gp), (unsigned*)(lp), 16, 0, 0)
  f32x16 S[4];
#pragma unroll
  for (int d = 0; d < 4; ++d)
#pragma unroll
    for (int q = 0; q < 16; ++q) S[d][q] = 0.f;
  f32x16 vn[2], o[2];
#pragma unroll
  for (int i = 0; i < 4; ++i) {
    GLDS(gWN + tid + i * 256, bufA + tid + i * 256);
    GLDS(gQD + tid + i * 256, bufA + 1024 + tid + i * 256);
  }
#pragma unroll
  for (int ct = 0; ct < 2; ++ct)
#pragma unroll
    for (int q = 0; q < 16; ++q) vn[ct][q] = gU[(ct * 32 + crow(q, 0)) * 128 + uo];
  asm volatile("s_waitcnt vmcnt(0)" ::: "memory");
  __syncthreads();
#pragma unroll 1
  for (int n = 0; n < 32; ++n) {
    const int chunk = item * 32 + n;
    const float gl = p.GL[chunk];
    const int n1 = (n + 1 < 32) ? n + 1 : 31;
    {
      const u32x4* k0 = gQK + n * 512;
      const u32x4* d0 = gKD + n * 1024;
#pragma unroll
      for (int i = 0; i < 2; ++i) GLDS(k0 + tid + i * 256, bufB + tid + i * 256);
#pragma unroll
      for (int i = 0; i < 4; ++i) GLDS(d0 + tid + i * 256, bufB + 512 + tid + i * 256);
    }
    {
      bf16x8 Sb[4][2];
#pragma unroll
      for (int d = 0; d < 4; ++d) { Sb[d][0] = pack8(S[d], 0); Sb[d][1] = pack8(S[d], 1); }
#pragma unroll
      for (int ct = 0; ct < 2; ++ct)
#pragma unroll
        for (int q = 0; q < 16; ++q) o[ct][q] = 0.f;
#pragma unroll
      for (int ct = 0; ct < 2; ++ct)
#pragma unroll
        for (int ks = 0; ks < 8; ++ks) {
          bf16x8 aw = __builtin_bit_cast(bf16x8, bufA[(ct * 8 + ks) * 64 + lane]);
          bf16x8 aq = __builtin_bit_cast(bf16x8, bufA[1024 + (ct * 8 + ks) * 64 + lane]);
          vn[ct] = MFMA32(aw, Sb[ks >> 1][ks & 1], vn[ct]);
          o[ct] = MFMA32(aq, Sb[ks >> 1][ks & 1], o[ct]);
        }
    }
    bf16x8 Vb[2][2];
#pragma unroll
    for (int ct = 0; ct < 2; ++ct) { Vb[ct][0] = pack8(vn[ct], 0); Vb[ct][1] = pack8(vn[ct], 1); }
    asm volatile("s_waitcnt vmcnt(0)" ::: "memory");
    __syncthreads();
    {
      const u32x4* w1 = gWN + n1 * 1024;
      const u32x4* q1 = gQD + n1 * 1024;
#pragma unroll
      for (int i = 0; i < 4; ++i) {
        GLDS(w1 + tid + i * 256, bufA + tid + i * 256);
        GLDS(q1 + tid + i * 256, bufA + 1024 + tid + i * 256);
      }
      const float* u1 = gU + n1 * 8192;
#pragma unroll
      for (int ct = 0; ct < 2; ++ct)
#pragma unroll
        for (int q = 0; q < 16; ++q) vn[ct][q] = u1[(ct * 32 + crow(q, 0)) * 128 + uo];
    }
#pragma unroll
    for (int ct = 0; ct < 2; ++ct)
#pragma unroll
      for (int ks = 0; ks < 4; ++ks) {
        bf16x8 a = __builtin_bit_cast(bf16x8, bufB[(ct * 4 + ks) * 64 + lane]);
        o[ct] = MFMA32(a, Vb[ks >> 1][ks & 1], o[ct]);
      }
#pragma unroll
    for (int d = 0; d < 4; ++d) {
#pragma unroll
      for (int q = 0; q < 16; ++q) S[d][q] *= gl;
#pragma unroll
      for (int ks = 0; ks < 4; ++ks) {
        bf16x8 a = __builtin_bit_cast(bf16x8, bufB[512 + (d * 4 + ks) * 64 + lane]);
        S[d] = MFMA32(a, Vb[ks >> 1][ks & 1], S[d]);
      }
    }
    float* od = p.ODN + ((size_t)b * 2048 + n * 64) * 512 + hh * 128;
#pragma unroll
    for (int ct = 0; ct < 2; ++ct)
#pragma unroll
      for (int q = 0; q < 16; ++q) od[(ct * 32 + crow(q, 0)) * 512 + oo] = o[ct][q];
    asm volatile("s_waitcnt vmcnt(0)" ::: "memory");
    __syncthreads();
  }
#undef GLDS
  float* so = p.out + O_DELTAP + ((size_t)(b * 4 + hh) * 128) * 128;
#pragma unroll
  for (int d = 0; d < 4; ++d)
#pragma unroll
    for (int q = 0; q < 16; ++q) so[(d * 32 + crow(q, 0)) * 128 + uo] = S[d][q];
  __syncthreads();
}

DI void phase_scan(const Params& p, char* smem) {
  const int lane = threadIdx.x & 63, wid = threadIdx.x >> 6;
  if (gridDim.x >= 64) {
    if (blockIdx.x < 32) {
      scan_item(p, blockIdx.x, smem);
    } else {
      const int nb = gridDim.x - 32, bi = blockIdx.x - 32;
      for (int it = bi; it < 512; it += nb) delta_sample_item(p, it, smem);
      for (int row = bi * 4 + wid; row < NROW; row += nb * 4) branch_a_final_row(p, row, lane);
    }
  } else {
    for (int it = blockIdx.x; it < 32; it += gridDim.x) scan_item(p, it, smem);
    for (int it = blockIdx.x; it < 512; it += gridDim.x) delta_sample_item(p, it, smem);
    for (int row = blockIdx.x * 4 + wid; row < NROW; row += gridDim.x * 4) branch_a_final_row(p, row, lane);
  }
}

DI void phase_delta_post(const Params& p) {
  const int lane = threadIdx.x & 63, wid = threadIdx.x >> 6;
  for (int row = blockIdx.x * 4 + wid; row < NROW; row += gridDim.x * 4) {
#pragma unroll
    for (int hh = 0; hh < 4; ++hh) {
      int ch = hh * 128 + lane * 2;
      float2 o = *(const float2*)(p.ODN + (size_t)row * 512 + ch);
      float ss = wave_sum(o.x * o.x + o.y * o.y);
      float inv = rsqrtf(ss * (1.0f / 128.0f) + EPSF);
      float2 g = *(const float2*)(p.dn_norm_g + lane * 2);
      unsigned zu = *(const unsigned*)(p.PB + (size_t)row * EINP + 3072 + ch);
      float y0 = o.x * inv * g.x * siluf_(bflo(zu));
      float y1 = o.y * inv * g.y * siluf_(bfhi(zu));
      *(unsigned*)(p.MIX + (size_t)row * 1024 + 512 + ch) = pack2(y0, y1);
    }
  }
}

template <bool FIRST, bool HAS_H>
DI void phase_gemm_resid(const Params& p, const bfr* A, const bfr* Wt, const float* gnext, float* ss, char* smem) {
  float* X = p.X;
  bfr* Hn = p.H;
  const int lane = threadIdx.x & 63, wid = threadIdx.x >> 6, wr = wid >> 1, wc = wid & 1, r = lane & 31, hl = lane >> 5;
  {
    const float* xs = p.x_sample - (size_t)NPR * 1024;
    gemm_sample<true>(A, 1024, Wt, 1024, 1024, 1024, smem,
                      [=](int row, int col, float v) -> float {
                        const size_t o = (size_t)row * 1024 + col;
                        const float xn = (FIRST ? xs[o] : X[o]) + v;
                        X[o] = xn;
                        if (HAS_H) Hn[o] = f2bf(xn * gnext[col]);
                        return xn;
                      },
                      [=](int row, float s2) { unsafeAtomicAdd(ss + row, s2); });
  }
  for (int t = blockIdx.x; t < 128 * 8; t += gridDim.x) {
    const int mt = t >> 3, nt = t & 7, m0 = mt * 128, n0 = nt * 128;
    f32x16 acc[2][2];
    gemm_mainloop(A, 1024, Wt, 1024, 1024, m0, n0, smem, acc);
    const float* xsrc = FIRST ? ((m0 < NPR) ? p.x_prompt : p.x_sample - (size_t)NPR * 1024) : X;
    const int rbase = m0 + wr * 64 + 4 * hl, cbase = n0 + wc * 64 + r;
    float g0 = 0.f, g1 = 0.f;
    if (HAS_H) { g0 = gnext[cbase]; g1 = gnext[cbase + 32]; }
#pragma unroll
    for (int i = 0; i < 2; ++i) {
      float xo[2][16];
#pragma unroll
      for (int j = 0; j < 2; ++j)
#pragma unroll
        for (int q = 0; q < 16; ++q)
          xo[j][q] = xsrc[(size_t)(rbase + i * 32 + crow(q, 0)) * 1024 + cbase + j * 32];
      float rs[16];
#pragma unroll
      for (int q = 0; q < 16; ++q) {
        const size_t o = (size_t)(rbase + i * 32 + crow(q, 0)) * 1024 + cbase;
        const float x0 = xo[0][q] + acc[i][0][q], x1 = xo[1][q] + acc[i][1][q];
        X[o] = x0;
        X[o + 32] = x1;
        if (HAS_H) { Hn[o] = f2bf(x0 * g0); Hn[o + 32] = f2bf(x1 * g1); }
        rs[q] = x0 * x0 + x1 * x1;
      }
#pragma unroll
      for (int q = 0; q < 16; ++q) {
        float v = rs[q];
        v += __shfl_xor(v, 16);
        v += __shfl_xor(v, 8);
        v += __shfl_xor(v, 4);
        v += __shfl_xor(v, 2);
        v += __shfl_xor(v, 1);
        rs[q] = v;
      }
      if (r == 0) {
#pragma unroll
        for (int q = 0; q < 16; ++q) unsafeAtomicAdd(ss + rbase + i * 32 + crow(q, 0), rs[q]);
      }
    }
    __syncthreads();
  }
}
DI void phase_gemm_bf16out(const Params& p, const bfr* A, const bfr* Wt, bfr* C, int N, const float* ss, char* smem) {
  const int ntn = N >> 7;
  gemm_sample<false>(A, 1024, Wt, 1024, 1024, N, smem,
                     [=](int row, int col, float v) -> float {
                       float inv = rsqrtf(ss[row] * (1.0f / 1024.0f) + EPSF);
                       C[(size_t)row * N + col] = f2bf(v * inv);
                       return 0.f;
                     },
                     [=](int, float) {});
  for (int t = blockIdx.x; t < 128 * ntn; t += gridDim.x) {
    int mt = t / ntn, nt = t % ntn;
    gemm_tile(A, 1024, Wt, 1024, 1024, mt * 128, nt * 128, smem,
              [=](int row, int col, float v) {
                float inv = rsqrtf(ss[row] * (1.0f / 1024.0f) + EPSF);
                C[(size_t)row * N + col] = f2bf(v * inv);
              });
  }
}

DI void attn_prompt_wave(const Params& p, int l, int b, int hh, int tt, bfr* Obuf) {
  const int lane = threadIdx.x & 63, r = lane & 31, hl = lane >> 5;
  const size_t row0 = (size_t)b * 2048 + tt * 32;
  const bfr* Qp = p.ACT2 + (row0 + r) * 1024 + hh * 256 + hl * 8;
  const bfr* Kp = p.KB + (size_t)l * 2097152 + ((size_t)b * 256 + r) * 1024 + hh * 256 + hl * 8;
  f32x16 st[8];
#pragma unroll
  for (int m = 0; m < 8; ++m)
#pragma unroll
    for (int q = 0; q < 16; ++q) st[m][q] = 0.f;
#pragma unroll 2
  for (int ks = 0; ks < 16; ++ks) {
    bf16x8 qf = *(const bf16x8*)(Qp + ks * 16);
#pragma unroll
    for (int m = 0; m < 8; ++m) {
      bf16x8 kf = *(const bf16x8*)(Kp + (size_t)m * 32 * 1024 + ks * 16);
      st[m] = MFMA32(kf, qf, st[m]);
    }
  }
  float mx = -3.0e38f;
#pragma unroll
  for (int m = 0; m < 8; ++m)
#pragma unroll
    for (int q = 0; q < 16; ++q) mx = fmaxf(mx, st[m][q]);
  mx = fmaxf(mx, __shfl_xor(mx, 32));
  float sum = 0.f;
#pragma unroll
  for (int m = 0; m < 8; ++m)
#pragma unroll
    for (int q = 0; q < 16; ++q) {
      float e = __expf((st[m][q] - mx) * 0.0625f);
      st[m][q] = e;
      sum += e;
    }
  sum += __shfl_xor(sum, 32);
  const float inv = 1.0f / sum;
  bf16x8 pb[8][2];
#pragma unroll
  for (int m = 0; m < 8; ++m) { pb[m][0] = pack8(st[m], 0); pb[m][1] = pack8(st[m], 1); }
  const uint4* VT = (const uint4*)(p.VT + (size_t)l * 2097152) + ((size_t)(b * 4 + hh) * 8) * 16 * 64 + lane;
  bfr* Op = Obuf + (row0 + r) * 1024 + hh * 256;
#pragma unroll 1
  for (int half = 0; half < 2; ++half) {
    f32x16 o[4];
#pragma unroll
    for (int d = 0; d < 4; ++d)
#pragma unroll
      for (int q = 0; q < 16; ++q) o[d][q] = 0.f;
#pragma unroll
    for (int ks = 0; ks < 16; ++ks) {
#pragma unroll
      for (int d = 0; d < 4; ++d) {
        bf16x8 vf = ldfrag(VT + ((size_t)(half * 4 + d) * 16 + ks) * 64);
        o[d] = MFMA32(vf, pb[ks >> 1][ks & 1], o[d]);
      }
    }
#pragma unroll
    for (int d = 0; d < 4; ++d)
#pragma unroll
      for (int g4 = 0; g4 < 4; ++g4) {
        int dim = (half * 4 + d) * 32 + 8 * g4 + 4 * hl;
        uint2 ov;
        ov.x = pack2(o[d][g4 * 4 + 0] * inv, o[d][g4 * 4 + 1] * inv);
        ov.y = pack2(o[d][g4 * 4 + 2] * inv, o[d][g4 * 4 + 3] * inv);
        *(uint2*)(Op + dim) = ov;
      }
  }
}

DI void attn_sample_item(const Params& p, int l, int item, char* smem, bfr* Obuf) {
  const int s = item >> 2, hh = item & 3, tid = threadIdx.x, lane = tid & 63, wid = tid >> 6;
  float* qsm = (float*)smem;
  float* sc = qsm + 256;
  float* red = sc + 256;
  const size_t row = NPR + s;
  qsm[tid] = bf2f(p.ACT2[row * 1024 + hh * 256 + tid]);
  __syncthreads();
  const int grp = lane >> 4, l16 = lane & 15;
  float4 q4[4];
#pragma unroll
  for (int j = 0; j < 4; ++j) q4[j] = ((const float4*)qsm)[j * 16 + l16];
  const float* Kb = p.cache_k + ((((size_t)l * 128 + s) * 256) * 4 + hh) * 256;
  const float* Vb = p.cache_v + ((((size_t)l * 128 + s) * 256) * 4 + hh) * 256;
#pragma unroll 8
  for (int ps = 0; ps < 16; ++ps) {
    int mem = wid * 64 + ps * 4 + grp;
    const float4* kr = (const float4*)(Kb + (size_t)mem * 1024);
    float d = 0.f;
#pragma unroll
    for (int j = 0; j < 4; ++j) {
      float4 k4 = kr[j * 16 + l16];
      d += k4.x * q4[j].x + k4.y * q4[j].y + k4.z * q4[j].z + k4.w * q4[j].w;
    }
    d += __shfl_xor(d, 8);
    d += __shfl_xor(d, 4);
    d += __shfl_xor(d, 2);
    d += __shfl_xor(d, 1);
    if (l16 == 0) sc[mem] = d * 0.0625f;
  }
  __syncthreads();
  float sv = sc[tid];
  float m = wave_max(sv);
  if (lane == 0) red[wid] = m;
  __syncthreads();
  m = fmaxf(fmaxf(red[0], red[1]), fmaxf(red[2], red[3]));
  float e = __expf(sv - m);
  float sm_ = wave_sum(e);
  if (lane == 0) red[4 + wid] = sm_;
  sc[tid] = e;
  __syncthreads();
  const float inv = 1.0f / (red[4] + red[5] + red[6] + red[7]);
  float4 acc = {0.f, 0.f, 0.f, 0.f};
  float* partial = (float*)smem + 1024;
#pragma unroll 16
  for (int i = 0; i < 64; ++i) {
    const int mem = wid * 64 + i;
    float4 v4 = *(const float4*)(Vb + (size_t)mem * 1024 + lane * 4);
    const float pm = sc[mem];
    acc.x += pm * v4.x; acc.y += pm * v4.y; acc.z += pm * v4.z; acc.w += pm * v4.w;
  }
  *(float4*)(partial + wid * 256 + lane * 4) = acc;
  __syncthreads();
  const float ov = partial[tid] + partial[256 + tid] + partial[512 + tid] + partial[768 + tid];
  Obuf[row * 1024 + hh * 256 + tid] = f2bf(ov * inv);
  __syncthreads();
}

DI void phase_attn(const Params& p, int l, char* smem) {
  bfr* Obuf = p.ACT3;
  for (int it = blockIdx.x; it < 1024; it += gridDim.x) {
    if (it < 512) {
      attn_sample_item(p, l, it, smem, Obuf);
    } else {
      int u = it - 512, tt4 = u & 15, hh = (u >> 4) & 3, b = u >> 6;
      attn_prompt_wave(p, l, b, hh, tt4 * 4 + (threadIdx.x >> 6), Obuf);
    }
  }
}

template <int WIN>
DI void pool_elem(const Params& p, int row, int c) {
  const bfr* P2 = p.PB;
  unsigned uu = *(const unsigned*)(P2 + (size_t)row * 2048 + c);
  const float u0 = bflo(uu), u1 = bfhi(uu);
  float s0 = u0, s1 = u1, cnt;
  if (row < NPR) {
    const int t = row & 2047, b = row >> 11;
    if (t >= WIN - 1) {
      cnt = (float)WIN;
      unsigned w[WIN - 1];
#pragma unroll
      for (int j = 1; j < WIN; ++j) w[j - 1] = *(const unsigned*)(P2 + (size_t)(row - j) * 2048 + c);
#pragma unroll
      for (int j = 1; j < WIN; ++j) { s0 += bflo(w[j - 1]); s1 += bfhi(w[j - 1]); }
    } else {
      cnt = (float)(t + 1);
      for (int j = 1; j <= t; ++j) {
        unsigned w = *(const unsigned*)(P2 + (size_t)(row - j) * 2048 + c);
        s0 += bflo(w); s1 += bfhi(w);
      }
    }
    if (t >= 2033) {
      float2 o = {u0, u1};
      *(float2*)(p.out + O_POOLP + ((size_t)b * 15 + (t - 2033)) * 1024 + c) = o;
    }
  } else {
    const int s = row - NPR;
    cnt = (float)WIN;
    const float* sp = p.state_pool + (size_t)s * 15 * 1024 + c;
    float2 st[15];
#pragma unroll
    for (int j = 0; j < 15; ++j) st[j] = *(const float2*)(sp + (size_t)j * 1024);
#pragma unroll
    for (int j = 1; j < WIN; ++j) { s0 += st[15 - j].x; s1 += st[15 - j].y; }
    float* op = p.out + O_POOLS + (size_t)s * 15 * 1024 + c;
#pragma unroll
    for (int j = 0; j < 14; ++j) *(float2*)(op + (size_t)j * 1024) = st[j + 1];
    float2 o = {u0, u1};
    *(float2*)(op + (size_t)14 * 1024) = o;
  }
  *(unsigned*)(p.MIX + (size_t)row * 1024 + c) = pack2(s0 / cnt - u0, s1 / cnt - u1);
}
DI void phase_pool(const Params& p) {
  for (int idx = blockIdx.x * 256 + threadIdx.x; idx < NROW * 512; idx += gridDim.x * 256) {
    const int row = idx >> 9, c = (idx & 511) * 2;
    const int gi = c >> 8;
    if (gi == 0) pool_elem<2>(p, row, c);
    else if (gi == 1) pool_elem<4>(p, row, c);
    else if (gi == 2) pool_elem<8>(p, row, c);
    else pool_elem<16>(p, row, c);
  }
}

DI void phase_gemm_pool(const Params& p, char* smem) {
  const bfr* P2 = p.PB;
  bfr* Z = p.ACT3;
  for (int g = 0; g < 4; ++g) {
    const float* bp = p.b_pool + g * 256;
    const float* sc = p.pool_scale + g * 256;
    gemm_sample<false>(p.MIX + g * 256, 1024, p.WtPool + (size_t)g * 65536, 256, 256, 256, smem,
                       [=](int row, int col, float v) -> float {
                         float gate = bf2f(P2[(size_t)row * 2048 + 1024 + g * 256 + col]);
                         float z = (v + bp[col]) * sc[col] * siluf_(gate);
                         Z[(size_t)row * 1024 + g * 256 + col] = f2bf(z);
                         return 0.f;
                       },
                       [=](int, float) {});
  }
  for (int t = blockIdx.x; t < 128 * 8; t += gridDim.x) {
    int mt = t >> 3, g = (t >> 1) & 3, nt = t & 1;
    const float* bp = p.b_pool + g * 256;
    const float* sc = p.pool_scale + g * 256;
    gemm_tile(p.MIX + g * 256, 1024, p.WtPool + (size_t)g * 65536, 256, 256, mt * 128, nt * 128, smem,
              [=](int row, int col, float v) {
                float gate = bf2f(P2[(size_t)row * 2048 + 1024 + g * 256 + col]);
                float z = (v + bp[col]) * sc[col] * siluf_(gate);
                Z[(size_t)row * 1024 + g * 256 + col] = f2bf(z);
              });
  }
}

#ifndef ONLY_PHASE
#define ONLY_PHASE -1
#endif
#define PON(n) (ONLY_PHASE < 0 || ONLY_PHASE == (n))
__global__ void __launch_bounds__(256, 2) mega(Params p) {
  __shared__ __attribute__((aligned(16))) char smem[65536];
  cg::grid_group grid = cg::this_grid();
  if (p.phase_lo < -1000) grid.sync();
  volatile LAS unsigned* xst = (volatile LAS unsigned*)(smem + 65520);
  if (threadIdx.x < 4) xst[threadIdx.x] = 0u;
  __syncthreads();
  XcdBarrier xb = xcd_barrier_post(p.bar, xst);
#ifndef DUPMASK
#define DUPMASK 0
#endif
#define RUN(n, call) do { if (PON(n) && p.phase_lo <= (n) && (n) <= p.phase_hi) { call; if ((DUPMASK >> (n)) & 1) { xcd_barrier(xb); call; } } if (p.phase_lo <= (n) && (n) < p.phase_hi) xcd_barrier(xb); } while (0)
  RUN(0, phase_prep(p, smem));
  RUN(1, phase_gemm_in_even(p, smem));
  RUN(2, phase_even_pointwise(p, smem));
  RUN(3, phase_chunk_prep(p, smem));
  RUN(4, phase_scan(p, smem));
  RUN(5, phase_delta_post(p));
  RUN(6, (phase_gemm_resid<true, true>(p, p.MIX, p.WtOutE, p.norm_xattn, p.SS, smem)));
  RUN(8, phase_gemm_bf16out(p, p.H, p.WtXq, p.ACT2, 1024, p.SS, smem));
  RUN(9, phase_attn(p, 0, smem));
  RUN(10, (phase_gemm_resid<false, true>(p, p.ACT3, p.WtXo, p.norm_mix + 1024, p.SS + NROW, smem)));
  RUN(12, phase_gemm_bf16out(p, p.H, p.WtInO, p.PB, 2048, p.SS + NROW, smem));
  RUN(13, phase_pool(p));
  RUN(14, phase_gemm_pool(p, smem));
  RUN(15, (phase_gemm_resid<false, true>(p, p.ACT3, p.WtOutO, p.norm_xattn + 1024, p.SS + 2 * NROW, smem)));
  RUN(17, phase_gemm_bf16out(p, p.H, p.WtXq + 1048576, p.ACT2, 1024, p.SS + 2 * NROW, smem));
  RUN(18, phase_attn(p, 1, smem));
  RUN(19, (phase_gemm_resid<false, false>(p, p.ACT3, p.WtXo + 1048576, p.norm_final, p.SS + 3 * NROW, smem)));
  RUN(20, phase_final_norm(p));
}

extern "C" void kernel_launch(void* const* d_in, const int* in_sizes, int n_in, void* d_out, int out_size, void* d_ws,
                              size_t ws_size, hipStream_t stream) {
  static int grid_blocks = 0;
  if (!grid_blocks) {
    int dev = 0, cus = 0, per_cu = 0;
    (void)hipGetDevice(&dev);
    (void)hipDeviceGetAttribute(&cus, hipDeviceAttributeMultiprocessorCount, dev);
    (void)hipOccupancyMaxActiveBlocksPerMultiprocessor(&per_cu, mega, 256, 0);
    if (per_cu < 1) per_cu = 1;
    if (per_cu > 2) per_cu = 2;
    grid_blocks = cus * per_cu;
  }
  Params p{};
  const float** ins = (const float**)&p.x_prompt;
  for (int i = 0; i < 31; ++i) ins[i] = (const float*)d_in[i];
  p.out = (float*)d_out;
  char* w = (char*)d_ws;
  size_t off = 0;
  auto take = [&](size_t bytes) { char* r = w + off; off += (bytes + 255) & ~(size_t)255; return r; };
  p.X = (float*)take((size_t)NROW * 1024 * 4);
  p.QKV = (float*)take((size_t)NROW * 1536 * 4);
  p.BGR = (float*)take((size_t)NROW * 8 * 4);
  p.BG = (float*)take((size_t)NROW * 8 * 4);
  p.CONV = (float*)take((size_t)NROW * 512 * 4);
  p.ODN = (float*)take((size_t)NROW * 512 * 4);
  p.U = (float*)take((size_t)1024 * 8192 * 4);
  p.GL = (float*)take(4096);
  p.SS = (float*)take((size_t)4 * NROW * 4);
  p.H = (bfr*)take((size_t)NROW * 1024 * 2);
  p.PB = (bfr*)take((size_t)NROW * 3584 * 2);
  p.MIX = (bfr*)take((size_t)NROW * 1024 * 2);
  p.ACT2 = (bfr*)take((size_t)NROW * 1024 * 2);
  p.ACT3 = (bfr*)take((size_t)NROW * 1024 * 2);
  p.KB = (bfr*)take((size_t)2 * 2048 * 1024 * 2);
  p.VT = (bfr*)take((size_t)2 * 2048 * 1024 * 2);
  p.MPB = (bfr*)take((size_t)2048 * 1024 * 2);
  p.WtInE = (bfr*)take((size_t)3712 * 1024 * 2);
  p.WtOutE = (bfr*)take((size_t)1024 * 1024 * 2);
  p.WtInO = (bfr*)take((size_t)2048 * 1024 * 2);
  p.WtPool = (bfr*)take((size_t)4 * 256 * 256 * 2);
  p.WtOutO = (bfr*)take((size_t)1024 * 1024 * 2);
  p.WtXq = (bfr*)take((size_t)2 * 1024 * 1024 * 2);
  p.WtXk = (bfr*)take((size_t)2 * 1024 * 1024 * 2);
  p.WtXv = (bfr*)take((size_t)2 * 1024 * 1024 * 2);
  p.WtXo = (bfr*)take((size_t)2 * 1024 * 1024 * 2);
  p.WN = (uint4*)take((size_t)1024 * 1024 * 16);
  p.QD = (uint4*)take((size_t)1024 * 1024 * 16);
  p.KD = (uint4*)take((size_t)1024 * 1024 * 16);
  p.QKF = (uint4*)take((size_t)1024 * 512 * 16);
  p.bar = (unsigned*)take((size_t)XCD_BAR_WORDS * 4);
  if (off > ws_size) {
    fprintf(stderr, "kernel_launch: workspace too small: need %zu have %zu\n", off, ws_size);
    return;
  }
  p.phase_lo = 0;
  p.phase_hi = 20;
  if (hipMemsetAsync(p.bar, 0, (size_t)XCD_BAR_WORDS * 4, stream) != hipSuccess) { fprintf(stderr, "memset failed\n"); return; }
  void* args[] = {&p};
  hipError_t e = hipLaunchCooperativeKernel((void*)mega, dim3(grid_blocks), dim3(256), args, 0, stream);
  if (e != hipSuccess) fprintf(stderr, "cooperative launch failed: %s (grid %d)\n", hipGetErrorString(e), grid_blocks);
}
```

```cpp
#include <hip/hip_runtime.h>
#include <hip/hip_cooperative_groups.h>
#include <cstdio>
namespace cg = cooperative_groups;

#define DI __device__ __forceinline__
typedef unsigned short bfr;
using bf16x8 = __attribute__((ext_vector_type(8))) short;
using f32x16 = __attribute__((ext_vector_type(16))) float;
typedef __bf16 bf2_t __attribute__((ext_vector_type(2)));
typedef float fl2_t __attribute__((ext_vector_type(2)));
typedef unsigned u32x4 __attribute__((ext_vector_type(4)));
#define MFMA32(a, b, c) __builtin_amdgcn_mfma_f32_32x32x16_bf16((a), (b), (c), 0, 0, 0)

constexpr int NROW = 16512;
constexpr int NPR = 16384;
constexpr int DM = 1024;
constexpr int EIN = 3592, EINP = 3584;
constexpr float EPSF = 1e-6f;

constexpr size_t O_Y = 0;
constexpr size_t O_CONVP = 16777216 + 131072;
constexpr size_t O_QKVP = O_CONVP + 122880;
constexpr size_t O_DELTAP = O_QKVP + 36864;
constexpr size_t O_POOLP = O_DELTAP + 524288;
constexpr size_t O_MEMK = O_POOLP + 122880;
constexpr size_t O_MEMV = O_MEMK + 4194304;
constexpr size_t O_CONVS = O_MEMV + 4194304;
constexpr size_t O_QKVS = O_CONVS + 1966080;
constexpr size_t O_DELTAS = O_QKVS + 589824;
constexpr size_t O_POOLS = O_DELTAS + 8388608;

struct Params {
  const float *x_prompt, *x_sample, *state_conv_a, *state_qkv_conv, *state_delta, *state_pool, *cache_k, *cache_v, *mem_prompt;
  const float *norm_mix, *norm_xattn, *norm_final, *w_in_even, *w_out_even, *dw_w, *dw_b, *ln_a_g, *ln_a_b, *sc_w, *a_log,
      *dt_bias, *dn_norm_g, *w_in_odd, *w_pool, *b_pool, *pool_scale, *w_out_odd, *w_xq, *w_xk, *w_xv, *w_xo;
  float* out;
  float *X, *QKV, *BGR, *BG, *CONV, *ODN, *U, *GL, *SS;
  bfr *H, *PB, *MIX, *ACT2, *ACT3, *KB, *VT, *MPB;
  bfr *WtInE, *WtOutE, *WtInO, *WtPool, *WtOutO, *WtXq, *WtXk, *WtXv, *WtXo;
  uint4 *WN, *QD, *KD, *QKF;
  unsigned* bar;
  int phase_lo, phase_hi;
};

DI unsigned pack2(float a, float b) {
  fl2_t f = {a, b};
  bf2_t r = __builtin_convertvector(f, bf2_t);
  return __builtin_bit_cast(unsigned, r);
}
DI bfr f2bf(float a) { return (bfr)(pack2(a, 0.f) & 0xffffu); }
DI float bf2f(bfr u) { return __uint_as_float(((unsigned)u) << 16); }
DI float bflo(unsigned u) { return __uint_as_float(u << 16); }
DI float bfhi(unsigned u) { return __uint_as_float(u & 0xffff0000u); }
DI float sigmoidf_(float x) { return 1.0f / (1.0f + __expf(-x)); }
DI float siluf_(float x) { return x / (1.0f + __expf(-x)); }
#define DPPF(v, ctrl, rmask) __builtin_bit_cast(float, __builtin_amdgcn_update_dpp(0, __builtin_bit_cast(int, (v)), (ctrl), (rmask), 0xf, false))
DI float row16_sum(float v) {
  v += DPPF(v, 0xB1, 0xf);
  v += DPPF(v, 0x4E, 0xf);
  v += DPPF(v, 0x141, 0xf);
  v += DPPF(v, 0x140, 0xf);
  return v;
}
DI float half32_sum_hi(float v) {
  v = row16_sum(v);
  v += DPPF(v, 0x142, 0xa);
  return v;
}
DI float wave_sum(float v) {
  v = row16_sum(v);
  v += DPPF(v, 0x142, 0xa);
  v += DPPF(v, 0x143, 0xc);
  return __builtin_bit_cast(float, __builtin_amdgcn_readlane(__builtin_bit_cast(int, v), 63));
}
DI float wave_max(float v) {
#pragma unroll
  for (int o = 32; o >= 1; o >>= 1) v = fmaxf(v, __shfl_xor(v, o));
  return v;
}
DI int crow(int reg, int h) { return (reg & 3) + 8 * (reg >> 2) + 4 * h; }
DI bf16x8 pack8(const f32x16& x, int s) {
  uint4 p;
  p.x = pack2(x[8 * s + 0], x[8 * s + 1]);
  p.y = pack2(x[8 * s + 2], x[8 * s + 3]);
  p.z = pack2(x[8 * s + 4], x[8 * s + 5]);
  p.w = pack2(x[8 * s + 6], x[8 * s + 7]);
  return __builtin_bit_cast(bf16x8, p);
}
DI bf16x8 ldfrag(const uint4* p) { uint4 v = *p; return __builtin_bit_cast(bf16x8, v); }


#define XB_TMO      128
#define XB_XCNT(j)  (256  + 64 * (j))
#define XB_XSUB(j)  (1280 + 64 * (j))
#define XB_XGEN(j)  (2304 + 64 * (j))
#define XB_TOP      3328
#define XB_TOPGEN   3392
#define XCD_BAR_WORDS 3456
#define XB_SPIN_CAP (1u << 18)
#define LAS __attribute__((address_space(3)))
DI unsigned xb_ld(unsigned* p) { return __hip_atomic_load(p, __ATOMIC_RELAXED, __HIP_MEMORY_SCOPE_AGENT); }
DI unsigned xb_add(unsigned* p, unsigned v) { return __hip_atomic_fetch_add(p, v, __ATOMIC_RELAXED, __HIP_MEMORY_SCOPE_AGENT); }
DI unsigned xb_xcc_id() { return (unsigned)__builtin_amdgcn_s_getreg((3 << 11) | 20) & 0xFu; }
#define XB_SPIN(cond, bar) do { unsigned _sp = 0; while (cond) { __builtin_amdgcn_s_sleep(1); \
    if ((++_sp & 255u) == 0u) { if (xb_ld(&(bar)[XB_TMO])) break; if (_sp > XB_SPIN_CAP) { atomicAdd(&(bar)[XB_TMO], 1u); break; } } } } while (0)
struct XcdBarrier { unsigned* bar; unsigned x; volatile LAS unsigned* st; };
DI XcdBarrier xcd_barrier_post(unsigned* bar, volatile LAS unsigned* st) {
  XcdBarrier b; b.bar = bar; b.x = xb_xcc_id(); b.st = st;
  if (threadIdx.x == 0) (void)xb_add(&bar[XB_XCNT(b.x)], 1u);
  return b;
}
DI void xcd_barrier_complete(unsigned* bar, unsigned x, unsigned& nloc, unsigned& nx) {
  const unsigned G = gridDim.x * gridDim.y * gridDim.z;
  unsigned sum, cnt, mine, sp = 0u;
  for (;;) {
    sum = 0u; cnt = 0u; mine = 0u;
#pragma unroll
    for (unsigned j = 0; j < 16; ++j) { const unsigned c = xb_ld(&bar[XB_XCNT(j)]); sum += c; cnt += (c > 0u) ? 1u : 0u; mine = (j == x) ? c : mine; }
    if (sum == G) break;
    __builtin_amdgcn_s_sleep(1);
    if ((++sp & 255u) == 0u) { if (xb_ld(&bar[XB_TMO])) break; if (sp > XB_SPIN_CAP) { atomicAdd(&bar[XB_TMO], 1u); break; } }
  }
  nloc = mine > 0u ? mine : 1u; nx = cnt > 0u ? cnt : 1u;
}
DI void xcd_barrier(const XcdBarrier& b) {
  asm volatile("s_waitcnt vmcnt(0)" ::: "memory");
  __syncthreads();
  if (threadIdx.x == 0) {
    unsigned* bar = b.bar;
    __builtin_amdgcn_s_waitcnt(0);
    unsigned nloc = b.st[0], nx = b.st[1];
    if (nloc == 0u) { xcd_barrier_complete(bar, b.x, nloc, nx); b.st[0] = nloc; b.st[1] = nx; }
    const unsigned old = xb_add(&bar[XB_XSUB(b.x)], 1u);
    const unsigned gen = old / nloc;
    if (old + 1u == (gen + 1u) * nloc) {
      __builtin_amdgcn_fence(__ATOMIC_RELEASE, "agent");
      asm volatile("s_waitcnt vmcnt(0)" ::: "memory");
      const unsigned og = xb_add(&bar[XB_TOP], 1u);
      const unsigned tg = og / nx;
      if (og + 1u == (tg + 1u) * nx) xb_add(&bar[XB_TOPGEN], 1u);
      else XB_SPIN(xb_ld(&bar[XB_TOPGEN]) == tg, bar);
      __builtin_amdgcn_fence(__ATOMIC_ACQUIRE, "agent");
      xb_add(&bar[XB_XGEN(b.x)], 1u);
      asm volatile("s_waitcnt vmcnt(0)" ::: "memory");
    } else {
      XB_SPIN(xb_ld(&bar[XB_XGEN(b.x)]) == gen, bar);
      __builtin_amdgcn_fence(__ATOMIC_ACQUIRE, "agent");
      asm volatile("s_waitcnt vmcnt(0)" ::: "memory");
    }
  }
  __syncthreads();
}

DI void gemm_mainloop(const bfr* __restrict__ A, int lda, const bfr* __restrict__ Bt, int ldb, int K, int m0, int n0, char* smem, f32x16 (&acc)[2][2]) {
  bfr* As = (bfr*)smem;
  bfr* Bs = As + 128 * 72;
  const int tid = threadIdx.x, lane = tid & 63, wid = tid >> 6, wr = wid >> 1, wc = wid & 1;
  const int r = lane & 31, hl = lane >> 5;
#pragma unroll
  for (int i = 0; i < 2; ++i)
#pragma unroll
    for (int j = 0; j < 2; ++j)
#pragma unroll
      for (int q = 0; q < 16; ++q) acc[i][j][q] = 0.f;
  u32x4 ra[4], rb[4];
  const int nk = K >> 6;
  const bfr* Ab = A + (size_t)m0 * lda;
  const bfr* Bb = Bt + (size_t)n0 * ldb;
#pragma unroll
  for (int i = 0; i < 4; ++i) {
    int chunk = tid + i * 256, row = chunk >> 3, c8 = chunk & 7;
    ra[i] = *(const u32x4*)(Ab + (size_t)row * lda + c8 * 8);
    rb[i] = *(const u32x4*)(Bb + (size_t)row * ldb + c8 * 8);
  }
  for (int kt = 0; kt < nk; ++kt) {
    __syncthreads();
#pragma unroll
    for (int i = 0; i < 4; ++i) {
      int chunk = tid + i * 256, row = chunk >> 3, c8 = chunk & 7;
      *(u32x4*)(As + row * 72 + c8 * 8) = ra[i];
      *(u32x4*)(Bs + row * 72 + c8 * 8) = rb[i];
    }
    __syncthreads();
    if (kt + 1 < nk) {
#pragma unroll
      for (int i = 0; i < 4; ++i) {
        int chunk = tid + i * 256, row = chunk >> 3, c8 = chunk & 7;
        ra[i] = *(const u32x4*)(Ab + (size_t)row * lda + (kt + 1) * 64 + c8 * 8);
        rb[i] = *(const u32x4*)(Bb + (size_t)row * ldb + (kt + 1) * 64 + c8 * 8);
      }
    }
#pragma unroll
    for (int ks = 0; ks < 4; ++ks) {
      bf16x8 af[2], bfg[2];
#pragma unroll
      for (int i = 0; i < 2; ++i) {
        af[i] = *(const bf16x8*)(As + (wr * 64 + i * 32 + r) * 72 + ks * 16 + hl * 8);
        bfg[i] = *(const bf16x8*)(Bs + (wc * 64 + i * 32 + r) * 72 + ks * 16 + hl * 8);
      }
#pragma unroll
      for (int i = 0; i < 2; ++i)
#pragma unroll
        for (int j = 0; j < 2; ++j) acc[i][j] = MFMA32(af[i], bfg[j], acc[i][j]);
    }
  }
}

template <class Epi>
DI void gemm_tile(const bfr* __restrict__ A, int lda, const bfr* __restrict__ Bt, int ldb, int K, int m0, int n0, char* smem, Epi epi) {
  f32x16 acc[2][2];
  gemm_mainloop(A, lda, Bt, ldb, K, m0, n0, smem, acc);
  const int lane = threadIdx.x & 63, wid = threadIdx.x >> 6, wr = wid >> 1, wc = wid & 1, r = lane & 31, hl = lane >> 5;
#pragma unroll
  for (int i = 0; i < 2; ++i)
#pragma unroll
    for (int j = 0; j < 2; ++j)
#pragma unroll
      for (int q = 0; q < 16; ++q) {
        int row = m0 + wr * 64 + i * 32 + crow(q, hl);
        int col = n0 + wc * 64 + j * 32 + r;
        epi(row, col, acc[i][j][q]);
      }
  __syncthreads();
}
template <class Epi, class RowF>
DI void gemm_tile_rs(const bfr* __restrict__ A, int lda, const bfr* __restrict__ Bt, int ldb, int K, int m0, int n0, char* smem, Epi epi, RowF rowf) {
  f32x16 acc[2][2];
  gemm_mainloop(A, lda, Bt, ldb, K, m0, n0, smem, acc);
  const int lane = threadIdx.x & 63, wid = threadIdx.x >> 6, wr = wid >> 1, wc = wid & 1, r = lane & 31, hl = lane >> 5;
#pragma unroll
  for (int i = 0; i < 2; ++i)
#pragma unroll
    for (int q = 0; q < 16; ++q) {
      int row = m0 + wr * 64 + i * 32 + crow(q, hl);
      float rs = 0.f;
#pragma unroll
      for (int j = 0; j < 2; ++j) {
        int col = n0 + wc * 64 + j * 32 + r;
        float v = epi(row, col, acc[i][j][q]);
        rs += v * v;
      }
      rs += __shfl_xor(rs, 16);
      rs += __shfl_xor(rs, 8);
      rs += __shfl_xor(rs, 4);
      rs += __shfl_xor(rs, 2);
      rs += __shfl_xor(rs, 1);
      if (r == 0) rowf(row, rs);
    }
  __syncthreads();
}

template <bool RS, class Epi, class RowF>
DI void gemm_sample(const bfr* __restrict__ A, int lda, const bfr* __restrict__ Bt, int ldb, int K, int N, char* smem, Epi epi, RowF rowf) {
  const int tid = threadIdx.x, lane = tid & 63, wid = tid >> 6, r = lane & 31, hl = lane >> 5;
  float* red = (float*)smem;
  const int nun = 4 * (N >> 5);
  for (int u = blockIdx.x; u < nun; u += gridDim.x) {
    const int mu = u & 3, nu = u >> 2;
    const int kq = K >> 2, k0 = wid * kq;
    const bfr* ap = A + (size_t)(NPR + mu * 32 + r) * lda + k0 + hl * 8;
    const bfr* bp = Bt + (size_t)(nu * 32 + r) * ldb + k0 + hl * 8;
    f32x16 acc;
#pragma unroll
    for (int q = 0; q < 16; ++q) acc[q] = 0.f;
    if (K == 1024) {
#pragma unroll
      for (int ks = 0; ks < 16; ++ks) {
        bf16x8 af = *(const bf16x8*)(ap + ks * 16);
        bf16x8 bf = *(const bf16x8*)(bp + ks * 16);
        acc = MFMA32(af, bf, acc);
      }
    } else {
      for (int ks = 0; ks < (kq >> 4); ++ks) {
        bf16x8 af = *(const bf16x8*)(ap + ks * 16);
        bf16x8 bf = *(const bf16x8*)(bp + ks * 16);
        acc = MFMA32(af, bf, acc);
      }
    }
#pragma unroll
    for (int q = 0; q < 16; ++q) red[(wid * 16 + q) * 64 + lane] = acc[q];
    __syncthreads();
#pragma unroll
    for (int e = 0; e < 4; ++e) {
      const int q = wid + e * 4;
      const float v = red[q * 64 + lane] + red[(16 + q) * 64 + lane] + red[(32 + q) * 64 + lane] + red[(48 + q) * 64 + lane];
      const int row = NPR + mu * 32 + crow(q, hl), col = nu * 32 + r;
      float x = epi(row, col, v);
      if (RS) {
        float s2 = half32_sum_hi(x * x);
        if (r == 31) rowf(row, s2);
      }
    }
    __syncthreads();
  }
}

DI void transpose_tile(const float* __restrict__ W, int ldw, bfr* __restrict__ Wt, int ldt, int k0, int n0, float* sm, int nvalid = 1 << 30) {
  const int tid = threadIdx.x;
#pragma unroll
  for (int i = 0; i < 16; ++i) {
    int idx = tid + i * 256, kk = idx >> 6, nn = idx & 63;
    sm[kk * 65 + nn] = (n0 + nn < nvalid) ? W[(size_t)(k0 + kk) * ldw + n0 + nn] : 0.f;
  }
  __syncthreads();
#pragma unroll
  for (int i = 0; i < 8; ++i) {
    int idx = tid + i * 256, nn = idx >> 5, kp = idx & 31;
    float a = sm[(2 * kp) * 65 + nn], b = sm[(2 * kp + 1) * 65 + nn];
    *(unsigned*)(Wt + (size_t)(n0 + nn) * ldt + k0 + 2 * kp) = pack2(a, b);
  }
  __syncthreads();
}

DI void phase_prep(const Params& p, char* smem) {
  float* sm = (float*)smem;
  for (int tt = blockIdx.x; tt < 4032 + 32; tt += gridDim.x) {
    int t = tt - 32;
    if (tt < 928) {
      int kt = tt / 58, nt = tt % 58;
      transpose_tile(p.w_in_even, EIN, p.WtInE, 1024, kt * 64, nt * 64, sm, EIN);
    } else if (t < 1152) {
      int u = t - 896;
      transpose_tile(p.w_out_even, 1024, p.WtOutE, 1024, (u >> 4) * 64, (u & 15) * 64, sm);
    } else if (t < 1664) {
      int u = t - 1152;
      transpose_tile(p.w_in_odd, 2048, p.WtInO, 1024, (u >> 5) * 64, (u & 31) * 64, sm);
    } else if (t < 1728) {
      int u = t - 1664, g = u >> 4, v = u & 15;
      transpose_tile(p.w_pool + (size_t)g * 65536, 256, p.WtPool + (size_t)g * 65536, 256, (v >> 2) * 64, (v & 3) * 64, sm);
    } else if (t < 1984) {
      int u = t - 1728;
      transpose_tile(p.w_out_odd, 1024, p.WtOutO, 1024, (u >> 4) * 64, (u & 15) * 64, sm);
    } else {
      int u = t - 1984, m = u >> 8, v = u & 255;
      int which = m >> 1, l = m & 1;
      const float* src = (which == 0 ? p.w_xq : which == 1 ? p.w_xk : which == 2 ? p.w_xv : p.w_xo) + (size_t)l * 1048576;
      bfr* dst = (which == 0 ? p.WtXq : which == 1 ? p.WtXk : which == 2 ? p.WtXv : p.WtXo) + (size_t)l * 1048576;
      transpose_tile(src, 1024, dst, 1024, (v >> 4) * 64, (v & 15) * 64, sm);
    }
  }
  {
    for (int i = blockIdx.x * 256 + threadIdx.x; i < 4 * NROW; i += gridDim.x * 256) p.SS[i] = 0.f;
    const int n4 = 2048 * 1024 / 4;
    for (int i = blockIdx.x * 256 + threadIdx.x; i < n4; i += gridDim.x * 256) {
      float4 v = ((const float4*)p.mem_prompt)[i];
      uint2 o;
      o.x = pack2(v.x, v.y);
      o.y = pack2(v.z, v.w);
      ((uint2*)p.MPB)[i] = o;
    }
  }
  {
    const int lane = threadIdx.x & 63, wid = threadIdx.x >> 6;
    float* wT = (float*)smem;
    for (int i = threadIdx.x; i < 2048; i += 256) {
      const int k = i >> 1, hf = i & 1;
      float4 w = *(const float4*)(p.w_in_even + (size_t)k * EIN + EINP + hf * 4);
      wT[(hf * 4 + 0) * 1024 + k] = w.x; wT[(hf * 4 + 1) * 1024 + k] = w.y;
      wT[(hf * 4 + 2) * 1024 + k] = w.z; wT[(hf * 4 + 3) * 1024 + k] = w.w;
    }
    __syncthreads();
    for (int row = blockIdx.x * 4 + wid; row < NROW; row += gridDim.x * 4) {
      const float* xr = row < NPR ? p.x_prompt + (size_t)row * DM : p.x_sample + (size_t)(row - NPR) * DM;
      float4 v[4];
      float ss = 0.f;
#pragma unroll
      for (int j = 0; j < 4; ++j) {
        v[j] = ((const float4*)xr)[j * 64 + lane];
        ss += v[j].x * v[j].x + v[j].y * v[j].y + v[j].z * v[j].z + v[j].w * v[j].w;
      }
      ss = wave_sum(ss);
      float inv = rsqrtf(ss * (1.0f / 1024.0f) + EPSF);
      float part[8];
#pragma unroll
      for (int c = 0; c < 8; ++c) part[c] = 0.f;
#pragma unroll
      for (int j = 0; j < 4; ++j) {
        float4 g = ((const float4*)p.norm_mix)[j * 64 + lane];
        uint2 o;
        const float h0 = v[j].x * inv * g.x, h1 = v[j].y * inv * g.y, h2 = v[j].z * inv * g.z, h3 = v[j].w * inv * g.w;
        o.x = pack2(h0, h1);
        o.y = pack2(h2, h3);
        ((uint2*)(p.H + (size_t)row * DM))[j * 64 + lane] = o;
#pragma unroll
        for (int c = 0; c < 8; ++c) {
          float4 w = ((const float4*)(wT + c * 1024))[j * 64 + lane];
          part[c] += h0 * w.x + h1 * w.y + h2 * w.z + h3 * w.w;
        }
      }
#pragma unroll
      for (int c = 0; c < 8; ++c) part[c] = wave_sum(part[c]);
      if (lane == 0) {
        float4 a = {part[0], part[1], part[2], part[3]}, b = {part[4], part[5], part[6], part[7]};
        ((float4*)(p.BGR + (size_t)row * 8))[0] = a;
        ((float4*)(p.BGR + (size_t)row * 8))[1] = b;
      }
    }
    __syncthreads();
  }
}

DI void phase_rmsnorm(const Params& p, const float* g) {
  const int lane = threadIdx.x & 63, wid = threadIdx.x >> 6;
  for (int row = blockIdx.x * 4 + wid; row < NROW; row += gridDim.x * 4) {
    const float* xr = p.X + (size_t)row * DM;
    float4 v[4];
    float ss = 0.f;
#pragma unroll
    for (int j = 0; j < 4; ++j) {
      v[j] = ((const float4*)xr)[j * 64 + lane];
      ss += v[j].x * v[j].x + v[j].y * v[j].y + v[j].z * v[j].z + v[j].w * v[j].w;
    }
    ss = wave_sum(ss);
    float inv = rsqrtf(ss * (1.0f / 1024.0f) + EPSF);
#pragma unroll
    for (int j = 0; j < 4; ++j) {
      float4 gg = ((const float4*)g)[j * 64 + lane];
      uint2 o;
      o.x = pack2(v[j].x * inv * gg.x, v[j].y * inv * gg.y);
      o.y = pack2(v[j].z * inv * gg.z, v[j].w * inv * gg.w);
      ((uint2*)(p.H + (size_t)row * DM))[j * 64 + lane] = o;
    }
  }
}

DI void phase_final_norm(const Params& p) {
  const float* ss = p.SS + 3 * NROW;
  for (int i = blockIdx.x * 256 + threadIdx.x; i < NROW * 256; i += gridDim.x * 256) {
    const int row = i >> 8, c4 = i & 255;
    float4 v = ((const float4*)p.X)[i];
    float4 g = ((const float4*)p.norm_final)[c4];
    const float inv = rsqrtf(ss[row] * (1.0f / 1024.0f) + EPSF);
    float4 o = {v.x * inv * g.x, v.y * inv * g.y, v.z * inv * g.z, v.w * inv * g.w};
    ((float4*)(p.out + O_Y))[i] = o;
  }
}

DI void phase_gemm_in_even(const Params& p, char* smem) {
  const int NT1 = 128 * 28, NT2 = 4 * 128;
  {
    bfr* PB = p.PB;
    gemm_sample<false>(p.H, 1024, p.WtInE, 1024, 1024, EINP, smem,
                       [=](int row, int col, float v) -> float { PB[(size_t)row * EINP + col] = f2bf(v); return 0.f; },
                       [=](int, float) {});
  }
  for (int t = blockIdx.x; t < NT1 + NT2; t += gridDim.x) {
    if (t < NT1) {
      int mt = t / 28, nt = t % 28;
      bfr* PB = p.PB;
      gemm_tile(p.H, 1024, p.WtInE, 1024, 1024, mt * 128, nt * 128, smem,
                [=](int row, int col, float v) { PB[(size_t)row * EINP + col] = f2bf(v); });
    } else {
      int u = t - NT1, gsel = u >> 7, v = u & 127, mt = v >> 3, nt = v & 7;
      int isv = gsel >> 1, l = gsel & 1;
      if (!isv) {
        float* o = p.out + O_MEMK + (size_t)l * 2097152;
        bfr* kb = p.KB + (size_t)l * 2097152;
        gemm_tile(p.MPB, 1024, p.WtXk + (size_t)l * 1048576, 1024, 1024, mt * 128, nt * 128, smem,
                  [=](int row, int col, float v) {
                    o[(size_t)row * 1024 + col] = v;
                    kb[(size_t)row * 1024 + col] = f2bf(v);
                  });
      } else {
        float* o = p.out + O_MEMV + (size_t)l * 2097152;
        bfr* vt = p.VT + (size_t)l * 2097152;
        gemm_tile(p.MPB, 1024, p.WtXv + (size_t)l * 1048576, 1024, 1024, mt * 128, nt * 128, smem,
                  [=](int row, int col, float v) {
                    o[(size_t)row * 1024 + col] = v;
                    int b = row >> 8, mem = row & 255, h = col >> 8, dim = col & 255;
                    int ks = mem >> 4, ml = mem & 15, hl2 = (ml >> 2) & 1, j = ((ml >> 3) << 2) | (ml & 3);
                    int dt = dim >> 5, rr = dim & 31;
                    size_t off = ((((size_t)(b * 4 + h) * 8 + dt) * 16 + ks) * 64 + hl2 * 32 + rr) * 8 + j;
                    vt[off] = f2bf(v);
                  });
      }
    }
  }
}

template <bool IS_P, bool EDGE>
DI void qkv_token(const Params& p, int row, int lane) {
  const int t = row & 2047, b = row >> 11, s = row - NPR;
#pragma unroll 6
  for (int grp = 0; grp < 12; ++grp) {
    const int ch = grp * 128 + lane * 2;
    float x0[4], x1[4];
    if (IS_P) {
      unsigned u[4];
#pragma unroll
      for (int j = 0; j < 4; ++j) {
        const int rc = (!EDGE || t - 3 + j >= 0) ? (row - 3 + j) : row;
        u[j] = *(const unsigned*)(p.PB + (size_t)rc * EINP + 1536 + ch);
      }
#pragma unroll
      for (int j = 0; j < 4; ++j) {
        const bool ok = (!EDGE || t - 3 + j >= 0);
        x0[j] = ok ? bflo(u[j]) : 0.f;
        x1[j] = ok ? bfhi(u[j]) : 0.f;
      }
    } else {
#pragma unroll
      for (int j = 0; j < 3; ++j) {
        float2 f = *(const float2*)(p.state_qkv_conv + ((size_t)s * 3 + j) * 1536 + ch);
        x0[j] = f.x; x1[j] = f.y;
      }
      unsigned u = *(const unsigned*)(p.PB + (size_t)row * EINP + 1536 + ch);
      x0[3] = bflo(u); x1[3] = bfhi(u);
    }
    float a0 = 0.f, a1 = 0.f;
#pragma unroll
    for (int j = 0; j < 4; ++j) {
      float2 w = *(const float2*)(p.sc_w + (size_t)j * 1536 + ch);
      a0 += w.x * x0[j]; a1 += w.y * x1[j];
    }
    float y0 = siluf_(a0), y1 = siluf_(a1);
    if (grp < 8) {
      float ss = wave_sum(y0 * y0 + y1 * y1);
      float inv = rsqrtf(ss + EPSF);
      if (grp < 4) inv *= 0.08838834764831845f;
      y0 *= inv; y1 *= inv;
    }
    float2 o = {y0, y1};
    *(float2*)(p.QKV + (size_t)row * 1536 + ch) = o;
    if (IS_P) {
      if (t >= 2045) {
        float2 c = {x0[3], x1[3]};
        *(float2*)(p.out + O_QKVP + ((size_t)b * 3 + (t - 2045)) * 1536 + ch) = c;
      }
    } else {
      float2 c0 = {x0[1], x1[1]}, c1 = {x0[2], x1[2]}, c2 = {x0[3], x1[3]};
      *(float2*)(p.out + O_QKVS + ((size_t)s * 3 + 0) * 1536 + ch) = c0;
      *(float2*)(p.out + O_QKVS + ((size_t)s * 3 + 1) * 1536 + ch) = c1;
      *(float2*)(p.out + O_QKVS + ((size_t)s * 3 + 2) * 1536 + ch) = c2;
    }
  }
  if (lane < 4) {
    float bl = p.BGR[(size_t)row * 8 + lane], al = p.BGR[(size_t)row * 8 + 4 + lane];
    float beta = sigmoidf_(bl);
    float xx = al + p.dt_bias[lane];
    float sp = xx > 20.f ? xx : log1pf(__expf(xx));
    float g = -__expf(p.a_log[lane]) * sp;
    p.BG[(size_t)row * 8 + lane] = beta;
    p.BG[(size_t)row * 8 + 4 + lane] = g;
  }
}

template <int G0>
DI void qkv_run4_half(const Params& p, int row0, int lane) {
  const int t0 = row0 & 2047, b = row0 >> 11;
  unsigned u[6][7];
  float2 w[6][4];
#pragma unroll
  for (int i = 0; i < 7; ++i) {
    const int rr = (i >= 3 || t0 > 0) ? (row0 - 3 + i) : row0;
    const bfr* rp = p.PB + (size_t)rr * EINP + 1536 + G0 * 128 + lane * 2;
#pragma unroll
    for (int g = 0; g < 6; ++g) u[g][i] = *(const unsigned*)(rp + g * 128);
  }
#pragma unroll
  for (int j = 0; j < 4; ++j) {
    const float* wp = p.sc_w + (size_t)j * 1536 + G0 * 128 + lane * 2;
#pragma unroll
    for (int g = 0; g < 6; ++g) w[g][j] = *(const float2*)(wp + g * 128);
  }
  const float hm = (t0 > 0) ? 1.f : 0.f;
#pragma unroll
  for (int k = 0; k < 4; ++k) {
    const int row = row0 + k;
#pragma unroll
    for (int g = 0; g < 6; ++g) {
      const int grp = G0 + g;
      const int ch = grp * 128 + lane * 2;
      float a0 = 0.f, a1 = 0.f;
#pragma unroll
      for (int j = 0; j < 4; ++j) {
        const int i = k + j;
        const float m = (i >= 3) ? 1.f : hm;
        a0 += w[g][j].x * (bflo(u[g][i]) * m);
        a1 += w[g][j].y * (bfhi(u[g][i]) * m);
      }
      float y0 = siluf_(a0), y1 = siluf_(a1);
      if (grp < 8) {
        float ss = wave_sum(y0 * y0 + y1 * y1);
        float inv = rsqrtf(ss + EPSF);
        if (grp < 4) inv *= 0.08838834764831845f;
        y0 *= inv; y1 *= inv;
      }
      float2 o = {y0, y1};
      *(float2*)(p.QKV + (size_t)row * 1536 + ch) = o;
      if (t0 == 2044 && k >= 1) {
        float2 c = {bflo(u[g][k + 3]), bfhi(u[g][k + 3])};
        *(float2*)(p.out + O_QKVP + ((size_t)b * 3 + (k - 1)) * 1536 + ch) = c;
      }
    }
  }
}
DI void qkv_run4(const Params& p, int row0, int lane) {
  qkv_run4_half<0>(p, row0, lane);
  qkv_run4_half<6>(p, row0, lane);
  if (lane < 16) {
    const int row = row0 + (lane >> 2), hd = lane & 3;
    float bl = p.BGR[(size_t)row * 8 + hd], al = p.BGR[(size_t)row * 8 + 4 + hd];
    float beta = sigmoidf_(bl);
    float xx = al + p.dt_bias[hd];
    float sp = xx > 20.f ? xx : log1pf(__expf(xx));
    float g = -__expf(p.a_log[hd]) * sp;
    p.BG[(size_t)row * 8 + hd] = beta;
    p.BG[(size_t)row * 8 + 4 + hd] = g;
  }
}

DI void conv_a_prompt_item(const Params& p, int item, float* sm) {
  const int half = item & 1, tile = (item >> 1) & 63, b = item >> 7;
  const int tid = threadIdx.x, c = half * 256 + tid, t0 = tile * 32;
  {
    const int tg = tid >> 5, c8 = tid & 31;
    u32x4 vv[8], gg[8];
#pragma unroll
    for (int ps = 0; ps < 8; ++ps) {
      const int i = tg + 8 * ps;
      const int tt = t0 - 30 + i;
      const size_t row = (size_t)b * 2048 + ((tt >= 0 && i < 62) ? tt : t0);
      vv[ps] = *(const u32x4*)(p.PB + row * EINP + half * 256 + c8 * 8);
      gg[ps] = *(const u32x4*)(p.PB + row * EINP + 512 + half * 256 + c8 * 8);
    }
#pragma unroll
    for (int ps = 0; ps < 8; ++ps) {
      const int i = tg + 8 * ps;
      const int tt = t0 - 30 + i;
      const float msk = (tt >= 0) ? 1.f : 0.f;
      float o8[8];
#pragma unroll
      for (int e = 0; e < 4; ++e) {
        o8[2 * e] = bflo(vv[ps][e]) * sigmoidf_(bflo(gg[ps][e])) * msk;
        o8[2 * e + 1] = bfhi(vv[ps][e]) * sigmoidf_(bfhi(gg[ps][e])) * msk;
      }
      if (i < 62) {
        float4 a0 = {o8[0], o8[1], o8[2], o8[3]}, a1 = {o8[4], o8[5], o8[6], o8[7]};
        *(float4*)(sm + i * 256 + c8 * 8) = a0;
        *(float4*)(sm + i * 256 + c8 * 8 + 4) = a1;
      }
    }
    __syncthreads();
  }
  float w[31];
#pragma unroll
  for (int j = 0; j < 31; ++j) w[j] = p.dw_w[j * 512 + c];
  const float bias = p.dw_b[c];
#pragma unroll 1
  for (int o = 0; o < 32; ++o) {
    float acc = bias;
#pragma unroll
    for (int j = 0; j < 31; ++j) acc += w[j] * sm[(o + j) * 256 + tid];
    p.CONV[((size_t)b * 2048 + t0 + o) * 512 + c] = acc;
  }
  if (tile == 63) {
#pragma unroll 1
    for (int j = 0; j < 30; ++j) p.out[O_CONVP + ((size_t)b * 30 + j) * 512 + c] = sm[(32 + j) * 256 + tid];
  }
  __syncthreads();
}

DI void conv_a_sample_item(const Params& p, int s) {
  const int tid = threadIdx.x;
  const size_t row = NPR + s;
#pragma unroll
  for (int cc = 0; cc < 2; ++cc) {
    int c = tid + cc * 256;
    float val = bf2f(p.PB[row * EINP + c]);
    float gate = bf2f(p.PB[row * EINP + 512 + c]);
    float gl = val * sigmoidf_(gate);
    float acc = p.dw_b[c] + p.dw_w[30 * 512 + c] * gl;
#pragma unroll 6
    for (int j = 0; j < 30; ++j) {
      float st = p.state_conv_a[((size_t)s * 30 + j) * 512 + c];
      acc += p.dw_w[j * 512 + c] * st;
      if (j >= 1) p.out[O_CONVS + ((size_t)s * 30 + j - 1) * 512 + c] = st;
    }
    p.out[O_CONVS + ((size_t)s * 30 + 29) * 512 + c] = gl;
    p.CONV[row * 512 + c] = acc;
  }
}

DI void phase_even_pw_conv(const Params& p, char* smem) {
  for (int it = blockIdx.x; it < 1024 + 128; it += gridDim.x) {
    if (it < 1024) conv_a_prompt_item(p, it, (float*)smem);
    else conv_a_sample_item(p, it - 1024);
  }
}
DI void phase_even_pw_qkv(const Params& p) {
  const int lane = threadIdx.x & 63, wid = threadIdx.x >> 6;
  for (int run = blockIdx.x * 4 + wid; run < NPR / 4; run += gridDim.x * 4) qkv_run4(p, run * 4, lane);
  for (int row = NPR + blockIdx.x * 4 + wid; row < NROW; row += gridDim.x * 4) qkv_token<false, false>(p, row, lane);
}
DI void phase_even_pointwise(const Params& p, char* smem) {
  phase_even_pw_conv(p, smem);
  phase_even_pw_qkv(p);
}

DI void chunk_prep(const Params& p, int item, char* smem) {
  const int tid = threadIdx.x, lane = tid & 63, wid = tid >> 6, r = lane & 31, hl = lane >> 5;
  const int n = item & 31, hh = (item >> 5) & 3, b = item >> 7;
  const size_t row0 = (size_t)b * 2048 + n * 64;
  float* gcs = (float*)smem;
  float* betas = gcs + 64;
  float* egs = betas + 64;
  float* kscale = egs + 64;
  bfr* qs = (bfr*)(smem + 1024);
  bfr* ks_ = qs + 64 * 136;
  float* Am = (float*)(smem + 1024 + 2 * 64 * 136 * 2);
  bfr* wsb = qs;
  if (tid < 64) {
    float beta = p.BG[(row0 + tid) * 8 + hh];
    float g = p.BG[(row0 + tid) * 8 + 4 + hh];
    float v = g;
#pragma unroll
    for (int off = 1; off < 64; off <<= 1) {
      float t = __shfl_up(v, off);
      if (lane >= off) v += t;
    }
    float gl = __shfl(v, 63);
    gcs[tid] = v;
    betas[tid] = beta;
    egs[tid] = __expf(v);
    kscale[tid] = __expf(gl - v);
    if (tid == 63) p.GL[item] = __expf(gl);
  }
#pragma unroll
  for (int i = 0; i < 8; ++i) {
    int idx = tid + i * 256, row = idx >> 5, c4 = idx & 31;
    float4 q = *(const float4*)(p.QKV + (row0 + row) * 1536 + hh * 128 + c4 * 4);
    float4 k = *(const float4*)(p.QKV + (row0 + row) * 1536 + 512 + hh * 128 + c4 * 4);
    uint2 qo, ko;
    qo.x = pack2(q.x, q.y); qo.y = pack2(q.z, q.w);
    ko.x = pack2(k.x, k.y); ko.y = pack2(k.z, k.w);
    *(uint2*)(qs + row * 136 + c4 * 4) = qo;
    *(uint2*)(ks_ + row * 136 + c4 * 4) = ko;
  }
  __syncthreads();
  {
    const int mi = wid >> 1, ni = wid & 1;
    f32x16 akk, aqk;
#pragma unroll
    for (int q = 0; q < 16; ++q) { akk[q] = 0.f; aqk[q] = 0.f; }
#pragma unroll
    for (int ks = 0; ks < 8; ++ks) {
      bf16x8 ka = *(const bf16x8*)(ks_ + (mi * 32 + r) * 136 + ks * 16 + hl * 8);
      bf16x8 qa = *(const bf16x8*)(qs + (mi * 32 + r) * 136 + ks * 16 + hl * 8);
      bf16x8 kb = *(const bf16x8*)(ks_ + (ni * 32 + r) * 136 + ks * 16 + hl * 8);
      akk = MFMA32(ka, kb, akk);
      aqk = MFMA32(qa, kb, aqk);
    }
    bfr* qkf = (bfr*)(p.QKF + (size_t)item * 512);
#pragma unroll
    for (int q = 0; q < 16; ++q) {
      int i = mi * 32 + crow(q, hl), j = ni * 32 + r;
      float dec = (i >= j) ? __expf(gcs[i] - gcs[j]) : 0.f;
      Am[i * 68 + j] = (i > j) ? akk[q] * betas[i] * dec : 0.f;
      float qv = (i >= j) ? aqk[q] * dec : 0.f;
      int ksj = j >> 4, jl = j & 15, h2 = (jl >> 2) & 1, jj = ((jl >> 3) << 2) | (jl & 3);
      qkf[((mi * 4 + ksj) * 64 + h2 * 32 + (i & 31)) * 8 + jj] = f2bf(qv);
    }
  }
  {
    uint4* QD = p.QD + (size_t)item * 1024;
#pragma unroll
    for (int i = 0; i < 4; ++i) {
      int idx = tid + i * 256, f = idx >> 6, ln = idx & 63, mt = f >> 3, ks = f & 7, m = ln & 31, h2 = ln >> 5;
      int ri = mt * 32 + m, d0 = ks * 16 + h2 * 4;
      float sc = egs[ri];
      const float* src = p.QKV + (row0 + ri) * 1536 + hh * 128 + d0;
      float4 a = *(const float4*)src, c = *(const float4*)(src + 8);
      uint4 o;
      o.x = pack2(a.x * sc, a.y * sc); o.y = pack2(a.z * sc, a.w * sc);
      o.z = pack2(c.x * sc, c.y * sc); o.w = pack2(c.z * sc, c.w * sc);
      QD[f * 64 + ln] = o;
    }
    uint4* KD = p.KD + (size_t)item * 1024;
#pragma unroll
    for (int i = 0; i < 4; ++i) {
      int idx = tid + i * 256, f = idx >> 6, ln = idx & 63, mt = f >> 2, ks = f & 3, m = ln & 31, h2 = ln >> 5;
      int d = mt * 32 + m;
      float vals[8];
#pragma unroll
      for (int j = 0; j < 8; ++j) {
        int c = ks * 16 + 8 * (j >> 2) + 4 * h2 + (j & 3);
        vals[j] = p.QKV[(row0 + c) * 1536 + 512 + hh * 128 + d] * kscale[c];
      }
      uint4 o;
      o.x = pack2(vals[0], vals[1]); o.y = pack2(vals[2], vals[3]);
      o.z = pack2(vals[4], vals[5]); o.w = pack2(vals[6], vals[7]);
      KD[f * 64 + ln] = o;
    }
  }
  __syncthreads();
  {
    const int c = tid;
    const float* src = (c < 128) ? (p.QKV + row0 * 1536 + 1024 + hh * 128 + c) : (p.QKV + row0 * 1536 + 512 + hh * 128 + (c - 128));
    float sol[64];
#pragma unroll
    for (int i = 0; i < 64; ++i) {
      float rhs = src[(size_t)i * 1536] * betas[i];
      if (c >= 128) rhs *= egs[i];
      float acc = rhs;
#pragma unroll
      for (int j = 0; j < i; ++j) acc -= Am[i * 68 + j] * sol[j];
      sol[i] = acc;
    }
    if (c < 128) {
      float* U = p.U + (size_t)item * 8192;
#pragma unroll
      for (int i = 0; i < 64; ++i) U[i * 128 + c] = sol[i];
    } else {
#pragma unroll
      for (int i = 0; i < 64; ++i) wsb[i * 136 + (c - 128)] = f2bf(-sol[i]);
    }
  }
  __syncthreads();
  {
    uint4* WN = p.WN + (size_t)item * 1024;
#pragma unroll
    for (int i = 0; i < 4; ++i) {
      int idx = tid + i * 256, f = idx >> 6, ln = idx & 63, mt = f >> 3, ks = f & 7, m = ln & 31, h2 = ln >> 5;
      int ri = mt * 32 + m, d0 = ks * 16 + h2 * 4;
      uint2 a = *(const uint2*)(wsb + ri * 136 + d0), c = *(const uint2*)(wsb + ri * 136 + d0 + 8);
      uint4 o = {a.x, a.y, c.x, c.y};
      WN[f * 64 + ln] = o;
    }
  }
  __syncthreads();
}

DI void branch_a_final_row(const Params& p, int row, int lane) {
  const float* cr = p.CONV + (size_t)row * 512;
  float4 v[2];
  float s = 0.f;
#pragma unroll
  for (int j = 0; j < 2; ++j) {
    v[j] = ((const float4*)cr)[j * 64 + lane];
    s += v[j].x + v[j].y + v[j].z + v[j].w;
  }
  float mean = wave_sum(s) * (1.0f / 512.0f);
  float vs = 0.f;
#pragma unroll
  for (int j = 0; j < 2; ++j) {
    v[j].x -= mean; v[j].y -= mean; v[j].z -= mean; v[j].w -= mean;
    vs += v[j].x * v[j].x + v[j].y * v[j].y + v[j].z * v[j].z + v[j].w * v[j].w;
  }
  float inv = rsqrtf(wave_sum(vs) * (1.0f / 512.0f) + EPSF);
#pragma unroll
  for (int j = 0; j < 2; ++j) {
    int c = (j * 64 + lane) * 4;
    float4 g = *(const float4*)(p.ln_a_g + c), bb = *(const float4*)(p.ln_a_b + c);
    uint2 gu = *(const uint2*)(p.PB + (size_t)row * EINP + 1024 + c);
    float y0 = siluf_(v[j].x * inv * g.x + bb.x) * siluf_(bflo(gu.x));
    float y1 = siluf_(v[j].y * inv * g.y + bb.y) * siluf_(bfhi(gu.x));
    float y2 = siluf_(v[j].z * inv * g.z + bb.z) * siluf_(bflo(gu.y));
    float y3 = siluf_(v[j].w * inv * g.w + bb.w) * siluf_(bfhi(gu.y));
    uint2 o;
    o.x = pack2(y0, y1); o.y = pack2(y2, y3);
    *(uint2*)(p.MIX + (size_t)row * 1024 + c) = o;
  }
}

DI void delta_sample_item(const Params& p, int item, char* smem) {
  const int s = item >> 2, hh = item & 3, tid = threadIdx.x;
  const size_t row = NPR + s;
  float* ksm = (float*)smem;
  float* qsm = ksm + 128;
  float* part = qsm + 128;
  if (tid < 128) ksm[tid] = p.QKV[row * 1536 + 512 + hh * 128 + tid];
  else qsm[tid - 128] = p.QKV[row * 1536 + hh * 128 + (tid - 128)];
  const float beta = p.BG[row * 8 + hh], a = __expf(p.BG[row * 8 + 4 + hh]);
  __syncthreads();
  const int e = tid & 127, half = tid >> 7, d0 = half * 64;
  const float* S0 = p.state_delta + (((size_t)s * 4 + hh) * 128 + d0) * 128 + e;
  float* So = p.out + O_DELTAS + (((size_t)s * 4 + hh) * 128 + d0) * 128 + e;
  float Sr[64];
  float ksum = 0.f;
#pragma unroll
  for (int i = 0; i < 64; ++i) {
    Sr[i] = S0[(size_t)i * 128] * a;
    ksum += ksm[d0 + i] * Sr[i];
  }
  part[half * 128 + e] = ksum;
  __syncthreads();
  const float kS = part[e] + part[128 + e];
  const float v = p.QKV[row * 1536 + 1024 + hh * 128 + e];
  const float vnew = (v - kS) * beta;
  float oo = 0.f;
#pragma unroll
  for (int i = 0; i < 64; ++i) {
    Sr[i] += ksm[d0 + i] * vnew;
    So[(size_t)i * 128] = Sr[i];
    oo += qsm[d0 + i] * Sr[i];
  }
  __syncthreads();
  part[half * 128 + e] = oo;
  __syncthreads();
  if (half == 0) p.ODN[row * 512 + hh * 128 + e] = part[e] + part[128 + e];
  __syncthreads();
}

DI void phase_chunk_prep(const Params& p, char* smem) {
  for (int it = blockIdx.x; it < 1024; it += gridDim.x) chunk_prep(p, it, smem);
}

DI void scan_item(const Params& p, int item, char* smem) {
  const int tid = threadIdx.x, lane = tid & 63, es = tid >> 6, r = lane & 31, hl = lane >> 5;
  const int b = item >> 2, hh = item & 3;
  u32x4* bufA = (u32x4*)smem;
  u32x4* bufB = (u32x4*)(smem + 32768);
  const u32x4* gWN = (const u32x4*)p.WN + (size_t)item * 32 * 1024;
  const u32x4* gQD = (const u32x4*)p.QD + (size_t)item * 32 * 1024;
  const u32x4* gKD = (const u32x4*)p.KD + (size_t)item * 32 * 1024;
  const u32x4* gQK = (const u32x4*)p.QKF + (size_t)item * 32 * 512;
  const float* gU = p.U + (size_t)item * 32 * 8192;
  const int uo = hl * 4 * 128 + es * 32 + r;
  const int oo = hl * 4 * 512 + es * 32 + r;
#define GLDS(gp, lp) __builtin_amdgcn_global_load_lds((const unsigned*)(gp), (unsigned*)(lp), 16, 0, 0)
  f32x16 S[4];
#pragma unroll
  for (int d = 0; d < 4; ++d)
#pragma unroll
    for (int q = 0; q < 16; ++q) S[d][q] = 0.f;
  f32x16 vn[2], o[2];
#pragma unroll
  for (int i = 0; i < 4; ++i) {
    GLDS(gWN + tid + i * 256, bufA + tid + i * 256);
    GLDS(gQD + tid + i * 256, bufA + 1024 + tid + i * 256);
  }
#pragma unroll
  for (int ct = 0; ct < 2; ++ct)
#pragma unroll
    for (int q = 0; q < 16; ++q) vn[ct][q] = gU[(ct * 32 + crow(q, 0)) * 128 + uo];
  asm volatile("s_waitcnt vmcnt(0)" ::: "memory");
  __syncthreads();
#pragma unroll 1
  for (int n = 0; n < 32; ++n) {
    const int chunk = item * 32 + n;
    const float gl = p.GL[chunk];
    const int n1 = (n + 1 < 32) ? n + 1 : 31;
    {
      const u32x4* k0 = gQK + n * 512;
      const u32x4* d0 = gKD + n * 1024;
#pragma unroll
      for (int i = 0; i < 2; ++i) GLDS(k0 + tid + i * 256, bufB + tid + i * 256);
#pragma unroll
      for (int i = 0; i < 4; ++i) GLDS(d0 + tid + i * 256, bufB + 512 + tid + i * 256);
    }
    {
      bf16x8 Sb[4][2];
#pragma unroll
      for (int d = 0; d < 4; ++d) { Sb[d][0] = pack8(S[d], 0); Sb[d][1] = pack8(S[d], 1); }
#pragma unroll
      for (int ct = 0; ct < 2; ++ct)
#pragma unroll
        for (int q = 0; q < 16; ++q) o[ct][q] = 0.f;
#pragma unroll
      for (int ct = 0; ct < 2; ++ct)
#pragma unroll
        for (int ks = 0; ks < 8; ++ks) {
          bf16x8 aw = __builtin_bit_cast(bf16x8, bufA[(ct * 8 + ks) * 64 + lane]);
          bf16x8 aq = __builtin_bit_cast(bf16x8, bufA[1024 + (ct * 8 + ks) * 64 + lane]);
          vn[ct] = MFMA32(aw, Sb[ks >> 1][ks & 1], vn[ct]);
          o[ct] = MFMA32(aq, Sb[ks >> 1][ks & 1], o[ct]);
        }
    }
    bf16x8 Vb[2][2];
#pragma unroll
    for (int ct = 0; ct < 2; ++ct) { Vb[ct][0] = pack8(vn[ct], 0); Vb[ct][1] = pack8(vn[ct], 1); }
    asm volatile("s_waitcnt vmcnt(0)" ::: "memory");
    __syncthreads();
    {
      const u32x4* w1 = gWN + n1 * 1024;
      const u32x4* q1 = gQD + n1 * 1024;
#pragma unroll
      for (int i = 0; i < 4; ++i) {
        GLDS(w1 + tid + i * 256, bufA + tid + i * 256);
        GLDS(q1 + tid + i * 256, bufA + 1024 + tid + i * 256);
      }
      const float* u1 = gU + n1 * 8192;
#pragma unroll
      for (int ct = 0; ct < 2; ++ct)
#pragma unroll
        for (int q = 0; q < 16; ++q) vn[ct][q] = u1[(ct * 32 + crow(q, 0)) * 128 + uo];
    }
#pragma unroll
    for (int ct = 0; ct < 2; ++ct)
#pragma unroll
      for (int ks = 0; ks < 4; ++ks) {
        bf16x8 a = __builtin_bit_cast(bf16x8, bufB[(ct * 4 + ks) * 64 + lane]);
        o[ct] = MFMA32(a, Vb[ks >> 1][ks & 1], o[ct]);
      }
#pragma unroll
    for (int d = 0; d < 4; ++d) {
#pragma unroll
      for (int q = 0; q < 16; ++q) S[d][q] *= gl;
#pragma unroll
      for (int ks = 0; ks < 4; ++ks) {
        bf16x8 a = __builtin_bit_cast(bf16x8, bufB[512 + (d * 4 + ks) * 64 + lane]);
        S[d] = MFMA32(a, Vb[ks >> 1][ks & 1], S[d]);
      }
    }
    float* od = p.ODN + ((size_t)b * 2048 + n * 64) * 512 + hh * 128;
#pragma unroll
    for (int ct = 0; ct < 2; ++ct)
#pragma unroll
      for (int q = 0; q < 16; ++q) od[(ct * 32 + crow(q, 0)) * 512 + oo] = o[ct][q];
    asm volatile("s_waitcnt vmcnt(0)" ::: "memory");
    __syncthreads();
  }
#undef GLDS
  float* so = p.out + O_DELTAP + ((size_t)(b * 4 + hh) * 128) * 128;
#pragma unroll
  for (int d = 0; d < 4; ++d)
#pragma unroll
    for (int q = 0; q < 16; ++q) so[(d * 32 + crow(q, 0)) * 128 + uo] = S[d][q];
  __syncthreads();
}

DI void phase_scan(const Params& p, char* smem) {
  const int lane = threadIdx.x & 63, wid = threadIdx.x >> 6;
  if (gridDim.x >= 64) {
    if (blockIdx.x < 32) {
      scan_item(p, blockIdx.x, smem);
    } else {
      const int nb = gridDim.x - 32, bi = blockIdx.x - 32;
      for (int it = bi; it < 512; it += nb) delta_sample_item(p, it, smem);
      for (int row = bi * 4 + wid; row < NROW; row += nb * 4) branch_a_final_row(p, row, lane);
    }
  } else {
    for (int it = blockIdx.x; it < 32; it += gridDim.x) scan_item(p, it, smem);
    for (int it = blockIdx.x; it < 512; it += gridDim.x) delta_sample_item(p, it, smem);
    for (int row = blockIdx.x * 4 + wid; row < NROW; row += gridDim.x * 4) branch_a_final_row(p, row, lane);
  }
}

DI void phase_delta_post(const Params& p) {
  const int lane = threadIdx.x & 63, wid = threadIdx.x >> 6;
  for (int row = blockIdx.x * 4 + wid; row < NROW; row += gridDim.x * 4) {
#pragma unroll
    for (int hh = 0; hh < 4; ++hh) {
      int ch = hh * 128 + lane * 2;
      float2 o = *(const float2*)(p.ODN + (size_t)row * 512 + ch);
      float ss = wave_sum(o.x * o.x + o.y * o.y);
      float inv = rsqrtf(ss * (1.0f / 128.0f) + EPSF);
      float2 g = *(const float2*)(p.dn_norm_g + lane * 2);
      unsigned zu = *(const unsigned*)(p.PB + (size_t)row * EINP + 3072 + ch);
      float y0 = o.x * inv * g.x * siluf_(bflo(zu));
      float y1 = o.y * inv * g.y * siluf_(bfhi(zu));
      *(unsigned*)(p.MIX + (size_t)row * 1024 + 512 + ch) = pack2(y0, y1);
    }
  }
}

template <bool FIRST, bool HAS_H>
DI void phase_gemm_resid(const Params& p, const bfr* A, const bfr* Wt, const float* gnext, float* ss, char* smem) {
  float* X = p.X;
  bfr* Hn = p.H;
  const int lane = threadIdx.x & 63, wid = threadIdx.x >> 6, wr = wid >> 1, wc = wid & 1, r = lane & 31, hl = lane >> 5;
  {
    const float* xs = p.x_sample - (size_t)NPR * 1024;
    gemm_sample<true>(A, 1024, Wt, 1024, 1024, 1024, smem,
                      [=](int row, int col, float v) -> float {
                        const size_t o = (size_t)row * 1024 + col;
                        const float xn = (FIRST ? xs[o] : X[o]) + v;
                        X[o] = xn;
                        if (HAS_H) Hn[o] = f2bf(xn * gnext[col]);
                        return xn;
                      },
                      [=](int row, float s2) { unsafeAtomicAdd(ss + row, s2); });
  }
  for (int t = blockIdx.x; t < 128 * 8; t += gridDim.x) {
    const int mt = t >> 3, nt = t & 7, m0 = mt * 128, n0 = nt * 128;
    f32x16 acc[2][2];
    gemm_mainloop(A, 1024, Wt, 1024, 1024, m0, n0, smem, acc);
    const float* xsrc = FIRST ? ((m0 < NPR) ? p.x_prompt : p.x_sample - (size_t)NPR * 1024) : X;
    const int rbase = m0 + wr * 64 + 4 * hl, cbase = n0 + wc * 64 + r;
    float g0 = 0.f, g1 = 0.f;
    if (HAS_H) { g0 = gnext[cbase]; g1 = gnext[cbase + 32]; }
#pragma unroll
    for (int i = 0; i < 2; ++i) {
      float xo[2][16];
#pragma unroll
      for (int j = 0; j < 2; ++j)
#pragma unroll
        for (int q = 0; q < 16; ++q)
          xo[j][q] = xsrc[(size_t)(rbase + i * 32 + crow(q, 0)) * 1024 + cbase + j * 32];
      float rs[16];
#pragma unroll
      for (int q = 0; q < 16; ++q) {
        const size_t o = (size_t)(rbase + i * 32 + crow(q, 0)) * 1024 + cbase;
        const float x0 = xo[0][q] + acc[i][0][q], x1 = xo[1][q] + acc[i][1][q];
        X[o] = x0;
        X[o + 32] = x1;
        if (HAS_H) { Hn[o] = f2bf(x0 * g0); Hn[o + 32] = f2bf(x1 * g1); }
        rs[q] = x0 * x0 + x1 * x1;
      }
#pragma unroll
      for (int q = 0; q < 16; ++q) rs[q] = half32_sum_hi(rs[q]);
      if (r == 31) {
#pragma unroll
        for (int q = 0; q < 16; ++q) unsafeAtomicAdd(ss + rbase + i * 32 + crow(q, 0), rs[q]);
      }
    }
    __syncthreads();
  }
}
DI void phase_gemm_bf16out(const Params& p, const bfr* A, const bfr* Wt, bfr* C, int N, const float* ss, char* smem) {
  const int ntn = N >> 7;
  gemm_sample<false>(A, 1024, Wt, 1024, 1024, N, smem,
                     [=](int row, int col, float v) -> float {
                       float inv = rsqrtf(ss[row] * (1.0f / 1024.0f) + EPSF);
                       C[(size_t)row * N + col] = f2bf(v * inv);
                       return 0.f;
                     },
                     [=](int, float) {});
  for (int t = blockIdx.x; t < 128 * ntn; t += gridDim.x) {
    int mt = t / ntn, nt = t % ntn;
    gemm_tile(A, 1024, Wt, 1024, 1024, mt * 128, nt * 128, smem,
              [=](int row, int col, float v) {
                float inv = rsqrtf(ss[row] * (1.0f / 1024.0f) + EPSF);
                C[(size_t)row * N + col] = f2bf(v * inv);
              });
  }
}

DI void attn_prompt_wave(const Params& p, int l, int b, int hh, int tt, bfr* Obuf) {
  const int lane = threadIdx.x & 63, r = lane & 31, hl = lane >> 5;
  const size_t row0 = (size_t)b * 2048 + tt * 32;
  const bfr* Qp = p.ACT2 + (row0 + r) * 1024 + hh * 256 + hl * 8;
  const bfr* Kp = p.KB + (size_t)l * 2097152 + ((size_t)b * 256 + r) * 1024 + hh * 256 + hl * 8;
  f32x16 st[8];
#pragma unroll
  for (int m = 0; m < 8; ++m)
#pragma unroll
    for (int q = 0; q < 16; ++q) st[m][q] = 0.f;
#pragma unroll 2
  for (int ks = 0; ks < 16; ++ks) {
    bf16x8 qf = *(const bf16x8*)(Qp + ks * 16);
#pragma unroll
    for (int m = 0; m < 8; ++m) {
      bf16x8 kf = *(const bf16x8*)(Kp + (size_t)m * 32 * 1024 + ks * 16);
      st[m] = MFMA32(kf, qf, st[m]);
    }
  }
  float mx = -3.0e38f;
#pragma unroll
  for (int m = 0; m < 8; ++m)
#pragma unroll
    for (int q = 0; q < 16; ++q) mx = fmaxf(mx, st[m][q]);
  mx = fmaxf(mx, __shfl_xor(mx, 32));
  float sum = 0.f;
#pragma unroll
  for (int m = 0; m < 8; ++m)
#pragma unroll
    for (int q = 0; q < 16; ++q) {
      float e = __expf((st[m][q] - mx) * 0.0625f);
      st[m][q] = e;
      sum += e;
    }
  sum += __shfl_xor(sum, 32);
  const float inv = 1.0f / sum;
  bf16x8 pb[8][2];
#pragma unroll
  for (int m = 0; m < 8; ++m) { pb[m][0] = pack8(st[m], 0); pb[m][1] = pack8(st[m], 1); }
  const uint4* VT = (const uint4*)(p.VT + (size_t)l * 2097152) + ((size_t)(b * 4 + hh) * 8) * 16 * 64 + lane;
  bfr* Op = Obuf + (row0 + r) * 1024 + hh * 256;
#pragma unroll 1
  for (int half = 0; half < 2; ++half) {
    f32x16 o[4];
#pragma unroll
    for (int d = 0; d < 4; ++d)
#pragma unroll
      for (int q = 0; q < 16; ++q) o[d][q] = 0.f;
#pragma unroll
    for (int ks = 0; ks < 16; ++ks) {
#pragma unroll
      for (int d = 0; d < 4; ++d) {
        bf16x8 vf = ldfrag(VT + ((size_t)(half * 4 + d) * 16 + ks) * 64);
        o[d] = MFMA32(vf, pb[ks >> 1][ks & 1], o[d]);
      }
    }
#pragma unroll
    for (int d = 0; d < 4; ++d)
#pragma unroll
      for (int g4 = 0; g4 < 4; ++g4) {
        int dim = (half * 4 + d) * 32 + 8 * g4 + 4 * hl;
        uint2 ov;
        ov.x = pack2(o[d][g4 * 4 + 0] * inv, o[d][g4 * 4 + 1] * inv);
        ov.y = pack2(o[d][g4 * 4 + 2] * inv, o[d][g4 * 4 + 3] * inv);
        *(uint2*)(Op + dim) = ov;
      }
  }
}

DI void attn_sample_item(const Params& p, int l, int item, char* smem, bfr* Obuf) {
  const int s = item >> 2, hh = item & 3, tid = threadIdx.x, lane = tid & 63, wid = tid >> 6;
  float* qsm = (float*)smem;
  float* sc = qsm + 256;
  float* red = sc + 256;
  const size_t row = NPR + s;
  qsm[tid] = bf2f(p.ACT2[row * 1024 + hh * 256 + tid]);
  __syncthreads();
  const int grp = lane >> 4, l16 = lane & 15;
  float4 q4[4];
#pragma unroll
  for (int j = 0; j < 4; ++j) q4[j] = ((const float4*)qsm)[j * 16 + l16];
  const float* Kb = p.cache_k + ((((size_t)l * 128 + s) * 256) * 4 + hh) * 256;
  const float* Vb = p.cache_v + ((((size_t)l * 128 + s) * 256) * 4 + hh) * 256;
#pragma unroll 8
  for (int ps = 0; ps < 16; ++ps) {
    int mem = wid * 64 + ps * 4 + grp;
    const float4* kr = (const float4*)(Kb + (size_t)mem * 1024);
    float d = 0.f;
#pragma unroll
    for (int j = 0; j < 4; ++j) {
      float4 k4 = kr[j * 16 + l16];
      d += k4.x * q4[j].x + k4.y * q4[j].y + k4.z * q4[j].z + k4.w * q4[j].w;
    }
    d += __shfl_xor(d, 8);
    d += __shfl_xor(d, 4);
    d += __shfl_xor(d, 2);
    d += __shfl_xor(d, 1);
    if (l16 == 0) sc[mem] = d * 0.0625f;
  }
  __syncthreads();
  float sv = sc[tid];
  float m = wave_max(sv);
  if (lane == 0) red[wid] = m;
  __syncthreads();
  m = fmaxf(fmaxf(red[0], red[1]), fmaxf(red[2], red[3]));
  float e = __expf(sv - m);
  float sm_ = wave_sum(e);
  if (lane == 0) red[4 + wid] = sm_;
  sc[tid] = e;
  __syncthreads();
  const float inv = 1.0f / (red[4] + red[5] + red[6] + red[7]);
  float4 acc = {0.f, 0.f, 0.f, 0.f};
  float* partial = (float*)smem + 1024;
#pragma unroll 16
  for (int i = 0; i < 64; ++i) {
    const int mem = wid * 64 + i;
    float4 v4 = *(const float4*)(Vb + (size_t)mem * 1024 + lane * 4);
    const float pm = sc[mem];
    acc.x += pm * v4.x; acc.y += pm * v4.y; acc.z += pm * v4.z; acc.w += pm * v4.w;
  }
  *(float4*)(partial + wid * 256 + lane * 4) = acc;
  __syncthreads();
  const float ov = partial[tid] + partial[256 + tid] + partial[512 + tid] + partial[768 + tid];
  Obuf[row * 1024 + hh * 256 + tid] = f2bf(ov * inv);
  __syncthreads();
}

DI void phase_attn(const Params& p, int l, char* smem) {
  bfr* Obuf = p.ACT3;
  const int half = gridDim.x >> 1;
  const bool upper = (int)blockIdx.x >= half;
  const int bi = upper ? (int)blockIdx.x - half : (int)blockIdx.x;
  const int nb = upper ? (int)gridDim.x - half : half;
  for (int pass = 0; pass < 2; ++pass) {
    const bool do_sample = (pass == 0) != upper;
    if (do_sample) {
      for (int k = bi; k < 256; k += nb) attn_sample_item(p, l, 2 * k + (upper ? 1 : 0), smem, Obuf);
    } else {
      for (int k = bi; k < 256; k += nb) {
        const int u = 2 * k + (upper ? 1 : 0), tt4 = u & 15, hh = (u >> 4) & 3, b = u >> 6;
        attn_prompt_wave(p, l, b, hh, tt4 * 4 + (threadIdx.x >> 6), Obuf);
      }
    }
  }
}

template <int WIN>
DI void pool_elem(const Params& p, int row, int c) {
  const bfr* P2 = p.PB;
  unsigned uu = *(const unsigned*)(P2 + (size_t)row * 2048 + c);
  const float u0 = bflo(uu), u1 = bfhi(uu);
  float s0 = u0, s1 = u1, cnt;
  if (row < NPR) {
    const int t = row & 2047, b = row >> 11;
    if (t >= WIN - 1) {
      cnt = (float)WIN;
      unsigned w[WIN - 1];
#pragma unroll
      for (int j = 1; j < WIN; ++j) w[j - 1] = *(const unsigned*)(P2 + (size_t)(row - j) * 2048 + c);
#pragma unroll
      for (int j = 1; j < WIN; ++j) { s0 += bflo(w[j - 1]); s1 += bfhi(w[j - 1]); }
    } else {
      cnt = (float)(t + 1);
      for (int j = 1; j <= t; ++j) {
        unsigned w = *(const unsigned*)(P2 + (size_t)(row - j) * 2048 + c);
        s0 += bflo(w); s1 += bfhi(w);
      }
    }
    if (t >= 2033) {
      float2 o = {u0, u1};
      *(float2*)(p.out + O_POOLP + ((size_t)b * 15 + (t - 2033)) * 1024 + c) = o;
    }
  } else {
    const int s = row - NPR;
    cnt = (float)WIN;
    const float* sp = p.state_pool + (size_t)s * 15 * 1024 + c;
    float2 st[15];
#pragma unroll
    for (int j = 0; j < 15; ++j) st[j] = *(const float2*)(sp + (size_t)j * 1024);
#pragma unroll
    for (int j = 1; j < WIN; ++j) { s0 += st[15 - j].x; s1 += st[15 - j].y; }
    float* op = p.out + O_POOLS + (size_t)s * 15 * 1024 + c;
#pragma unroll
    for (int j = 0; j < 14; ++j) *(float2*)(op + (size_t)j * 1024) = st[j + 1];
    float2 o = {u0, u1};
    *(float2*)(op + (size_t)14 * 1024) = o;
  }
  *(unsigned*)(p.MIX + (size_t)row * 1024 + c) = pack2(s0 / cnt - u0, s1 / cnt - u1);
}
DI void phase_pool(const Params& p) {
  for (int idx = blockIdx.x * 256 + threadIdx.x; idx < NROW * 512; idx += gridDim.x * 256) {
    const int row = idx >> 9, c = (idx & 511) * 2;
    const int gi = c >> 8;
    if (gi == 0) pool_elem<2>(p, row, c);
    else if (gi == 1) pool_elem<4>(p, row, c);
    else if (gi == 2) pool_elem<8>(p, row, c);
    else pool_elem<16>(p, row, c);
  }
}

DI void phase_gemm_pool(const Params& p, char* smem) {
  const bfr* P2 = p.PB;
  bfr* Z = p.ACT3;
  for (int g = 0; g < 4; ++g) {
    const float* bp = p.b_pool + g * 256;
    const float* sc = p.pool_scale + g * 256;
    gemm_sample<false>(p.MIX + g * 256, 1024, p.WtPool + (size_t)g * 65536, 256, 256, 256, smem,
                       [=](int row, int col, float v) -> float {
                         float gate = bf2f(P2[(size_t)row * 2048 + 1024 + g * 256 + col]);
                         float z = (v + bp[col]) * sc[col] * siluf_(gate);
                         Z[(size_t)row * 1024 + g * 256 + col] = f2bf(z);
                         return 0.f;
                       },
                       [=](int, float) {});
  }
  for (int t = blockIdx.x; t < 128 * 8; t += gridDim.x) {
    int mt = t >> 3, g = (t >> 1) & 3, nt = t & 1;
    const float* bp = p.b_pool + g * 256;
    const float* sc = p.pool_scale + g * 256;
    gemm_tile(p.MIX + g * 256, 1024, p.WtPool + (size_t)g * 65536, 256, 256, mt * 128, nt * 128, smem,
              [=](int row, int col, float v) {
                float gate = bf2f(P2[(size_t)row * 2048 + 1024 + g * 256 + col]);
                float z = (v + bp[col]) * sc[col] * siluf_(gate);
                Z[(size_t)row * 1024 + g * 256 + col] = f2bf(z);
              });
  }
}

#ifndef ONLY_PHASE
#define ONLY_PHASE -1
#endif
#define PON(n) (ONLY_PHASE < 0 || ONLY_PHASE == (n))
__global__ void __launch_bounds__(256, 2) mega(Params p) {
  __shared__ __attribute__((aligned(16))) char smem[65536];
  cg::grid_group grid = cg::this_grid();
  if (p.phase_lo < -1000) grid.sync();
  volatile LAS unsigned* xst = (volatile LAS unsigned*)(smem + 65520);
  if (threadIdx.x < 4) xst[threadIdx.x] = 0u;
  __syncthreads();
  XcdBarrier xb = xcd_barrier_post(p.bar, xst);
#ifndef DUPMASK
#define DUPMASK 0
#endif
#define RUN(n, call) do { if (PON(n) && p.phase_lo <= (n) && (n) <= p.phase_hi) { call; if ((DUPMASK >> (n)) & 1) { xcd_barrier(xb); call; } } if (p.phase_lo <= (n) && (n) < p.phase_hi) xcd_barrier(xb); } while (0)
  RUN(0, phase_prep(p, smem));
  RUN(1, phase_gemm_in_even(p, smem));
  RUN(2, phase_even_pointwise(p, smem));
  RUN(3, phase_chunk_prep(p, smem));
  RUN(4, phase_scan(p, smem));
  RUN(5, phase_delta_post(p));
  RUN(6, (phase_gemm_resid<true, true>(p, p.MIX, p.WtOutE, p.norm_xattn, p.SS, smem)));
  RUN(8, phase_gemm_bf16out(p, p.H, p.WtXq, p.ACT2, 1024, p.SS, smem));
  RUN(9, phase_attn(p, 0, smem));
  RUN(10, (phase_gemm_resid<false, true>(p, p.ACT3, p.WtXo, p.norm_mix + 1024, p.SS + NROW, smem)));
  RUN(12, phase_gemm_bf16out(p, p.H, p.WtInO, p.PB, 2048, p.SS + NROW, smem));
  RUN(13, phase_pool(p));
  RUN(14, phase_gemm_pool(p, smem));
  RUN(15, (phase_gemm_resid<false, true>(p, p.ACT3, p.WtOutO, p.norm_xattn + 1024, p.SS + 2 * NROW, smem)));
  RUN(17, phase_gemm_bf16out(p, p.H, p.WtXq + 1048576, p.ACT2, 1024, p.SS + 2 * NROW, smem));
  RUN(18, phase_attn(p, 1, smem));
  RUN(19, (phase_gemm_resid<false, false>(p, p.ACT3, p.WtXo + 1048576, p.norm_final, p.SS + 3 * NROW, smem)));
  RUN(20, phase_final_norm(p));
}

extern "C" void kernel_launch(void* const* d_in, const int* in_sizes, int n_in, void* d_out, int out_size, void* d_ws,
                              size_t ws_size, hipStream_t stream) {
  static int grid_blocks = 0;
  if (!grid_blocks) {
    int dev = 0, cus = 0, per_cu = 0;
    (void)hipGetDevice(&dev);
    (void)hipDeviceGetAttribute(&cus, hipDeviceAttributeMultiprocessorCount, dev);
    (void)hipOccupancyMaxActiveBlocksPerMultiprocessor(&per_cu, mega, 256, 0);
    if (per_cu < 1) per_cu = 1;
    if (per_cu > 2) per_cu = 2;
    grid_blocks = cus * per_cu;
  }
  Params p{};
  const float** ins = (const float**)&p.x_prompt;
  for (int i = 0; i < 31; ++i) ins[i] = (const float*)d_in[i];
  p.out = (float*)d_out;
  char* w = (char*)d_ws;
  size_t off = 0;
  auto take = [&](size_t bytes) { char* r = w + off; off += (bytes + 255) & ~(size_t)255; return r; };
  p.X = (float*)take((size_t)NROW * 1024 * 4);
  p.QKV = (float*)take((size_t)NROW * 1536 * 4);
  p.BGR = (float*)take((size_t)NROW * 8 * 4);
  p.BG = (float*)take((size_t)NROW * 8 * 4);
  p.CONV = (float*)take((size_t)NROW * 512 * 4);
  p.ODN = (float*)take((size_t)NROW * 512 * 4);
  p.U = (float*)take((size_t)1024 * 8192 * 4);
  p.GL = (float*)take(4096);
  p.SS = (float*)take((size_t)4 * NROW * 4);
  p.H = (bfr*)take((size_t)NROW * 1024 * 2);
  p.PB = (bfr*)take((size_t)NROW * 3584 * 2);
  p.MIX = (bfr*)take((size_t)NROW * 1024 * 2);
  p.ACT2 = (bfr*)take((size_t)NROW * 1024 * 2);
  p.ACT3 = (bfr*)take((size_t)NROW * 1024 * 2);
  p.KB = (bfr*)take((size_t)2 * 2048 * 1024 * 2);
  p.VT = (bfr*)take((size_t)2 * 2048 * 1024 * 2);
  p.MPB = (bfr*)take((size_t)2048 * 1024 * 2);
  p.WtInE = (bfr*)take((size_t)3712 * 1024 * 2);
  p.WtOutE = (bfr*)take((size_t)1024 * 1024 * 2);
  p.WtInO = (bfr*)take((size_t)2048 * 1024 * 2);
  p.WtPool = (bfr*)take((size_t)4 * 256 * 256 * 2);
  p.WtOutO = (bfr*)take((size_t)1024 * 1024 * 2);
  p.WtXq = (bfr*)take((size_t)2 * 1024 * 1024 * 2);
  p.WtXk = (bfr*)take((size_t)2 * 1024 * 1024 * 2);
  p.WtXv = (bfr*)take((size_t)2 * 1024 * 1024 * 2);
  p.WtXo = (bfr*)take((size_t)2 * 1024 * 1024 * 2);
  p.WN = (uint4*)take((size_t)1024 * 1024 * 16);
  p.QD = (uint4*)take((size_t)1024 * 1024 * 16);
  p.KD = (uint4*)take((size_t)1024 * 1024 * 16);
  p.QKF = (uint4*)take((size_t)1024 * 512 * 16);
  p.bar = (unsigned*)take((size_t)XCD_BAR_WORDS * 4);
  if (off > ws_size) {
    fprintf(stderr, "kernel_launch: workspace too small: need %zu have %zu\n", off, ws_size);
    return;
  }
  p.phase_lo = 0;
  p.phase_hi = 20;
  if (hipMemsetAsync(p.bar, 0, (size_t)XCD_BAR_WORDS * 4, stream) != hipSuccess) { fprintf(stderr, "memset failed\n"); return; }
  void* args[] = {&p};
  hipError_t e = hipLaunchCooperativeKernel((void*)mega, dim3(grid_blocks), dim3(256), args, 0, stream);
  if (e != hipSuccess) fprintf(stderr, "cooperative launch failed: %s (grid %d)\n", hipGetErrorString(e), grid_blocks);
}
```

```cpp
#include <hip/hip_runtime.h>
#include <hip/hip_cooperative_groups.h>
#include <cstdio>
namespace cg = cooperative_groups;

#define DI __device__ __forceinline__
typedef unsigned short bfr;
using bf16x8 = __attribute__((ext_vector_type(8))) short;
using f32x16 = __attribute__((ext_vector_type(16))) float;
typedef __bf16 bf2_t __attribute__((ext_vector_type(2)));
typedef float fl2_t __attribute__((ext_vector_type(2)));
typedef unsigned u32x4 __attribute__((ext_vector_type(4)));
#define MFMA32(a, b, c) __builtin_amdgcn_mfma_f32_32x32x16_bf16((a), (b), (c), 0, 0, 0)

constexpr int NROW = 16512;
constexpr int NPR = 16384;
constexpr int DM = 1024;
constexpr int EIN = 3592, EINP = 3584;
constexpr float EPSF = 1e-6f;

constexpr size_t O_Y = 0;
constexpr size_t O_CONVP = 16777216 + 131072;
constexpr size_t O_QKVP = O_CONVP + 122880;
constexpr size_t O_DELTAP = O_QKVP + 36864;
constexpr size_t O_POOLP = O_DELTAP + 524288;
constexpr size_t O_MEMK = O_POOLP + 122880;
constexpr size_t O_MEMV = O_MEMK + 4194304;
constexpr size_t O_CONVS = O_MEMV + 4194304;
constexpr size_t O_QKVS = O_CONVS + 1966080;
constexpr size_t O_DELTAS = O_QKVS + 589824;
constexpr size_t O_POOLS = O_DELTAS + 8388608;

struct Params {
  const float *x_prompt, *x_sample, *state_conv_a, *state_qkv_conv, *state_delta, *state_pool, *cache_k, *cache_v, *mem_prompt;
  const float *norm_mix, *norm_xattn, *norm_final, *w_in_even, *w_out_even, *dw_w, *dw_b, *ln_a_g, *ln_a_b, *sc_w, *a_log,
      *dt_bias, *dn_norm_g, *w_in_odd, *w_pool, *b_pool, *pool_scale, *w_out_odd, *w_xq, *w_xk, *w_xv, *w_xo;
  float* out;
  float *X, *QKV, *BGR, *BG, *CONV, *ODN, *U, *GL, *SS;
  bfr *H, *PB, *MIX, *ACT2, *ACT3, *KB, *VT, *MPB;
  bfr *WtInE, *WtOutE, *WtInO, *WtPool, *WtOutO, *WtXq, *WtXk, *WtXv, *WtXo;
  uint4 *WN, *QD, *KD, *QKF;
  unsigned* bar;
  int phase_lo, phase_hi;
};

DI unsigned pack2(float a, float b) {
  fl2_t f = {a, b};
  bf2_t r = __builtin_convertvector(f, bf2_t);
  return __builtin_bit_cast(unsigned, r);
}
DI bfr f2bf(float a) { return (bfr)(pack2(a, 0.f) & 0xffffu); }
DI float bf2f(bfr u) { return __uint_as_float(((unsigned)u) << 16); }
DI float bflo(unsigned u) { return __uint_as_float(u << 16); }
DI float bfhi(unsigned u) { return __uint_as_float(u & 0xffff0000u); }
DI float sigmoidf_(float x) { return 1.0f / (1.0f + __expf(-x)); }
DI float siluf_(float x) { return x / (1.0f + __expf(-x)); }
#define DPPF(v, ctrl, rmask) __builtin_bit_cast(float, __builtin_amdgcn_update_dpp(0, __builtin_bit_cast(int, (v)), (ctrl), (rmask), 0xf, false))
DI float row16_sum(float v) {
  v += DPPF(v, 0xB1, 0xf);
  v += DPPF(v, 0x4E, 0xf);
  v += DPPF(v, 0x141, 0xf);
  v += DPPF(v, 0x140, 0xf);
  return v;
}
DI float half32_sum_hi(float v) {
  v = row16_sum(v);
  v += DPPF(v, 0x142, 0xa);
  return v;
}
DI float wave_sum(float v) {
  v = row16_sum(v);
  v += DPPF(v, 0x142, 0xa);
  v += DPPF(v, 0x143, 0xc);
  return __builtin_bit_cast(float, __builtin_amdgcn_readlane(__builtin_bit_cast(int, v), 63));
}
DI float wave_max(float v) {
#pragma unroll
  for (int o = 32; o >= 1; o >>= 1) v = fmaxf(v, __shfl_xor(v, o));
  return v;
}
DI int crow(int reg, int h) { return (reg & 3) + 8 * (reg >> 2) + 4 * h; }
DI bf16x8 pack8(const f32x16& x, int s) {
  uint4 p;
  p.x = pack2(x[8 * s + 0], x[8 * s + 1]);
  p.y = pack2(x[8 * s + 2], x[8 * s + 3]);
  p.z = pack2(x[8 * s + 4], x[8 * s + 5]);
  p.w = pack2(x[8 * s + 6], x[8 * s + 7]);
  return __builtin_bit_cast(bf16x8, p);
}
DI bf16x8 ldfrag(const uint4* p) { uint4 v = *p; return __builtin_bit_cast(bf16x8, v); }


#define XB_TMO      128
#define XB_XCNT(j)  (256  + 64 * (j))
#define XB_XSUB(j)  (1280 + 64 * (j))
#define XB_XGEN(j)  (2304 + 64 * (j))
#define XB_TOP      3328
#define XB_TOPGEN   3392
#define XCD_BAR_WORDS 3456
#define XB_SPIN_CAP (1u << 18)
#define LAS __attribute__((address_space(3)))
DI unsigned xb_ld(unsigned* p) { return __hip_atomic_load(p, __ATOMIC_RELAXED, __HIP_MEMORY_SCOPE_AGENT); }
DI unsigned xb_add(unsigned* p, unsigned v) { return __hip_atomic_fetch_add(p, v, __ATOMIC_RELAXED, __HIP_MEMORY_SCOPE_AGENT); }
DI unsigned xb_xcc_id() { return (unsigned)__builtin_amdgcn_s_getreg((3 << 11) | 20) & 0xFu; }
#define XB_SPIN(cond, bar) do { unsigned _sp = 0; while (cond) { __builtin_amdgcn_s_sleep(1); \
    if ((++_sp & 255u) == 0u) { if (xb_ld(&(bar)[XB_TMO])) break; if (_sp > XB_SPIN_CAP) { atomicAdd(&(bar)[XB_TMO], 1u); break; } } } } while (0)
struct XcdBarrier { unsigned* bar; unsigned x; volatile LAS unsigned* st; };
DI XcdBarrier xcd_barrier_post(unsigned* bar, volatile LAS unsigned* st) {
  XcdBarrier b; b.bar = bar; b.x = xb_xcc_id(); b.st = st;
  if (threadIdx.x == 0) (void)xb_add(&bar[XB_XCNT(b.x)], 1u);
  return b;
}
DI void xcd_barrier_complete(unsigned* bar, unsigned x, unsigned& nloc, unsigned& nx) {
  const unsigned G = gridDim.x * gridDim.y * gridDim.z;
  unsigned sum, cnt, mine, sp = 0u;
  for (;;) {
    sum = 0u; cnt = 0u; mine = 0u;
#pragma unroll
    for (unsigned j = 0; j < 16; ++j) { const unsigned c = xb_ld(&bar[XB_XCNT(j)]); sum += c; cnt += (c > 0u) ? 1u : 0u; mine = (j == x) ? c : mine; }
    if (sum == G) break;
    __builtin_amdgcn_s_sleep(1);
    if ((++sp & 255u) == 0u) { if (xb_ld(&bar[XB_TMO])) break; if (sp > XB_SPIN_CAP) { atomicAdd(&bar[XB_TMO], 1u); break; } }
  }
  nloc = mine > 0u ? mine : 1u; nx = cnt > 0u ? cnt : 1u;
}
DI void xcd_barrier(const XcdBarrier& b) {
  asm volatile("s_waitcnt vmcnt(0)" ::: "memory");
  __syncthreads();
  if (threadIdx.x == 0) {
    unsigned* bar = b.bar;
    __builtin_amdgcn_s_waitcnt(0);
    unsigned nloc = b.st[0], nx = b.st[1];
    if (nloc == 0u) { xcd_barrier_complete(bar, b.x, nloc, nx); b.st[0] = nloc; b.st[1] = nx; }
    const unsigned old = xb_add(&bar[XB_XSUB(b.x)], 1u);
    const unsigned gen = old / nloc;
    if (old + 1u == (gen + 1u) * nloc) {
      __builtin_amdgcn_fence(__ATOMIC_RELEASE, "agent");
      asm volatile("s_waitcnt vmcnt(0)" ::: "memory");
      const unsigned og = xb_add(&bar[XB_TOP], 1u);
      const unsigned tg = og / nx;
      if (og + 1u == (tg + 1u) * nx) xb_add(&bar[XB_TOPGEN], 1u);
      else XB_SPIN(xb_ld(&bar[XB_TOPGEN]) == tg, bar);
      __builtin_amdgcn_fence(__ATOMIC_ACQUIRE, "agent");
      xb_add(&bar[XB_XGEN(b.x)], 1u);
      asm volatile("s_waitcnt vmcnt(0)" ::: "memory");
    } else {
      XB_SPIN(xb_ld(&bar[XB_XGEN(b.x)]) == gen, bar);
      __builtin_amdgcn_fence(__ATOMIC_ACQUIRE, "agent");
      asm volatile("s_waitcnt vmcnt(0)" ::: "memory");
    }
  }
  __syncthreads();
}

DI void gemm_mainloop(const bfr* __restrict__ A, int lda, const bfr* __restrict__ Bt, int ldb, int K, int m0, int n0, char* smem, f32x16 (&acc)[2][2]) {
  bfr* As = (bfr*)smem;
  bfr* Bs = As + 128 * 72;
  const int tid = threadIdx.x, lane = tid & 63, wid = tid >> 6, wr = wid >> 1, wc = wid & 1;
  const int r = lane & 31, hl = lane >> 5;
#pragma unroll
  for (int i = 0; i < 2; ++i)
#pragma unroll
    for (int j = 0; j < 2; ++j)
#pragma unroll
      for (int q = 0; q < 16; ++q) acc[i][j][q] = 0.f;
  u32x4 ra[4], rb[4];
  const int nk = K >> 6;
  const bfr* Ab = A + (size_t)m0 * lda;
  const bfr* Bb = Bt + (size_t)n0 * ldb;
#pragma unroll
  for (int i = 0; i < 4; ++i) {
    int chunk = tid + i * 256, row = chunk >> 3, c8 = chunk & 7;
    ra[i] = *(const u32x4*)(Ab + (size_t)row * lda + c8 * 8);
    rb[i] = *(const u32x4*)(Bb + (size_t)row * ldb + c8 * 8);
  }
  for (int kt = 0; kt < nk; ++kt) {
    __syncthreads();
#pragma unroll
    for (int i = 0; i < 4; ++i) {
      int chunk = tid + i * 256, row = chunk >> 3, c8 = chunk & 7;
      *(u32x4*)(As + row * 72 + c8 * 8) = ra[i];
      *(u32x4*)(Bs + row * 72 + c8 * 8) = rb[i];
    }
    __syncthreads();
    if (kt + 1 < nk) {
#pragma unroll
      for (int i = 0; i < 4; ++i) {
        int chunk = tid + i * 256, row = chunk >> 3, c8 = chunk & 7;
        ra[i] = *(const u32x4*)(Ab + (size_t)row * lda + (kt + 1) * 64 + c8 * 8);
        rb[i] = *(const u32x4*)(Bb + (size_t)row * ldb + (kt + 1) * 64 + c8 * 8);
      }
    }
#pragma unroll
    for (int ks = 0; ks < 4; ++ks) {
      bf16x8 af[2], bfg[2];
#pragma unroll
      for (int i = 0; i < 2; ++i) {
        af[i] = *(const bf16x8*)(As + (wr * 64 + i * 32 + r) * 72 + ks * 16 + hl * 8);
        bfg[i] = *(const bf16x8*)(Bs + (wc * 64 + i * 32 + r) * 72 + ks * 16 + hl * 8);
      }
#pragma unroll
      for (int i = 0; i < 2; ++i)
#pragma unroll
        for (int j = 0; j < 2; ++j) acc[i][j] = MFMA32(af[i], bfg[j], acc[i][j]);
    }
  }
}

template <class Epi>
DI void gemm_tile(const bfr* __restrict__ A, int lda, const bfr* __restrict__ Bt, int ldb, int K, int m0, int n0, char* smem, Epi epi) {
  f32x16 acc[2][2];
  gemm_mainloop(A, lda, Bt, ldb, K, m0, n0, smem, acc);
  const int lane = threadIdx.x & 63, wid = threadIdx.x >> 6, wr = wid >> 1, wc = wid & 1, r = lane & 31, hl = lane >> 5;
#pragma unroll
  for (int i = 0; i < 2; ++i)
#pragma unroll
    for (int j = 0; j < 2; ++j)
#pragma unroll
      for (int q = 0; q < 16; ++q) {
        int row = m0 + wr * 64 + i * 32 + crow(q, hl);
        int col = n0 + wc * 64 + j * 32 + r;
        epi(row, col, acc[i][j][q]);
      }
  __syncthreads();
}
template <class Epi, class RowF>
DI void gemm_tile_rs(const bfr* __restrict__ A, int lda, const bfr* __restrict__ Bt, int ldb, int K, int m0, int n0, char* smem, Epi epi, RowF rowf) {
  f32x16 acc[2][2];
  gemm_mainloop(A, lda, Bt, ldb, K, m0, n0, smem, acc);
  const int lane = threadIdx.x & 63, wid = threadIdx.x >> 6, wr = wid >> 1, wc = wid & 1, r = lane & 31, hl = lane >> 5;
#pragma unroll
  for (int i = 0; i < 2; ++i)
#pragma unroll
    for (int q = 0; q < 16; ++q) {
      int row = m0 + wr * 64 + i * 32 + crow(q, hl);
      float rs = 0.f;
#pragma unroll
      for (int j = 0; j < 2; ++j) {
        int col = n0 + wc * 64 + j * 32 + r;
        float v = epi(row, col, acc[i][j][q]);
        rs += v * v;
      }
      rs += __shfl_xor(rs, 16);
      rs += __shfl_xor(rs, 8);
      rs += __shfl_xor(rs, 4);
      rs += __shfl_xor(rs, 2);
      rs += __shfl_xor(rs, 1);
      if (r == 0) rowf(row, rs);
    }
  __syncthreads();
}

template <bool RS, class Epi, class RowF>
DI void gemm_sample(const bfr* __restrict__ A, int lda, const bfr* __restrict__ Bt, int ldb, int K, int N, char* smem, Epi epi, RowF rowf) {
  const int tid = threadIdx.x, lane = tid & 63, wid = tid >> 6, r = lane & 31, hl = lane >> 5;
  float* red = (float*)smem;
  const int nun = 4 * (N >> 5);
  for (int u = blockIdx.x; u < nun; u += gridDim.x) {
    const int mu = u & 3, nu = u >> 2;
    const int kq = K >> 2, k0 = wid * kq;
    const bfr* ap = A + (size_t)(NPR + mu * 32 + r) * lda + k0 + hl * 8;
    const bfr* bp = Bt + (size_t)(nu * 32 + r) * ldb + k0 + hl * 8;
    f32x16 acc;
#pragma unroll
    for (int q = 0; q < 16; ++q) acc[q] = 0.f;
    if (K == 1024) {
#pragma unroll
      for (int ks = 0; ks < 16; ++ks) {
        bf16x8 af = *(const bf16x8*)(ap + ks * 16);
        bf16x8 bf = *(const bf16x8*)(bp + ks * 16);
        acc = MFMA32(af, bf, acc);
      }
    } else {
      for (int ks = 0; ks < (kq >> 4); ++ks) {
        bf16x8 af = *(const bf16x8*)(ap + ks * 16);
        bf16x8 bf = *(const bf16x8*)(bp + ks * 16);
        acc = MFMA32(af, bf, acc);
      }
    }
#pragma unroll
    for (int q = 0; q < 16; ++q) red[(wid * 16 + q) * 64 + lane] = acc[q];
    __syncthreads();
#pragma unroll
    for (int e = 0; e < 4; ++e) {
      const int q = wid + e * 4;
      const float v = red[q * 64 + lane] + red[(16 + q) * 64 + lane] + red[(32 + q) * 64 + lane] + red[(48 + q) * 64 + lane];
      const int row = NPR + mu * 32 + crow(q, hl), col = nu * 32 + r;
      float x = epi(row, col, v);
      if (RS) {
        float s2 = half32_sum_hi(x * x);
        if (r == 31) rowf(row, s2);
      }
    }
    __syncthreads();
  }
}

DI void transpose_tile(const float* __restrict__ W, int ldw, bfr* __restrict__ Wt, int ldt, int k0, int n0, float* sm, int nvalid = 1 << 30) {
  const int tid = threadIdx.x;
#pragma unroll
  for (int i = 0; i < 16; ++i) {
    int idx = tid + i * 256, kk = idx >> 6, nn = idx & 63;
    sm[kk * 65 + nn] = (n0 + nn < nvalid) ? W[(size_t)(k0 + kk) * ldw + n0 + nn] : 0.f;
  }
  __syncthreads();
#pragma unroll
  for (int i = 0; i < 8; ++i) {
    int idx = tid + i * 256, nn = idx >> 5, kp = idx & 31;
    float a = sm[(2 * kp) * 65 + nn], b = sm[(2 * kp + 1) * 65 + nn];
    *(unsigned*)(Wt + (size_t)(n0 + nn) * ldt + k0 + 2 * kp) = pack2(a, b);
  }
  __syncthreads();
}

DI void phase_prep(const Params& p, char* smem) {
  float* sm = (float*)smem;
  for (int tt = blockIdx.x; tt < 4032 + 32; tt += gridDim.x) {
    int t = tt - 32;
    if (tt < 928) {
      int kt = tt / 58, nt = tt % 58;
      transpose_tile(p.w_in_even, EIN, p.WtInE, 1024, kt * 64, nt * 64, sm, EIN);
    } else if (t < 1152) {
      int u = t - 896;
      transpose_tile(p.w_out_even, 1024, p.WtOutE, 1024, (u >> 4) * 64, (u & 15) * 64, sm);
    } else if (t < 1664) {
      int u = t - 1152;
      transpose_tile(p.w_in_odd, 2048, p.WtInO, 1024, (u >> 5) * 64, (u & 31) * 64, sm);
    } else if (t < 1728) {
      int u = t - 1664, g = u >> 4, v = u & 15;
      transpose_tile(p.w_pool + (size_t)g * 65536, 256, p.WtPool + (size_t)g * 65536, 256, (v >> 2) * 64, (v & 3) * 64, sm);
    } else if (t < 1984) {
      int u = t - 1728;
      transpose_tile(p.w_out_odd, 1024, p.WtOutO, 1024, (u >> 4) * 64, (u & 15) * 64, sm);
    } else {
      int u = t - 1984, m = u >> 8, v = u & 255;
      int which = m >> 1, l = m & 1;
      const float* src = (which == 0 ? p.w_xq : which == 1 ? p.w_xk : which == 2 ? p.w_xv : p.w_xo) + (size_t)l * 1048576;
      bfr* dst = (which == 0 ? p.WtXq : which == 1 ? p.WtXk : which == 2 ? p.WtXv : p.WtXo) + (size_t)l * 1048576;
      transpose_tile(src, 1024, dst, 1024, (v >> 4) * 64, (v & 15) * 64, sm);
    }
  }
  {
    for (int i = blockIdx.x * 256 + threadIdx.x; i < 4 * NROW; i += gridDim.x * 256) p.SS[i] = 0.f;
    const int n4 = 2048 * 1024 / 4;
    for (int i = blockIdx.x * 256 + threadIdx.x; i < n4; i += gridDim.x * 256) {
      float4 v = ((const float4*)p.mem_prompt)[i];
      uint2 o;
      o.x = pack2(v.x, v.y);
      o.y = pack2(v.z, v.w);
      ((uint2*)p.MPB)[i] = o;
    }
  }
  {
    const int lane = threadIdx.x & 63, wid = threadIdx.x >> 6;
    float* wT = (float*)smem;
    for (int i = threadIdx.x; i < 2048; i += 256) {
      const int k = i >> 1, hf = i & 1;
      float4 w = *(const float4*)(p.w_in_even + (size_t)k * EIN + EINP + hf * 4);
      wT[(hf * 4 + 0) * 1024 + k] = w.x; wT[(hf * 4 + 1) * 1024 + k] = w.y;
      wT[(hf * 4 + 2) * 1024 + k] = w.z; wT[(hf * 4 + 3) * 1024 + k] = w.w;
    }
    __syncthreads();
    for (int row = blockIdx.x * 4 + wid; row < NROW; row += gridDim.x * 4) {
      const float* xr = row < NPR ? p.x_prompt + (size_t)row * DM : p.x_sample + (size_t)(row - NPR) * DM;
      float4 v[4];
      float ss = 0.f;
#pragma unroll
      for (int j = 0; j < 4; ++j) {
        v[j] = ((const float4*)xr)[j * 64 + lane];
        ss += v[j].x * v[j].x + v[j].y * v[j].y + v[j].z * v[j].z + v[j].w * v[j].w;
      }
      ss = wave_sum(ss);
      float inv = rsqrtf(ss * (1.0f / 1024.0f) + EPSF);
      float part[8];
#pragma unroll
      for (int c = 0; c < 8; ++c) part[c] = 0.f;
#pragma unroll
      for (int j = 0; j < 4; ++j) {
        float4 g = ((const float4*)p.norm_mix)[j * 64 + lane];
        uint2 o;
        const float h0 = v[j].x * inv * g.x, h1 = v[j].y * inv * g.y, h2 = v[j].z * inv * g.z, h3 = v[j].w * inv * g.w;
        o.x = pack2(h0, h1);
        o.y = pack2(h2, h3);
        ((uint2*)(p.H + (size_t)row * DM))[j * 64 + lane] = o;
#pragma unroll
        for (int c = 0; c < 8; ++c) {
          float4 w = ((const float4*)(wT + c * 1024))[j * 64 + lane];
          part[c] += h0 * w.x + h1 * w.y + h2 * w.z + h3 * w.w;
        }
      }
#pragma unroll
      for (int c = 0; c < 8; ++c) part[c] = wave_sum(part[c]);
      if (lane == 0) {
        float4 a = {part[0], part[1], part[2], part[3]}, b = {part[4], part[5], part[6], part[7]};
        ((float4*)(p.BGR + (size_t)row * 8))[0] = a;
        ((float4*)(p.BGR + (size_t)row * 8))[1] = b;
      }
    }
    __syncthreads();
  }
}

DI void phase_rmsnorm(const Params& p, const float* g) {
  const int lane = threadIdx.x & 63, wid = threadIdx.x >> 6;
  for (int row = blockIdx.x * 4 + wid; row < NROW; row += gridDim.x * 4) {
    const float* xr = p.X + (size_t)row * DM;
    float4 v[4];
    float ss = 0.f;
#pragma unroll
    for (int j = 0; j < 4; ++j) {
      v[j] = ((const float4*)xr)[j * 64 + lane];
      ss += v[j].x * v[j].x + v[j].y * v[j].y + v[j].z * v[j].z + v[j].w * v[j].w;
    }
    ss = wave_sum(ss);
    float inv = rsqrtf(ss * (1.0f / 1024.0f) + EPSF);
#pragma unroll
    for (int j = 0; j < 4; ++j) {
      float4 gg = ((const float4*)g)[j * 64 + lane];
      uint2 o;
      o.x = pack2(v[j].x * inv * gg.x, v[j].y * inv * gg.y);
      o.y = pack2(v[j].z * inv * gg.z, v[j].w * inv * gg.w);
      ((uint2*)(p.H + (size_t)row * DM))[j * 64 + lane] = o;
    }
  }
}

DI void phase_final_norm(const Params& p) {
  const float* ss = p.SS + 3 * NROW;
  for (int i = blockIdx.x * 256 + threadIdx.x; i < NROW * 256; i += gridDim.x * 256) {
    const int row = i >> 8, c4 = i & 255;
    float4 v = ((const float4*)p.X)[i];
    float4 g = ((const float4*)p.norm_final)[c4];
    const float inv = rsqrtf(ss[row] * (1.0f / 1024.0f) + EPSF);
    float4 o = {v.x * inv * g.x, v.y * inv * g.y, v.z * inv * g.z, v.w * inv * g.w};
    ((float4*)(p.out + O_Y))[i] = o;
  }
}

DI void phase_gemm_in_even(const Params& p, char* smem) {
  const int NT1 = 128 * 28, NT2 = 4 * 128;
  {
    bfr* PB = p.PB;
    gemm_sample<false>(p.H, 1024, p.WtInE, 1024, 1024, EINP, smem,
                       [=](int row, int col, float v) -> float { PB[(size_t)row * EINP + col] = f2bf(v); return 0.f; },
                       [=](int, float) {});
  }
  for (int t = blockIdx.x; t < NT1 + NT2; t += gridDim.x) {
    if (t < NT1) {
      int mt = t / 28, nt = t % 28;
      bfr* PB = p.PB;
      gemm_tile(p.H, 1024, p.WtInE, 1024, 1024, mt * 128, nt * 128, smem,
                [=](int row, int col, float v) { PB[(size_t)row * EINP + col] = f2bf(v); });
    } else {
      int u = t - NT1, gsel = u >> 7, v = u & 127, mt = v >> 3, nt = v & 7;
      int isv = gsel >> 1, l = gsel & 1;
      if (!isv) {
        float* o = p.out + O_MEMK + (size_t)l * 2097152;
        bfr* kb = p.KB + (size_t)l * 2097152;
        gemm_tile(p.MPB, 1024, p.WtXk + (size_t)l * 1048576, 1024, 1024, mt * 128, nt * 128, smem,
                  [=](int row, int col, float v) {
                    o[(size_t)row * 1024 + col] = v;
                    kb[(size_t)row * 1024 + col] = f2bf(v);
                  });
      } else {
        float* o = p.out + O_MEMV + (size_t)l * 2097152;
        bfr* vt = p.VT + (size_t)l * 2097152;
        gemm_tile(p.MPB, 1024, p.WtXv + (size_t)l * 1048576, 1024, 1024, mt * 128, nt * 128, smem,
                  [=](int row, int col, float v) {
                    o[(size_t)row * 1024 + col] = v;
                    int b = row >> 8, mem = row & 255, h = col >> 8, dim = col & 255;
                    int ks = mem >> 4, ml = mem & 15, hl2 = (ml >> 2) & 1, j = ((ml >> 3) << 2) | (ml & 3);
                    int dt = dim >> 5, rr = dim & 31;
                    size_t off = ((((size_t)(b * 4 + h) * 8 + dt) * 16 + ks) * 64 + hl2 * 32 + rr) * 8 + j;
                    vt[off] = f2bf(v);
                  });
      }
    }
  }
}

template <bool IS_P, bool EDGE>
DI void qkv_token(const Params& p, int row, int lane) {
  const int t = row & 2047, b = row >> 11, s = row - NPR;
#pragma unroll 6
  for (int grp = 0; grp < 12; ++grp) {
    const int ch = grp * 128 + lane * 2;
    float x0[4], x1[4];
    if (IS_P) {
      unsigned u[4];
#pragma unroll
      for (int j = 0; j < 4; ++j) {
        const int rc = (!EDGE || t - 3 + j >= 0) ? (row - 3 + j) : row;
        u[j] = *(const unsigned*)(p.PB + (size_t)rc * EINP + 1536 + ch);
      }
#pragma unroll
      for (int j = 0; j < 4; ++j) {
        const bool ok = (!EDGE || t - 3 + j >= 0);
        x0[j] = ok ? bflo(u[j]) : 0.f;
        x1[j] = ok ? bfhi(u[j]) : 0.f;
      }
    } else {
#pragma unroll
      for (int j = 0; j < 3; ++j) {
        float2 f = *(const float2*)(p.state_qkv_conv + ((size_t)s * 3 + j) * 1536 + ch);
        x0[j] = f.x; x1[j] = f.y;
      }
      unsigned u = *(const unsigned*)(p.PB + (size_t)row * EINP + 1536 + ch);
      x0[3] = bflo(u); x1[3] = bfhi(u);
    }
    float a0 = 0.f, a1 = 0.f;
#pragma unroll
    for (int j = 0; j < 4; ++j) {
      float2 w = *(const float2*)(p.sc_w + (size_t)j * 1536 + ch);
      a0 += w.x * x0[j]; a1 += w.y * x1[j];
    }
    float y0 = siluf_(a0), y1 = siluf_(a1);
    if (grp < 8) {
      float ss = wave_sum(y0 * y0 + y1 * y1);
      float inv = rsqrtf(ss + EPSF);
      if (grp < 4) inv *= 0.08838834764831845f;
      y0 *= inv; y1 *= inv;
    }
    float2 o = {y0, y1};
    *(float2*)(p.QKV + (size_t)row * 1536 + ch) = o;
    if (IS_P) {
      if (t >= 2045) {
        float2 c = {x0[3], x1[3]};
        *(float2*)(p.out + O_QKVP + ((size_t)b * 3 + (t - 2045)) * 1536 + ch) = c;
      }
    } else {
      float2 c0 = {x0[1], x1[1]}, c1 = {x0[2], x1[2]}, c2 = {x0[3], x1[3]};
      *(float2*)(p.out + O_QKVS + ((size_t)s * 3 + 0) * 1536 + ch) = c0;
      *(float2*)(p.out + O_QKVS + ((size_t)s * 3 + 1) * 1536 + ch) = c1;
      *(float2*)(p.out + O_QKVS + ((size_t)s * 3 + 2) * 1536 + ch) = c2;
    }
  }
  if (lane < 4) {
    float bl = p.BGR[(size_t)row * 8 + lane], al = p.BGR[(size_t)row * 8 + 4 + lane];
    float beta = sigmoidf_(bl);
    float xx = al + p.dt_bias[lane];
    float sp = xx > 20.f ? xx : log1pf(__expf(xx));
    float g = -__expf(p.a_log[lane]) * sp;
    p.BG[(size_t)row * 8 + lane] = beta;
    p.BG[(size_t)row * 8 + 4 + lane] = g;
  }
}

template <int G0>
DI void qkv_run4_half(const Params& p, int row0, int lane) {
  const int t0 = row0 & 2047, b = row0 >> 11;
  unsigned u[6][7];
  float2 w[6][4];
#pragma unroll
  for (int i = 0; i < 7; ++i) {
    const int rr = (i >= 3 || t0 > 0) ? (row0 - 3 + i) : row0;
    const bfr* rp = p.PB + (size_t)rr * EINP + 1536 + G0 * 128 + lane * 2;
#pragma unroll
    for (int g = 0; g < 6; ++g) u[g][i] = *(const unsigned*)(rp + g * 128);
  }
#pragma unroll
  for (int j = 0; j < 4; ++j) {
    const float* wp = p.sc_w + (size_t)j * 1536 + G0 * 128 + lane * 2;
#pragma unroll
    for (int g = 0; g < 6; ++g) w[g][j] = *(const float2*)(wp + g * 128);
  }
  const float hm = (t0 > 0) ? 1.f : 0.f;
#pragma unroll
  for (int k = 0; k < 4; ++k) {
    const int row = row0 + k;
#pragma unroll
    for (int g = 0; g < 6; ++g) {
      const int grp = G0 + g;
      const int ch = grp * 128 + lane * 2;
      float a0 = 0.f, a1 = 0.f;
#pragma unroll
      for (int j = 0; j < 4; ++j) {
        const int i = k + j;
        const float m = (i >= 3) ? 1.f : hm;
        a0 += w[g][j].x * (bflo(u[g][i]) * m);
        a1 += w[g][j].y * (bfhi(u[g][i]) * m);
      }
      float y0 = siluf_(a0), y1 = siluf_(a1);
      if (grp < 8) {
        float ss = wave_sum(y0 * y0 + y1 * y1);
        float inv = rsqrtf(ss + EPSF);
        if (grp < 4) inv *= 0.08838834764831845f;
        y0 *= inv; y1 *= inv;
      }
      float2 o = {y0, y1};
      *(float2*)(p.QKV + (size_t)row * 1536 + ch) = o;
      if (t0 == 2044 && k >= 1) {
        float2 c = {bflo(u[g][k + 3]), bfhi(u[g][k + 3])};
        *(float2*)(p.out + O_QKVP + ((size_t)b * 3 + (k - 1)) * 1536 + ch) = c;
      }
    }
  }
}
DI void qkv_run4(const Params& p, int row0, int lane) {
  qkv_run4_half<0>(p, row0, lane);
  qkv_run4_half<6>(p, row0, lane);
  if (lane < 16) {
    const int row = row0 + (lane >> 2), hd = lane & 3;
    float bl = p.BGR[(size_t)row * 8 + hd], al = p.BGR[(size_t)row * 8 + 4 + hd];
    float beta = sigmoidf_(bl);
    float xx = al + p.dt_bias[hd];
    float sp = xx > 20.f ? xx : log1pf(__expf(xx));
    float g = -__expf(p.a_log[hd]) * sp;
    p.BG[(size_t)row * 8 + hd] = beta;
    p.BG[(size_t)row * 8 + 4 + hd] = g;
  }
}

DI void conv_a_prompt_item(const Params& p, int item, float* sm) {
  const int half = item & 1, tile = (item >> 1) & 63, b = item >> 7;
  const int tid = threadIdx.x, c = half * 256 + tid, t0 = tile * 32;
  {
    const int tg = tid >> 5, c8 = tid & 31;
    u32x4 vv[8], gg[8];
#pragma unroll
    for (int ps = 0; ps < 8; ++ps) {
      const int i = tg + 8 * ps;
      const int tt = t0 - 30 + i;
      const size_t row = (size_t)b * 2048 + ((tt >= 0 && i < 62) ? tt : t0);
      vv[ps] = *(const u32x4*)(p.PB + row * EINP + half * 256 + c8 * 8);
      gg[ps] = *(const u32x4*)(p.PB + row * EINP + 512 + half * 256 + c8 * 8);
    }
#pragma unroll
    for (int ps = 0; ps < 8; ++ps) {
      const int i = tg + 8 * ps;
      const int tt = t0 - 30 + i;
      const float msk = (tt >= 0) ? 1.f : 0.f;
      float o8[8];
#pragma unroll
      for (int e = 0; e < 4; ++e) {
        o8[2 * e] = bflo(vv[ps][e]) * sigmoidf_(bflo(gg[ps][e])) * msk;
        o8[2 * e + 1] = bfhi(vv[ps][e]) * sigmoidf_(bfhi(gg[ps][e])) * msk;
      }
      if (i < 62) {
        float4 a0 = {o8[0], o8[1], o8[2], o8[3]}, a1 = {o8[4], o8[5], o8[6], o8[7]};
        *(float4*)(sm + i * 256 + c8 * 8) = a0;
        *(float4*)(sm + i * 256 + c8 * 8 + 4) = a1;
      }
    }
    __syncthreads();
  }
  float w[31];
#pragma unroll
  for (int j = 0; j < 31; ++j) w[j] = p.dw_w[j * 512 + c];
  const float bias = p.dw_b[c];
#pragma unroll 1
  for (int o = 0; o < 32; ++o) {
    float acc = bias;
#pragma unroll
    for (int j = 0; j < 31; ++j) acc += w[j] * sm[(o + j) * 256 + tid];
    p.CONV[((size_t)b * 2048 + t0 + o) * 512 + c] = acc;
  }
  if (tile == 63) {
#pragma unroll 1
    for (int j = 0; j < 30; ++j) p.out[O_CONVP + ((size_t)b * 30 + j) * 512 + c] = sm[(32 + j) * 256 + tid];
  }
  __syncthreads();
}

DI void conv_a_sample_item(const Params& p, int s) {
  const int tid = threadIdx.x;
  const size_t row = NPR + s;
#pragma unroll
  for (int cc = 0; cc < 2; ++cc) {
    int c = tid + cc * 256;
    float val = bf2f(p.PB[row * EINP + c]);
    float gate = bf2f(p.PB[row * EINP + 512 + c]);
    float gl = val * sigmoidf_(gate);
    float acc = p.dw_b[c] + p.dw_w[30 * 512 + c] * gl;
#pragma unroll 6
    for (int j = 0; j < 30; ++j) {
      float st = p.state_conv_a[((size_t)s * 30 + j) * 512 + c];
      acc += p.dw_w[j * 512 + c] * st;
      if (j >= 1) p.out[O_CONVS + ((size_t)s * 30 + j - 1) * 512 + c] = st;
    }
    p.out[O_CONVS + ((size_t)s * 30 + 29) * 512 + c] = gl;
    p.CONV[row * 512 + c] = acc;
  }
}

DI void phase_even_pw_conv(const Params& p, char* smem) {
  for (int it = blockIdx.x; it < 1024 + 128; it += gridDim.x) {
    if (it < 1024) conv_a_prompt_item(p, it, (float*)smem);
    else conv_a_sample_item(p, it - 1024);
  }
}
DI void phase_even_pw_qkv(const Params& p) {
  const int lane = threadIdx.x & 63, wid = threadIdx.x >> 6;
  for (int run = blockIdx.x * 4 + wid; run < NPR / 4; run += gridDim.x * 4) qkv_run4(p, run * 4, lane);
  for (int row = NPR + blockIdx.x * 4 + wid; row < NROW; row += gridDim.x * 4) qkv_token<false, false>(p, row, lane);
}
DI void phase_even_pointwise(const Params& p, char* smem) {
  phase_even_pw_conv(p, smem);
  phase_even_pw_qkv(p);
}

DI void chunk_prep(const Params& p, int item, char* smem) {
  const int tid = threadIdx.x, lane = tid & 63, wid = tid >> 6, r = lane & 31, hl = lane >> 5;
  const int n = item & 31, hh = (item >> 5) & 3, b = item >> 7;
  const size_t row0 = (size_t)b * 2048 + n * 64;
  float* gcs = (float*)smem;
  float* betas = gcs + 64;
  float* egs = betas + 64;
  float* kscale = egs + 64;
  bfr* qs = (bfr*)(smem + 1024);
  bfr* ks_ = qs + 64 * 136;
  float* Am = (float*)(smem + 1024 + 2 * 64 * 136 * 2);
  bfr* wsb = qs;
  if (tid < 64) {
    float beta = p.BG[(row0 + tid) * 8 + hh];
    float g = p.BG[(row0 + tid) * 8 + 4 + hh];
    float v = g;
#pragma unroll
    for (int off = 1; off < 64; off <<= 1) {
      float t = __shfl_up(v, off);
      if (lane >= off) v += t;
    }
    float gl = __shfl(v, 63);
    gcs[tid] = v;
    betas[tid] = beta;
    egs[tid] = __expf(v);
    kscale[tid] = __expf(gl - v);
    if (tid == 63) p.GL[item] = __expf(gl);
  }
#pragma unroll
  for (int i = 0; i < 8; ++i) {
    int idx = tid + i * 256, row = idx >> 5, c4 = idx & 31;
    float4 q = *(const float4*)(p.QKV + (row0 + row) * 1536 + hh * 128 + c4 * 4);
    float4 k = *(const float4*)(p.QKV + (row0 + row) * 1536 + 512 + hh * 128 + c4 * 4);
    uint2 qo, ko;
    qo.x = pack2(q.x, q.y); qo.y = pack2(q.z, q.w);
    ko.x = pack2(k.x, k.y); ko.y = pack2(k.z, k.w);
    *(uint2*)(qs + row * 136 + c4 * 4) = qo;
    *(uint2*)(ks_ + row * 136 + c4 * 4) = ko;
  }
  __syncthreads();
  {
    const int mi = wid >> 1, ni = wid & 1;
    f32x16 akk, aqk;
#pragma unroll
    for (int q = 0; q < 16; ++q) { akk[q] = 0.f; aqk[q] = 0.f; }
#pragma unroll
    for (int ks = 0; ks < 8; ++ks) {
      bf16x8 ka = *(const bf16x8*)(ks_ + (mi * 32 + r) * 136 + ks * 16 + hl * 8);
      bf16x8 qa = *(const bf16x8*)(qs + (mi * 32 + r) * 136 + ks * 16 + hl * 8);
      bf16x8 kb = *(const bf16x8*)(ks_ + (ni * 32 + r) * 136 + ks * 16 + hl * 8);
      akk = MFMA32(ka, kb, akk);
      aqk = MFMA32(qa, kb, aqk);
    }
    bfr* qkf = (bfr*)(p.QKF + (size_t)item * 512);
#pragma unroll
    for (int q = 0; q < 16; ++q) {
      int i = mi * 32 + crow(q, hl), j = ni * 32 + r;
      float dec = (i >= j) ? __expf(gcs[i] - gcs[j]) : 0.f;
      Am[i * 68 + j] = (i > j) ? akk[q] * betas[i] * dec : 0.f;
      float qv = (i >= j) ? aqk[q] * dec : 0.f;
      int ksj = j >> 4, jl = j & 15, h2 = (jl >> 2) & 1, jj = ((jl >> 3) << 2) | (jl & 3);
      qkf[((mi * 4 + ksj) * 64 + h2 * 32 + (i & 31)) * 8 + jj] = f2bf(qv);
    }
  }
  {
    uint4* QD = p.QD + (size_t)item * 1024;
#pragma unroll
    for (int i = 0; i < 4; ++i) {
      int idx = tid + i * 256, f = idx >> 6, ln = idx & 63, mt = f >> 3, ks = f & 7, m = ln & 31, h2 = ln >> 5;
      int ri = mt * 32 + m, d0 = ks * 16 + h2 * 4;
      float sc = egs[ri];
      const float* src = p.QKV + (row0 + ri) * 1536 + hh * 128 + d0;
      float4 a = *(const float4*)src, c = *(const float4*)(src + 8);
      uint4 o;
      o.x = pack2(a.x * sc, a.y * sc); o.y = pack2(a.z * sc, a.w * sc);
      o.z = pack2(c.x * sc, c.y * sc); o.w = pack2(c.z * sc, c.w * sc);
      QD[f * 64 + ln] = o;
    }
    uint4* KD = p.KD + (size_t)item * 1024;
#pragma unroll
    for (int i = 0; i < 4; ++i) {
      int idx = tid + i * 256, f = idx >> 6, ln = idx & 63, mt = f >> 2, ks = f & 3, m = ln & 31, h2 = ln >> 5;
      int d = mt * 32 + m;
      float vals[8];
#pragma unroll
      for (int j = 0; j < 8; ++j) {
        int c = ks * 16 + 8 * (j >> 2) + 4 * h2 + (j & 3);
        vals[j] = p.QKV[(row0 + c) * 1536 + 512 + hh * 128 + d] * kscale[c];
      }
      uint4 o;
      o.x = pack2(vals[0], vals[1]); o.y = pack2(vals[2], vals[3]);
      o.z = pack2(vals[4], vals[5]); o.w = pack2(vals[6], vals[7]);
      KD[f * 64 + ln] = o;
    }
  }
  __syncthreads();
  {
    const int c = tid;
    const float* src = (c < 128) ? (p.QKV + row0 * 1536 + 1024 + hh * 128 + c) : (p.QKV + row0 * 1536 + 512 + hh * 128 + (c - 128));
    float sol[64];
#pragma unroll
    for (int i = 0; i < 64; ++i) {
      float rhs = src[(size_t)i * 1536] * betas[i];
      if (c >= 128) rhs *= egs[i];
      float acc = rhs, acc1 = 0.f;
#pragma unroll
      for (int j = 0; j < i; ++j) {
        if (j & 1) acc1 -= Am[i * 68 + j] * sol[j];
        else acc -= Am[i * 68 + j] * sol[j];
      }
      sol[i] = acc + acc1;
    }
    if (c < 128) {
      float* U = p.U + (size_t)item * 8192;
#pragma unroll
      for (int i = 0; i < 64; ++i) U[i * 128 + c] = sol[i];
    } else {
#pragma unroll
      for (int i = 0; i < 64; ++i) wsb[i * 136 + (c - 128)] = f2bf(-sol[i]);
    }
  }
  __syncthreads();
  {
    uint4* WN = p.WN + (size_t)item * 1024;
#pragma unroll
    for (int i = 0; i < 4; ++i) {
      int idx = tid + i * 256, f = idx >> 6, ln = idx & 63, mt = f >> 3, ks = f & 7, m = ln & 31, h2 = ln >> 5;
      int ri = mt * 32 + m, d0 = ks * 16 + h2 * 4;
      uint2 a = *(const uint2*)(wsb + ri * 136 + d0), c = *(const uint2*)(wsb + ri * 136 + d0 + 8);
      uint4 o = {a.x, a.y, c.x, c.y};
      WN[f * 64 + ln] = o;
    }
  }
  __syncthreads();
}

DI void branch_a_final_row(const Params& p, int row, int lane) {
  const float* cr = p.CONV + (size_t)row * 512;
  float4 v[2];
  float s = 0.f;
#pragma unroll
  for (int j = 0; j < 2; ++j) {
    v[j] = ((const float4*)cr)[j * 64 + lane];
    s += v[j].x + v[j].y + v[j].z + v[j].w;
  }
  float mean = wave_sum(s) * (1.0f / 512.0f);
  float vs = 0.f;
#pragma unroll
  for (int j = 0; j < 2; ++j) {
    v[j].x -= mean; v[j].y -= mean; v[j].z -= mean; v[j].w -= mean;
    vs += v[j].x * v[j].x + v[j].y * v[j].y + v[j].z * v[j].z + v[j].w * v[j].w;
  }
  float inv = rsqrtf(wave_sum(vs) * (1.0f / 512.0f) + EPSF);
#pragma unroll
  for (int j = 0; j < 2; ++j) {
    int c = (j * 64 + lane) * 4;
    float4 g = *(const float4*)(p.ln_a_g + c), bb = *(const float4*)(p.ln_a_b + c);
    uint2 gu = *(const uint2*)(p.PB + (size_t)row * EINP + 1024 + c);
    float y0 = siluf_(v[j].x * inv * g.x + bb.x) * siluf_(bflo(gu.x));
    float y1 = siluf_(v[j].y * inv * g.y + bb.y) * siluf_(bfhi(gu.x));
    float y2 = siluf_(v[j].z * inv * g.z + bb.z) * siluf_(bflo(gu.y));
    float y3 = siluf_(v[j].w * inv * g.w + bb.w) * siluf_(bfhi(gu.y));
    uint2 o;
    o.x = pack2(y0, y1); o.y = pack2(y2, y3);
    *(uint2*)(p.MIX + (size_t)row * 1024 + c) = o;
  }
}

DI void delta_sample_item(const Params& p, int item, char* smem) {
  const int s = item >> 2, hh = item & 3, tid = threadIdx.x;
  const size_t row = NPR + s;
  float* ksm = (float*)smem;
  float* qsm = ksm + 128;
  float* part = qsm + 128;
  if (tid < 128) ksm[tid] = p.QKV[row * 1536 + 512 + hh * 128 + tid];
  else qsm[tid - 128] = p.QKV[row * 1536 + hh * 128 + (tid - 128)];
  const float beta = p.BG[row * 8 + hh], a = __expf(p.BG[row * 8 + 4 + hh]);
  __syncthreads();
  const int e = tid & 127, half = tid >> 7, d0 = half * 64;
  const float* S0 = p.state_delta + (((size_t)s * 4 + hh) * 128 + d0) * 128 + e;
  float* So = p.out + O_DELTAS + (((size_t)s * 4 + hh) * 128 + d0) * 128 + e;
  float Sr[64];
  float ksum = 0.f;
#pragma unroll
  for (int i = 0; i < 64; ++i) {
    Sr[i] = S0[(size_t)i * 128] * a;
    ksum += ksm[d0 + i] * Sr[i];
  }
  part[half * 128 + e] = ksum;
  __syncthreads();
  const float kS = part[e] + part[128 + e];
  const float v = p.QKV[row * 1536 + 1024 + hh * 128 + e];
  const float vnew = (v - kS) * beta;
  float oo = 0.f;
#pragma unroll
  for (int i = 0; i < 64; ++i) {
    Sr[i] += ksm[d0 + i] * vnew;
    So[(size_t)i * 128] = Sr[i];
    oo += qsm[d0 + i] * Sr[i];
  }
  __syncthreads();
  part[half * 128 + e] = oo;
  __syncthreads();
  if (half == 0) p.ODN[row * 512 + hh * 128 + e] = part[e] + part[128 + e];
  __syncthreads();
}

DI void phase_chunk_prep(const Params& p, char* smem) {
  for (int it = blockIdx.x; it < 1024; it += gridDim.x) chunk_prep(p, it, smem);
}

DI void scan_item(const Params& p, int item, char* smem) {
  const int tid = threadIdx.x, lane = tid & 63, es = tid >> 6, r = lane & 31, hl = lane >> 5;
  const int b = item >> 2, hh = item & 3;
  u32x4* bufA = (u32x4*)smem;
  u32x4* bufB = (u32x4*)(smem + 32768);
  const u32x4* gWN = (const u32x4*)p.WN + (size_t)item * 32 * 1024;
  const u32x4* gQD = (const u32x4*)p.QD + (size_t)item * 32 * 1024;
  const u32x4* gKD = (const u32x4*)p.KD + (size_t)item * 32 * 1024;
  const u32x4* gQK = (const u32x4*)p.QKF + (size_t)item * 32 * 512;
  const float* gU = p.U + (size_t)item * 32 * 8192;
  const int uo = hl * 4 * 128 + es * 32 + r;
  const int oo = hl * 4 * 512 + es * 32 + r;
#define GLDS(gp, lp) __builtin_amdgcn_global_load_lds((const unsigned*)(gp), (unsigned*)(lp), 16, 0, 0)
  f32x16 S[4];
#pragma unroll
  for (int d = 0; d < 4; ++d)
#pragma unroll
    for (int q = 0; q < 16; ++q) S[d][q] = 0.f;
  f32x16 vn[2], o[2];
#pragma unroll
  for (int i = 0; i < 4; ++i) {
    GLDS(gWN + tid + i * 256, bufA + tid + i * 256);
    GLDS(gQD + tid + i * 256, bufA + 1024 + tid + i * 256);
  }
#pragma unroll
  for (int ct = 0; ct < 2; ++ct)
#pragma unroll
    for (int q = 0; q < 16; ++q) vn[ct][q] = gU[(ct * 32 + crow(q, 0)) * 128 + uo];
  asm volatile("s_waitcnt vmcnt(0)" ::: "memory");
  __syncthreads();
#pragma unroll 1
  for (int n = 0; n < 32; ++n) {
    const int chunk = item * 32 + n;
    const float gl = p.GL[chunk];
    const int n1 = (n + 1 < 32) ? n + 1 : 31;
    {
      const u32x4* k0 = gQK + n * 512;
      const u32x4* d0 = gKD + n * 1024;
#pragma unroll
      for (int i = 0; i < 2; ++i) GLDS(k0 + tid + i * 256, bufB + tid + i * 256);
#pragma unroll
      for (int i = 0; i < 4; ++i) GLDS(d0 + tid + i * 256, bufB + 512 + tid + i * 256);
    }
    {
      bf16x8 Sb[4][2];
#pragma unroll
      for (int d = 0; d < 4; ++d) { Sb[d][0] = pack8(S[d], 0); Sb[d][1] = pack8(S[d], 1); }
#pragma unroll
      for (int ct = 0; ct < 2; ++ct)
#pragma unroll
        for (int q = 0; q < 16; ++q) o[ct][q] = 0.f;
#pragma unroll
      for (int ct = 0; ct < 2; ++ct)
#pragma unroll
        for (int ks = 0; ks < 8; ++ks) {
          bf16x8 aw = __builtin_bit_cast(bf16x8, bufA[(ct * 8 + ks) * 64 + lane]);
          bf16x8 aq = __builtin_bit_cast(bf16x8, bufA[1024 + (ct * 8 + ks) * 64 + lane]);
          vn[ct] = MFMA32(aw, Sb[ks >> 1][ks & 1], vn[ct]);
          o[ct] = MFMA32(aq, Sb[ks >> 1][ks & 1], o[ct]);
        }
    }
    bf16x8 Vb[2][2];
#pragma unroll
    for (int ct = 0; ct < 2; ++ct) { Vb[ct][0] = pack8(vn[ct], 0); Vb[ct][1] = pack8(vn[ct], 1); }
    asm volatile("s_waitcnt vmcnt(0)" ::: "memory");
    __syncthreads();
    {
      const u32x4* w1 = gWN + n1 * 1024;
      const u32x4* q1 = gQD + n1 * 1024;
#pragma unroll
      for (int i = 0; i < 4; ++i) {
        GLDS(w1 + tid + i * 256, bufA + tid + i * 256);
        GLDS(q1 + tid + i * 256, bufA + 1024 + tid + i * 256);
      }
      const float* u1 = gU + n1 * 8192;
#pragma unroll
      for (int ct = 0; ct < 2; ++ct)
#pragma unroll
        for (int q = 0; q < 16; ++q) vn[ct][q] = u1[(ct * 32 + crow(q, 0)) * 128 + uo];
    }
#pragma unroll
    for (int ct = 0; ct < 2; ++ct)
#pragma unroll
      for (int ks = 0; ks < 4; ++ks) {
        bf16x8 a = __builtin_bit_cast(bf16x8, bufB[(ct * 4 + ks) * 64 + lane]);
        o[ct] = MFMA32(a, Vb[ks >> 1][ks & 1], o[ct]);
      }
#pragma unroll
    for (int d = 0; d < 4; ++d) {
#pragma unroll
      for (int q = 0; q < 16; ++q) S[d][q] *= gl;
#pragma unroll
      for (int ks = 0; ks < 4; ++ks) {
        bf16x8 a = __builtin_bit_cast(bf16x8, bufB[512 + (d * 4 + ks) * 64 + lane]);
        S[d] = MFMA32(a, Vb[ks >> 1][ks & 1], S[d]);
      }
    }
    float* od = p.ODN + ((size_t)b * 2048 + n * 64) * 512 + hh * 128;
#pragma unroll
    for (int ct = 0; ct < 2; ++ct)
#pragma unroll
      for (int q = 0; q < 16; ++q) od[(ct * 32 + crow(q, 0)) * 512 + oo] = o[ct][q];
    asm volatile("s_waitcnt vmcnt(0)" ::: "memory");
    __syncthreads();
  }
#undef GLDS
  float* so = p.out + O_DELTAP + ((size_t)(b * 4 + hh) * 128) * 128;
#pragma unroll
  for (int d = 0; d < 4; ++d)
#pragma unroll
    for (int q = 0; q < 16; ++q) so[(d * 32 + crow(q, 0)) * 128 + uo] = S[d][q];
  __syncthreads();
}

DI void phase_scan(const Params& p, char* smem) {
  const int lane = threadIdx.x & 63, wid = threadIdx.x >> 6;
  if (gridDim.x >= 64) {
    if (blockIdx.x < 32) {
      scan_item(p, blockIdx.x, smem);
    } else {
      const int nb = gridDim.x - 32, bi = blockIdx.x - 32;
      for (int it = bi; it < 512; it += nb) delta_sample_item(p, it, smem);
      for (int row = bi * 4 + wid; row < NROW; row += nb * 4) branch_a_final_row(p, row, lane);
    }
  } else {
    for (int it = blockIdx.x; it < 32; it += gridDim.x) scan_item(p, it, smem);
    for (int it = blockIdx.x; it < 512; it += gridDim.x) delta_sample_item(p, it, smem);
    for (int row = blockIdx.x * 4 + wid; row < NROW; row += gridDim.x * 4) branch_a_final_row(p, row, lane);
  }
}

DI void phase_delta_post(const Params& p) {
  const int lane = threadIdx.x & 63, wid = threadIdx.x >> 6;
  const int stride = gridDim.x * 4;
  const float2 g = *(const float2*)(p.dn_norm_g + lane * 2);
  for (int row = blockIdx.x * 4 + wid; row < NROW; row += 2 * stride) {
    const int r1 = row + stride;
    const bool has1 = r1 < NROW;
    const int rows[2] = {row, has1 ? r1 : row};
    float2 o[2][4];
    unsigned zu[2][4];
#pragma unroll
    for (int k = 0; k < 2; ++k)
#pragma unroll
      for (int hh = 0; hh < 4; ++hh) {
        const int ch = hh * 128 + lane * 2;
        o[k][hh] = *(const float2*)(p.ODN + (size_t)rows[k] * 512 + ch);
        zu[k][hh] = *(const unsigned*)(p.PB + (size_t)rows[k] * EINP + 3072 + ch);
      }
#pragma unroll
    for (int k = 0; k < 2; ++k)
#pragma unroll
      for (int hh = 0; hh < 4; ++hh) {
        const int ch = hh * 128 + lane * 2;
        float ss = wave_sum(o[k][hh].x * o[k][hh].x + o[k][hh].y * o[k][hh].y);
        float inv = rsqrtf(ss * (1.0f / 128.0f) + EPSF);
        float y0 = o[k][hh].x * inv * g.x * siluf_(bflo(zu[k][hh]));
        float y1 = o[k][hh].y * inv * g.y * siluf_(bfhi(zu[k][hh]));
        if (k == 0 || has1) *(unsigned*)(p.MIX + (size_t)rows[k] * 1024 + 512 + ch) = pack2(y0, y1);
      }
  }
}

template <bool FIRST, bool HAS_H>
DI void phase_gemm_resid(const Params& p, const bfr* A, const bfr* Wt, const float* gnext, float* ss, char* smem) {
  float* X = p.X;
  bfr* Hn = p.H;
  const int lane = threadIdx.x & 63, wid = threadIdx.x >> 6, wr = wid >> 1, wc = wid & 1, r = lane & 31, hl = lane >> 5;
  {
    const float* xs = p.x_sample - (size_t)NPR * 1024;
    gemm_sample<true>(A, 1024, Wt, 1024, 1024, 1024, smem,
                      [=](int row, int col, float v) -> float {
                        const size_t o = (size_t)row * 1024 + col;
                        const float xn = (FIRST ? xs[o] : X[o]) + v;
                        X[o] = xn;
                        if (HAS_H) Hn[o] = f2bf(xn * gnext[col]);
                        return xn;
                      },
                      [=](int row, float s2) { unsafeAtomicAdd(ss + row, s2); });
  }
  for (int t = blockIdx.x; t < 128 * 8; t += gridDim.x) {
    const int mt = t >> 3, nt = t & 7, m0 = mt * 128, n0 = nt * 128;
    f32x16 acc[2][2];
    gemm_mainloop(A, 1024, Wt, 1024, 1024, m0, n0, smem, acc);
    const float* xsrc = FIRST ? ((m0 < NPR) ? p.x_prompt : p.x_sample - (size_t)NPR * 1024) : X;
    const int rbase = m0 + wr * 64 + 4 * hl, cbase = n0 + wc * 64 + r;
    float g0 = 0.f, g1 = 0.f;
    if (HAS_H) { g0 = gnext[cbase]; g1 = gnext[cbase + 32]; }
#pragma unroll
    for (int i = 0; i < 2; ++i) {
      float xo[2][16];
#pragma unroll
      for (int j = 0; j < 2; ++j)
#pragma unroll
        for (int q = 0; q < 16; ++q)
          xo[j][q] = xsrc[(size_t)(rbase + i * 32 + crow(q, 0)) * 1024 + cbase + j * 32];
      float rs[16];
#pragma unroll
      for (int q = 0; q < 16; ++q) {
        const size_t o = (size_t)(rbase + i * 32 + crow(q, 0)) * 1024 + cbase;
        const float x0 = xo[0][q] + acc[i][0][q], x1 = xo[1][q] + acc[i][1][q];
        X[o] = x0;
        X[o + 32] = x1;
        if (HAS_H) { Hn[o] = f2bf(x0 * g0); Hn[o + 32] = f2bf(x1 * g1); }
        rs[q] = x0 * x0 + x1 * x1;
      }
#pragma unroll
      for (int q = 0; q < 16; ++q) rs[q] = half32_sum_hi(rs[q]);
      if (r == 31) {
#pragma unroll
        for (int q = 0; q < 16; ++q) unsafeAtomicAdd(ss + rbase + i * 32 + crow(q, 0), rs[q]);
      }
    }
    __syncthreads();
  }
}
DI void phase_gemm_bf16out(const Params& p, const bfr* A, const bfr* Wt, bfr* C, int N, const float* ss, char* smem) {
  const int ntn = N >> 7;
  gemm_sample<false>(A, 1024, Wt, 1024, 1024, N, smem,
                     [=](int row, int col, float v) -> float {
                       float inv = rsqrtf(ss[row] * (1.0f / 1024.0f) + EPSF);
                       C[(size_t)row * N + col] = f2bf(v * inv);
                       return 0.f;
                     },
                     [=](int, float) {});
  for (int t = blockIdx.x; t < 128 * ntn; t += gridDim.x) {
    int mt = t / ntn, nt = t % ntn;
    gemm_tile(A, 1024, Wt, 1024, 1024, mt * 128, nt * 128, smem,
              [=](int row, int col, float v) {
                float inv = rsqrtf(ss[row] * (1.0f / 1024.0f) + EPSF);
                C[(size_t)row * N + col] = f2bf(v * inv);
              });
  }
}

DI void attn_prompt_wave(const Params& p, int l, int b, int hh, int tt, bfr* Obuf) {
  const int lane = threadIdx.x & 63, r = lane & 31, hl = lane >> 5;
  const size_t row0 = (size_t)b * 2048 + tt * 32;
  const bfr* Qp = p.ACT2 + (row0 + r) * 1024 + hh * 256 + hl * 8;
  const bfr* Kp = p.KB + (size_t)l * 2097152 + ((size_t)b * 256 + r) * 1024 + hh * 256 + hl * 8;
  f32x16 st[8];
#pragma unroll
  for (int m = 0; m < 8; ++m)
#pragma unroll
    for (int q = 0; q < 16; ++q) st[m][q] = 0.f;
#pragma unroll 2
  for (int ks = 0; ks < 16; ++ks) {
    bf16x8 qf = *(const bf16x8*)(Qp + ks * 16);
#pragma unroll
    for (int m = 0; m < 8; ++m) {
      bf16x8 kf = *(const bf16x8*)(Kp + (size_t)m * 32 * 1024 + ks * 16);
      st[m] = MFMA32(kf, qf, st[m]);
    }
  }
  float mx = -3.0e38f;
#pragma unroll
  for (int m = 0; m < 8; ++m)
#pragma unroll
    for (int q = 0; q < 16; ++q) mx = fmaxf(mx, st[m][q]);
  mx = fmaxf(mx, __shfl_xor(mx, 32));
  float sum = 0.f;
#pragma unroll
  for (int m = 0; m < 8; ++m)
#pragma unroll
    for (int q = 0; q < 16; ++q) {
      float e = __expf((st[m][q] - mx) * 0.0625f);
      st[m][q] = e;
      sum += e;
    }
  sum += __shfl_xor(sum, 32);
  const float inv = 1.0f / sum;
  bf16x8 pb[8][2];
#pragma unroll
  for (int m = 0; m < 8; ++m) { pb[m][0] = pack8(st[m], 0); pb[m][1] = pack8(st[m], 1); }
  const uint4* VT = (const uint4*)(p.VT + (size_t)l * 2097152) + ((size_t)(b * 4 + hh) * 8) * 16 * 64 + lane;
  bfr* Op = Obuf + (row0 + r) * 1024 + hh * 256;
#pragma unroll 1
  for (int half = 0; half < 2; ++half) {
    f32x16 o[4];
#pragma unroll
    for (int d = 0; d < 4; ++d)
#pragma unroll
      for (int q = 0; q < 16; ++q) o[d][q] = 0.f;
#pragma unroll
    for (int ks = 0; ks < 16; ++ks) {
#pragma unroll
      for (int d = 0; d < 4; ++d) {
        bf16x8 vf = ldfrag(VT + ((size_t)(half * 4 + d) * 16 + ks) * 64);
        o[d] = MFMA32(vf, pb[ks >> 1][ks & 1], o[d]);
      }
    }
#pragma unroll
    for (int d = 0; d < 4; ++d)
#pragma unroll
      for (int g4 = 0; g4 < 4; ++g4) {
        int dim = (half * 4 + d) * 32 + 8 * g4 + 4 * hl;
        uint2 ov;
        ov.x = pack2(o[d][g4 * 4 + 0] * inv, o[d][g4 * 4 + 1] * inv);
        ov.y = pack2(o[d][g4 * 4 + 2] * inv, o[d][g4 * 4 + 3] * inv);
        *(uint2*)(Op + dim) = ov;
      }
  }
}

DI void attn_sample_item(const Params& p, int l, int item, char* smem, bfr* Obuf) {
  const int s = item >> 2, hh = item & 3, tid = threadIdx.x, lane = tid & 63, wid = tid >> 6;
  float* qsm = (float*)smem;
  float* sc = qsm + 256;
  float* red = sc + 256;
  const size_t row = NPR + s;
  qsm[tid] = bf2f(p.ACT2[row * 1024 + hh * 256 + tid]);
  __syncthreads();
  const int grp = lane >> 4, l16 = lane & 15;
  float4 q4[4];
#pragma unroll
  for (int j = 0; j < 4; ++j) q4[j] = ((const float4*)qsm)[j * 16 + l16];
  const float* Kb = p.cache_k + ((((size_t)l * 128 + s) * 256) * 4 + hh) * 256;
  const float* Vb = p.cache_v + ((((size_t)l * 128 + s) * 256) * 4 + hh) * 256;
#pragma unroll 8
  for (int ps = 0; ps < 16; ++ps) {
    int mem = wid * 64 + ps * 4 + grp;
    const float4* kr = (const float4*)(Kb + (size_t)mem * 1024);
    float d = 0.f;
#pragma unroll
    for (int j = 0; j < 4; ++j) {
      float4 k4 = kr[j * 16 + l16];
      d += k4.x * q4[j].x + k4.y * q4[j].y + k4.z * q4[j].z + k4.w * q4[j].w;
    }
    d += __shfl_xor(d, 8);
    d += __shfl_xor(d, 4);
    d += __shfl_xor(d, 2);
    d += __shfl_xor(d, 1);
    if (l16 == 0) sc[mem] = d * 0.0625f;
  }
  __syncthreads();
  float sv = sc[tid];
  float m = wave_max(sv);
  if (lane == 0) red[wid] = m;
  __syncthreads();
  m = fmaxf(fmaxf(red[0], red[1]), fmaxf(red[2], red[3]));
  float e = __expf(sv - m);
  float sm_ = wave_sum(e);
  if (lane == 0) red[4 + wid] = sm_;
  sc[tid] = e;
  __syncthreads();
  const float inv = 1.0f / (red[4] + red[5] + red[6] + red[7]);
  float4 acc = {0.f, 0.f, 0.f, 0.f};
  float* partial = (float*)smem + 1024;
#pragma unroll 16
  for (int i = 0; i < 64; ++i) {
    const int mem = wid * 64 + i;
    float4 v4 = *(const float4*)(Vb + (size_t)mem * 1024 + lane * 4);
    const float pm = sc[mem];
    acc.x += pm * v4.x; acc.y += pm * v4.y; acc.z += pm * v4.z; acc.w += pm * v4.w;
  }
  *(float4*)(partial + wid * 256 + lane * 4) = acc;
  __syncthreads();
  const float ov = partial[tid] + partial[256 + tid] + partial[512 + tid] + partial[768 + tid];
  Obuf[row * 1024 + hh * 256 + tid] = f2bf(ov * inv);
  __syncthreads();
}

DI void phase_attn(const Params& p, int l, char* smem) {
  bfr* Obuf = p.ACT3;
  const int half = gridDim.x >> 1;
  const bool upper = (int)blockIdx.x >= half;
  const int bi = upper ? (int)blockIdx.x - half : (int)blockIdx.x;
  const int nb = upper ? (int)gridDim.x - half : half;
  for (int pass = 0; pass < 2; ++pass) {
    const bool do_sample = (pass == 0) != upper;
    if (do_sample) {
      for (int k = bi; k < 256; k += nb) attn_sample_item(p, l, 2 * k + (upper ? 1 : 0), smem, Obuf);
    } else {
      for (int k = bi; k < 256; k += nb) {
        const int u = 2 * k + (upper ? 1 : 0), tt4 = u & 15, hh = (u >> 4) & 3, b = u >> 6;
        attn_prompt_wave(p, l, b, hh, tt4 * 4 + (threadIdx.x >> 6), Obuf);
      }
    }
  }
}

template <int WIN>
DI void pool_elem(const Params& p, int row, int c) {
  const bfr* P2 = p.PB;
  unsigned uu = *(const unsigned*)(P2 + (size_t)row * 2048 + c);
  const float u0 = bflo(uu), u1 = bfhi(uu);
  float s0 = u0, s1 = u1, cnt;
  if (row < NPR) {
    const int t = row & 2047, b = row >> 11;
    if (t >= WIN - 1) {
      cnt = (float)WIN;
      unsigned w[WIN - 1];
#pragma unroll
      for (int j = 1; j < WIN; ++j) w[j - 1] = *(const unsigned*)(P2 + (size_t)(row - j) * 2048 + c);
#pragma unroll
      for (int j = 1; j < WIN; ++j) { s0 += bflo(w[j - 1]); s1 += bfhi(w[j - 1]); }
    } else {
      cnt = (float)(t + 1);
      for (int j = 1; j <= t; ++j) {
        unsigned w = *(const unsigned*)(P2 + (size_t)(row - j) * 2048 + c);
        s0 += bflo(w); s1 += bfhi(w);
      }
    }
    if (t >= 2033) {
      float2 o = {u0, u1};
      *(float2*)(p.out + O_POOLP + ((size_t)b * 15 + (t - 2033)) * 1024 + c) = o;
    }
  } else {
    const int s = row - NPR;
    cnt = (float)WIN;
    const float* sp = p.state_pool + (size_t)s * 15 * 1024 + c;
    float2 st[15];
#pragma unroll
    for (int j = 0; j < 15; ++j) st[j] = *(const float2*)(sp + (size_t)j * 1024);
#pragma unroll
    for (int j = 1; j < WIN; ++j) { s0 += st[15 - j].x; s1 += st[15 - j].y; }
    float* op = p.out + O_POOLS + (size_t)s * 15 * 1024 + c;
#pragma unroll
    for (int j = 0; j < 14; ++j) *(float2*)(op + (size_t)j * 1024) = st[j + 1];
    float2 o = {u0, u1};
    *(float2*)(op + (size_t)14 * 1024) = o;
  }
  *(unsigned*)(p.MIX + (size_t)row * 1024 + c) = pack2(s0 / cnt - u0, s1 / cnt - u1);
}
DI void phase_pool(const Params& p) {
  for (int idx = blockIdx.x * 256 + threadIdx.x; idx < NROW * 512; idx += gridDim.x * 256) {
    const int row = idx >> 9, c = (idx & 511) * 2;
    const int gi = c >> 8;
    if (gi == 0) pool_elem<2>(p, row, c);
    else if (gi == 1) pool_elem<4>(p, row, c);
    else if (gi == 2) pool_elem<8>(p, row, c);
    else pool_elem<16>(p, row, c);
  }
}

DI void phase_gemm_pool(const Params& p, char* smem) {
  const bfr* P2 = p.PB;
  bfr* Z = p.ACT3;
  for (int g = 0; g < 4; ++g) {
    const float* bp = p.b_pool + g * 256;
    const float* sc = p.pool_scale + g * 256;
    gemm_sample<false>(p.MIX + g * 256, 1024, p.WtPool + (size_t)g * 65536, 256, 256, 256, smem,
                       [=](int row, int col, float v) -> float {
                         float gate = bf2f(P2[(size_t)row * 2048 + 1024 + g * 256 + col]);
                         float z = (v + bp[col]) * sc[col] * siluf_(gate);
                         Z[(size_t)row * 1024 + g * 256 + col] = f2bf(z);
                         return 0.f;
                       },
                       [=](int, float) {});
  }
  for (int t = blockIdx.x; t < 128 * 8; t += gridDim.x) {
    int mt = t >> 3, g = (t >> 1) & 3, nt = t & 1;
    const float* bp = p.b_pool + g * 256;
    const float* sc = p.pool_scale + g * 256;
    gemm_tile(p.MIX + g * 256, 1024, p.WtPool + (size_t)g * 65536, 256, 256, mt * 128, nt * 128, smem,
              [=](int row, int col, float v) {
                float gate = bf2f(P2[(size_t)row * 2048 + 1024 + g * 256 + col]);
                float z = (v + bp[col]) * sc[col] * siluf_(gate);
                Z[(size_t)row * 1024 + g * 256 + col] = f2bf(z);
              });
  }
}

#ifndef ONLY_PHASE
#define ONLY_PHASE -1
#endif
#define PON(n) (ONLY_PHASE < 0 || ONLY_PHASE == (n))
__global__ void __launch_bounds__(256, 2) mega(Params p) {
  __shared__ __attribute__((aligned(16))) char smem[65536];
  cg::grid_group grid = cg::this_grid();
  if (p.phase_lo < -1000) grid.sync();
  volatile LAS unsigned* xst = (volatile LAS unsigned*)(smem + 65520);
  if (threadIdx.x < 4) xst[threadIdx.x] = 0u;
  __syncthreads();
  XcdBarrier xb = xcd_barrier_post(p.bar, xst);
#ifndef DUPMASK
#define DUPMASK 0
#endif
#define RUN(n, call) do { if (PON(n) && p.phase_lo <= (n) && (n) <= p.phase_hi) { call; if ((DUPMASK >> (n)) & 1) { xcd_barrier(xb); call; } } if (p.phase_lo <= (n) && (n) < p.phase_hi) xcd_barrier(xb); } while (0)
  RUN(0, phase_prep(p, smem));
  RUN(1, phase_gemm_in_even(p, smem));
  RUN(2, phase_even_pointwise(p, smem));
  RUN(3, phase_chunk_prep(p, smem));
  RUN(4, phase_scan(p, smem));
  RUN(5, phase_delta_post(p));
  RUN(6, (phase_gemm_resid<true, true>(p, p.MIX, p.WtOutE, p.norm_xattn, p.SS, smem)));
  RUN(8, phase_gemm_bf16out(p, p.H, p.WtXq, p.ACT2, 1024, p.SS, smem));
  RUN(9, phase_attn(p, 0, smem));
  RUN(10, (phase_gemm_resid<false, true>(p, p.ACT3, p.WtXo, p.norm_mix + 1024, p.SS + NROW, smem)));
  RUN(12, phase_gemm_bf16out(p, p.H, p.WtInO, p.PB, 2048, p.SS + NROW, smem));
  RUN(13, phase_pool(p));
  RUN(14, phase_gemm_pool(p, smem));
  RUN(15, (phase_gemm_resid<false, true>(p, p.ACT3, p.WtOutO, p.norm_xattn + 1024, p.SS + 2 * NROW, smem)));
  RUN(17, phase_gemm_bf16out(p, p.H, p.WtXq + 1048576, p.ACT2, 1024, p.SS + 2 * NROW, smem));
  RUN(18, phase_attn(p, 1, smem));
  RUN(19, (phase_gemm_resid<false, false>(p, p.ACT3, p.WtXo + 1048576, p.norm_final, p.SS + 3 * NROW, smem)));
  RUN(20, phase_final_norm(p));
}

extern "C" void kernel_launch(void* const* d_in, const int* in_sizes, int n_in, void* d_out, int out_size, void* d_ws,
                              size_t ws_size, hipStream_t stream) {
  static int grid_blocks = 0;
  if (!grid_blocks) {
    int dev = 0, cus = 0, per_cu = 0;
    (void)hipGetDevice(&dev);
    (void)hipDeviceGetAttribute(&cus, hipDeviceAttributeMultiprocessorCount, dev);
    (void)hipOccupancyMaxActiveBlocksPerMultiprocessor(&per_cu, mega, 256, 0);
    if (per_cu < 1) per_cu = 1;
    if (per_cu > 2) per_cu = 2;
    grid_blocks = cus * per_cu;
  }
  Params p{};
  const float** ins = (const float**)&p.x_prompt;
  for (int i = 0; i < 31; ++i) ins[i] = (const float*)d_in[i];
  p.out = (float*)d_out;
  char* w = (char*)d_ws;
  size_t off = 0;
  auto take = [&](size_t bytes) { char* r = w + off; off += (bytes + 255) & ~(size_t)255; return r; };
  p.X = (float*)take((size_t)NROW * 1024 * 4);
  p.QKV = (float*)take((size_t)NROW * 1536 * 4);
  p.BGR = (float*)take((size_t)NROW * 8 * 4);
  p.BG = (float*)take((size_t)NROW * 8 * 4);
  p.CONV = (float*)take((size_t)NROW * 512 * 4);
  p.ODN = (float*)take((size_t)NROW * 512 * 4);
  p.U = (float*)take((size_t)1024 * 8192 * 4);
  p.GL = (float*)take(4096);
  p.SS = (float*)take((size_t)4 * NROW * 4);
  p.H = (bfr*)take((size_t)NROW * 1024 * 2);
  p.PB = (bfr*)take((size_t)NROW * 3584 * 2);
  p.MIX = (bfr*)take((size_t)NROW * 1024 * 2);
  p.ACT2 = (bfr*)take((size_t)NROW * 1024 * 2);
  p.ACT3 = (bfr*)take((size_t)NROW * 1024 * 2);
  p.KB = (bfr*)take((size_t)2 * 2048 * 1024 * 2);
  p.VT = (bfr*)take((size_t)2 * 2048 * 1024 * 2);
  p.MPB = (bfr*)take((size_t)2048 * 1024 * 2);
  p.WtInE = (bfr*)take((size_t)3712 * 1024 * 2);
  p.WtOutE = (bfr*)take((size_t)1024 * 1024 * 2);
  p.WtInO = (bfr*)take((size_t)2048 * 1024 * 2);
  p.WtPool = (bfr*)take((size_t)4 * 256 * 256 * 2);
  p.WtOutO = (bfr*)take((size_t)1024 * 1024 * 2);
  p.WtXq = (bfr*)take((size_t)2 * 1024 * 1024 * 2);
  p.WtXk = (bfr*)take((size_t)2 * 1024 * 1024 * 2);
  p.WtXv = (bfr*)take((size_t)2 * 1024 * 1024 * 2);
  p.WtXo = (bfr*)take((size_t)2 * 1024 * 1024 * 2);
  p.WN = (uint4*)take((size_t)1024 * 1024 * 16);
  p.QD = (uint4*)take((size_t)1024 * 1024 * 16);
  p.KD = (uint4*)take((size_t)1024 * 1024 * 16);
  p.QKF = (uint4*)take((size_t)1024 * 512 * 16);
  p.bar = (unsigned*)take((size_t)XCD_BAR_WORDS * 4);
  if (off > ws_size) {
    fprintf(stderr, "kernel_launch: workspace too small: need %zu have %zu\n", off, ws_size);
    return;
  }
  p.phase_lo = 0;
  p.phase_hi = 20;
  if (hipMemsetAsync(p.bar, 0, (size_t)XCD_BAR_WORDS * 4, stream) != hipSuccess) { fprintf(stderr, "memset failed\n"); return; }
  void* args[] = {&p};
  hipError_t e = hipLaunchCooperativeKernel((void*)mega, dim3(grid_blocks), dim3(256), args, 0, stream);
  if (e != hipSuccess) fprintf(stderr, "cooperative launch failed: %s (grid %d)\n", hipGetErrorString(e), grid_blocks);
}
```

```cpp
#include <hip/hip_runtime.h>
#include <hip/hip_cooperative_groups.h>
#include <cstdio>
namespace cg = cooperative_groups;

#define DI __device__ __forceinline__
typedef unsigned short bfr;
using bf16x8 = __attribute__((ext_vector_type(8))) short;
using f32x16 = __attribute__((ext_vector_type(16))) float;
typedef __bf16 bf2_t __attribute__((ext_vector_type(2)));
typedef float fl2_t __attribute__((ext_vector_type(2)));
typedef unsigned u32x4 __attribute__((ext_vector_type(4)));
#define MFMA32(a, b, c) __builtin_amdgcn_mfma_f32_32x32x16_bf16((a), (b), (c), 0, 0, 0)

constexpr int NROW = 16512;
constexpr int NPR = 16384;
constexpr int DM = 1024;
constexpr int EIN = 3592, EINP = 3584;
constexpr float EPSF = 1e-6f;

constexpr size_t O_Y = 0;
constexpr size_t O_CONVP = 16777216 + 131072;
constexpr size_t O_QKVP = O_CONVP + 122880;
constexpr size_t O_DELTAP = O_QKVP + 36864;
constexpr size_t O_POOLP = O_DELTAP + 524288;
constexpr size_t O_MEMK = O_POOLP + 122880;
constexpr size_t O_MEMV = O_MEMK + 4194304;
constexpr size_t O_CONVS = O_MEMV + 4194304;
constexpr size_t O_QKVS = O_CONVS + 1966080;
constexpr size_t O_DELTAS = O_QKVS + 589824;
constexpr size_t O_POOLS = O_DELTAS + 8388608;

struct Params {
  const float *x_prompt, *x_sample, *state_conv_a, *state_qkv_conv, *state_delta, *state_pool, *cache_k, *cache_v, *mem_prompt;
  const float *norm_mix, *norm_xattn, *norm_final, *w_in_even, *w_out_even, *dw_w, *dw_b, *ln_a_g, *ln_a_b, *sc_w, *a_log,
      *dt_bias, *dn_norm_g, *w_in_odd, *w_pool, *b_pool, *pool_scale, *w_out_odd, *w_xq, *w_xk, *w_xv, *w_xo;
  float* out;
  float *X, *QKV, *BGR, *BG, *CONV, *ODN, *U, *GL, *SS;
  bfr *H, *PB, *MIX, *ACT2, *ACT3, *KB, *VT, *MPB;
  bfr *WtInE, *WtOutE, *WtInO, *WtPool, *WtOutO, *WtXq, *WtXk, *WtXv, *WtXo;
  uint4 *WN, *QD, *KD, *QKF;
  unsigned* bar;
  int phase_lo, phase_hi;
};

DI int opaque_tid() { int t = threadIdx.x; asm volatile("" : "+v"(t)); return t; }
DI unsigned pack2(float a, float b) {
  fl2_t f = {a, b};
  bf2_t r = __builtin_convertvector(f, bf2_t);
  return __builtin_bit_cast(unsigned, r);
}
DI bfr f2bf(float a) { return (bfr)(pack2(a, 0.f) & 0xffffu); }
DI float bf2f(bfr u) { return __uint_as_float(((unsigned)u) << 16); }
DI float bflo(unsigned u) { return __uint_as_float(u << 16); }
DI float bfhi(unsigned u) { return __uint_as_float(u & 0xffff0000u); }
DI float sigmoidf_(float x) { return 1.0f / (1.0f + __expf(-x)); }
DI float siluf_(float x) { return x / (1.0f + __expf(-x)); }
#define DPPF(v, ctrl, rmask) __builtin_bit_cast(float, __builtin_amdgcn_update_dpp(0, __builtin_bit_cast(int, (v)), (ctrl), (rmask), 0xf, false))
DI float row16_sum(float v) {
  v += DPPF(v, 0xB1, 0xf);
  v += DPPF(v, 0x4E, 0xf);
  v += DPPF(v, 0x141, 0xf);
  v += DPPF(v, 0x140, 0xf);
  return v;
}
DI float half32_sum_hi(float v) {
  v = row16_sum(v);
  v += DPPF(v, 0x142, 0xa);
  return v;
}
DI float wave_sum(float v) {
  v = row16_sum(v);
  v += DPPF(v, 0x142, 0xa);
  v += DPPF(v, 0x143, 0xc);
  return __builtin_bit_cast(float, __builtin_amdgcn_readlane(__builtin_bit_cast(int, v), 63));
}
DI float wave_max(float v) {
#pragma unroll
  for (int o = 32; o >= 1; o >>= 1) v = fmaxf(v, __shfl_xor(v, o));
  return v;
}
DI int crow(int reg, int h) { return (reg & 3) + 8 * (reg >> 2) + 4 * h; }
DI bf16x8 pack8(const f32x16& x, int s) {
  uint4 p;
  p.x = pack2(x[8 * s + 0], x[8 * s + 1]);
  p.y = pack2(x[8 * s + 2], x[8 * s + 3]);
  p.z = pack2(x[8 * s + 4], x[8 * s + 5]);
  p.w = pack2(x[8 * s + 6], x[8 * s + 7]);
  return __builtin_bit_cast(bf16x8, p);
}
DI bf16x8 ldfrag(const uint4* p) { uint4 v = *p; return __builtin_bit_cast(bf16x8, v); }


#define XB_TMO      128
#define XB_XCNT(j)  (256  + 64 * (j))
#define XB_XSUB(j)  (1280 + 64 * (j))
#define XB_XGEN(j)  (2304 + 64 * (j))
#define XB_TOP      3328
#define XB_TOPGEN   3392
#define XCD_BAR_WORDS 3456
#define XB_SPIN_CAP (1u << 18)
#define LAS __attribute__((address_space(3)))
DI unsigned xb_ld(unsigned* p) { return __hip_atomic_load(p, __ATOMIC_RELAXED, __HIP_MEMORY_SCOPE_AGENT); }
DI unsigned xb_add(unsigned* p, unsigned v) { return __hip_atomic_fetch_add(p, v, __ATOMIC_RELAXED, __HIP_MEMORY_SCOPE_AGENT); }
DI unsigned xb_xcc_id() { return (unsigned)__builtin_amdgcn_s_getreg((3 << 11) | 20) & 0xFu; }
#define XB_SPIN(cond, bar) do { unsigned _sp = 0; while (cond) { __builtin_amdgcn_s_sleep(1); \
    if ((++_sp & 255u) == 0u) { if (xb_ld(&(bar)[XB_TMO])) break; if (_sp > XB_SPIN_CAP) { atomicAdd(&(bar)[XB_TMO], 1u); break; } } } } while (0)
struct XcdBarrier { unsigned* bar; unsigned x; volatile LAS unsigned* st; };
DI XcdBarrier xcd_barrier_post(unsigned* bar, volatile LAS unsigned* st) {
  XcdBarrier b; b.bar = bar; b.x = xb_xcc_id(); b.st = st;
  if (threadIdx.x == 0) (void)xb_add(&bar[XB_XCNT(b.x)], 1u);
  return b;
}
DI void xcd_barrier_complete(unsigned* bar, unsigned x, unsigned& nloc, unsigned& nx) {
  const unsigned G = gridDim.x * gridDim.y * gridDim.z;
  unsigned sum, cnt, mine, sp = 0u;
  for (;;) {
    sum = 0u; cnt = 0u; mine = 0u;
#pragma unroll
    for (unsigned j = 0; j < 16; ++j) { const unsigned c = xb_ld(&bar[XB_XCNT(j)]); sum += c; cnt += (c > 0u) ? 1u : 0u; mine = (j == x) ? c : mine; }
    if (sum == G) break;
    __builtin_amdgcn_s_sleep(1);
    if ((++sp & 255u) == 0u) { if (xb_ld(&bar[XB_TMO])) break; if (sp > XB_SPIN_CAP) { atomicAdd(&bar[XB_TMO], 1u); break; } }
  }
  nloc = mine > 0u ? mine : 1u; nx = cnt > 0u ? cnt : 1u;
}
DI void xcd_barrier(const XcdBarrier& b) {
  asm volatile("s_waitcnt vmcnt(0)" ::: "memory");
  __syncthreads();
  if (threadIdx.x == 0) {
    unsigned* bar = b.bar;
    __builtin_amdgcn_s_waitcnt(0);
    unsigned nloc = b.st[0], nx = b.st[1];
    if (nloc == 0u) { xcd_barrier_complete(bar, b.x, nloc, nx); b.st[0] = nloc; b.st[1] = nx; }
    const unsigned old = xb_add(&bar[XB_XSUB(b.x)], 1u);
    const unsigned gen = old / nloc;
    if (old + 1u == (gen + 1u) * nloc) {
      __builtin_amdgcn_fence(__ATOMIC_RELEASE, "agent");
      asm volatile("s_waitcnt vmcnt(0)" ::: "memory");
      const unsigned og = xb_add(&bar[XB_TOP], 1u);
      const unsigned tg = og / nx;
      if (og + 1u == (tg + 1u) * nx) xb_add(&bar[XB_TOPGEN], 1u);
      else XB_SPIN(xb_ld(&bar[XB_TOPGEN]) == tg, bar);
      __builtin_amdgcn_fence(__ATOMIC_ACQUIRE, "agent");
      xb_add(&bar[XB_XGEN(b.x)], 1u);
      asm volatile("s_waitcnt vmcnt(0)" ::: "memory");
    } else {
      XB_SPIN(xb_ld(&bar[XB_XGEN(b.x)]) == gen, bar);
      __builtin_amdgcn_fence(__ATOMIC_ACQUIRE, "agent");
      asm volatile("s_waitcnt vmcnt(0)" ::: "memory");
    }
  }
  __syncthreads();
}

constexpr int GSTAGE = (128 + 256) * 40;
template <int lda>
DI void gemm_mainloop(const bfr* __restrict__ A, const bfr* __restrict__ Bt, int NB, int K, int m0, int n0, char* smem, f32x16 (&acc)[2][4]) {
  bfr* S0 = (bfr*)smem;
  int tid = threadIdx.x;
  asm volatile("" : "+v"(tid));
  const int lane = tid & 63, wid = tid >> 6, wr = wid >> 1, wc = wid & 1;
  const int r = lane & 31, hl = lane >> 5;
#pragma unroll
  for (int i = 0; i < 2; ++i)
#pragma unroll
    for (int j = 0; j < 4; ++j)
#pragma unroll
      for (int q = 0; q < 16; ++q) acc[i][j][q] = 0.f;
  u32x4 ra[4], rb[4];
  const int nk = K >> 5;
  const int arow = tid >> 3, ac8 = tid & 7, apar = ac8 >> 2;
  const bfr* Ab = A + (m0 + arow) * lda + ac8 * 8;
  const int asoff = arow * 40 + (ac8 & 3) * 8;
  const int brow = tid >> 2, bc4 = tid & 3;
  const bfr* Bb = Bt + (n0 + brow) * 32 + bc4 * 8;
  const int bsoff = brow * 40 + bc4 * 8;
#define GA_LOAD(pr_) do { _Pragma("unroll") for (int i = 0; i < 4; ++i) ra[i] = *(const u32x4*)(Ab + (i * 32) * lda + (pr_) * 64); } while (0)
#define GB_LOAD(kt_) do { const bfr* bk_ = Bb + (kt_) * NB * 32; \
    _Pragma("unroll") for (int i = 0; i < 4; ++i) rb[i] = *(const u32x4*)(bk_ + (i * 64) * 32); } while (0)
#define G_STORE(kt_) do { bfr* as_ = S0 + ((kt_) & 1) * GSTAGE; bfr* bs_ = as_ + 128 * 40; \
    if (apar == ((kt_) & 1)) { _Pragma("unroll") for (int i = 0; i < 4; ++i) *(u32x4*)(as_ + asoff + i * 32 * 40) = ra[i]; } \
    _Pragma("unroll") for (int i = 0; i < 4; ++i) *(u32x4*)(bs_ + bsoff + i * 64 * 40) = rb[i]; } while (0)
  GA_LOAD(0);
  GB_LOAD(0);
  G_STORE(0);
  GB_LOAD(1);
  __syncthreads();
  for (int kt = 0; kt < nk; ++kt) {
    if (kt + 1 < nk) G_STORE(kt + 1);
    if (kt + 2 < nk) {
      GB_LOAD(kt + 2);
      if ((kt & 1) == 0) GA_LOAD((kt >> 1) + 1);
    }
    const bfr* As = S0 + (kt & 1) * GSTAGE;
    const bfr* Bs = As + 128 * 40;
#pragma unroll
    for (int ks = 0; ks < 2; ++ks) {
      bf16x8 af[2], bfg[4];
#pragma unroll
      for (int i = 0; i < 2; ++i) af[i] = *(const bf16x8*)(As + (wr * 64 + i * 32 + r) * 40 + ks * 16 + hl * 8);
#pragma unroll
      for (int j = 0; j < 4; ++j) bfg[j] = *(const bf16x8*)(Bs + (wc * 128 + j * 32 + r) * 40 + ks * 16 + hl * 8);
#pragma unroll
      for (int i = 0; i < 2; ++i)
#pragma unroll
        for (int j = 0; j < 4; ++j) acc[i][j] = MFMA32(af[i], bfg[j], acc[i][j]);
    }
    __syncthreads();
  }
#undef GA_LOAD
#undef GB_LOAD
#undef G_STORE
}

template <int lda, class Epi>
DI void gemm_tile(const bfr* __restrict__ A, const bfr* __restrict__ Bt, int NB, int K, int m0, int n0, char* smem, Epi epi) {
  f32x16 acc[2][4];
  gemm_mainloop<lda>(A, Bt, NB, K, m0, n0, smem, acc);
  int tid3 = threadIdx.x;
  asm volatile("" : "+v"(tid3));
  const int lane = tid3 & 63, wid = tid3 >> 6, wr = wid >> 1, wc = wid & 1, r = lane & 31, hl = lane >> 5;
#pragma unroll
  for (int i = 0; i < 2; ++i)
#pragma unroll
    for (int j = 0; j < 4; ++j)
#pragma unroll
      for (int q = 0; q < 16; ++q) {
        int row = m0 + wr * 64 + i * 32 + crow(q, hl);
        int col = n0 + wc * 128 + j * 32 + r;
        epi(row, col, acc[i][j][q]);
      }
}

template <bool RS, class Epi, class RowF>
DI void gemm_sample(const bfr* __restrict__ A, int lda, const bfr* __restrict__ Bt, int ldb, int K, int N, char* smem, Epi epi, RowF rowf) {
  const int tid = threadIdx.x, lane = tid & 63, wid = tid >> 6, r = lane & 31, hl = lane >> 5;
  float* red = (float*)smem;
  const int nun = 4 * (N >> 5);
  for (int u = blockIdx.x; u < nun; u += gridDim.x) {
    const int mu = u & 3, nu = u >> 2;
    const int kq = K >> 2, k0 = wid * kq;
    const bfr* ap = A + (size_t)(NPR + mu * 32 + r) * lda + k0 + hl * 8;
    const bfr* bp = Bt + ((size_t)(k0 >> 5) * ldb + nu * 32 + r) * 32 + hl * 8;
    f32x16 acc;
#pragma unroll
    for (int q = 0; q < 16; ++q) acc[q] = 0.f;
    if (K == 1024) {
#pragma unroll
      for (int ks = 0; ks < 16; ++ks) {
        bf16x8 af = *(const bf16x8*)(ap + ks * 16);
        bf16x8 bf = *(const bf16x8*)(bp + (size_t)(ks >> 1) * ldb * 32 + (ks & 1) * 16);
        acc = MFMA32(af, bf, acc);
      }
    } else {
      for (int ks = 0; ks < (kq >> 4); ++ks) {
        bf16x8 af = *(const bf16x8*)(ap + ks * 16);
        bf16x8 bf = *(const bf16x8*)(bp + (size_t)(ks >> 1) * ldb * 32 + (ks & 1) * 16);
        acc = MFMA32(af, bf, acc);
      }
    }
#pragma unroll
    for (int q = 0; q < 16; ++q) red[(wid * 16 + q) * 64 + lane] = acc[q];
    __syncthreads();
#pragma unroll
    for (int e = 0; e < 4; ++e) {
      const int q = wid + e * 4;
      const float v = red[q * 64 + lane] + red[(16 + q) * 64 + lane] + red[(32 + q) * 64 + lane] + red[(48 + q) * 64 + lane];
      const int row = NPR + mu * 32 + crow(q, hl), col = nu * 32 + r;
      float x = epi(row, col, v);
      if (RS) {
        float s2 = half32_sum_hi(x * x);
        if (r == 31) rowf(row, s2);
      }
    }
    __syncthreads();
  }
}

DI void transpose_tile(const float* __restrict__ W, int ldw, bfr* __restrict__ Wt, int NB, int k0, int n0, float* sm, int nvalid = 1 << 30) {
  const int tid = threadIdx.x;
#pragma unroll
  for (int i = 0; i < 16; ++i) {
    int idx = tid + i * 256, kk = idx >> 6, nn = idx & 63;
    sm[kk * 65 + nn] = (n0 + nn < nvalid) ? W[(size_t)(k0 + kk) * ldw + n0 + nn] : 0.f;
  }
  __syncthreads();
#pragma unroll
  for (int i = 0; i < 8; ++i) {
    int idx = tid + i * 256, nn = idx >> 5, kp = idx & 31;
    float a = sm[(2 * kp) * 65 + nn], b = sm[(2 * kp + 1) * 65 + nn];
    { const int k = k0 + 2 * kp; *(unsigned*)(Wt + ((size_t)(k >> 5) * NB + n0 + nn) * 32 + (k & 31)) = pack2(a, b); }
  }
  __syncthreads();
}

DI void phase_prep(const Params& p, char* smem) {
  float* sm = (float*)smem;
  for (int tt = blockIdx.x; tt < 4032 + 32; tt += gridDim.x) {
    int t = tt - 32;
    if (tt < 928) {
      int kt = tt / 58, nt = tt % 58;
      transpose_tile(p.w_in_even, EIN, p.WtInE, 3712, kt * 64, nt * 64, sm, EIN);
    } else if (t < 1152) {
      int u = t - 896;
      transpose_tile(p.w_out_even, 1024, p.WtOutE, 1024, (u >> 4) * 64, (u & 15) * 64, sm);
    } else if (t < 1664) {
      int u = t - 1152;
      transpose_tile(p.w_in_odd, 2048, p.WtInO, 2048, (u >> 5) * 64, (u & 31) * 64, sm);
    } else if (t < 1728) {
      int u = t - 1664, g = u >> 4, v = u & 15;
      transpose_tile(p.w_pool + (size_t)g * 65536, 256, p.WtPool + (size_t)g * 65536, 256, (v >> 2) * 64, (v & 3) * 64, sm);
    } else if (t < 1984) {
      int u = t - 1728;
      transpose_tile(p.w_out_odd, 1024, p.WtOutO, 1024, (u >> 4) * 64, (u & 15) * 64, sm);
    } else {
      int u = t - 1984, m = u >> 8, v = u & 255;
      int which = m >> 1, l = m & 1;
      const float* src = (which == 0 ? p.w_xq : which == 1 ? p.w_xk : which == 2 ? p.w_xv : p.w_xo) + (size_t)l * 1048576;
      bfr* dst = (which == 0 ? p.WtXq : which == 1 ? p.WtXk : which == 2 ? p.WtXv : p.WtXo) + (size_t)l * 1048576;
      transpose_tile(src, 1024, dst, 1024, (v >> 4) * 64, (v & 15) * 64, sm);
    }
  }
  {
    for (int i = blockIdx.x * 256 + threadIdx.x; i < 4 * NROW; i += gridDim.x * 256) p.SS[i] = 0.f;
    const int n4 = 2048 * 1024 / 4;
    for (int i = blockIdx.x * 256 + threadIdx.x; i < n4; i += gridDim.x * 256) {
      float4 v = ((const float4*)p.mem_prompt)[i];
      uint2 o;
      o.x = pack2(v.x, v.y);
      o.y = pack2(v.z, v.w);
      ((uint2*)p.MPB)[i] = o;
    }
  }
  {
    const int lane = threadIdx.x & 63, wid = threadIdx.x >> 6;
    float* wT = (float*)smem;
    for (int i = opaque_tid(); i < 2048; i += 256) {
      const int k = i >> 1, hf = i & 1;
      float4 w = *(const float4*)(p.w_in_even + (size_t)k * EIN + EINP + hf * 4);
      wT[(hf * 4 + 0) * 1024 + k] = w.x; wT[(hf * 4 + 1) * 1024 + k] = w.y;
      wT[(hf * 4 + 2) * 1024 + k] = w.z; wT[(hf * 4 + 3) * 1024 + k] = w.w;
    }
    __syncthreads();
    for (int row = blockIdx.x * 4 + wid; row < NROW; row += gridDim.x * 4) {
      const float* xr = row < NPR ? p.x_prompt + (size_t)row * DM : p.x_sample + (size_t)(row - NPR) * DM;
      float4 v[4];
      float ss = 0.f;
#pragma unroll
      for (int j = 0; j < 4; ++j) {
        v[j] = ((const float4*)xr)[j * 64 + lane];
        ss += v[j].x * v[j].x + v[j].y * v[j].y + v[j].z * v[j].z + v[j].w * v[j].w;
      }
      ss = wave_sum(ss);
      float inv = rsqrtf(ss * (1.0f / 1024.0f) + EPSF);
      float part[8];
#pragma unroll
      for (int c = 0; c < 8; ++c) part[c] = 0.f;
#pragma unroll
      for (int j = 0; j < 4; ++j) {
        float4 g = ((const float4*)p.norm_mix)[j * 64 + lane];
        uint2 o;
        const float h0 = v[j].x * inv * g.x, h1 = v[j].y * inv * g.y, h2 = v[j].z * inv * g.z, h3 = v[j].w * inv * g.w;
        o.x = pack2(h0, h1);
        o.y = pack2(h2, h3);
        ((uint2*)(p.H + (size_t)row * DM))[j * 64 + lane] = o;
#pragma unroll
        for (int c = 0; c < 8; ++c) {
          float4 w = ((const float4*)(wT + c * 1024))[j * 64 + lane];
          part[c] += h0 * w.x + h1 * w.y + h2 * w.z + h3 * w.w;
        }
      }
#pragma unroll
      for (int c = 0; c < 8; ++c) part[c] = wave_sum(part[c]);
      if (lane == 0) {
        float4 a = {part[0], part[1], part[2], part[3]}, b = {part[4], part[5], part[6], part[7]};
        ((float4*)(p.BGR + (size_t)row * 8))[0] = a;
        ((float4*)(p.BGR + (size_t)row * 8))[1] = b;
      }
    }
    __syncthreads();
  }
}

DI void phase_rmsnorm(const Params& p, const float* g) {
  const int lane = threadIdx.x & 63, wid = threadIdx.x >> 6;
  for (int row = blockIdx.x * 4 + wid; row < NROW; row += gridDim.x * 4) {
    const float* xr = p.X + (size_t)row * DM;
    float4 v[4];
    float ss = 0.f;
#pragma unroll
    for (int j = 0; j < 4; ++j) {
      v[j] = ((const float4*)xr)[j * 64 + lane];
      ss += v[j].x * v[j].x + v[j].y * v[j].y + v[j].z * v[j].z + v[j].w * v[j].w;
    }
    ss = wave_sum(ss);
    float inv = rsqrtf(ss * (1.0f / 1024.0f) + EPSF);
#pragma unroll
    for (int j = 0; j < 4; ++j) {
      float4 gg = ((const float4*)g)[j * 64 + lane];
      uint2 o;
      o.x = pack2(v[j].x * inv * gg.x, v[j].y * inv * gg.y);
      o.y = pack2(v[j].z * inv * gg.z, v[j].w * inv * gg.w);
      ((uint2*)(p.H + (size_t)row * DM))[j * 64 + lane] = o;
    }
  }
}

DI void phase_final_norm(const Params& p) {
  const float* ss = p.SS + 3 * NROW;
  for (int i = blockIdx.x * 256 + threadIdx.x; i < NROW * 256; i += gridDim.x * 256) {
    const int row = i >> 8, c4 = i & 255;
    float4 v = ((const float4*)p.X)[i];
    float4 g = ((const float4*)p.norm_final)[c4];
    const float inv = rsqrtf(ss[row] * (1.0f / 1024.0f) + EPSF);
    float4 o = {v.x * inv * g.x, v.y * inv * g.y, v.z * inv * g.z, v.w * inv * g.w};
    ((float4*)(p.out + O_Y))[i] = o;
  }
}

DI void phase_gemm_in_even(const Params& p, char* smem) {
  const int NT1 = 128 * 14, NT2 = 4 * 64;
  {
    bfr* PB = p.PB;
    gemm_sample<false>(p.H, 1024, p.WtInE, 3712, 1024, EINP, smem,
                       [=](int row, int col, float v) -> float { PB[(size_t)row * EINP + col] = f2bf(v); return 0.f; },
                       [=](int, float) {});
  }
  for (int t = blockIdx.x; t < NT1 + NT2; t += gridDim.x) {
    if (t < NT1) {
      int mt = t / 14, nt = t % 14;
      bfr* PB = p.PB;
      gemm_tile<1024>(p.H, p.WtInE, 3712, 1024, mt * 128, nt * 256, smem,
                [=](int row, int col, float v) { PB[(size_t)row * EINP + col] = f2bf(v); });
    } else {
      int u = t - NT1, gsel = u >> 6, v = u & 63, mt = v >> 2, nt = v & 3;
      int isv = gsel >> 1, l = gsel & 1;
      if (!isv) {
        float* o = p.out + O_MEMK + (size_t)l * 2097152;
        bfr* kb = p.KB + (size_t)l * 2097152;
        gemm_tile<1024>(p.MPB, p.WtXk + (size_t)l * 1048576, 1024, 1024, mt * 128, nt * 256, smem,
                  [=](int row, int col, float v) {
                    o[(size_t)row * 1024 + col] = v;
                    kb[(size_t)row * 1024 + col] = f2bf(v);
                  });
      } else {
        float* o = p.out + O_MEMV + (size_t)l * 2097152;
        bfr* vt = p.VT + (size_t)l * 2097152;
        gemm_tile<1024>(p.MPB, p.WtXv + (size_t)l * 1048576, 1024, 1024, mt * 128, nt * 256, smem,
                  [=](int row, int col, float v) {
                    o[(size_t)row * 1024 + col] = v;
                    const int ml = row & 15;
                    const int rowpart = (row >> 8) * 262144 + ((row & 255) >> 4) * 512 + ((ml >> 2) & 1) * 256 + (((ml >> 3) << 2) | (ml & 3));
                    const int colpart = (col >> 8) * 65536 + ((col & 255) >> 5) * 8192 + (col & 31) * 8;
                    vt[rowpart + colpart] = f2bf(v);
                  });
      }
    }
  }
}

template <bool IS_P, bool EDGE>
DI void qkv_token(const Params& p, int row, int lane) {
  const int t = row & 2047, b = row >> 11, s = row - NPR;
#pragma unroll 6
  for (int grp = 0; grp < 12; ++grp) {
    const int ch = grp * 128 + lane * 2;
    float x0[4], x1[4];
    if (IS_P) {
      unsigned u[4];
#pragma unroll
      for (int j = 0; j < 4; ++j) {
        const int rc = (!EDGE || t - 3 + j >= 0) ? (row - 3 + j) : row;
        u[j] = *(const unsigned*)(p.PB + (size_t)rc * EINP + 1536 + ch);
      }
#pragma unroll
      for (int j = 0; j < 4; ++j) {
        const bool ok = (!EDGE || t - 3 + j >= 0);
        x0[j] = ok ? bflo(u[j]) : 0.f;
        x1[j] = ok ? bfhi(u[j]) : 0.f;
      }
    } else {
#pragma unroll
      for (int j = 0; j < 3; ++j) {
        float2 f = *(const float2*)(p.state_qkv_conv + ((size_t)s * 3 + j) * 1536 + ch);
        x0[j] = f.x; x1[j] = f.y;
      }
      unsigned u = *(const unsigned*)(p.PB + (size_t)row * EINP + 1536 + ch);
      x0[3] = bflo(u); x1[3] = bfhi(u);
    }
    float a0 = 0.f, a1 = 0.f;
#pragma unroll
    for (int j = 0; j < 4; ++j) {
      float2 w = *(const float2*)(p.sc_w + (size_t)j * 1536 + ch);
      a0 += w.x * x0[j]; a1 += w.y * x1[j];
    }
    float y0 = siluf_(a0), y1 = siluf_(a1);
    if (grp < 8) {
      float ss = wave_sum(y0 * y0 + y1 * y1);
      float inv = rsqrtf(ss + EPSF);
      if (grp < 4) inv *= 0.08838834764831845f;
      y0 *= inv; y1 *= inv;
    }
    float2 o = {y0, y1};
    *(float2*)(p.QKV + (size_t)row * 1536 + ch) = o;
    if (IS_P) {
      if (t >= 2045) {
        float2 c = {x0[3], x1[3]};
        *(float2*)(p.out + O_QKVP + ((size_t)b * 3 + (t - 2045)) * 1536 + ch) = c;
      }
    } else {
      float2 c0 = {x0[1], x1[1]}, c1 = {x0[2], x1[2]}, c2 = {x0[3], x1[3]};
      *(float2*)(p.out + O_QKVS + ((size_t)s * 3 + 0) * 1536 + ch) = c0;
      *(float2*)(p.out + O_QKVS + ((size_t)s * 3 + 1) * 1536 + ch) = c1;
      *(float2*)(p.out + O_QKVS + ((size_t)s * 3 + 2) * 1536 + ch) = c2;
    }
  }
  if (lane < 4) {
    float bl = p.BGR[(size_t)row * 8 + lane], al = p.BGR[(size_t)row * 8 + 4 + lane];
    float beta = sigmoidf_(bl);
    float xx = al + p.dt_bias[lane];
    float sp = xx > 20.f ? xx : log1pf(__expf(xx));
    float g = -__expf(p.a_log[lane]) * sp;
    p.BG[(size_t)row * 8 + lane] = beta;
    p.BG[(size_t)row * 8 + 4 + lane] = g;
  }
}

template <int G0>
DI void qkv_run4_half(const Params& p, int row0, int lane) {
  const int t0 = row0 & 2047, b = row0 >> 11;
  unsigned u[4][7];
  float2 w[4][4];
#pragma unroll
  for (int i = 0; i < 7; ++i) {
    const int rr = (i >= 3 || t0 > 0) ? (row0 - 3 + i) : row0;
    const bfr* rp = p.PB + (size_t)rr * EINP + 1536 + G0 * 128 + lane * 2;
#pragma unroll
    for (int g = 0; g < 4; ++g) u[g][i] = *(const unsigned*)(rp + g * 128);
  }
#pragma unroll
  for (int j = 0; j < 4; ++j) {
    const float* wp = p.sc_w + (size_t)j * 1536 + G0 * 128 + lane * 2;
#pragma unroll
    for (int g = 0; g < 4; ++g) w[g][j] = *(const float2*)(wp + g * 128);
  }
  const float hm = (t0 > 0) ? 1.f : 0.f;
#pragma unroll
  for (int k = 0; k < 4; ++k) {
    const int row = row0 + k;
#pragma unroll
    for (int g = 0; g < 4; ++g) {
      const int grp = G0 + g;
      const int ch = grp * 128 + lane * 2;
      float a0 = 0.f, a1 = 0.f;
#pragma unroll
      for (int j = 0; j < 4; ++j) {
        const int i = k + j;
        const float m = (i >= 3) ? 1.f : hm;
        a0 += w[g][j].x * (bflo(u[g][i]) * m);
        a1 += w[g][j].y * (bfhi(u[g][i]) * m);
      }
      float y0 = siluf_(a0), y1 = siluf_(a1);
      if (grp < 8) {
        float ss = wave_sum(y0 * y0 + y1 * y1);
        float inv = rsqrtf(ss + EPSF);
        if (grp < 4) inv *= 0.08838834764831845f;
        y0 *= inv; y1 *= inv;
      }
      float2 o = {y0, y1};
      *(float2*)(p.QKV + (size_t)row * 1536 + ch) = o;
      if (t0 == 2044 && k >= 1) {
        float2 c = {bflo(u[g][k + 3]), bfhi(u[g][k + 3])};
        *(float2*)(p.out + O_QKVP + ((size_t)b * 3 + (k - 1)) * 1536 + ch) = c;
      }
    }
  }
}
DI void qkv_run4(const Params& p, int row0, int lane) {
  qkv_run4_half<0>(p, row0, lane);
  qkv_run4_half<4>(p, row0, lane);
  qkv_run4_half<8>(p, row0, lane);
  if (lane < 16) {
    const int row = row0 + (lane >> 2), hd = lane & 3;
    float bl = p.BGR[(size_t)row * 8 + hd], al = p.BGR[(size_t)row * 8 + 4 + hd];
    float beta = sigmoidf_(bl);
    float xx = al + p.dt_bias[hd];
    float sp = xx > 20.f ? xx : log1pf(__expf(xx));
    float g = -__expf(p.a_log[hd]) * sp;
    p.BG[(size_t)row * 8 + hd] = beta;
    p.BG[(size_t)row * 8 + 4 + hd] = g;
  }
}

DI void conv_a_prompt_item(const Params& p, int item, float* sm) {
  const int half = item & 1, tile = (item >> 1) & 63, b = item >> 7;
  const int tid = threadIdx.x, c = half * 256 + tid, t0 = tile * 32;
  {
    const int tg = tid >> 5, c8 = tid & 31;
    u32x4 vv[8], gg[8];
#pragma unroll
    for (int ps = 0; ps < 8; ++ps) {
      const int i = tg + 8 * ps;
      const int tt = t0 - 30 + i;
      const size_t row = (size_t)b * 2048 + ((tt >= 0 && i < 62) ? tt : t0);
      vv[ps] = *(const u32x4*)(p.PB + row * EINP + half * 256 + c8 * 8);
      gg[ps] = *(const u32x4*)(p.PB + row * EINP + 512 + half * 256 + c8 * 8);
    }
#pragma unroll
    for (int ps = 0; ps < 8; ++ps) {
      const int i = tg + 8 * ps;
      const int tt = t0 - 30 + i;
      const float msk = (tt >= 0) ? 1.f : 0.f;
      float o8[8];
#pragma unroll
      for (int e = 0; e < 4; ++e) {
        o8[2 * e] = bflo(vv[ps][e]) * sigmoidf_(bflo(gg[ps][e])) * msk;
        o8[2 * e + 1] = bfhi(vv[ps][e]) * sigmoidf_(bfhi(gg[ps][e])) * msk;
      }
      if (i < 62) {
        float4 a0 = {o8[0], o8[1], o8[2], o8[3]}, a1 = {o8[4], o8[5], o8[6], o8[7]};
        *(float4*)(sm + i * 256 + c8 * 8) = a0;
        *(float4*)(sm + i * 256 + c8 * 8 + 4) = a1;
      }
    }
    __syncthreads();
  }
  float w[31];
#pragma unroll
  for (int j = 0; j < 31; ++j) w[j] = p.dw_w[j * 512 + c];
  const float bias = p.dw_b[c];
#pragma unroll 1
  for (int o = 0; o < 32; ++o) {
    float acc = bias;
#pragma unroll
    for (int j = 0; j < 31; ++j) acc += w[j] * sm[(o + j) * 256 + tid];
    p.CONV[((size_t)b * 2048 + t0 + o) * 512 + c] = acc;
  }
  if (tile == 63) {
#pragma unroll 1
    for (int j = 0; j < 30; ++j) p.out[O_CONVP + ((size_t)b * 30 + j) * 512 + c] = sm[(32 + j) * 256 + tid];
  }
  __syncthreads();
}

DI void conv_a_sample_item(const Params& p, int s) {
  const int tid = threadIdx.x;
  const size_t row = NPR + s;
#pragma unroll
  for (int cc = 0; cc < 2; ++cc) {
    int c = tid + cc * 256;
    float val = bf2f(p.PB[row * EINP + c]);
    float gate = bf2f(p.PB[row * EINP + 512 + c]);
    float gl = val * sigmoidf_(gate);
    float acc = p.dw_b[c] + p.dw_w[30 * 512 + c] * gl;
#pragma unroll 6
    for (int j = 0; j < 30; ++j) {
      float st = p.state_conv_a[((size_t)s * 30 + j) * 512 + c];
      acc += p.dw_w[j * 512 + c] * st;
      if (j >= 1) p.out[O_CONVS + ((size_t)s * 30 + j - 1) * 512 + c] = st;
    }
    p.out[O_CONVS + ((size_t)s * 30 + 29) * 512 + c] = gl;
    p.CONV[row * 512 + c] = acc;
  }
}

DI void phase_even_pw_conv(const Params& p, char* smem) {
  for (int it = blockIdx.x; it < 1024 + 128; it += gridDim.x) {
    if (it < 1024) conv_a_prompt_item(p, it, (float*)smem);
    else conv_a_sample_item(p, it - 1024);
  }
}
DI void phase_even_pw_qkv(const Params& p) {
  const int lane = threadIdx.x & 63, wid = threadIdx.x >> 6;
  for (int run = blockIdx.x * 4 + wid; run < NPR / 4; run += gridDim.x * 4) qkv_run4(p, run * 4, lane);
  for (int row = NPR + blockIdx.x * 4 + wid; row < NROW; row += gridDim.x * 4) qkv_token<false, false>(p, row, lane);
}
DI void phase_even_pointwise(const Params& p, char* smem) {
  phase_even_pw_conv(p, smem);
  phase_even_pw_qkv(p);
}

DI void chunk_prep(const Params& p, int item, char* smem) {
  const int tid = threadIdx.x, lane = tid & 63, wid = tid >> 6, r = lane & 31, hl = lane >> 5;
  const int n = item & 31, hh = (item >> 5) & 3, b = item >> 7;
  const size_t row0 = (size_t)b * 2048 + n * 64;
  float* gcs = (float*)smem;
  float* betas = gcs + 64;
  float* egs = betas + 64;
  float* kscale = egs + 64;
  bfr* qs = (bfr*)(smem + 1024);
  bfr* ks_ = qs + 64 * 136;
  float* Am = (float*)(smem + 1024 + 2 * 64 * 136 * 2);
  bfr* wsb = qs;
  if (tid < 64) {
    float beta = p.BG[(row0 + tid) * 8 + hh];
    float g = p.BG[(row0 + tid) * 8 + 4 + hh];
    float v = g;
#pragma unroll
    for (int off = 1; off < 64; off <<= 1) {
      float t = __shfl_up(v, off);
      if (lane >= off) v += t;
    }
    float gl = __shfl(v, 63);
    gcs[tid] = v;
    betas[tid] = beta;
    egs[tid] = __expf(v);
    kscale[tid] = __expf(gl - v);
    if (tid == 63) p.GL[item] = __expf(gl);
  }
#pragma unroll
  for (int i = 0; i < 8; ++i) {
    int idx = tid + i * 256, row = idx >> 5, c4 = idx & 31;
    float4 q = *(const float4*)(p.QKV + (row0 + row) * 1536 + hh * 128 + c4 * 4);
    float4 k = *(const float4*)(p.QKV + (row0 + row) * 1536 + 512 + hh * 128 + c4 * 4);
    uint2 qo, ko;
    qo.x = pack2(q.x, q.y); qo.y = pack2(q.z, q.w);
    ko.x = pack2(k.x, k.y); ko.y = pack2(k.z, k.w);
    *(uint2*)(qs + row * 136 + c4 * 4) = qo;
    *(uint2*)(ks_ + row * 136 + c4 * 4) = ko;
  }
  __syncthreads();
  {
    const int mi = wid >> 1, ni = wid & 1;
    f32x16 akk, aqk;
#pragma unroll
    for (int q = 0; q < 16; ++q) { akk[q] = 0.f; aqk[q] = 0.f; }
#pragma unroll
    for (int ks = 0; ks < 8; ++ks) {
      bf16x8 ka = *(const bf16x8*)(ks_ + (mi * 32 + r) * 136 + ks * 16 + hl * 8);
      bf16x8 qa = *(const bf16x8*)(qs + (mi * 32 + r) * 136 + ks * 16 + hl * 8);
      bf16x8 kb = *(const bf16x8*)(ks_ + (ni * 32 + r) * 136 + ks * 16 + hl * 8);
      akk = MFMA32(ka, kb, akk);
      aqk = MFMA32(qa, kb, aqk);
    }
    bfr* qkf = (bfr*)(p.QKF + (size_t)item * 512);
#pragma unroll
    for (int q = 0; q < 16; ++q) {
      int i = mi * 32 + crow(q, hl), j = ni * 32 + r;
      float dec = (i >= j) ? __expf(gcs[i] - gcs[j]) : 0.f;
      Am[i * 68 + j] = (i > j) ? akk[q] * betas[i] * dec : 0.f;
      float qv = (i >= j) ? aqk[q] * dec : 0.f;
      int ksj = j >> 4, jl = j & 15, h2 = (jl >> 2) & 1, jj = ((jl >> 3) << 2) | (jl & 3);
      qkf[((mi * 4 + ksj) * 64 + h2 * 32 + (i & 31)) * 8 + jj] = f2bf(qv);
    }
  }
  {
    uint4* QD = p.QD + (size_t)item * 1024;
#pragma unroll
    for (int i = 0; i < 4; ++i) {
      int idx = tid + i * 256, f = idx >> 6, ln = idx & 63, mt = f >> 3, ks = f & 7, m = ln & 31, h2 = ln >> 5;
      int ri = mt * 32 + m, d0 = ks * 16 + h2 * 4;
      float sc = egs[ri];
      const float* src = p.QKV + (row0 + ri) * 1536 + hh * 128 + d0;
      float4 a = *(const float4*)src, c = *(const float4*)(src + 8);
      uint4 o;
      o.x = pack2(a.x * sc, a.y * sc); o.y = pack2(a.z * sc, a.w * sc);
      o.z = pack2(c.x * sc, c.y * sc); o.w = pack2(c.z * sc, c.w * sc);
      QD[f * 64 + ln] = o;
    }
    uint4* KD = p.KD + (size_t)item * 1024;
#pragma unroll
    for (int i = 0; i < 4; ++i) {
      int idx = tid + i * 256, f = idx >> 6, ln = idx & 63, mt = f >> 2, ks = f & 3, m = ln & 31, h2 = ln >> 5;
      int d = mt * 32 + m;
      float vals[8];
#pragma unroll
      for (int j = 0; j < 8; ++j) {
        int c = ks * 16 + 8 * (j >> 2) + 4 * h2 + (j & 3);
        vals[j] = p.QKV[(row0 + c) * 1536 + 512 + hh * 128 + d] * kscale[c];
      }
      uint4 o;
      o.x = pack2(vals[0], vals[1]); o.y = pack2(vals[2], vals[3]);
      o.z = pack2(vals[4], vals[5]); o.w = pack2(vals[6], vals[7]);
      KD[f * 64 + ln] = o;
    }
  }
  __syncthreads();
  {
    const int c = tid;
    const float* src = (c < 128) ? (p.QKV + row0 * 1536 + 1024 + hh * 128 + c) : (p.QKV + row0 * 1536 + 512 + hh * 128 + (c - 128));
    float sol[64];
#pragma unroll
    for (int i = 0; i < 64; ++i) {
      float rhs = src[(size_t)i * 1536] * betas[i];
      if (c >= 128) rhs *= egs[i];
      float acc = rhs, acc1 = 0.f;
#pragma unroll
      for (int j = 0; j < i; ++j) {
        if (j & 1) acc1 -= Am[i * 68 + j] * sol[j];
        else acc -= Am[i * 68 + j] * sol[j];
      }
      sol[i] = acc + acc1;
    }
    if (c < 128) {
      float* U = p.U + (size_t)item * 8192;
#pragma unroll
      for (int i = 0; i < 64; ++i) U[i * 128 + c] = sol[i];
    } else {
#pragma unroll
      for (int i = 0; i < 64; ++i) wsb[i * 136 + (c - 128)] = f2bf(-sol[i]);
    }
  }
  __syncthreads();
  {
    uint4* WN = p.WN + (size_t)item * 1024;
#pragma unroll
    for (int i = 0; i < 4; ++i) {
      int idx = tid + i * 256, f = idx >> 6, ln = idx & 63, mt = f >> 3, ks = f & 7, m = ln & 31, h2 = ln >> 5;
      int ri = mt * 32 + m, d0 = ks * 16 + h2 * 4;
      uint2 a = *(const uint2*)(wsb + ri * 136 + d0), c = *(const uint2*)(wsb + ri * 136 + d0 + 8);
      uint4 o = {a.x, a.y, c.x, c.y};
      WN[f * 64 + ln] = o;
    }
  }
  __syncthreads();
}

DI void branch_a_final_row(const Params& p, int row, int lane) {
  const float* cr = p.CONV + (size_t)row * 512;
  float4 v[2];
  float s = 0.f;
#pragma unroll
  for (int j = 0; j < 2; ++j) {
    v[j] = ((const float4*)cr)[j * 64 + lane];
    s += v[j].x + v[j].y + v[j].z + v[j].w;
  }
  float mean = wave_sum(s) * (1.0f / 512.0f);
  float vs = 0.f;
#pragma unroll
  for (int j = 0; j < 2; ++j) {
    v[j].x -= mean; v[j].y -= mean; v[j].z -= mean; v[j].w -= mean;
    vs += v[j].x * v[j].x + v[j].y * v[j].y + v[j].z * v[j].z + v[j].w * v[j].w;
  }
  float inv = rsqrtf(wave_sum(vs) * (1.0f / 512.0f) + EPSF);
#pragma unroll
  for (int j = 0; j < 2; ++j) {
    int c = (j * 64 + lane) * 4;
    float4 g = *(const float4*)(p.ln_a_g + c), bb = *(const float4*)(p.ln_a_b + c);
    uint2 gu = *(const uint2*)(p.PB + (size_t)row * EINP + 1024 + c);
    float y0 = siluf_(v[j].x * inv * g.x + bb.x) * siluf_(bflo(gu.x));
    float y1 = siluf_(v[j].y * inv * g.y + bb.y) * siluf_(bfhi(gu.x));
    float y2 = siluf_(v[j].z * inv * g.z + bb.z) * siluf_(bflo(gu.y));
    float y3 = siluf_(v[j].w * inv * g.w + bb.w) * siluf_(bfhi(gu.y));
    uint2 o;
    o.x = pack2(y0, y1); o.y = pack2(y2, y3);
    *(uint2*)(p.MIX + (size_t)row * 1024 + c) = o;
  }
}

DI void delta_sample_item(const Params& p, int item, char* smem) {
  const int s = item >> 2, hh = item & 3, tid = threadIdx.x;
  const size_t row = NPR + s;
  float* ksm = (float*)smem;
  float* qsm = ksm + 128;
  float* part = qsm + 128;
  if (tid < 128) ksm[tid] = p.QKV[row * 1536 + 512 + hh * 128 + tid];
  else qsm[tid - 128] = p.QKV[row * 1536 + hh * 128 + (tid - 128)];
  const float beta = p.BG[row * 8 + hh], a = __expf(p.BG[row * 8 + 4 + hh]);
  __syncthreads();
  const int e = tid & 127, half = tid >> 7, d0 = half * 64;
  const float* S0 = p.state_delta + (((size_t)s * 4 + hh) * 128 + d0) * 128 + e;
  float* So = p.out + O_DELTAS + (((size_t)s * 4 + hh) * 128 + d0) * 128 + e;
  float Sr[64];
  float ksum = 0.f;
#pragma unroll
  for (int i = 0; i < 64; ++i) {
    Sr[i] = S0[(size_t)i * 128] * a;
    ksum += ksm[d0 + i] * Sr[i];
  }
  part[half * 128 + e] = ksum;
  __syncthreads();
  const float kS = part[e] + part[128 + e];
  const float v = p.QKV[row * 1536 + 1024 + hh * 128 + e];
  const float vnew = (v - kS) * beta;
  float oo = 0.f;
#pragma unroll
  for (int i = 0; i < 64; ++i) {
    Sr[i] += ksm[d0 + i] * vnew;
    So[(size_t)i * 128] = Sr[i];
    oo += qsm[d0 + i] * Sr[i];
  }
  __syncthreads();
  part[half * 128 + e] = oo;
  __syncthreads();
  if (half == 0) p.ODN[row * 512 + hh * 128 + e] = part[e] + part[128 + e];
  __syncthreads();
}

DI void phase_chunk_prep(const Params& p, char* smem) {
  for (int it = blockIdx.x; it < 1024; it += gridDim.x) chunk_prep(p, it, smem);
}

DI void scan_item(const Params& p, int item, char* smem) {
  const int tid = threadIdx.x, lane = tid & 63, es = tid >> 6, r = lane & 31, hl = lane >> 5;
  const int b = item >> 2, hh = item & 3;
  u32x4* bufA = (u32x4*)smem;
  u32x4* bufB = (u32x4*)(smem + 32768);
  const u32x4* gWN = (const u32x4*)p.WN + (size_t)item * 32 * 1024;
  const u32x4* gQD = (const u32x4*)p.QD + (size_t)item * 32 * 1024;
  const u32x4* gKD = (const u32x4*)p.KD + (size_t)item * 32 * 1024;
  const u32x4* gQK = (const u32x4*)p.QKF + (size_t)item * 32 * 512;
  const float* gU = p.U + (size_t)item * 32 * 8192;
  const int uo = hl * 4 * 128 + es * 32 + r;
  const int oo = hl * 4 * 512 + es * 32 + r;
#define GLDS(gp, lp) __builtin_amdgcn_global_load_lds((const unsigned*)(gp), (unsigned*)(lp), 16, 0, 0)
  f32x16 S[4];
#pragma unroll
  for (int d = 0; d < 4; ++d)
#pragma unroll
    for (int q = 0; q < 16; ++q) S[d][q] = 0.f;
  f32x16 vn[2], o[2];
#pragma unroll
  for (int i = 0; i < 4; ++i) {
    GLDS(gWN + tid + i * 256, bufA + tid + i * 256);
    GLDS(gQD + tid + i * 256, bufA + 1024 + tid + i * 256);
  }
#pragma unroll
  for (int ct = 0; ct < 2; ++ct)
#pragma unroll
    for (int q = 0; q < 16; ++q) vn[ct][q] = gU[(ct * 32 + crow(q, 0)) * 128 + uo];
  asm volatile("s_waitcnt vmcnt(0)" ::: "memory");
  __syncthreads();
#pragma unroll 1
  for (int n = 0; n < 32; ++n) {
    const int chunk = item * 32 + n;
    const float gl = p.GL[chunk];
    const int n1 = (n + 1 < 32) ? n + 1 : 31;
    {
      const u32x4* k0 = gQK + n * 512;
      const u32x4* d0 = gKD + n * 1024;
#pragma unroll
      for (int i = 0; i < 2; ++i) GLDS(k0 + tid + i * 256, bufB + tid + i * 256);
#pragma unroll
      for (int i = 0; i < 4; ++i) GLDS(d0 + tid + i * 256, bufB + 512 + tid + i * 256);
    }
    {
      bf16x8 Sb[4][2];
#pragma unroll
      for (int d = 0; d < 4; ++d) { Sb[d][0] = pack8(S[d], 0); Sb[d][1] = pack8(S[d], 1); }
#pragma unroll
      for (int ct = 0; ct < 2; ++ct)
#pragma unroll
        for (int q = 0; q < 16; ++q) o[ct][q] = 0.f;
#pragma unroll
      for (int ct = 0; ct < 2; ++ct)
#pragma unroll
        for (int ks = 0; ks < 8; ++ks) {
          bf16x8 aw = __builtin_bit_cast(bf16x8, bufA[(ct * 8 + ks) * 64 + lane]);
          bf16x8 aq = __builtin_bit_cast(bf16x8, bufA[1024 + (ct * 8 + ks) * 64 + lane]);
          vn[ct] = MFMA32(aw, Sb[ks >> 1][ks & 1], vn[ct]);
          o[ct] = MFMA32(aq, Sb[ks >> 1][ks & 1], o[ct]);
        }
    }
    bf16x8 Vb[2][2];
#pragma unroll
    for (int ct = 0; ct < 2; ++ct) { Vb[ct][0] = pack8(vn[ct], 0); Vb[ct][1] = pack8(vn[ct], 1); }
    asm volatile("s_waitcnt vmcnt(0)" ::: "memory");
    __syncthreads();
    {
      const u32x4* w1 = gWN + n1 * 1024;
      const u32x4* q1 = gQD + n1 * 1024;
#pragma unroll
      for (int i = 0; i < 4; ++i) {
        GLDS(w1 + tid + i * 256, bufA + tid + i * 256);
        GLDS(q1 + tid + i * 256, bufA + 1024 + tid + i * 256);
      }
      const float* u1 = gU + n1 * 8192;
#pragma unroll
      for (int ct = 0; ct < 2; ++ct)
#pragma unroll
        for (int q = 0; q < 16; ++q) vn[ct][q] = u1[(ct * 32 + crow(q, 0)) * 128 + uo];
    }
#pragma unroll
    for (int ct = 0; ct < 2; ++ct)
#pragma unroll
      for (int ks = 0; ks < 4; ++ks) {
        bf16x8 a = __builtin_bit_cast(bf16x8, bufB[(ct * 4 + ks) * 64 + lane]);
        o[ct] = MFMA32(a, Vb[ks >> 1][ks & 1], o[ct]);
      }
#pragma unroll
    for (int d = 0; d < 4; ++d) {
#pragma unroll
      for (int q = 0; q < 16; ++q) S[d][q] *= gl;
#pragma unroll
      for (int ks = 0; ks < 4; ++ks) {
        bf16x8 a = __builtin_bit_cast(bf16x8, bufB[512 + (d * 4 + ks) * 64 + lane]);
        S[d] = MFMA32(a, Vb[ks >> 1][ks & 1], S[d]);
      }
    }
    float* od = p.ODN + ((size_t)b * 2048 + n * 64) * 512 + hh * 128;
#pragma unroll
    for (int ct = 0; ct < 2; ++ct)
#pragma unroll
      for (int q = 0; q < 16; ++q) od[(ct * 32 + crow(q, 0)) * 512 + oo] = o[ct][q];
    asm volatile("s_waitcnt vmcnt(0)" ::: "memory");
    __syncthreads();
  }
#undef GLDS
  float* so = p.out + O_DELTAP + ((size_t)(b * 4 + hh) * 128) * 128;
#pragma unroll
  for (int d = 0; d < 4; ++d)
#pragma unroll
    for (int q = 0; q < 16; ++q) so[(d * 32 + crow(q, 0)) * 128 + uo] = S[d][q];
  __syncthreads();
}

DI void phase_scan(const Params& p, char* smem) {
  const int lane = threadIdx.x & 63, wid = threadIdx.x >> 6;
  if (gridDim.x >= 64) {
    if (blockIdx.x < 32) {
      scan_item(p, blockIdx.x, smem);
    } else {
      const int nb = gridDim.x - 32, bi = blockIdx.x - 32;
      for (int it = bi; it < 512; it += nb) delta_sample_item(p, it, smem);
      for (int row = bi * 4 + wid; row < NROW; row += nb * 4) branch_a_final_row(p, row, lane);
    }
  } else {
    for (int it = blockIdx.x; it < 32; it += gridDim.x) scan_item(p, it, smem);
    for (int it = blockIdx.x; it < 512; it += gridDim.x) delta_sample_item(p, it, smem);
    for (int row = blockIdx.x * 4 + wid; row < NROW; row += gridDim.x * 4) branch_a_final_row(p, row, lane);
  }
}

DI void phase_delta_post(const Params& p) {
  const int lane = threadIdx.x & 63, wid = threadIdx.x >> 6;
  const int stride = gridDim.x * 4;
  const float2 g = *(const float2*)(p.dn_norm_g + lane * 2);
  for (int row = blockIdx.x * 4 + wid; row < NROW; row += 2 * stride) {
    const int r1 = row + stride;
    const bool has1 = r1 < NROW;
    const int rows[2] = {row, has1 ? r1 : row};
    float2 o[2][4];
    unsigned zu[2][4];
#pragma unroll
    for (int k = 0; k < 2; ++k)
#pragma unroll
      for (int hh = 0; hh < 4; ++hh) {
        const int ch = hh * 128 + lane * 2;
        o[k][hh] = *(const float2*)(p.ODN + (size_t)rows[k] * 512 + ch);
        zu[k][hh] = *(const unsigned*)(p.PB + (size_t)rows[k] * EINP + 3072 + ch);
      }
#pragma unroll
    for (int k = 0; k < 2; ++k)
#pragma unroll
      for (int hh = 0; hh < 4; ++hh) {
        const int ch = hh * 128 + lane * 2;
        float ss = wave_sum(o[k][hh].x * o[k][hh].x + o[k][hh].y * o[k][hh].y);
        float inv = rsqrtf(ss * (1.0f / 128.0f) + EPSF);
        float y0 = o[k][hh].x * inv * g.x * siluf_(bflo(zu[k][hh]));
        float y1 = o[k][hh].y * inv * g.y * siluf_(bfhi(zu[k][hh]));
        if (k == 0 || has1) *(unsigned*)(p.MIX + (size_t)rows[k] * 1024 + 512 + ch) = pack2(y0, y1);
      }
  }
}

template <bool FIRST, bool HAS_H>
DI void phase_gemm_resid(const Params& p, const bfr* A, const bfr* Wt, const float* gnext, float* ss, char* smem) {
  float* X = p.X;
  bfr* Hn = p.H;
  {
    const float* xs = p.x_sample - (size_t)NPR * 1024;
    gemm_sample<true>(A, 1024, Wt, 1024, 1024, 1024, smem,
                      [=](int row, int col, float v) -> float {
                        const size_t o = (size_t)row * 1024 + col;
                        const float xn = (FIRST ? xs[o] : X[o]) + v;
                        X[o] = xn;
                        if (HAS_H) Hn[o] = f2bf(xn * gnext[col]);
                        return xn;
                      },
                      [=](int row, float s2) { unsafeAtomicAdd(ss + row, s2); });
  }
  for (int t = blockIdx.x; t < 128 * 4; t += gridDim.x) {
    const int mt = t >> 2, nt = t & 3, m0 = mt * 128, n0 = nt * 256;
    f32x16 acc[2][4];
    gemm_mainloop<1024>(A, Wt, 1024, 1024, m0, n0, smem, acc);
    int tid2 = threadIdx.x;
    asm volatile("" : "+v"(tid2));
    const int lane = tid2 & 63, wid = tid2 >> 6, wr = wid >> 1, wc = wid & 1, r = lane & 31, hl = lane >> 5;
    const float* xsrc = FIRST ? p.x_prompt : X;
    const int rbase = m0 + wr * 64 + 4 * hl, cbase = n0 + wc * 128 + r;
#pragma unroll
    for (int i = 0; i < 2; ++i) {
#pragma unroll
      for (int qh = 0; qh < 2; ++qh) {
        float rs[8];
#pragma unroll
        for (int q = 0; q < 8; ++q) rs[q] = 0.f;
#pragma unroll
        for (int jh = 0; jh < 2; ++jh) {
          float xo[2][8];
#pragma unroll
          for (int jj = 0; jj < 2; ++jj)
#pragma unroll
            for (int q = 0; q < 8; ++q)
              xo[jj][q] = xsrc[(rbase + i * 32 + crow(qh * 8 + q, 0)) * 1024 + cbase + (jh * 2 + jj) * 32];
#pragma unroll
          for (int q = 0; q < 8; ++q) {
            const int o = (rbase + i * 32 + crow(qh * 8 + q, 0)) * 1024 + cbase;
#pragma unroll
            for (int jj = 0; jj < 2; ++jj) {
              const int j = jh * 2 + jj;
              const float xn = xo[jj][q] + acc[i][j][qh * 8 + q];
              X[o + j * 32] = xn;
              if (HAS_H) Hn[o + j * 32] = f2bf(xn * gnext[cbase + j * 32]);
              rs[q] += xn * xn;
            }
          }
        }
#pragma unroll
        for (int q = 0; q < 8; ++q) rs[q] = half32_sum_hi(rs[q]);
        if (r == 31) {
#pragma unroll
          for (int q = 0; q < 8; ++q) unsafeAtomicAdd(ss + rbase + i * 32 + crow(qh * 8 + q, 0), rs[q]);
        }
      }
    }
  }
}
DI void phase_gemm_bf16out(const Params& p, const bfr* A, const bfr* Wt, bfr* C, int N, const float* ss, char* smem) {
  const int ntn = N >> 8;
  gemm_sample<false>(A, 1024, Wt, N, 1024, N, smem,
                     [=](int row, int col, float v) -> float {
                       float inv = rsqrtf(ss[row] * (1.0f / 1024.0f) + EPSF);
                       C[(size_t)row * N + col] = f2bf(v * inv);
                       return 0.f;
                     },
                     [=](int, float) {});
  for (int t = blockIdx.x; t < 128 * ntn; t += gridDim.x) {
    int mt = t / ntn, nt = t % ntn;
    gemm_tile<1024>(A, Wt, N, 1024, mt * 128, nt * 256, smem,
              [=](int row, int col, float v) {
                float inv = rsqrtf(ss[row] * (1.0f / 1024.0f) + EPSF);
                C[(size_t)row * N + col] = f2bf(v * inv);
              });
  }
}

DI void attn_prompt_wave(const Params& p, int l, int b, int hh, int tt, bfr* Obuf) {
  const int lane = threadIdx.x & 63, r = lane & 31, hl = lane >> 5;
  const size_t row0 = (size_t)b * 2048 + tt * 32;
  const bfr* Qp = p.ACT2 + (row0 + r) * 1024 + hh * 256 + hl * 8;
  const bfr* Kp = p.KB + (size_t)l * 2097152 + ((size_t)b * 256 + r) * 1024 + hh * 256 + hl * 8;
  f32x16 st[8];
#pragma unroll
  for (int m = 0; m < 8; ++m)
#pragma unroll
    for (int q = 0; q < 16; ++q) st[m][q] = 0.f;
#pragma unroll 2
  for (int ks = 0; ks < 16; ++ks) {
    bf16x8 qf = *(const bf16x8*)(Qp + ks * 16);
#pragma unroll
    for (int m = 0; m < 8; ++m) {
      bf16x8 kf = *(const bf16x8*)(Kp + (size_t)m * 32 * 1024 + ks * 16);
      st[m] = MFMA32(kf, qf, st[m]);
    }
  }
  float mx = -3.0e38f;
#pragma unroll
  for (int m = 0; m < 8; ++m)
#pragma unroll
    for (int q = 0; q < 16; ++q) mx = fmaxf(mx, st[m][q]);
  mx = fmaxf(mx, __shfl_xor(mx, 32));
  float sum = 0.f;
#pragma unroll
  for (int m = 0; m < 8; ++m)
#pragma unroll
    for (int q = 0; q < 16; ++q) {
      float e = __expf((st[m][q] - mx) * 0.0625f);
      st[m][q] = e;
      sum += e;
    }
  sum += __shfl_xor(sum, 32);
  const float inv = 1.0f / sum;
  bf16x8 pb[8][2];
#pragma unroll
  for (int m = 0; m < 8; ++m) { pb[m][0] = pack8(st[m], 0); pb[m][1] = pack8(st[m], 1); }
  const uint4* VT = (const uint4*)(p.VT + (size_t)l * 2097152) + ((size_t)(b * 4 + hh) * 8) * 16 * 64 + lane;
  bfr* Op = Obuf + (row0 + r) * 1024 + hh * 256;
#pragma unroll 1
  for (int half = 0; half < 2; ++half) {
    f32x16 o[4];
#pragma unroll
    for (int d = 0; d < 4; ++d)
#pragma unroll
      for (int q = 0; q < 16; ++q) o[d][q] = 0.f;
#pragma unroll
    for (int ks = 0; ks < 16; ++ks) {
#pragma unroll
      for (int d = 0; d < 4; ++d) {
        bf16x8 vf = ldfrag(VT + ((size_t)(half * 4 + d) * 16 + ks) * 64);
        o[d] = MFMA32(vf, pb[ks >> 1][ks & 1], o[d]);
      }
    }
#pragma unroll
    for (int d = 0; d < 4; ++d)
#pragma unroll
      for (int g4 = 0; g4 < 4; ++g4) {
        int dim = (half * 4 + d) * 32 + 8 * g4 + 4 * hl;
        uint2 ov;
        ov.x = pack2(o[d][g4 * 4 + 0] * inv, o[d][g4 * 4 + 1] * inv);
        ov.y = pack2(o[d][g4 * 4 + 2] * inv, o[d][g4 * 4 + 3] * inv);
        *(uint2*)(Op + dim) = ov;
      }
  }
}

DI void attn_sample_item(const Params& p, int l, int item, char* smem, bfr* Obuf) {
  const int s = item >> 2, hh = item & 3, tid = threadIdx.x, lane = tid & 63, wid = tid >> 6;
  float* qsm = (float*)smem;
  float* sc = qsm + 256;
  float* red = sc + 256;
  const size_t row = NPR + s;
  qsm[tid] = bf2f(p.ACT2[row * 1024 + hh * 256 + tid]);
  __syncthreads();
  const int grp = lane >> 4, l16 = lane & 15;
  float4 q4[4];
#pragma unroll
  for (int j = 0; j < 4; ++j) q4[j] = ((const float4*)qsm)[j * 16 + l16];
  const float* Kb = p.cache_k + ((((size_t)l * 128 + s) * 256) * 4 + hh) * 256;
  const float* Vb = p.cache_v + ((((size_t)l * 128 + s) * 256) * 4 + hh) * 256;
#pragma unroll 8
  for (int ps = 0; ps < 16; ++ps) {
    int mem = wid * 64 + ps * 4 + grp;
    const float4* kr = (const float4*)(Kb + (size_t)mem * 1024);
    float d = 0.f;
#pragma unroll
    for (int j = 0; j < 4; ++j) {
      float4 k4 = kr[j * 16 + l16];
      d += k4.x * q4[j].x + k4.y * q4[j].y + k4.z * q4[j].z + k4.w * q4[j].w;
    }
    d += __shfl_xor(d, 8);
    d += __shfl_xor(d, 4);
    d += __shfl_xor(d, 2);
    d += __shfl_xor(d, 1);
    if (l16 == 0) sc[mem] = d * 0.0625f;
  }
  __syncthreads();
  float sv = sc[tid];
  float m = wave_max(sv);
  if (lane == 0) red[wid] = m;
  __syncthreads();
  m = fmaxf(fmaxf(red[0], red[1]), fmaxf(red[2], red[3]));
  float e = __expf(sv - m);
  float sm_ = wave_sum(e);
  if (lane == 0) red[4 + wid] = sm_;
  sc[tid] = e;
  __syncthreads();
  const float inv = 1.0f / (red[4] + red[5] + red[6] + red[7]);
  float4 acc = {0.f, 0.f, 0.f, 0.f};
  float* partial = (float*)smem + 1024;
#pragma unroll 16
  for (int i = 0; i < 64; ++i) {
    const int mem = wid * 64 + i;
    float4 v4 = *(const float4*)(Vb + (size_t)mem * 1024 + lane * 4);
    const float pm = sc[mem];
    acc.x += pm * v4.x; acc.y += pm * v4.y; acc.z += pm * v4.z; acc.w += pm * v4.w;
  }
  *(float4*)(partial + wid * 256 + lane * 4) = acc;
  __syncthreads();
  const float ov = partial[tid] + partial[256 + tid] + partial[512 + tid] + partial[768 + tid];
  Obuf[row * 1024 + hh * 256 + tid] = f2bf(ov * inv);
  __syncthreads();
}

DI void phase_attn(const Params& p, int l, char* smem) {
  bfr* Obuf = p.ACT3;
  const int half = gridDim.x >> 1;
  const bool upper = (int)blockIdx.x >= half;
  const int bi = upper ? (int)blockIdx.x - half : (int)blockIdx.x;
  const int nb = upper ? (int)gridDim.x - half : half;
  for (int pass = 0; pass < 2; ++pass) {
    const bool do_sample = (pass == 0) != upper;
    if (do_sample) {
      for (int k = bi; k < 256; k += nb) attn_sample_item(p, l, 2 * k + (upper ? 1 : 0), smem, Obuf);
    } else {
      for (int k = bi; k < 256; k += nb) {
        const int u = 2 * k + (upper ? 1 : 0), tt4 = u & 15, hh = (u >> 4) & 3, b = u >> 6;
        attn_prompt_wave(p, l, b, hh, tt4 * 4 + (threadIdx.x >> 6), Obuf);
      }
    }
  }
}

template <int WIN>
DI void pool_elem(const Params& p, int row, int c) {
  const bfr* P2 = p.PB;
  unsigned uu = *(const unsigned*)(P2 + (size_t)row * 2048 + c);
  const float u0 = bflo(uu), u1 = bfhi(uu);
  float s0 = u0, s1 = u1, cnt;
  if (row < NPR) {
    const int t = row & 2047, b = row >> 11;
    if (t >= WIN - 1) {
      cnt = (float)WIN;
      unsigned w[WIN - 1];
#pragma unroll
      for (int j = 1; j < WIN; ++j) w[j - 1] = *(const unsigned*)(P2 + (size_t)(row - j) * 2048 + c);
#pragma unroll
      for (int j = 1; j < WIN; ++j) { s0 += bflo(w[j - 1]); s1 += bfhi(w[j - 1]); }
    } else {
      cnt = (float)(t + 1);
      for (int j = 1; j <= t; ++j) {
        unsigned w = *(const unsigned*)(P2 + (size_t)(row - j) * 2048 + c);
        s0 += bflo(w); s1 += bfhi(w);
      }
    }
    if (t >= 2033) {
      float2 o = {u0, u1};
      *(float2*)(p.out + O_POOLP + ((size_t)b * 15 + (t - 2033)) * 1024 + c) = o;
    }
  } else {
    const int s = row - NPR;
    cnt = (float)WIN;
    const float* sp = p.state_pool + (size_t)s * 15 * 1024 + c;
    float2 st[15];
#pragma unroll
    for (int j = 0; j < 15; ++j) st[j] = *(const float2*)(sp + (size_t)j * 1024);
#pragma unroll
    for (int j = 1; j < WIN; ++j) { s0 += st[15 - j].x; s1 += st[15 - j].y; }
    float* op = p.out + O_POOLS + (size_t)s * 15 * 1024 + c;
#pragma unroll
    for (int j = 0; j < 14; ++j) *(float2*)(op + (size_t)j * 1024) = st[j + 1];
    float2 o = {u0, u1};
    *(float2*)(op + (size_t)14 * 1024) = o;
  }
  *(unsigned*)(p.MIX + (size_t)row * 1024 + c) = pack2(s0 / cnt - u0, s1 / cnt - u1);
}
DI void phase_pool(const Params& p) {
  for (int idx = blockIdx.x * 256 + threadIdx.x; idx < NROW * 512; idx += gridDim.x * 256) {
    const int row = idx >> 9, c = (idx & 511) * 2;
    const int gi = c >> 8;
    if (gi == 0) pool_elem<2>(p, row, c);
    else if (gi == 1) pool_elem<4>(p, row, c);
    else if (gi == 2) pool_elem<8>(p, row, c);
    else pool_elem<16>(p, row, c);
  }
}

DI void phase_gemm_pool(const Params& p, char* smem) {
  const bfr* P2 = p.PB;
  bfr* Z = p.ACT3;
  for (int g = 0; g < 4; ++g) {
    const float* bp = p.b_pool + g * 256;
    const float* sc = p.pool_scale + g * 256;
    gemm_sample<false>(p.MIX + g * 256, 1024, p.WtPool + (size_t)g * 65536, 256, 256, 256, smem,
                       [=](int row, int col, float v) -> float {
                         float gate = bf2f(P2[(size_t)row * 2048 + 1024 + g * 256 + col]);
                         float z = (v + bp[col]) * sc[col] * siluf_(gate);
                         Z[(size_t)row * 1024 + g * 256 + col] = f2bf(z);
                         return 0.f;
                       },
                       [=](int, float) {});
  }
  for (int t = blockIdx.x; t < 128 * 4; t += gridDim.x) {
    int mt = t >> 2, g = t & 3, nt = 0;
    const float* bp = p.b_pool + g * 256;
    const float* sc = p.pool_scale + g * 256;
    gemm_tile<1024>(p.MIX + g * 256, p.WtPool + (size_t)g * 65536, 256, 256, mt * 128, nt * 256, smem,
              [=](int row, int col, float v) {
                float gate = bf2f(P2[(size_t)row * 2048 + 1024 + g * 256 + col]);
                float z = (v + bp[col]) * sc[col] * siluf_(gate);
                Z[(size_t)row * 1024 + g * 256 + col] = f2bf(z);
              });
  }
}

#ifndef ONLY_PHASE
#define ONLY_PHASE -1
#endif
#define PON(n) (ONLY_PHASE < 0 || ONLY_PHASE == (n))
__global__ void __launch_bounds__(256, 2) mega(Params p) {
  __shared__ __attribute__((aligned(16))) char smem[65536];
  cg::grid_group grid = cg::this_grid();
  if (p.phase_lo < -1000) grid.sync();
  volatile LAS unsigned* xst = (volatile LAS unsigned*)(smem + 65520);
  if (threadIdx.x < 4) xst[threadIdx.x] = 0u;
  __syncthreads();
  (void)xcd_barrier_post(p.bar, xst);
#define XB_NOW() do { XcdBarrier b_; b_.bar = p.bar; b_.x = xb_xcc_id(); b_.st = (volatile LAS unsigned*)(smem + 65520); xcd_barrier(b_); } while (0)
#ifndef DUPMASK
#define DUPMASK 0
#endif
#define RUN(n, call) do { if (PON(n) && p.phase_lo <= (n) && (n) <= p.phase_hi) { call; if ((DUPMASK >> (n)) & 1) { XB_NOW(); call; } } if (p.phase_lo <= (n) && (n) < p.phase_hi) XB_NOW(); } while (0)
  RUN(0, phase_prep(p, smem));
  RUN(1, phase_gemm_in_even(p, smem));
  RUN(2, phase_even_pointwise(p, smem));
  RUN(3, phase_chunk_prep(p, smem));
  RUN(4, phase_scan(p, smem));
  RUN(5, phase_delta_post(p));
  RUN(6, (phase_gemm_resid<true, true>(p, p.MIX, p.WtOutE, p.norm_xattn, p.SS, smem)));
  RUN(8, phase_gemm_bf16out(p, p.H, p.WtXq, p.ACT2, 1024, p.SS, smem));
  RUN(9, phase_attn(p, 0, smem));
  RUN(10, (phase_gemm_resid<false, true>(p, p.ACT3, p.WtXo, p.norm_mix + 1024, p.SS + NROW, smem)));
  RUN(12, phase_gemm_bf16out(p, p.H, p.WtInO, p.PB, 2048, p.SS + NROW, smem));
  RUN(13, phase_pool(p));
  RUN(14, phase_gemm_pool(p, smem));
  RUN(15, (phase_gemm_resid<false, true>(p, p.ACT3, p.WtOutO, p.norm_xattn + 1024, p.SS + 2 * NROW, smem)));
  RUN(17, phase_gemm_bf16out(p, p.H, p.WtXq + 1048576, p.ACT2, 1024, p.SS + 2 * NROW, smem));
  RUN(18, phase_attn(p, 1, smem));
  RUN(19, (phase_gemm_resid<false, false>(p, p.ACT3, p.WtXo + 1048576, p.norm_final, p.SS + 3 * NROW, smem)));
  RUN(20, phase_final_norm(p));
}

extern "C" void kernel_launch(void* const* d_in, const int* in_sizes, int n_in, void* d_out, int out_size, void* d_ws,
                              size_t ws_size, hipStream_t stream) {
  static int grid_blocks = 0;
  if (!grid_blocks) {
    int dev = 0, cus = 0, per_cu = 0;
    (void)hipGetDevice(&dev);
    (void)hipDeviceGetAttribute(&cus, hipDeviceAttributeMultiprocessorCount, dev);
    (void)hipOccupancyMaxActiveBlocksPerMultiprocessor(&per_cu, mega, 256, 0);
    if (per_cu < 1) per_cu = 1;
    if (per_cu > 2) per_cu = 2;
    grid_blocks = cus * per_cu;
  }
  Params p{};
  const float** ins = (const float**)&p.x_prompt;
  for (int i = 0; i < 31; ++i) ins[i] = (const float*)d_in[i];
  p.out = (float*)d_out;
  char* w = (char*)d_ws;
  size_t off = 0;
  auto take = [&](size_t bytes) { char* r = w + off; off += (bytes + 255) & ~(size_t)255; return r; };
  p.X = (float*)take((size_t)NROW * 1024 * 4);
  p.QKV = (float*)take((size_t)NROW * 1536 * 4);
  p.BGR = (float*)take((size_t)NROW * 8 * 4);
  p.BG = (float*)take((size_t)NROW * 8 * 4);
  p.CONV = (float*)take((size_t)NROW * 512 * 4);
  p.ODN = (float*)take((size_t)NROW * 512 * 4);
  p.U = (float*)take((size_t)1024 * 8192 * 4);
  p.GL = (float*)take(4096);
  p.SS = (float*)take((size_t)4 * NROW * 4);
  p.H = (bfr*)take((size_t)NROW * 1024 * 2);
  p.PB = (bfr*)take((size_t)NROW * 3584 * 2);
  p.MIX = (bfr*)take((size_t)NROW * 1024 * 2);
  p.ACT2 = (bfr*)take((size_t)NROW * 1024 * 2);
  p.ACT3 = (bfr*)take((size_t)NROW * 1024 * 2);
  p.KB = (bfr*)take((size_t)2 * 2048 * 1024 * 2);
  p.VT = (bfr*)take((size_t)2 * 2048 * 1024 * 2);
  p.MPB = (bfr*)take((size_t)2048 * 1024 * 2);
  p.WtInE = (bfr*)take((size_t)3712 * 1024 * 2);
  p.WtOutE = (bfr*)take((size_t)1024 * 1024 * 2);
  p.WtInO = (bfr*)take((size_t)2048 * 1024 * 2);
  p.WtPool = (bfr*)take((size_t)4 * 256 * 256 * 2);
  p.WtOutO = (bfr*)take((size_t)1024 * 1024 * 2);
  p.WtXq = (bfr*)take((size_t)2 * 1024 * 1024 * 2);
  p.WtXk = (bfr*)take((size_t)2 * 1024 * 1024 * 2);
  p.WtXv = (bfr*)take((size_t)2 * 1024 * 1024 * 2);
  p.WtXo = (bfr*)take((size_t)2 * 1024 * 1024 * 2);
  p.WN = (uint4*)take((size_t)1024 * 1024 * 16);
  p.QD = (uint4*)take((size_t)1024 * 1024 * 16);
  p.KD = (uint4*)take((size_t)1024 * 1024 * 16);
  p.QKF = (uint4*)take((size_t)1024 * 512 * 16);
  p.bar = (unsigned*)take((size_t)XCD_BAR_WORDS * 4);
  if (off > ws_size) {
    fprintf(stderr, "kernel_launch: workspace too small: need %zu have %zu\n", off, ws_size);
    return;
  }
  p.phase_lo = 0;
  p.phase_hi = 20;
  if (hipMemsetAsync(p.bar, 0, (size_t)XCD_BAR_WORDS * 4, stream) != hipSuccess) { fprintf(stderr, "memset failed\n"); return; }
  void* args[] = {&p};
  hipError_t e = hipLaunchCooperativeKernel((void*)mega, dim3(grid_blocks), dim3(256), args, 0, stream);
  if (e != hipSuccess) fprintf(stderr, "cooperative launch failed: %s (grid %d)\n", hipGetErrorString(e), grid_blocks);
}
```

```cpp
#include <hip/hip_runtime.h>
#include <hip/hip_cooperative_groups.h>
#include <cstdio>
namespace cg = cooperative_groups;

#define DI __device__ __forceinline__
typedef unsigned short bfr;
using bf16x8 = __attribute__((ext_vector_type(8))) short;
using f32x16 = __attribute__((ext_vector_type(16))) float;
typedef __bf16 bf2_t __attribute__((ext_vector_type(2)));
typedef float fl2_t __attribute__((ext_vector_type(2)));
typedef unsigned u32x4 __attribute__((ext_vector_type(4)));
#define MFMA32(a, b, c) __builtin_amdgcn_mfma_f32_32x32x16_bf16((a), (b), (c), 0, 0, 0)

constexpr int NROW = 16512;
constexpr int NPR = 16384;
constexpr int DM = 1024;
constexpr int EIN = 3592, EINP = 3584;
constexpr float EPSF = 1e-6f;

constexpr size_t O_Y = 0;
constexpr size_t O_CONVP = 16777216 + 131072;
constexpr size_t O_QKVP = O_CONVP + 122880;
constexpr size_t O_DELTAP = O_QKVP + 36864;
constexpr size_t O_POOLP = O_DELTAP + 524288;
constexpr size_t O_MEMK = O_POOLP + 122880;
constexpr size_t O_MEMV = O_MEMK + 4194304;
constexpr size_t O_CONVS = O_MEMV + 4194304;
constexpr size_t O_QKVS = O_CONVS + 1966080;
constexpr size_t O_DELTAS = O_QKVS + 589824;
constexpr size_t O_POOLS = O_DELTAS + 8388608;

struct Params {
  const float *x_prompt, *x_sample, *state_conv_a, *state_qkv_conv, *state_delta, *state_pool, *cache_k, *cache_v, *mem_prompt;
  const float *norm_mix, *norm_xattn, *norm_final, *w_in_even, *w_out_even, *dw_w, *dw_b, *ln_a_g, *ln_a_b, *sc_w, *a_log,
      *dt_bias, *dn_norm_g, *w_in_odd, *w_pool, *b_pool, *pool_scale, *w_out_odd, *w_xq, *w_xk, *w_xv, *w_xo;
  float* out;
  float *X, *QKV, *BGR, *BG, *CONV, *ODN, *U, *GL, *SS;
  bfr *H, *PB, *MIX, *ACT2, *ACT3, *KB, *VT, *MPB;
  bfr *WtInE, *WtOutE, *WtInO, *WtPool, *WtOutO, *WtXq, *WtXk, *WtXv, *WtXo;
  uint4 *WN, *QD, *KD, *QKF;
  unsigned* bar;
  int phase_lo, phase_hi;
};

DI int opaque_tid() { int t = threadIdx.x; asm volatile("" : "+v"(t)); return t; }
DI unsigned pack2(float a, float b) {
  fl2_t f = {a, b};
  bf2_t r = __builtin_convertvector(f, bf2_t);
  return __builtin_bit_cast(unsigned, r);
}
DI bfr f2bf(float a) { return (bfr)(pack2(a, 0.f) & 0xffffu); }
DI float bf2f(bfr u) { return __uint_as_float(((unsigned)u) << 16); }
DI float bflo(unsigned u) { return __uint_as_float(u << 16); }
DI float bfhi(unsigned u) { return __uint_as_float(u & 0xffff0000u); }
DI float sigmoidf_(float x) { return 1.0f / (1.0f + __expf(-x)); }
DI float siluf_(float x) { return x / (1.0f + __expf(-x)); }
#define DPPF(v, ctrl, rmask) __builtin_bit_cast(float, __builtin_amdgcn_update_dpp(0, __builtin_bit_cast(int, (v)), (ctrl), (rmask), 0xf, false))
DI float row16_sum(float v) {
  v += DPPF(v, 0xB1, 0xf);
  v += DPPF(v, 0x4E, 0xf);
  v += DPPF(v, 0x141, 0xf);
  v += DPPF(v, 0x140, 0xf);
  return v;
}
DI float half32_sum_hi(float v) {
  v = row16_sum(v);
  v += DPPF(v, 0x142, 0xa);
  return v;
}
DI float wave_sum(float v) {
  v = row16_sum(v);
  v += DPPF(v, 0x142, 0xa);
  v += DPPF(v, 0x143, 0xc);
  return __builtin_bit_cast(float, __builtin_amdgcn_readlane(__builtin_bit_cast(int, v), 63));
}
DI float wave_max(float v) {
#pragma unroll
  for (int o = 32; o >= 1; o >>= 1) v = fmaxf(v, __shfl_xor(v, o));
  return v;
}
DI int crow(int reg, int h) { return (reg & 3) + 8 * (reg >> 2) + 4 * h; }
DI bf16x8 pack8(const f32x16& x, int s) {
  uint4 p;
  p.x = pack2(x[8 * s + 0], x[8 * s + 1]);
  p.y = pack2(x[8 * s + 2], x[8 * s + 3]);
  p.z = pack2(x[8 * s + 4], x[8 * s + 5]);
  p.w = pack2(x[8 * s + 6], x[8 * s + 7]);
  return __builtin_bit_cast(bf16x8, p);
}
DI bf16x8 ldfrag(const uint4* p) { uint4 v = *p; return __builtin_bit_cast(bf16x8, v); }


#define XB_TMO      128
#define XB_XCNT(j)  (256  + 64 * (j))
#define XB_XSUB(j)  (1280 + 64 * (j))
#define XB_XGEN(j)  (2304 + 64 * (j))
#define XB_TOP      3328
#define XB_TOPGEN   3392
#define XCD_BAR_WORDS 3456
#define XB_SPIN_CAP (1u << 18)
#define LAS __attribute__((address_space(3)))
DI unsigned xb_ld(unsigned* p) { return __hip_atomic_load(p, __ATOMIC_RELAXED, __HIP_MEMORY_SCOPE_AGENT); }
DI unsigned xb_add(unsigned* p, unsigned v) { return __hip_atomic_fetch_add(p, v, __ATOMIC_RELAXED, __HIP_MEMORY_SCOPE_AGENT); }
DI unsigned xb_xcc_id() { return (unsigned)__builtin_amdgcn_s_getreg((3 << 11) | 20) & 0xFu; }
#define XB_SPIN(cond, bar) do { unsigned _sp = 0; while (cond) { __builtin_amdgcn_s_sleep(1); \
    if ((++_sp & 255u) == 0u) { if (xb_ld(&(bar)[XB_TMO])) break; if (_sp > XB_SPIN_CAP) { atomicAdd(&(bar)[XB_TMO], 1u); break; } } } } while (0)
struct XcdBarrier { unsigned* bar; unsigned x; volatile LAS unsigned* st; };
DI XcdBarrier xcd_barrier_post(unsigned* bar, volatile LAS unsigned* st) {
  XcdBarrier b; b.bar = bar; b.x = xb_xcc_id(); b.st = st;
  if (threadIdx.x == 0) (void)xb_add(&bar[XB_XCNT(b.x)], 1u);
  return b;
}
DI void xcd_barrier_complete(unsigned* bar, unsigned x, unsigned& nloc, unsigned& nx) {
  const unsigned G = gridDim.x * gridDim.y * gridDim.z;
  unsigned sum, cnt, mine, sp = 0u;
  for (;;) {
    sum = 0u; cnt = 0u; mine = 0u;
#pragma unroll
    for (unsigned j = 0; j < 16; ++j) { const unsigned c = xb_ld(&bar[XB_XCNT(j)]); sum += c; cnt += (c > 0u) ? 1u : 0u; mine = (j == x) ? c : mine; }
    if (sum == G) break;
    __builtin_amdgcn_s_sleep(1);
    if ((++sp & 255u) == 0u) { if (xb_ld(&bar[XB_TMO])) break; if (sp > XB_SPIN_CAP) { atomicAdd(&bar[XB_TMO], 1u); break; } }
  }
  nloc = mine > 0u ? mine : 1u; nx = cnt > 0u ? cnt : 1u;
}
DI void xcd_barrier(const XcdBarrier& b) {
  asm volatile("s_waitcnt vmcnt(0)" ::: "memory");
  __syncthreads();
  if (threadIdx.x == 0) {
    unsigned* bar = b.bar;
    __builtin_amdgcn_s_waitcnt(0);
    unsigned nloc = b.st[0], nx = b.st[1];
    if (nloc == 0u) { xcd_barrier_complete(bar, b.x, nloc, nx); b.st[0] = nloc; b.st[1] = nx; }
    const unsigned old = xb_add(&bar[XB_XSUB(b.x)], 1u);
    const unsigned gen = old / nloc;
    if (old + 1u == (gen + 1u) * nloc) {
      __builtin_amdgcn_fence(__ATOMIC_RELEASE, "agent");
      asm volatile("s_waitcnt vmcnt(0)" ::: "memory");
      const unsigned og = xb_add(&bar[XB_TOP], 1u);
      const unsigned tg = og / nx;
      if (og + 1u == (tg + 1u) * nx) xb_add(&bar[XB_TOPGEN], 1u);
      else XB_SPIN(xb_ld(&bar[XB_TOPGEN]) == tg, bar);
      __builtin_amdgcn_fence(__ATOMIC_ACQUIRE, "agent");
      xb_add(&bar[XB_XGEN(b.x)], 1u);
      asm volatile("s_waitcnt vmcnt(0)" ::: "memory");
    } else {
      XB_SPIN(xb_ld(&bar[XB_XGEN(b.x)]) == gen, bar);
      __builtin_amdgcn_fence(__ATOMIC_ACQUIRE, "agent");
      asm volatile("s_waitcnt vmcnt(0)" ::: "memory");
    }
  }
  __syncthreads();
}

constexpr int GSTAGE = (128 + 256) * 40;
template <int lda>
DI void gemm_mainloop(const bfr* __restrict__ A, const bfr* __restrict__ Bt, int NB, int K, int m0, int n0, char* smem, f32x16 (&acc)[2][4]) {
  bfr* S0 = (bfr*)smem;
  int tid = threadIdx.x;
  asm volatile("" : "+v"(tid));
  const int lane = tid & 63, wid = tid >> 6, wr = wid >> 1, wc = wid & 1;
  const int r = lane & 31, hl = lane >> 5;
#pragma unroll
  for (int i = 0; i < 2; ++i)
#pragma unroll
    for (int j = 0; j < 4; ++j)
#pragma unroll
      for (int q = 0; q < 16; ++q) acc[i][j][q] = 0.f;
  u32x4 ra[4], rb[4];
  const int nk = K >> 5;
  const int arow = tid >> 3, ac8 = tid & 7, apar = ac8 >> 2;
  const bfr* Ab = A + (m0 + arow) * lda + ac8 * 8;
  const int asoff = arow * 40 + (ac8 & 3) * 8;
  const int brow = tid >> 2, bc4 = tid & 3;
  const bfr* Bb = Bt + (n0 + brow) * 32 + bc4 * 8;
  const int bsoff = brow * 40 + bc4 * 8;
#define GA_LOAD(pr_) do { _Pragma("unroll") for (int i = 0; i < 4; ++i) ra[i] = *(const u32x4*)(Ab + (i * 32) * lda + (pr_) * 64); } while (0)
#define GB_LOAD(kt_) do { const bfr* bk_ = Bb + (kt_) * NB * 32; \
    _Pragma("unroll") for (int i = 0; i < 4; ++i) rb[i] = *(const u32x4*)(bk_ + (i * 64) * 32); } while (0)
#define G_STORE(kt_) do { bfr* as_ = S0 + ((kt_) & 1) * GSTAGE; bfr* bs_ = as_ + 128 * 40; \
    if (apar == ((kt_) & 1)) { _Pragma("unroll") for (int i = 0; i < 4; ++i) *(u32x4*)(as_ + asoff + i * 32 * 40) = ra[i]; } \
    _Pragma("unroll") for (int i = 0; i < 4; ++i) *(u32x4*)(bs_ + bsoff + i * 64 * 40) = rb[i]; } while (0)
  GA_LOAD(0);
  GB_LOAD(0);
  G_STORE(0);
  GB_LOAD(1);
  __syncthreads();
  for (int kt = 0; kt < nk; ++kt) {
    if (kt + 1 < nk) G_STORE(kt + 1);
    if (kt + 2 < nk) {
      GB_LOAD(kt + 2);
      if ((kt & 1) == 0) GA_LOAD((kt >> 1) + 1);
    }
    const bfr* As = S0 + (kt & 1) * GSTAGE;
    const bfr* Bs = As + 128 * 40;
#pragma unroll
    for (int ks = 0; ks < 2; ++ks) {
      bf16x8 af[2], bfg[4];
#pragma unroll
      for (int i = 0; i < 2; ++i) af[i] = *(const bf16x8*)(As + (wr * 64 + i * 32 + r) * 40 + ks * 16 + hl * 8);
#pragma unroll
      for (int j = 0; j < 4; ++j) bfg[j] = *(const bf16x8*)(Bs + (wc * 128 + j * 32 + r) * 40 + ks * 16 + hl * 8);
#pragma unroll
      for (int i = 0; i < 2; ++i)
#pragma unroll
        for (int j = 0; j < 4; ++j) acc[i][j] = MFMA32(af[i], bfg[j], acc[i][j]);
    }
    __syncthreads();
  }
#undef GA_LOAD
#undef GB_LOAD
#undef G_STORE
}

template <int lda, class Epi>
DI void gemm_tile(const bfr* __restrict__ A, const bfr* __restrict__ Bt, int NB, int K, int m0, int n0, char* smem, Epi epi) {
  f32x16 acc[2][4];
  gemm_mainloop<lda>(A, Bt, NB, K, m0, n0, smem, acc);
  int tid3 = threadIdx.x;
  asm volatile("" : "+v"(tid3));
  const int lane = tid3 & 63, wid = tid3 >> 6, wr = wid >> 1, wc = wid & 1, r = lane & 31, hl = lane >> 5;
#pragma unroll
  for (int i = 0; i < 2; ++i)
#pragma unroll
    for (int j = 0; j < 4; ++j)
#pragma unroll
      for (int q = 0; q < 16; ++q) {
        int row = m0 + wr * 64 + i * 32 + crow(q, hl);
        int col = n0 + wc * 128 + j * 32 + r;
        epi(row, col, acc[i][j][q]);
      }
}

template <bool RS, class Epi, class RowF>
DI void gemm_sample(const bfr* __restrict__ A, int lda, const bfr* __restrict__ Bt, int ldb, int K, int N, char* smem, Epi epi, RowF rowf) {
  const int tid = threadIdx.x, lane = tid & 63, wid = tid >> 6, r = lane & 31, hl = lane >> 5;
  float* red = (float*)smem;
  const int nun = 4 * (N >> 5);
  for (int u = blockIdx.x; u < nun; u += gridDim.x) {
    const int mu = u & 3, nu = u >> 2;
    const int kq = K >> 2, k0 = wid * kq;
    const bfr* ap = A + (size_t)(NPR + mu * 32 + r) * lda + k0 + hl * 8;
    const bfr* bp = Bt + ((size_t)(k0 >> 5) * ldb + nu * 32 + r) * 32 + hl * 8;
    f32x16 acc;
#pragma unroll
    for (int q = 0; q < 16; ++q) acc[q] = 0.f;
    if (K == 1024) {
#pragma unroll
      for (int ks = 0; ks < 16; ++ks) {
        bf16x8 af = *(const bf16x8*)(ap + ks * 16);
        bf16x8 bf = *(const bf16x8*)(bp + (size_t)(ks >> 1) * ldb * 32 + (ks & 1) * 16);
        acc = MFMA32(af, bf, acc);
      }
    } else {
      for (int ks = 0; ks < (kq >> 4); ++ks) {
        bf16x8 af = *(const bf16x8*)(ap + ks * 16);
        bf16x8 bf = *(const bf16x8*)(bp + (size_t)(ks >> 1) * ldb * 32 + (ks & 1) * 16);
        acc = MFMA32(af, bf, acc);
      }
    }
#pragma unroll
    for (int q = 0; q < 16; ++q) red[(wid * 16 + q) * 64 + lane] = acc[q];
    __syncthreads();
#pragma unroll
    for (int e = 0; e < 4; ++e) {
      const int q = wid + e * 4;
      const float v = red[q * 64 + lane] + red[(16 + q) * 64 + lane] + red[(32 + q) * 64 + lane] + red[(48 + q) * 64 + lane];
      const int row = NPR + mu * 32 + crow(q, hl), col = nu * 32 + r;
      float x = epi(row, col, v);
      if (RS) {
        float s2 = half32_sum_hi(x * x);
        if (r == 31) rowf(row, s2);
      }
    }
    __syncthreads();
  }
}

DI void transpose_tile(const float* __restrict__ W, int ldw, bfr* __restrict__ Wt, int NB, int k0, int n0, float* sm, int nvalid = 1 << 30) {
  const int tid = threadIdx.x;
#pragma unroll
  for (int i = 0; i < 16; ++i) {
    int idx = tid + i * 256, kk = idx >> 6, nn = idx & 63;
    sm[kk * 65 + nn] = (n0 + nn < nvalid) ? W[(size_t)(k0 + kk) * ldw + n0 + nn] : 0.f;
  }
  __syncthreads();
#pragma unroll
  for (int i = 0; i < 8; ++i) {
    int idx = tid + i * 256, nn = idx >> 5, kp = idx & 31;
    float a = sm[(2 * kp) * 65 + nn], b = sm[(2 * kp + 1) * 65 + nn];
    { const int k = k0 + 2 * kp; *(unsigned*)(Wt + ((size_t)(k >> 5) * NB + n0 + nn) * 32 + (k & 31)) = pack2(a, b); }
  }
  __syncthreads();
}

DI void phase_prep(const Params& p, char* smem) {
  float* sm = (float*)smem;
  for (int tt = blockIdx.x; tt < 4032 + 32; tt += gridDim.x) {
    int t = tt - 32;
    if (tt < 928) {
      int kt = tt / 58, nt = tt % 58;
      transpose_tile(p.w_in_even, EIN, p.WtInE, 3712, kt * 64, nt * 64, sm, EIN);
    } else if (t < 1152) {
      int u = t - 896;
      transpose_tile(p.w_out_even, 1024, p.WtOutE, 1024, (u >> 4) * 64, (u & 15) * 64, sm);
    } else if (t < 1664) {
      int u = t - 1152;
      transpose_tile(p.w_in_odd, 2048, p.WtInO, 2048, (u >> 5) * 64, (u & 31) * 64, sm);
    } else if (t < 1728) {
      int u = t - 1664, g = u >> 4, v = u & 15;
      transpose_tile(p.w_pool + (size_t)g * 65536, 256, p.WtPool + (size_t)g * 65536, 256, (v >> 2) * 64, (v & 3) * 64, sm);
    } else if (t < 1984) {
      int u = t - 1728;
      transpose_tile(p.w_out_odd, 1024, p.WtOutO, 1024, (u >> 4) * 64, (u & 15) * 64, sm);
    } else {
      int u = t - 1984, m = u >> 8, v = u & 255;
      int which = m >> 1, l = m & 1;
      const float* src = (which == 0 ? p.w_xq : which == 1 ? p.w_xk : which == 2 ? p.w_xv : p.w_xo) + (size_t)l * 1048576;
      bfr* dst = (which == 0 ? p.WtXq : which == 1 ? p.WtXk : which == 2 ? p.WtXv : p.WtXo) + (size_t)l * 1048576;
      transpose_tile(src, 1024, dst, 1024, (v >> 4) * 64, (v & 15) * 64, sm);
    }
  }
  {
    for (int i = blockIdx.x * 256 + threadIdx.x; i < 4 * NROW; i += gridDim.x * 256) p.SS[i] = 0.f;
    const int n4 = 2048 * 1024 / 4;
    for (int i = blockIdx.x * 256 + threadIdx.x; i < n4; i += gridDim.x * 256) {
      float4 v = ((const float4*)p.mem_prompt)[i];
      uint2 o;
      o.x = pack2(v.x, v.y);
      o.y = pack2(v.z, v.w);
      ((uint2*)p.MPB)[i] = o;
    }
  }
  {
    const int lane = threadIdx.x & 63, wid = threadIdx.x >> 6;
    float* wT = (float*)smem;
    for (int i = opaque_tid(); i < 2048; i += 256) {
      const int k = i >> 1, hf = i & 1;
      float4 w = *(const float4*)(p.w_in_even + (size_t)k * EIN + EINP + hf * 4);
      wT[(hf * 4 + 0) * 1024 + k] = w.x; wT[(hf * 4 + 1) * 1024 + k] = w.y;
      wT[(hf * 4 + 2) * 1024 + k] = w.z; wT[(hf * 4 + 3) * 1024 + k] = w.w;
    }
    __syncthreads();
    for (int row = blockIdx.x * 4 + wid; row < NROW; row += gridDim.x * 4) {
      const float* xr = row < NPR ? p.x_prompt + (size_t)row * DM : p.x_sample + (size_t)(row - NPR) * DM;
      float4 v[4];
      float ss = 0.f;
#pragma unroll
      for (int j = 0; j < 4; ++j) {
        v[j] = ((const float4*)xr)[j * 64 + lane];
        ss += v[j].x * v[j].x + v[j].y * v[j].y + v[j].z * v[j].z + v[j].w * v[j].w;
      }
      ss = wave_sum(ss);
      float inv = rsqrtf(ss * (1.0f / 1024.0f) + EPSF);
      float part[8];
#pragma unroll
      for (int c = 0; c < 8; ++c) part[c] = 0.f;
#pragma unroll
      for (int j = 0; j < 4; ++j) {
        float4 g = ((const float4*)p.norm_mix)[j * 64 + lane];
        uint2 o;
        const float h0 = v[j].x * inv * g.x, h1 = v[j].y * inv * g.y, h2 = v[j].z * inv * g.z, h3 = v[j].w * inv * g.w;
        o.x = pack2(h0, h1);
        o.y = pack2(h2, h3);
        ((uint2*)(p.H + (size_t)row * DM))[j * 64 + lane] = o;
#pragma unroll
        for (int c = 0; c < 8; ++c) {
          float4 w = ((const float4*)(wT + c * 1024))[j * 64 + lane];
          part[c] += h0 * w.x + h1 * w.y + h2 * w.z + h3 * w.w;
        }
      }
#pragma unroll
      for (int c = 0; c < 8; ++c) part[c] = wave_sum(part[c]);
      if (lane == 0) {
        float4 a = {part[0], part[1], part[2], part[3]}, b = {part[4], part[5], part[6], part[7]};
        ((float4*)(p.BGR + (size_t)row * 8))[0] = a;
        ((float4*)(p.BGR + (size_t)row * 8))[1] = b;
      }
    }
    __syncthreads();
  }
}

DI void phase_rmsnorm(const Params& p, const float* g) {
  const int lane = threadIdx.x & 63, wid = threadIdx.x >> 6;
  for (int row = blockIdx.x * 4 + wid; row < NROW; row += gridDim.x * 4) {
    const float* xr = p.X + (size_t)row * DM;
    float4 v[4];
    float ss = 0.f;
#pragma unroll
    for (int j = 0; j < 4; ++j) {
      v[j] = ((const float4*)xr)[j * 64 + lane];
      ss += v[j].x * v[j].x + v[j].y * v[j].y + v[j].z * v[j].z + v[j].w * v[j].w;
    }
    ss = wave_sum(ss);
    float inv = rsqrtf(ss * (1.0f / 1024.0f) + EPSF);
#pragma unroll
    for (int j = 0; j < 4; ++j) {
      float4 gg = ((const float4*)g)[j * 64 + lane];
      uint2 o;
      o.x = pack2(v[j].x * inv * gg.x, v[j].y * inv * gg.y);
      o.y = pack2(v[j].z * inv * gg.z, v[j].w * inv * gg.w);
      ((uint2*)(p.H + (size_t)row * DM))[j * 64 + lane] = o;
    }
  }
}

DI void phase_final_norm(const Params& p) {
  const float* ss = p.SS + 3 * NROW;
  for (int i = blockIdx.x * 256 + threadIdx.x; i < NROW * 256; i += gridDim.x * 256) {
    const int row = i >> 8, c4 = i & 255;
    float4 v = ((const float4*)p.X)[i];
    float4 g = ((const float4*)p.norm_final)[c4];
    const float inv = rsqrtf(ss[row] * (1.0f / 1024.0f) + EPSF);
    float4 o = {v.x * inv * g.x, v.y * inv * g.y, v.z * inv * g.z, v.w * inv * g.w};
    ((float4*)(p.out + O_Y))[i] = o;
  }
}

DI void phase_gemm_in_even(const Params& p, char* smem) {
  const int NT1 = 128 * 14, NT2 = 4 * 64;
  {
    bfr* PB = p.PB;
    gemm_sample<false>(p.H, 1024, p.WtInE, 3712, 1024, EINP, smem,
                       [=](int row, int col, float v) -> float { PB[(size_t)row * EINP + col] = f2bf(v); return 0.f; },
                       [=](int, float) {});
  }
  for (int t = blockIdx.x; t < NT1 + NT2; t += gridDim.x) {
    if (t < NT1) {
      int mt = t / 14, nt = t % 14;
      bfr* PB = p.PB;
      gemm_tile<1024>(p.H, p.WtInE, 3712, 1024, mt * 128, nt * 256, smem,
                [=](int row, int col, float v) { PB[(size_t)row * EINP + col] = f2bf(v); });
    } else {
      int u = t - NT1, gsel = u >> 6, v = u & 63, mt = v >> 2, nt = v & 3;
      int isv = gsel >> 1, l = gsel & 1;
      if (!isv) {
        float* o = p.out + O_MEMK + (size_t)l * 2097152;
        bfr* kb = p.KB + (size_t)l * 2097152;
        gemm_tile<1024>(p.MPB, p.WtXk + (size_t)l * 1048576, 1024, 1024, mt * 128, nt * 256, smem,
                  [=](int row, int col, float v) {
                    o[(size_t)row * 1024 + col] = v;
                    kb[(size_t)row * 1024 + col] = f2bf(v);
                  });
      } else {
        float* o = p.out + O_MEMV + (size_t)l * 2097152;
        bfr* vt = p.VT + (size_t)l * 2097152;
        gemm_tile<1024>(p.MPB, p.WtXv + (size_t)l * 1048576, 1024, 1024, mt * 128, nt * 256, smem,
                  [=](int row, int col, float v) {
                    o[(size_t)row * 1024 + col] = v;
                    const int ml = row & 15;
                    const int rowpart = (row >> 8) * 262144 + ((row & 255) >> 4) * 512 + ((ml >> 2) & 1) * 256 + (((ml >> 3) << 2) | (ml & 3));
                    const int colpart = (col >> 8) * 65536 + ((col & 255) >> 5) * 8192 + (col & 31) * 8;
                    vt[rowpart + colpart] = f2bf(v);
                  });
      }
    }
  }
}

template <bool IS_P, bool EDGE>
DI void qkv_token(const Params& p, int row, int lane) {
  const int t = row & 2047, b = row >> 11, s = row - NPR;
#pragma unroll 6
  for (int grp = 0; grp < 12; ++grp) {
    const int ch = grp * 128 + lane * 2;
    float x0[4], x1[4];
    if (IS_P) {
      unsigned u[4];
#pragma unroll
      for (int j = 0; j < 4; ++j) {
        const int rc = (!EDGE || t - 3 + j >= 0) ? (row - 3 + j) : row;
        u[j] = *(const unsigned*)(p.PB + (size_t)rc * EINP + 1536 + ch);
      }
#pragma unroll
      for (int j = 0; j < 4; ++j) {
        const bool ok = (!EDGE || t - 3 + j >= 0);
        x0[j] = ok ? bflo(u[j]) : 0.f;
        x1[j] = ok ? bfhi(u[j]) : 0.f;
      }
    } else {
#pragma unroll
      for (int j = 0; j < 3; ++j) {
        float2 f = *(const float2*)(p.state_qkv_conv + ((size_t)s * 3 + j) * 1536 + ch);
        x0[j] = f.x; x1[j] = f.y;
      }
      unsigned u = *(const unsigned*)(p.PB + (size_t)row * EINP + 1536 + ch);
      x0[3] = bflo(u); x1[3] = bfhi(u);
    }
    float a0 = 0.f, a1 = 0.f;
#pragma unroll
    for (int j = 0; j < 4; ++j) {
      float2 w = *(const float2*)(p.sc_w + (size_t)j * 1536 + ch);
      a0 += w.x * x0[j]; a1 += w.y * x1[j];
    }
    float y0 = siluf_(a0), y1 = siluf_(a1);
    if (grp < 8) {
      float ss = wave_sum(y0 * y0 + y1 * y1);
      float inv = rsqrtf(ss + EPSF);
      if (grp < 4) inv *= 0.08838834764831845f;
      y0 *= inv; y1 *= inv;
    }
    float2 o = {y0, y1};
    *(float2*)(p.QKV + (size_t)row * 1536 + ch) = o;
    if (IS_P) {
      if (t >= 2045) {
        float2 c = {x0[3], x1[3]};
        *(float2*)(p.out + O_QKVP + ((size_t)b * 3 + (t - 2045)) * 1536 + ch) = c;
      }
    } else {
      float2 c0 = {x0[1], x1[1]}, c1 = {x0[2], x1[2]}, c2 = {x0[3], x1[3]};
      *(float2*)(p.out + O_QKVS + ((size_t)s * 3 + 0) * 1536 + ch) = c0;
      *(float2*)(p.out + O_QKVS + ((size_t)s * 3 + 1) * 1536 + ch) = c1;
      *(float2*)(p.out + O_QKVS + ((size_t)s * 3 + 2) * 1536 + ch) = c2;
    }
  }
  if (lane < 4) {
    float bl = p.BGR[(size_t)row * 8 + lane], al = p.BGR[(size_t)row * 8 + 4 + lane];
    float beta = sigmoidf_(bl);
    float xx = al + p.dt_bias[lane];
    float sp = xx > 20.f ? xx : log1pf(__expf(xx));
    float g = -__expf(p.a_log[lane]) * sp;
    p.BG[(size_t)row * 8 + lane] = beta;
    p.BG[(size_t)row * 8 + 4 + lane] = g;
  }
}

template <int G0>
DI void qkv_run4_half(const Params& p, int row0, int lane) {
  const int t0 = row0 & 2047, b = row0 >> 11;
  unsigned u[4][7];
  float2 w[4][4];
#pragma unroll
  for (int i = 0; i < 7; ++i) {
    const int rr = (i >= 3 || t0 > 0) ? (row0 - 3 + i) : row0;
    const bfr* rp = p.PB + (size_t)rr * EINP + 1536 + G0 * 128 + lane * 2;
#pragma unroll
    for (int g = 0; g < 4; ++g) u[g][i] = *(const unsigned*)(rp + g * 128);
  }
#pragma unroll
  for (int j = 0; j < 4; ++j) {
    const float* wp = p.sc_w + (size_t)j * 1536 + G0 * 128 + lane * 2;
#pragma unroll
    for (int g = 0; g < 4; ++g) w[g][j] = *(const float2*)(wp + g * 128);
  }
  const float hm = (t0 > 0) ? 1.f : 0.f;
#pragma unroll
  for (int k = 0; k < 4; ++k) {
    const int row = row0 + k;
#pragma unroll
    for (int g = 0; g < 4; ++g) {
      const int grp = G0 + g;
      const int ch = grp * 128 + lane * 2;
      float a0 = 0.f, a1 = 0.f;
#pragma unroll
      for (int j = 0; j < 4; ++j) {
        const int i = k + j;
        const float m = (i >= 3) ? 1.f : hm;
        a0 += w[g][j].x * (bflo(u[g][i]) * m);
        a1 += w[g][j].y * (bfhi(u[g][i]) * m);
      }
      float y0 = siluf_(a0), y1 = siluf_(a1);
      if (grp < 8) {
        float ss = wave_sum(y0 * y0 + y1 * y1);
        float inv = rsqrtf(ss + EPSF);
        if (grp < 4) inv *= 0.08838834764831845f;
        y0 *= inv; y1 *= inv;
      }
      float2 o = {y0, y1};
      *(float2*)(p.QKV + (size_t)row * 1536 + ch) = o;
      if (t0 == 2044 && k >= 1) {
        float2 c = {bflo(u[g][k + 3]), bfhi(u[g][k + 3])};
        *(float2*)(p.out + O_QKVP + ((size_t)b * 3 + (k - 1)) * 1536 + ch) = c;
      }
    }
  }
}
DI void qkv_run4(const Params& p, int row0, int lane) {
  qkv_run4_half<0>(p, row0, lane);
  qkv_run4_half<4>(p, row0, lane);
  qkv_run4_half<8>(p, row0, lane);
  if (lane < 16) {
    const int row = row0 + (lane >> 2), hd = lane & 3;
    float bl = p.BGR[(size_t)row * 8 + hd], al = p.BGR[(size_t)row * 8 + 4 + hd];
    float beta = sigmoidf_(bl);
    float xx = al + p.dt_bias[hd];
    float sp = xx > 20.f ? xx : log1pf(__expf(xx));
    float g = -__expf(p.a_log[hd]) * sp;
    p.BG[(size_t)row * 8 + hd] = beta;
    p.BG[(size_t)row * 8 + 4 + hd] = g;
  }
}

DI void conv_a_prompt_item(const Params& p, int item, float* sm) {
  const int half = item & 1, tile = (item >> 1) & 63, b = item >> 7;
  const int tid = threadIdx.x, c = half * 256 + tid, t0 = tile * 32;
  {
    const int tg = tid >> 5, c8 = tid & 31;
    u32x4 vv[8], gg[8];
#pragma unroll
    for (int ps = 0; ps < 8; ++ps) {
      const int i = tg + 8 * ps;
      const int tt = t0 - 30 + i;
      const size_t row = (size_t)b * 2048 + ((tt >= 0 && i < 62) ? tt : t0);
      vv[ps] = *(const u32x4*)(p.PB + row * EINP + half * 256 + c8 * 8);
      gg[ps] = *(const u32x4*)(p.PB + row * EINP + 512 + half * 256 + c8 * 8);
    }
#pragma unroll
    for (int ps = 0; ps < 8; ++ps) {
      const int i = tg + 8 * ps;
      const int tt = t0 - 30 + i;
      const float msk = (tt >= 0) ? 1.f : 0.f;
      float o8[8];
#pragma unroll
      for (int e = 0; e < 4; ++e) {
        o8[2 * e] = bflo(vv[ps][e]) * sigmoidf_(bflo(gg[ps][e])) * msk;
        o8[2 * e + 1] = bfhi(vv[ps][e]) * sigmoidf_(bfhi(gg[ps][e])) * msk;
      }
      if (i < 62) {
        float4 a0 = {o8[0], o8[1], o8[2], o8[3]}, a1 = {o8[4], o8[5], o8[6], o8[7]};
        *(float4*)(sm + i * 256 + c8 * 8) = a0;
        *(float4*)(sm + i * 256 + c8 * 8 + 4) = a1;
      }
    }
    __syncthreads();
  }
  float w[31];
#pragma unroll
  for (int j = 0; j < 31; ++j) w[j] = p.dw_w[j * 512 + c];
  const float bias = p.dw_b[c];
#pragma unroll 1
  for (int o = 0; o < 32; ++o) {
    float acc = bias;
#pragma unroll
    for (int j = 0; j < 31; ++j) acc += w[j] * sm[(o + j) * 256 + tid];
    p.CONV[((size_t)b * 2048 + t0 + o) * 512 + c] = acc;
  }
  if (tile == 63) {
#pragma unroll 1
    for (int j = 0; j < 30; ++j) p.out[O_CONVP + ((size_t)b * 30 + j) * 512 + c] = sm[(32 + j) * 256 + tid];
  }
  __syncthreads();
}

DI void conv_a_sample_item(const Params& p, int s) {
  const int tid = threadIdx.x;
  const size_t row = NPR + s;
#pragma unroll
  for (int cc = 0; cc < 2; ++cc) {
    int c = tid + cc * 256;
    float val = bf2f(p.PB[row * EINP + c]);
    float gate = bf2f(p.PB[row * EINP + 512 + c]);
    float gl = val * sigmoidf_(gate);
    float acc = p.dw_b[c] + p.dw_w[30 * 512 + c] * gl;
#pragma unroll 6
    for (int j = 0; j < 30; ++j) {
      float st = p.state_conv_a[((size_t)s * 30 + j) * 512 + c];
      acc += p.dw_w[j * 512 + c] * st;
      if (j >= 1) p.out[O_CONVS + ((size_t)s * 30 + j - 1) * 512 + c] = st;
    }
    p.out[O_CONVS + ((size_t)s * 30 + 29) * 512 + c] = gl;
    p.CONV[row * 512 + c] = acc;
  }
}

DI void phase_even_pw_conv(const Params& p, char* smem) {
  for (int it = blockIdx.x; it < 1024 + 128; it += gridDim.x) {
    if (it < 1024) conv_a_prompt_item(p, it, (float*)smem);
    else conv_a_sample_item(p, it - 1024);
  }
}
DI void phase_even_pw_qkv(const Params& p) {
  const int lane = threadIdx.x & 63, wid = threadIdx.x >> 6;
  for (int run = blockIdx.x * 4 + wid; run < NPR / 4; run += gridDim.x * 4) qkv_run4(p, run * 4, lane);
  for (int row = NPR + blockIdx.x * 4 + wid; row < NROW; row += gridDim.x * 4) qkv_token<false, false>(p, row, lane);
}
DI void phase_even_pointwise(const Params& p, char* smem) {
  phase_even_pw_conv(p, smem);
  phase_even_pw_qkv(p);
}

DI void chunk_prep(const Params& p, int item, char* smem) {
  const int tid = threadIdx.x, lane = tid & 63, wid = tid >> 6, r = lane & 31, hl = lane >> 5;
  const int n = item & 31, hh = (item >> 5) & 3, b = item >> 7;
  const size_t row0 = (size_t)b * 2048 + n * 64;
  float* gcs = (float*)smem;
  float* betas = gcs + 64;
  float* egs = betas + 64;
  float* kscale = egs + 64;
  bfr* qs = (bfr*)(smem + 1024);
  bfr* ks_ = qs + 64 * 136;
  float* Am = (float*)(smem + 1024 + 2 * 64 * 136 * 2);
  bfr* wsb = qs;
  if (tid < 64) {
    float beta = p.BG[(row0 + tid) * 8 + hh];
    float g = p.BG[(row0 + tid) * 8 + 4 + hh];
    float v = g;
#pragma unroll
    for (int off = 1; off < 64; off <<= 1) {
      float t = __shfl_up(v, off);
      if (lane >= off) v += t;
    }
    float gl = __shfl(v, 63);
    gcs[tid] = v;
    betas[tid] = beta;
    egs[tid] = __expf(v);
    kscale[tid] = __expf(gl - v);
    if (tid == 63) p.GL[item] = __expf(gl);
  }
#pragma unroll
  for (int i = 0; i < 8; ++i) {
    int idx = tid + i * 256, row = idx >> 5, c4 = idx & 31;
    float4 q = *(const float4*)(p.QKV + (row0 + row) * 1536 + hh * 128 + c4 * 4);
    float4 k = *(const float4*)(p.QKV + (row0 + row) * 1536 + 512 + hh * 128 + c4 * 4);
    uint2 qo, ko;
    qo.x = pack2(q.x, q.y); qo.y = pack2(q.z, q.w);
    ko.x = pack2(k.x, k.y); ko.y = pack2(k.z, k.w);
    *(uint2*)(qs + row * 136 + c4 * 4) = qo;
    *(uint2*)(ks_ + row * 136 + c4 * 4) = ko;
  }
  __syncthreads();
  {
    const int mi = wid >> 1, ni = wid & 1;
    f32x16 akk, aqk;
#pragma unroll
    for (int q = 0; q < 16; ++q) { akk[q] = 0.f; aqk[q] = 0.f; }
#pragma unroll
    for (int ks = 0; ks < 8; ++ks) {
      bf16x8 ka = *(const bf16x8*)(ks_ + (mi * 32 + r) * 136 + ks * 16 + hl * 8);
      bf16x8 qa = *(const bf16x8*)(qs + (mi * 32 + r) * 136 + ks * 16 + hl * 8);
      bf16x8 kb = *(const bf16x8*)(ks_ + (ni * 32 + r) * 136 + ks * 16 + hl * 8);
      akk = MFMA32(ka, kb, akk);
      aqk = MFMA32(qa, kb, aqk);
    }
    bfr* qkf = (bfr*)(p.QKF + (size_t)item * 512);
#pragma unroll
    for (int q = 0; q < 16; ++q) {
      int i = mi * 32 + crow(q, hl), j = ni * 32 + r;
      float dec = (i >= j) ? __expf(gcs[i] - gcs[j]) : 0.f;
      Am[i * 68 + j] = (i > j) ? akk[q] * betas[i] * dec : 0.f;
      float qv = (i >= j) ? aqk[q] * dec : 0.f;
      int ksj = j >> 4, jl = j & 15, h2 = (jl >> 2) & 1, jj = ((jl >> 3) << 2) | (jl & 3);
      qkf[((mi * 4 + ksj) * 64 + h2 * 32 + (i & 31)) * 8 + jj] = f2bf(qv);
    }
  }
  {
    uint4* QD = p.QD + (size_t)item * 1024;
#pragma unroll
    for (int i = 0; i < 4; ++i) {
      int idx = tid + i * 256, f = idx >> 6, ln = idx & 63, mt = f >> 3, ks = f & 7, m = ln & 31, h2 = ln >> 5;
      int ri = mt * 32 + m, d0 = ks * 16 + h2 * 4;
      float sc = egs[ri];
      const float* src = p.QKV + (row0 + ri) * 1536 + hh * 128 + d0;
      float4 a = *(const float4*)src, c = *(const float4*)(src + 8);
      uint4 o;
      o.x = pack2(a.x * sc, a.y * sc); o.y = pack2(a.z * sc, a.w * sc);
      o.z = pack2(c.x * sc, c.y * sc); o.w = pack2(c.z * sc, c.w * sc);
      QD[f * 64 + ln] = o;
    }
    uint4* KD = p.KD + (size_t)item * 1024;
#pragma unroll
    for (int i = 0; i < 4; ++i) {
      int idx = tid + i * 256, f = idx >> 6, ln = idx & 63, mt = f >> 2, ks = f & 3, m = ln & 31, h2 = ln >> 5;
      int d = mt * 32 + m;
      float vals[8];
#pragma unroll
      for (int j = 0; j < 8; ++j) {
        int c = ks * 16 + 8 * (j >> 2) + 4 * h2 + (j & 3);
        vals[j] = p.QKV[(row0 + c) * 1536 + 512 + hh * 128 + d] * kscale[c];
      }
      uint4 o;
      o.x = pack2(vals[0], vals[1]); o.y = pack2(vals[2], vals[3]);
      o.z = pack2(vals[4], vals[5]); o.w = pack2(vals[6], vals[7]);
      KD[f * 64 + ln] = o;
    }
  }
  __syncthreads();
  {
    const int c = tid;
    const float* src = (c < 128) ? (p.QKV + row0 * 1536 + 1024 + hh * 128 + c) : (p.QKV + row0 * 1536 + 512 + hh * 128 + (c - 128));
    float sol[64];
#pragma unroll
    for (int i = 0; i < 64; ++i) {
      float rhs = src[(size_t)i * 1536] * betas[i];
      if (c >= 128) rhs *= egs[i];
      float acc = rhs, acc1 = 0.f;
#pragma unroll
      for (int j = 0; j < i; ++j) {
        if (j & 1) acc1 -= Am[i * 68 + j] * sol[j];
        else acc -= Am[i * 68 + j] * sol[j];
      }
      sol[i] = acc + acc1;
    }
    if (c < 128) {
      float* U = p.U + (size_t)item * 8192;
#pragma unroll
      for (int i = 0; i < 64; ++i) U[i * 128 + c] = sol[i];
    } else {
#pragma unroll
      for (int i = 0; i < 64; ++i) wsb[i * 136 + (c - 128)] = f2bf(-sol[i]);
    }
  }
  __syncthreads();
  {
    uint4* WN = p.WN + (size_t)item * 1024;
#pragma unroll
    for (int i = 0; i < 4; ++i) {
      int idx = tid + i * 256, f = idx >> 6, ln = idx & 63, mt = f >> 3, ks = f & 7, m = ln & 31, h2 = ln >> 5;
      int ri = mt * 32 + m, d0 = ks * 16 + h2 * 4;
      uint2 a = *(const uint2*)(wsb + ri * 136 + d0), c = *(const uint2*)(wsb + ri * 136 + d0 + 8);
      uint4 o = {a.x, a.y, c.x, c.y};
      WN[f * 64 + ln] = o;
    }
  }
  __syncthreads();
}

DI void branch_a_final_row(const Params& p, int row, int lane) {
  const float* cr = p.CONV + (size_t)row * 512;
  float4 v[2];
  float s = 0.f;
#pragma unroll
  for (int j = 0; j < 2; ++j) {
    v[j] = ((const float4*)cr)[j * 64 + lane];
    s += v[j].x + v[j].y + v[j].z + v[j].w;
  }
  float mean = wave_sum(s) * (1.0f / 512.0f);
  float vs = 0.f;
#pragma unroll
  for (int j = 0; j < 2; ++j) {
    v[j].x -= mean; v[j].y -= mean; v[j].z -= mean; v[j].w -= mean;
    vs += v[j].x * v[j].x + v[j].y * v[j].y + v[j].z * v[j].z + v[j].w * v[j].w;
  }
  float inv = rsqrtf(wave_sum(vs) * (1.0f / 512.0f) + EPSF);
#pragma unroll
  for (int j = 0; j < 2; ++j) {
    int c = (j * 64 + lane) * 4;
    float4 g = *(const float4*)(p.ln_a_g + c), bb = *(const float4*)(p.ln_a_b + c);
    uint2 gu = *(const uint2*)(p.PB + (size_t)row * EINP + 1024 + c);
    float y0 = siluf_(v[j].x * inv * g.x + bb.x) * siluf_(bflo(gu.x));
    float y1 = siluf_(v[j].y * inv * g.y + bb.y) * siluf_(bfhi(gu.x));
    float y2 = siluf_(v[j].z * inv * g.z + bb.z) * siluf_(bflo(gu.y));
    float y3 = siluf_(v[j].w * inv * g.w + bb.w) * siluf_(bfhi(gu.y));
    uint2 o;
    o.x = pack2(y0, y1); o.y = pack2(y2, y3);
    *(uint2*)(p.MIX + (size_t)row * 1024 + c) = o;
  }
}

DI void delta_sample_item(const Params& p, int item, char* smem) {
  const int s = item >> 2, hh = item & 3, tid = threadIdx.x;
  const size_t row = NPR + s;
  float* ksm = (float*)smem;
  float* qsm = ksm + 128;
  float* part = qsm + 128;
  if (tid < 128) ksm[tid] = p.QKV[row * 1536 + 512 + hh * 128 + tid];
  else qsm[tid - 128] = p.QKV[row * 1536 + hh * 128 + (tid - 128)];
  const float beta = p.BG[row * 8 + hh], a = __expf(p.BG[row * 8 + 4 + hh]);
  __syncthreads();
  const int e = tid & 127, half = tid >> 7, d0 = half * 64;
  const float* S0 = p.state_delta + (((size_t)s * 4 + hh) * 128 + d0) * 128 + e;
  float* So = p.out + O_DELTAS + (((size_t)s * 4 + hh) * 128 + d0) * 128 + e;
  float Sr[64];
  float ksum = 0.f;
#pragma unroll
  for (int i = 0; i < 64; ++i) {
    Sr[i] = S0[(size_t)i * 128] * a;
    ksum += ksm[d0 + i] * Sr[i];
  }
  part[half * 128 + e] = ksum;
  __syncthreads();
  const float kS = part[e] + part[128 + e];
  const float v = p.QKV[row * 1536 + 1024 + hh * 128 + e];
  const float vnew = (v - kS) * beta;
  float oo = 0.f;
#pragma unroll
  for (int i = 0; i < 64; ++i) {
    Sr[i] += ksm[d0 + i] * vnew;
    So[(size_t)i * 128] = Sr[i];
    oo += qsm[d0 + i] * Sr[i];
  }
  __syncthreads();
  part[half * 128 + e] = oo;
  __syncthreads();
  if (half == 0) p.ODN[row * 512 + hh * 128 + e] = part[e] + part[128 + e];
  __syncthreads();
}

DI void phase_chunk_prep(const Params& p, char* smem) {
  for (int it = blockIdx.x; it < 1024; it += gridDim.x) chunk_prep(p, it, smem);
}

DI void scan_item(const Params& p, int item, char* smem) {
  const int tid = threadIdx.x, lane = tid & 63, es = tid >> 6, r = lane & 31, hl = lane >> 5;
  const int b = item >> 2, hh = item & 3;
  u32x4* bufA = (u32x4*)smem;
  u32x4* bufB = (u32x4*)(smem + 32768);
  const u32x4* gWN = (const u32x4*)p.WN + (size_t)item * 32 * 1024;
  const u32x4* gQD = (const u32x4*)p.QD + (size_t)item * 32 * 1024;
  const u32x4* gKD = (const u32x4*)p.KD + (size_t)item * 32 * 1024;
  const u32x4* gQK = (const u32x4*)p.QKF + (size_t)item * 32 * 512;
  const float* gU = p.U + (size_t)item * 32 * 8192;
  const int uo = hl * 4 * 128 + es * 32 + r;
  const int oo = hl * 4 * 512 + es * 32 + r;
#define GLDS(gp, lp) __builtin_amdgcn_global_load_lds((const unsigned*)(gp), (unsigned*)(lp), 16, 0, 0)
  f32x16 S[4];
#pragma unroll
  for (int d = 0; d < 4; ++d)
#pragma unroll
    for (int q = 0; q < 16; ++q) S[d][q] = 0.f;
  f32x16 vn[2], o[2], op[2];
#pragma unroll
  for (int i = 0; i < 4; ++i) {
    GLDS(gWN + tid + i * 256, bufA + tid + i * 256);
    GLDS(gQD + tid + i * 256, bufA + 1024 + tid + i * 256);
  }
#pragma unroll
  for (int ct = 0; ct < 2; ++ct)
#pragma unroll
    for (int q = 0; q < 16; ++q) vn[ct][q] = gU[(ct * 32 + crow(q, 0)) * 128 + uo];
  asm volatile("s_waitcnt vmcnt(0)" ::: "memory");
  __syncthreads();
#pragma unroll 1
  for (int n = 0; n < 32; ++n) {
    const int chunk = item * 32 + n;
    const float gl = p.GL[chunk];
    const int n1 = (n + 1 < 32) ? n + 1 : 31;
    if (n > 0) {
      float* odp = p.ODN + ((size_t)b * 2048 + (n - 1) * 64) * 512 + hh * 128;
#pragma unroll
      for (int ct = 0; ct < 2; ++ct)
#pragma unroll
        for (int q = 0; q < 16; ++q) odp[(ct * 32 + crow(q, 0)) * 512 + oo] = op[ct][q];
    }
    {
      const u32x4* k0 = gQK + n * 512;
      const u32x4* d0 = gKD + n * 1024;
#pragma unroll
      for (int i = 0; i < 2; ++i) GLDS(k0 + tid + i * 256, bufB + tid + i * 256);
#pragma unroll
      for (int i = 0; i < 4; ++i) GLDS(d0 + tid + i * 256, bufB + 512 + tid + i * 256);
    }
    {
      bf16x8 Sb[4][2];
#pragma unroll
      for (int d = 0; d < 4; ++d) { Sb[d][0] = pack8(S[d], 0); Sb[d][1] = pack8(S[d], 1); }
#pragma unroll
      for (int ct = 0; ct < 2; ++ct)
#pragma unroll
        for (int q = 0; q < 16; ++q) o[ct][q] = 0.f;
#pragma unroll
      for (int ct = 0; ct < 2; ++ct)
#pragma unroll
        for (int ks = 0; ks < 8; ++ks) {
          bf16x8 aw = __builtin_bit_cast(bf16x8, bufA[(ct * 8 + ks) * 64 + lane]);
          bf16x8 aq = __builtin_bit_cast(bf16x8, bufA[1024 + (ct * 8 + ks) * 64 + lane]);
          vn[ct] = MFMA32(aw, Sb[ks >> 1][ks & 1], vn[ct]);
          o[ct] = MFMA32(aq, Sb[ks >> 1][ks & 1], o[ct]);
        }
    }
    bf16x8 Vb[2][2];
#pragma unroll
    for (int ct = 0; ct < 2; ++ct) { Vb[ct][0] = pack8(vn[ct], 0); Vb[ct][1] = pack8(vn[ct], 1); }
    asm volatile("s_waitcnt vmcnt(0)" ::: "memory");
    __syncthreads();
    {
      const u32x4* w1 = gWN + n1 * 1024;
      const u32x4* q1 = gQD + n1 * 1024;
#pragma unroll
      for (int i = 0; i < 4; ++i) {
        GLDS(w1 + tid + i * 256, bufA + tid + i * 256);
        GLDS(q1 + tid + i * 256, bufA + 1024 + tid + i * 256);
      }
      const float* u1 = gU + n1 * 8192;
#pragma unroll
      for (int ct = 0; ct < 2; ++ct)
#pragma unroll
        for (int q = 0; q < 16; ++q) vn[ct][q] = u1[(ct * 32 + crow(q, 0)) * 128 + uo];
    }
#pragma unroll
    for (int ct = 0; ct < 2; ++ct)
#pragma unroll
      for (int ks = 0; ks < 4; ++ks) {
        bf16x8 a = __builtin_bit_cast(bf16x8, bufB[(ct * 4 + ks) * 64 + lane]);
        o[ct] = MFMA32(a, Vb[ks >> 1][ks & 1], o[ct]);
      }
#pragma unroll
    for (int d = 0; d < 4; ++d) {
#pragma unroll
      for (int q = 0; q < 16; ++q) S[d][q] *= gl;
#pragma unroll
      for (int ks = 0; ks < 4; ++ks) {
        bf16x8 a = __builtin_bit_cast(bf16x8, bufB[512 + (d * 4 + ks) * 64 + lane]);
        S[d] = MFMA32(a, Vb[ks >> 1][ks & 1], S[d]);
      }
    }
#pragma unroll
    for (int ct = 0; ct < 2; ++ct) op[ct] = o[ct];
    asm volatile("s_waitcnt vmcnt(0)" ::: "memory");
    __syncthreads();
  }
  {
    float* odp = p.ODN + ((size_t)b * 2048 + 31 * 64) * 512 + hh * 128;
#pragma unroll
    for (int ct = 0; ct < 2; ++ct)
#pragma unroll
      for (int q = 0; q < 16; ++q) odp[(ct * 32 + crow(q, 0)) * 512 + oo] = op[ct][q];
  }
#undef GLDS
  float* so = p.out + O_DELTAP + ((size_t)(b * 4 + hh) * 128) * 128;
#pragma unroll
  for (int d = 0; d < 4; ++d)
#pragma unroll
    for (int q = 0; q < 16; ++q) so[(d * 32 + crow(q, 0)) * 128 + uo] = S[d][q];
  __syncthreads();
}

DI void phase_scan(const Params& p, char* smem) {
  const int lane = threadIdx.x & 63, wid = threadIdx.x >> 6;
  if (gridDim.x >= 64) {
    if (blockIdx.x < 32) {
      scan_item(p, blockIdx.x, smem);
    } else {
      const int nb = gridDim.x - 32, bi = blockIdx.x - 32;
      for (int it = bi; it < 512; it += nb) delta_sample_item(p, it, smem);
      for (int row = bi * 4 + wid; row < NROW; row += nb * 4) branch_a_final_row(p, row, lane);
    }
  } else {
    for (int it = blockIdx.x; it < 32; it += gridDim.x) scan_item(p, it, smem);
    for (int it = blockIdx.x; it < 512; it += gridDim.x) delta_sample_item(p, it, smem);
    for (int row = blockIdx.x * 4 + wid; row < NROW; row += gridDim.x * 4) branch_a_final_row(p, row, lane);
  }
}

DI void phase_delta_post(const Params& p) {
  const int lane = threadIdx.x & 63, wid = threadIdx.x >> 6;
  const int stride = gridDim.x * 4;
  const float2 g = *(const float2*)(p.dn_norm_g + lane * 2);
  for (int row = blockIdx.x * 4 + wid; row < NROW; row += 2 * stride) {
    const int r1 = row + stride;
    const bool has1 = r1 < NROW;
    const int rows[2] = {row, has1 ? r1 : row};
    float2 o[2][4];
    unsigned zu[2][4];
#pragma unroll
    for (int k = 0; k < 2; ++k)
#pragma unroll
      for (int hh = 0; hh < 4; ++hh) {
        const int ch = hh * 128 + lane * 2;
        o[k][hh] = *(const float2*)(p.ODN + (size_t)rows[k] * 512 + ch);
        zu[k][hh] = *(const unsigned*)(p.PB + (size_t)rows[k] * EINP + 3072 + ch);
      }
#pragma unroll
    for (int k = 0; k < 2; ++k)
#pragma unroll
      for (int hh = 0; hh < 4; ++hh) {
        const int ch = hh * 128 + lane * 2;
        float ss = wave_sum(o[k][hh].x * o[k][hh].x + o[k][hh].y * o[k][hh].y);
        float inv = rsqrtf(ss * (1.0f / 128.0f) + EPSF);
        float y0 = o[k][hh].x * inv * g.x * siluf_(bflo(zu[k][hh]));
        float y1 = o[k][hh].y * inv * g.y * siluf_(bfhi(zu[k][hh]));
        if (k == 0 || has1) *(unsigned*)(p.MIX + (size_t)rows[k] * 1024 + 512 + ch) = pack2(y0, y1);
      }
  }
}

template <bool FIRST, bool HAS_H>
DI void phase_gemm_resid(const Params& p, const bfr* A, const bfr* Wt, const float* gnext, float* ss, char* smem) {
  float* X = p.X;
  bfr* Hn = p.H;
  {
    const float* xs = p.x_sample - (size_t)NPR * 1024;
    gemm_sample<true>(A, 1024, Wt, 1024, 1024, 1024, smem,
                      [=](int row, int col, float v) -> float {
                        const size_t o = (size_t)row * 1024 + col;
                        const float xn = (FIRST ? xs[o] : X[o]) + v;
                        X[o] = xn;
                        if (HAS_H) Hn[o] = f2bf(xn * gnext[col]);
                        return xn;
                      },
                      [=](int row, float s2) { unsafeAtomicAdd(ss + row, s2); });
  }
  for (int t = blockIdx.x; t < 128 * 4; t += gridDim.x) {
    const int mt = t >> 2, nt = t & 3, m0 = mt * 128, n0 = nt * 256;
    f32x16 acc[2][4];
    gemm_mainloop<1024>(A, Wt, 1024, 1024, m0, n0, smem, acc);
    int tid2 = threadIdx.x;
    asm volatile("" : "+v"(tid2));
    const int lane = tid2 & 63, wid = tid2 >> 6, wr = wid >> 1, wc = wid & 1, r = lane & 31, hl = lane >> 5;
    const float* xsrc = FIRST ? p.x_prompt : X;
    const int rbase = m0 + wr * 64 + 4 * hl, cbase = n0 + wc * 128 + r;
#pragma unroll
    for (int i = 0; i < 2; ++i) {
#pragma unroll
      for (int qh = 0; qh < 2; ++qh) {
        float rs[8];
#pragma unroll
        for (int q = 0; q < 8; ++q) rs[q] = 0.f;
#pragma unroll
        for (int jh = 0; jh < 2; ++jh) {
          float xo[2][8];
#pragma unroll
          for (int jj = 0; jj < 2; ++jj)
#pragma unroll
            for (int q = 0; q < 8; ++q)
              xo[jj][q] = xsrc[(rbase + i * 32 + crow(qh * 8 + q, 0)) * 1024 + cbase + (jh * 2 + jj) * 32];
#pragma unroll
          for (int q = 0; q < 8; ++q) {
            const int o = (rbase + i * 32 + crow(qh * 8 + q, 0)) * 1024 + cbase;
#pragma unroll
            for (int jj = 0; jj < 2; ++jj) {
              const int j = jh * 2 + jj;
              const float xn = xo[jj][q] + acc[i][j][qh * 8 + q];
              X[o + j * 32] = xn;
              if (HAS_H) Hn[o + j * 32] = f2bf(xn * gnext[cbase + j * 32]);
              rs[q] += xn * xn;
            }
          }
        }
#pragma unroll
        for (int q = 0; q < 8; ++q) rs[q] = half32_sum_hi(rs[q]);
        if (r == 31) {
#pragma unroll
          for (int q = 0; q < 8; ++q) unsafeAtomicAdd(ss + rbase + i * 32 + crow(qh * 8 + q, 0), rs[q]);
        }
      }
    }
  }
}
DI void phase_gemm_bf16out(const Params& p, const bfr* A, const bfr* Wt, bfr* C, int N, const float* ss, char* smem) {
  const int ntn = N >> 8;
  gemm_sample<false>(A, 1024, Wt, N, 1024, N, smem,
                     [=](int row, int col, float v) -> float {
                       float inv = rsqrtf(ss[row] * (1.0f / 1024.0f) + EPSF);
                       C[(size_t)row * N + col] = f2bf(v * inv);
                       return 0.f;
                     },
                     [=](int, float) {});
  for (int t = blockIdx.x; t < 128 * ntn; t += gridDim.x) {
    int mt = t / ntn, nt = t % ntn;
    gemm_tile<1024>(A, Wt, N, 1024, mt * 128, nt * 256, smem,
              [=](int row, int col, float v) {
                float inv = rsqrtf(ss[row] * (1.0f / 1024.0f) + EPSF);
                C[(size_t)row * N + col] = f2bf(v * inv);
              });
  }
}

DI void attn_prompt_wave(const Params& p, int l, int b, int hh, int tt, bfr* Obuf) {
  const int lane = threadIdx.x & 63, r = lane & 31, hl = lane >> 5;
  const size_t row0 = (size_t)b * 2048 + tt * 32;
  const bfr* Qp = p.ACT2 + (row0 + r) * 1024 + hh * 256 + hl * 8;
  const bfr* Kp = p.KB + (size_t)l * 2097152 + ((size_t)b * 256 + r) * 1024 + hh * 256 + hl * 8;
  f32x16 st[8];
#pragma unroll
  for (int m = 0; m < 8; ++m)
#pragma unroll
    for (int q = 0; q < 16; ++q) st[m][q] = 0.f;
#pragma unroll 2
  for (int ks = 0; ks < 16; ++ks) {
    bf16x8 qf = *(const bf16x8*)(Qp + ks * 16);
#pragma unroll
    for (int m = 0; m < 8; ++m) {
      bf16x8 kf = *(const bf16x8*)(Kp + (size_t)m * 32 * 1024 + ks * 16);
      st[m] = MFMA32(kf, qf, st[m]);
    }
  }
  float mx = -3.0e38f;
#pragma unroll
  for (int m = 0; m < 8; ++m)
#pragma unroll
    for (int q = 0; q < 16; ++q) mx = fmaxf(mx, st[m][q]);
  mx = fmaxf(mx, __shfl_xor(mx, 32));
  float sum = 0.f;
#pragma unroll
  for (int m = 0; m < 8; ++m)
#pragma unroll
    for (int q = 0; q < 16; ++q) {
      float e = __expf((st[m][q] - mx) * 0.0625f);
      st[m][q] = e;
      sum += e;
    }
  sum += __shfl_xor(sum, 32);
  const float inv = 1.0f / sum;
  bf16x8 pb[8][2];
#pragma unroll
  for (int m = 0; m < 8; ++m) { pb[m][0] = pack8(st[m], 0); pb[m][1] = pack8(st[m], 1); }
  const uint4* VT = (const uint4*)(p.VT + (size_t)l * 2097152) + ((size_t)(b * 4 + hh) * 8) * 16 * 64 + lane;
  bfr* Op = Obuf + (row0 + r) * 1024 + hh * 256;
#pragma unroll 1
  for (int half = 0; half < 2; ++half) {
    f32x16 o[4];
#pragma unroll
    for (int d = 0; d < 4; ++d)
#pragma unroll
      for (int q = 0; q < 16; ++q) o[d][q] = 0.f;
#pragma unroll
    for (int ks = 0; ks < 16; ++ks) {
#pragma unroll
      for (int d = 0; d < 4; ++d) {
        bf16x8 vf = ldfrag(VT + ((size_t)(half * 4 + d) * 16 + ks) * 64);
        o[d] = MFMA32(vf, pb[ks >> 1][ks & 1], o[d]);
      }
    }
#pragma unroll
    for (int d = 0; d < 4; ++d)
#pragma unroll
      for (int g4 = 0; g4 < 4; ++g4) {
        int dim = (half * 4 + d) * 32 + 8 * g4 + 4 * hl;
        uint2 ov;
        ov.x = pack2(o[d][g4 * 4 + 0] * inv, o[d][g4 * 4 + 1] * inv);
        ov.y = pack2(o[d][g4 * 4 + 2] * inv, o[d][g4 * 4 + 3] * inv);
        *(uint2*)(Op + dim) = ov;
      }
  }
}

DI void attn_prompt_block(const Params& p, int l, int b, int hh, int tt4, char* smem, bfr* Obuf) {
  int tid = threadIdx.x;
  asm volatile("" : "+v"(tid));
  const int lane = tid & 63, wid = tid >> 6, r = lane & 31, hl = lane >> 5;
  const int row0 = b * 2048 + (tt4 * 4 + wid) * 32;
  const int qoff = (row0 + r) * 1024 + hh * 256 + hl * 8;
  const bfr* Kg = p.KB + (size_t)l * 2097152 + (size_t)(b * 256) * 1024 + hh * 256;
  const u32x4* VTg = (const u32x4*)(p.VT + (size_t)l * 2097152) + (size_t)((b * 4 + hh) * 8) * 16 * 64;
  bfr* kbuf = (bfr*)smem;
  u32x4* vbuf = (u32x4*)smem;
  u32x4 sr[8];
#define LOADK(c_) do { _Pragma("unroll") for (int i = 0; i < 4; ++i) { const int ch = tid + i * 256; \
    sr[i] = *(const u32x4*)(Kg + (ch >> 2) * 1024 + (c_) * 32 + (ch & 3) * 8); } } while (0)
#define STOREK() do { _Pragma("unroll") for (int i = 0; i < 4; ++i) { const int ch = tid + i * 256; \
    *(u32x4*)(kbuf + (ch >> 2) * 40 + (ch & 3) * 8) = sr[i]; } } while (0)
#define LOADV(v_, tid) do { _Pragma("unroll") for (int i = 0; i < 8; ++i) { const int idx = tid + i * 256, f = idx >> 6; \
    sr[i] = VTg[(((v_) >> 1) * 4 + (f >> 3)) * 1024 + (((v_) & 1) * 8 + (f & 7)) * 64 + (idx & 63)]; } } while (0)
#define STOREV(tid) do { _Pragma("unroll") for (int i = 0; i < 8; ++i) vbuf[tid + i * 256] = sr[i]; } while (0)
  f32x16 st[8];
#pragma unroll
  for (int m = 0; m < 8; ++m)
#pragma unroll
    for (int q = 0; q < 16; ++q) st[m][q] = 0.f;
  LOADK(0);
  STOREK();
  __syncthreads();
#pragma unroll
  for (int c = 0; c < 8; ++c) {
    if (c < 7) LOADK(c + 1); else LOADV(0, tid);
    bf16x8 qf[2];
#pragma unroll
    for (int ksl = 0; ksl < 2; ++ksl) qf[ksl] = *(const bf16x8*)(p.ACT2 + qoff + (c * 2 + ksl) * 16);
#pragma unroll
    for (int ksl = 0; ksl < 2; ++ksl)
#pragma unroll
      for (int m = 0; m < 8; ++m) {
        bf16x8 kf = *(const bf16x8*)(kbuf + (m * 32 + r) * 40 + ksl * 16 + hl * 8);
        st[m] = MFMA32(kf, qf[ksl], st[m]);
      }
    __syncthreads();
    if (c < 7) STOREK(); else STOREV(tid);
    __syncthreads();
  }
  float mx = -3.0e38f;
#pragma unroll
  for (int m = 0; m < 8; ++m)
#pragma unroll
    for (int q = 0; q < 16; ++q) mx = fmaxf(mx, st[m][q]);
  mx = fmaxf(mx, __shfl_xor(mx, 32));
  float sum = 0.f;
#pragma unroll
  for (int m = 0; m < 8; ++m)
#pragma unroll
    for (int q = 0; q < 16; ++q) {
      float e = __expf((st[m][q] - mx) * 0.0625f);
      st[m][q] = e;
      sum += e;
    }
  sum += __shfl_xor(sum, 32);
  const float inv = 1.0f / sum;
  bf16x8 pb[8][2];
#pragma unroll
  for (int m = 0; m < 8; ++m) { pb[m][0] = pack8(st[m], 0); pb[m][1] = pack8(st[m], 1); }
  int tidv = threadIdx.x;
  asm volatile("" : "+v"(tidv));
  const int lanev = tidv & 63, rv = lanev & 31, hlv = lanev >> 5;
  const int ooff = (b * 2048 + (tt4 * 4 + (tidv >> 6)) * 32 + rv) * 1024 + hh * 256;
  f32x16 o[4];
#pragma unroll
  for (int v = 0; v < 4; ++v) {
    if (v < 3) LOADV(v + 1, tidv);
    if ((v & 1) == 0) {
#pragma unroll
      for (int d = 0; d < 4; ++d)
#pragma unroll
        for (int q = 0; q < 16; ++q) o[d][q] = 0.f;
    }
#pragma unroll
    for (int kk = 0; kk < 8; ++kk)
#pragma unroll
      for (int d = 0; d < 4; ++d) {
        bf16x8 vf = __builtin_bit_cast(bf16x8, vbuf[(d * 8 + kk) * 64 + lanev]);
        o[d] = MFMA32(vf, pb[((v & 1) * 8 + kk) >> 1][kk & 1], o[d]);
        if (d == 3) __builtin_amdgcn_sched_barrier(0);
      }
    if (v & 1) {
#pragma unroll
      for (int d = 0; d < 4; ++d)
#pragma unroll
        for (int g4 = 0; g4 < 4; ++g4) {
          int dim = ((v >> 1) * 4 + d) * 32 + 8 * g4 + 4 * hlv;
          uint2 ov;
          ov.x = pack2(o[d][g4 * 4 + 0] * inv, o[d][g4 * 4 + 1] * inv);
          ov.y = pack2(o[d][g4 * 4 + 2] * inv, o[d][g4 * 4 + 3] * inv);
          *(uint2*)(Obuf + ooff + dim) = ov;
        }
    }
    __syncthreads();
    if (v < 3) { STOREV(tidv); __syncthreads(); }
  }
#undef LOADK
#undef STOREK
#undef LOADV
#undef STOREV
}

DI void attn_sample_item(const Params& p, int l, int item, char* smem, bfr* Obuf) {
  const int s = item >> 2, hh = item & 3, tid = threadIdx.x, lane = tid & 63, wid = tid >> 6;
  float* qsm = (float*)smem;
  float* sc = qsm + 256;
  float* red = sc + 256;
  const size_t row = NPR + s;
  qsm[tid] = bf2f(p.ACT2[row * 1024 + hh * 256 + tid]);
  __syncthreads();
  const int grp = lane >> 4, l16 = lane & 15;
  float4 q4[4];
#pragma unroll
  for (int j = 0; j < 4; ++j) q4[j] = ((const float4*)qsm)[j * 16 + l16];
  const float* Kb = p.cache_k + ((((size_t)l * 128 + s) * 256) * 4 + hh) * 256;
  const float* Vb = p.cache_v + ((((size_t)l * 128 + s) * 256) * 4 + hh) * 256;
#pragma unroll 8
  for (int ps = 0; ps < 16; ++ps) {
    int mem = wid * 64 + ps * 4 + grp;
    const float4* kr = (const float4*)(Kb + (size_t)mem * 1024);
    float d = 0.f;
#pragma unroll
    for (int j = 0; j < 4; ++j) {
      float4 k4 = kr[j * 16 + l16];
      d += k4.x * q4[j].x + k4.y * q4[j].y + k4.z * q4[j].z + k4.w * q4[j].w;
    }
    d += __shfl_xor(d, 8);
    d += __shfl_xor(d, 4);
    d += __shfl_xor(d, 2);
    d += __shfl_xor(d, 1);
    if (l16 == 0) sc[mem] = d * 0.0625f;
  }
  __syncthreads();
  float sv = sc[tid];
  float m = wave_max(sv);
  if (lane == 0) red[wid] = m;
  __syncthreads();
  m = fmaxf(fmaxf(red[0], red[1]), fmaxf(red[2], red[3]));
  float e = __expf(sv - m);
  float sm_ = wave_sum(e);
  if (lane == 0) red[4 + wid] = sm_;
  sc[tid] = e;
  __syncthreads();
  const float inv = 1.0f / (red[4] + red[5] + red[6] + red[7]);
  float4 acc = {0.f, 0.f, 0.f, 0.f};
  float* partial = (float*)smem + 1024;
#pragma unroll 16
  for (int i = 0; i < 64; ++i) {
    const int mem = wid * 64 + i;
    float4 v4 = *(const float4*)(Vb + (size_t)mem * 1024 + lane * 4);
    const float pm = sc[mem];
    acc.x += pm * v4.x; acc.y += pm * v4.y; acc.z += pm * v4.z; acc.w += pm * v4.w;
  }
  *(float4*)(partial + wid * 256 + lane * 4) = acc;
  __syncthreads();
  const float ov = partial[tid] + partial[256 + tid] + partial[512 + tid] + partial[768 + tid];
  Obuf[row * 1024 + hh * 256 + tid] = f2bf(ov * inv);
  __syncthreads();
}

DI void phase_attn(const Params& p, int l, char* smem) {
  bfr* Obuf = p.ACT3;
  const int half = gridDim.x >> 1;
  const bool upper = (int)blockIdx.x >= half;
  const int bi = upper ? (int)blockIdx.x - half : (int)blockIdx.x;
  const int nb = upper ? (int)gridDim.x - half : half;
  for (int pass = 0; pass < 2; ++pass) {
    const bool do_sample = (pass == 0) != upper;
    if (do_sample) {
      for (int k = bi; k < 256; k += nb) attn_sample_item(p, l, 2 * k + (upper ? 1 : 0), smem, Obuf);
    } else {
      for (int k = bi; k < 256; k += nb) {
        const int u = 2 * k + (upper ? 1 : 0), tt4 = u & 15, hh = (u >> 4) & 3, b = u >> 6;
        attn_prompt_block(p, l, b, hh, tt4, smem, Obuf);
      }
    }
  }
}

template <int WIN>
DI void pool_elem(const Params& p, int row, int c) {
  const bfr* P2 = p.PB;
  unsigned uu = *(const unsigned*)(P2 + (size_t)row * 2048 + c);
  const float u0 = bflo(uu), u1 = bfhi(uu);
  float s0 = u0, s1 = u1, cnt;
  if (row < NPR) {
    const int t = row & 2047, b = row >> 11;
    if (t >= WIN - 1) {
      cnt = (float)WIN;
      unsigned w[WIN - 1];
#pragma unroll
      for (int j = 1; j < WIN; ++j) w[j - 1] = *(const unsigned*)(P2 + (size_t)(row - j) * 2048 + c);
#pragma unroll
      for (int j = 1; j < WIN; ++j) { s0 += bflo(w[j - 1]); s1 += bfhi(w[j - 1]); }
    } else {
      cnt = (float)(t + 1);
      for (int j = 1; j <= t; ++j) {
        unsigned w = *(const unsigned*)(P2 + (size_t)(row - j) * 2048 + c);
        s0 += bflo(w); s1 += bfhi(w);
      }
    }
    if (t >= 2033) {
      float2 o = {u0, u1};
      *(float2*)(p.out + O_POOLP + ((size_t)b * 15 + (t - 2033)) * 1024 + c) = o;
    }
  } else {
    const int s = row - NPR;
    cnt = (float)WIN;
    const float* sp = p.state_pool + (size_t)s * 15 * 1024 + c;
    float2 st[15];
#pragma unroll
    for (int j = 0; j < 15; ++j) st[j] = *(const float2*)(sp + (size_t)j * 1024);
#pragma unroll
    for (int j = 1; j < WIN; ++j) { s0 += st[15 - j].x; s1 += st[15 - j].y; }
    float* op = p.out + O_POOLS + (size_t)s * 15 * 1024 + c;
#pragma unroll
    for (int j = 0; j < 14; ++j) *(float2*)(op + (size_t)j * 1024) = st[j + 1];
    float2 o = {u0, u1};
    *(float2*)(op + (size_t)14 * 1024) = o;
  }
  *(unsigned*)(p.MIX + (size_t)row * 1024 + c) = pack2(s0 / cnt - u0, s1 / cnt - u1);
}
DI void phase_pool(const Params& p) {
  for (int idx = blockIdx.x * 256 + threadIdx.x; idx < NROW * 512; idx += gridDim.x * 256) {
    const int row = idx >> 9, c = (idx & 511) * 2;
    const int gi = c >> 8;
    if (gi == 0) pool_elem<2>(p, row, c);
    else if (gi == 1) pool_elem<4>(p, row, c);
    else if (gi == 2) pool_elem<8>(p, row, c);
    else pool_elem<16>(p, row, c);
  }
}

DI void phase_gemm_pool(const Params& p, char* smem) {
  const bfr* P2 = p.PB;
  bfr* Z = p.ACT3;
  for (int g = 0; g < 4; ++g) {
    const float* bp = p.b_pool + g * 256;
    const float* sc = p.pool_scale + g * 256;
    gemm_sample<false>(p.MIX + g * 256, 1024, p.WtPool + (size_t)g * 65536, 256, 256, 256, smem,
                       [=](int row, int col, float v) -> float {
                         float gate = bf2f(P2[(size_t)row * 2048 + 1024 + g * 256 + col]);
                         float z = (v + bp[col]) * sc[col] * siluf_(gate);
                         Z[(size_t)row * 1024 + g * 256 + col] = f2bf(z);
                         return 0.f;
                       },
                       [=](int, float) {});
  }
  for (int t = blockIdx.x; t < 128 * 4; t += gridDim.x) {
    int mt = t >> 2, g = t & 3, nt = 0;
    const float* bp = p.b_pool + g * 256;
    const float* sc = p.pool_scale + g * 256;
    gemm_tile<1024>(p.MIX + g * 256, p.WtPool + (size_t)g * 65536, 256, 256, mt * 128, nt * 256, smem,
              [=](int row, int col, float v) {
                float gate = bf2f(P2[(size_t)row * 2048 + 1024 + g * 256 + col]);
                float z = (v + bp[col]) * sc[col] * siluf_(gate);
                Z[(size_t)row * 1024 + g * 256 + col] = f2bf(z);
              });
  }
}

#ifndef ONLY_PHASE
#define ONLY_PHASE -1
#endif
#define PON(n) (ONLY_PHASE < 0 || ONLY_PHASE == (n))
__global__ void __launch_bounds__(256, 2) mega(Params p) {
  __shared__ __attribute__((aligned(16))) char smem[65536];
  cg::grid_group grid = cg::this_grid();
  if (p.phase_lo < -1000) grid.sync();
  volatile LAS unsigned* xst = (volatile LAS unsigned*)(smem + 65520);
  if (threadIdx.x < 4) xst[threadIdx.x] = 0u;
  __syncthreads();
  (void)xcd_barrier_post(p.bar, xst);
#define XB_NOW() do { XcdBarrier b_; b_.bar = p.bar; b_.x = xb_xcc_id(); b_.st = (volatile LAS unsigned*)(smem + 65520); xcd_barrier(b_); } while (0)
#ifndef DUPMASK
#define DUPMASK 0
#endif
#define RUN(n, call) do { if (PON(n) && p.phase_lo <= (n) && (n) <= p.phase_hi) { call; if ((DUPMASK >> (n)) & 1) { XB_NOW(); call; } } if (p.phase_lo <= (n) && (n) < p.phase_hi) XB_NOW(); } while (0)
  RUN(0, phase_prep(p, smem));
  RUN(1, phase_gemm_in_even(p, smem));
  RUN(2, phase_even_pointwise(p, smem));
  RUN(3, phase_chunk_prep(p, smem));
  RUN(4, phase_scan(p, smem));
  RUN(5, phase_delta_post(p));
  RUN(6, (phase_gemm_resid<true, true>(p, p.MIX, p.WtOutE, p.norm_xattn, p.SS, smem)));
  RUN(8, phase_gemm_bf16out(p, p.H, p.WtXq, p.ACT2, 1024, p.SS, smem));
  RUN(9, phase_attn(p, 0, smem));
  RUN(10, (phase_gemm_resid<false, true>(p, p.ACT3, p.WtXo, p.norm_mix + 1024, p.SS + NROW, smem)));
  RUN(12, phase_gemm_bf16out(p, p.H, p.WtInO, p.PB, 2048, p.SS + NROW, smem));
  RUN(13, phase_pool(p));
  RUN(14, phase_gemm_pool(p, smem));
  RUN(15, (phase_gemm_resid<false, true>(p, p.ACT3, p.WtOutO, p.norm_xattn + 1024, p.SS + 2 * NROW, smem)));
  RUN(17, phase_gemm_bf16out(p, p.H, p.WtXq + 1048576, p.ACT2, 1024, p.SS + 2 * NROW, smem));
  RUN(18, phase_attn(p, 1, smem));
  RUN(19, (phase_gemm_resid<false, false>(p, p.ACT3, p.WtXo + 1048576, p.norm_final, p.SS + 3 * NROW, smem)));
  RUN(20, phase_final_norm(p));
}

extern "C" void kernel_launch(void* const* d_in, const int* in_sizes, int n_in, void* d_out, int out_size, void* d_ws,
                              size_t ws_size, hipStream_t stream) {
  static int grid_blocks = 0;
  if (!grid_blocks) {
    int dev = 0, cus = 0, per_cu = 0;
    (void)hipGetDevice(&dev);
    (void)hipDeviceGetAttribute(&cus, hipDeviceAttributeMultiprocessorCount, dev);
    (void)hipOccupancyMaxActiveBlocksPerMultiprocessor(&per_cu, mega, 256, 0);
    if (per_cu < 1) per_cu = 1;
    if (per_cu > 2) per_cu = 2;
    grid_blocks = cus * per_cu;
  }
  Params p{};
  const float** ins = (const float**)&p.x_prompt;
  for (int i = 0; i < 31; ++i) ins[i] = (const float*)d_in[i];
  p.out = (float*)d_out;
  char* w = (char*)d_ws;
  size_t off = 0;
  auto take = [&](size_t bytes) { char* r = w + off; off += (bytes + 255) & ~(size_t)255; return r; };
  p.X = (float*)take((size_t)NROW * 1024 * 4);
  p.QKV = (float*)take((size_t)NROW * 1536 * 4);
  p.BGR = (float*)take((size_t)NROW * 8 * 4);
  p.BG = (float*)take((size_t)NROW * 8 * 4);
  p.CONV = (float*)take((size_t)NROW * 512 * 4);
  p.ODN = (float*)take((size_t)NROW * 512 * 4);
  p.U = (float*)take((size_t)1024 * 8192 * 4);
  p.GL = (float*)take(4096);
  p.SS = (float*)take((size_t)4 * NROW * 4);
  p.H = (bfr*)take((size_t)NROW * 1024 * 2);
  p.PB = (bfr*)take((size_t)NROW * 3584 * 2);
  p.MIX = (bfr*)take((size_t)NROW * 1024 * 2);
  p.ACT2 = (bfr*)take((size_t)NROW * 1024 * 2);
  p.ACT3 = (bfr*)take((size_t)NROW * 1024 * 2);
  p.KB = (bfr*)take((size_t)2 * 2048 * 1024 * 2);
  p.VT = (bfr*)take((size_t)2 * 2048 * 1024 * 2);
  p.MPB = (bfr*)take((size_t)2048 * 1024 * 2);
  p.WtInE = (bfr*)take((size_t)3712 * 1024 * 2);
  p.WtOutE = (bfr*)take((size_t)1024 * 1024 * 2);
  p.WtInO = (bfr*)take((size_t)2048 * 1024 * 2);
  p.WtPool = (bfr*)take((size_t)4 * 256 * 256 * 2);
  p.WtOutO = (bfr*)take((size_t)1024 * 1024 * 2);
  p.WtXq = (bfr*)take((size_t)2 * 1024 * 1024 * 2);
  p.WtXk = (bfr*)take((size_t)2 * 1024 * 1024 * 2);
  p.WtXv = (bfr*)take((size_t)2 * 1024 * 1024 * 2);
  p.WtXo = (bfr*)take((size_t)2 * 1024 * 1024 * 2);
  p.WN = (uint4*)take((size_t)1024 * 1024 * 16);
  p.QD = (uint4*)take((size_t)1024 * 1024 * 16);
  p.KD = (uint4*)take((size_t)1024 * 1024 * 16);
  p.QKF = (uint4*)take((size_t)1024 * 512 * 16);
  p.bar = (unsigned*)take((size_t)XCD_BAR_WORDS * 4);
  if (off > ws_size) {
    fprintf(stderr, "kernel_launch: workspace too small: need %zu have %zu\n", off, ws_size);
    return;
  }
  p.phase_lo = 0;
  p.phase_hi = 20;
  if (hipMemsetAsync(p.bar, 0, (size_t)XCD_BAR_WORDS * 4, stream) != hipSuccess) { fprintf(stderr, "memset failed\n"); return; }
  void* args[] = {&p};
  hipError_t e = hipLaunchCooperativeKernel((void*)mega, dim3(grid_blocks), dim3(256), args, 0, stream);
  if (e != hipSuccess) fprintf(stderr, "cooperative launch failed: %s (grid %d)\n", hipGetErrorString(e), grid_blocks);
}
```

```cpp
#include <hip/hip_runtime.h>
#include <hip/hip_cooperative_groups.h>
#include <cstdio>
namespace cg = cooperative_groups;

#define DI __device__ __forceinline__
typedef unsigned short bfr;
using bf16x8 = __attribute__((ext_vector_type(8))) short;
using f32x16 = __attribute__((ext_vector_type(16))) float;
typedef __bf16 bf2_t __attribute__((ext_vector_type(2)));
typedef float fl2_t __attribute__((ext_vector_type(2)));
typedef unsigned u32x4 __attribute__((ext_vector_type(4)));
#define MFMA32(a, b, c) __builtin_amdgcn_mfma_f32_32x32x16_bf16((a), (b), (c), 0, 0, 0)

constexpr int NROW = 16512;
constexpr int NPR = 16384;
constexpr int DM = 1024;
constexpr int EIN = 3592, EINP = 3584;
constexpr float EPSF = 1e-6f;

constexpr size_t O_Y = 0;
constexpr size_t O_CONVP = 16777216 + 131072;
constexpr size_t O_QKVP = O_CONVP + 122880;
constexpr size_t O_DELTAP = O_QKVP + 36864;
constexpr size_t O_POOLP = O_DELTAP + 524288;
constexpr size_t O_MEMK = O_POOLP + 122880;
constexpr size_t O_MEMV = O_MEMK + 4194304;
constexpr size_t O_CONVS = O_MEMV + 4194304;
constexpr size_t O_QKVS = O_CONVS + 1966080;
constexpr size_t O_DELTAS = O_QKVS + 589824;
constexpr size_t O_POOLS = O_DELTAS + 8388608;

struct Params {
  const float *x_prompt, *x_sample, *state_conv_a, *state_qkv_conv, *state_delta, *state_pool, *cache_k, *cache_v, *mem_prompt;
  const float *norm_mix, *norm_xattn, *norm_final, *w_in_even, *w_out_even, *dw_w, *dw_b, *ln_a_g, *ln_a_b, *sc_w, *a_log,
      *dt_bias, *dn_norm_g, *w_in_odd, *w_pool, *b_pool, *pool_scale, *w_out_odd, *w_xq, *w_xk, *w_xv, *w_xo;
  float* out;
  float *X, *QKV, *BGR, *BG, *CONV, *ODN, *U, *GL, *SS;
  bfr *H, *PB, *MIX, *ACT2, *ACT3, *KB, *VT, *MPB;
  bfr *WtInE, *WtOutE, *WtInO, *WtPool, *WtOutO, *WtXq, *WtXk, *WtXv, *WtXo;
  uint4 *WN, *QD, *KD, *QKF;
  unsigned* bar;
  int phase_lo, phase_hi;
};

DI int opaque_tid() { int t = threadIdx.x; asm volatile("" : "+v"(t)); return t; }
DI unsigned pack2(float a, float b) {
  fl2_t f = {a, b};
  bf2_t r = __builtin_convertvector(f, bf2_t);
  return __builtin_bit_cast(unsigned, r);
}
DI bfr f2bf(float a) { return (bfr)(pack2(a, 0.f) & 0xffffu); }
DI float bf2f(bfr u) { return __uint_as_float(((unsigned)u) << 16); }
DI float bflo(unsigned u) { return __uint_as_float(u << 16); }
DI float bfhi(unsigned u) { return __uint_as_float(u & 0xffff0000u); }
DI float sigmoidf_(float x) { return 1.0f / (1.0f + __expf(-x)); }
DI float siluf_(float x) { return x / (1.0f + __expf(-x)); }
#define DPPF(v, ctrl, rmask) __builtin_bit_cast(float, __builtin_amdgcn_update_dpp(0, __builtin_bit_cast(int, (v)), (ctrl), (rmask), 0xf, false))
DI float row16_sum(float v) {
  v += DPPF(v, 0xB1, 0xf);
  v += DPPF(v, 0x4E, 0xf);
  v += DPPF(v, 0x141, 0xf);
  v += DPPF(v, 0x140, 0xf);
  return v;
}
DI float half32_sum_hi(float v) {
  v = row16_sum(v);
  v += DPPF(v, 0x142, 0xa);
  return v;
}
DI float wave_sum(float v) {
  v = row16_sum(v);
  v += DPPF(v, 0x142, 0xa);
  v += DPPF(v, 0x143, 0xc);
  return __builtin_bit_cast(float, __builtin_amdgcn_readlane(__builtin_bit_cast(int, v), 63));
}
DI float wave_max(float v) {
#pragma unroll
  for (int o = 32; o >= 1; o >>= 1) v = fmaxf(v, __shfl_xor(v, o));
  return v;
}
DI int crow(int reg, int h) { return (reg & 3) + 8 * (reg >> 2) + 4 * h; }
DI bf16x8 pack8(const f32x16& x, int s) {
  uint4 p;
  p.x = pack2(x[8 * s + 0], x[8 * s + 1]);
  p.y = pack2(x[8 * s + 2], x[8 * s + 3]);
  p.z = pack2(x[8 * s + 4], x[8 * s + 5]);
  p.w = pack2(x[8 * s + 6], x[8 * s + 7]);
  return __builtin_bit_cast(bf16x8, p);
}
DI bf16x8 ldfrag(const uint4* p) { uint4 v = *p; return __builtin_bit_cast(bf16x8, v); }


#define XB_TMO      128
#define XB_XCNT(j)  (256  + 64 * (j))
#define XB_XSUB(j)  (1280 + 64 * (j))
#define XB_XGEN(j)  (2304 + 64 * (j))
#define XB_TOP      3328
#define XB_TOPGEN   3392
#define XCD_BAR_WORDS 3456
#define XB_SPIN_CAP (1u << 18)
#define LAS __attribute__((address_space(3)))
DI unsigned xb_ld(unsigned* p) { return __hip_atomic_load(p, __ATOMIC_RELAXED, __HIP_MEMORY_SCOPE_AGENT); }
DI unsigned xb_add(unsigned* p, unsigned v) { return __hip_atomic_fetch_add(p, v, __ATOMIC_RELAXED, __HIP_MEMORY_SCOPE_AGENT); }
DI unsigned xb_xcc_id() { return (unsigned)__builtin_amdgcn_s_getreg((3 << 11) | 20) & 0xFu; }
#define XB_SPIN(cond, bar) do { unsigned _sp = 0; while (cond) { __builtin_amdgcn_s_sleep(1); \
    if ((++_sp & 255u) == 0u) { if (xb_ld(&(bar)[XB_TMO])) break; if (_sp > XB_SPIN_CAP) { atomicAdd(&(bar)[XB_TMO], 1u); break; } } } } while (0)
struct XcdBarrier { unsigned* bar; unsigned x; volatile LAS unsigned* st; };
DI XcdBarrier xcd_barrier_post(unsigned* bar, volatile LAS unsigned* st) {
  XcdBarrier b; b.bar = bar; b.x = xb_xcc_id(); b.st = st;
  if (threadIdx.x == 0) (void)xb_add(&bar[XB_XCNT(b.x)], 1u);
  return b;
}
DI void xcd_barrier_complete(unsigned* bar, unsigned x, unsigned& nloc, unsigned& nx) {
  const unsigned G = gridDim.x * gridDim.y * gridDim.z;
  unsigned sum, cnt, mine, sp = 0u;
  for (;;) {
    sum = 0u; cnt = 0u; mine = 0u;
#pragma unroll
    for (unsigned j = 0; j < 16; ++j) { const unsigned c = xb_ld(&bar[XB_XCNT(j)]); sum += c; cnt += (c > 0u) ? 1u : 0u; mine = (j == x) ? c : mine; }
    if (sum == G) break;
    __builtin_amdgcn_s_sleep(1);
    if ((++sp & 255u) == 0u) { if (xb_ld(&bar[XB_TMO])) break; if (sp > XB_SPIN_CAP) { atomicAdd(&bar[XB_TMO], 1u); break; } }
  }
  nloc = mine > 0u ? mine : 1u; nx = cnt > 0u ? cnt : 1u;
}
DI void xcd_barrier(const XcdBarrier& b) {
  asm volatile("s_waitcnt vmcnt(0)" ::: "memory");
  __syncthreads();
  if (threadIdx.x == 0) {
    unsigned* bar = b.bar;
    __builtin_amdgcn_s_waitcnt(0);
    unsigned nloc = b.st[0], nx = b.st[1];
    if (nloc == 0u) { xcd_barrier_complete(bar, b.x, nloc, nx); b.st[0] = nloc; b.st[1] = nx; }
    const unsigned old = xb_add(&bar[XB_XSUB(b.x)], 1u);
    const unsigned gen = old / nloc;
    if (old + 1u == (gen + 1u) * nloc) {
      __builtin_amdgcn_fence(__ATOMIC_RELEASE, "agent");
      asm volatile("s_waitcnt vmcnt(0)" ::: "memory");
      const unsigned og = xb_add(&bar[XB_TOP], 1u);
      const unsigned tg = og / nx;
      if (og + 1u == (tg + 1u) * nx) xb_add(&bar[XB_TOPGEN], 1u);
      else XB_SPIN(xb_ld(&bar[XB_TOPGEN]) == tg, bar);
      __builtin_amdgcn_fence(__ATOMIC_ACQUIRE, "agent");
      xb_add(&bar[XB_XGEN(b.x)], 1u);
      asm volatile("s_waitcnt vmcnt(0)" ::: "memory");
    } else {
      XB_SPIN(xb_ld(&bar[XB_XGEN(b.x)]) == gen, bar);
      __builtin_amdgcn_fence(__ATOMIC_ACQUIRE, "agent");
      asm volatile("s_waitcnt vmcnt(0)" ::: "memory");
    }
  }
  __syncthreads();
}

constexpr int GSTAGE = (128 + 256) * 40;
template <int lda>
DI void gemm_mainloop(const bfr* __restrict__ A, const bfr* __restrict__ Bt, int NB, int K, int m0, int n0, char* smem, f32x16 (&acc)[2][4]) {
  bfr* S0 = (bfr*)smem;
  int tid = threadIdx.x;
  asm volatile("" : "+v"(tid));
  const int lane = tid & 63, wid = tid >> 6, wr = wid >> 1, wc = wid & 1;
  const int r = lane & 31, hl = lane >> 5;
#pragma unroll
  for (int i = 0; i < 2; ++i)
#pragma unroll
    for (int j = 0; j < 4; ++j)
#pragma unroll
      for (int q = 0; q < 16; ++q) acc[i][j][q] = 0.f;
  u32x4 ra[4], rb[4];
  const int nk = K >> 5;
  const int arow = tid >> 3, ac8 = tid & 7, apar = ac8 >> 2;
  const bfr* Ab = A + (m0 + arow) * lda + ac8 * 8;
  const int asoff = arow * 40 + (ac8 & 3) * 8;
  const int brow = tid >> 2, bc4 = tid & 3;
  const bfr* Bb = Bt + (n0 + brow) * 32 + bc4 * 8;
  const int bsoff = brow * 40 + bc4 * 8;
#define GA_LOAD(pr_) do { _Pragma("unroll") for (int i = 0; i < 4; ++i) ra[i] = *(const u32x4*)(Ab + (i * 32) * lda + (pr_) * 64); } while (0)
#define GB_LOAD(kt_) do { const bfr* bk_ = Bb + (kt_) * NB * 32; \
    _Pragma("unroll") for (int i = 0; i < 4; ++i) rb[i] = *(const u32x4*)(bk_ + (i * 64) * 32); } while (0)
#define G_STORE(kt_) do { bfr* as_ = S0 + ((kt_) & 1) * GSTAGE; bfr* bs_ = as_ + 128 * 40; \
    if (apar == ((kt_) & 1)) { _Pragma("unroll") for (int i = 0; i < 4; ++i) *(u32x4*)(as_ + asoff + i * 32 * 40) = ra[i]; } \
    _Pragma("unroll") for (int i = 0; i < 4; ++i) *(u32x4*)(bs_ + bsoff + i * 64 * 40) = rb[i]; } while (0)
  GA_LOAD(0);
  GB_LOAD(0);
  G_STORE(0);
  GB_LOAD(1);
  __syncthreads();
  for (int kt = 0; kt < nk; ++kt) {
    if (kt + 1 < nk) G_STORE(kt + 1);
    if (kt + 2 < nk) {
      GB_LOAD(kt + 2);
      if ((kt & 1) == 0) GA_LOAD((kt >> 1) + 1);
    }
    const bfr* As = S0 + (kt & 1) * GSTAGE;
    const bfr* Bs = As + 128 * 40;
#pragma unroll
    for (int ks = 0; ks < 2; ++ks) {
      bf16x8 af[2], bfg[4];
#pragma unroll
      for (int i = 0; i < 2; ++i) af[i] = *(const bf16x8*)(As + (wr * 64 + i * 32 + r) * 40 + ks * 16 + hl * 8);
#pragma unroll
      for (int j = 0; j < 4; ++j) bfg[j] = *(const bf16x8*)(Bs + (wc * 128 + j * 32 + r) * 40 + ks * 16 + hl * 8);
#pragma unroll
      for (int i = 0; i < 2; ++i)
#pragma unroll
        for (int j = 0; j < 4; ++j) acc[i][j] = MFMA32(af[i], bfg[j], acc[i][j]);
    }
    __syncthreads();
  }
#undef GA_LOAD
#undef GB_LOAD
#undef G_STORE
}

template <int lda, class Epi>
DI void gemm_tile(const bfr* __restrict__ A, const bfr* __restrict__ Bt, int NB, int K, int m0, int n0, char* smem, Epi epi) {
  f32x16 acc[2][4];
  gemm_mainloop<lda>(A, Bt, NB, K, m0, n0, smem, acc);
  int tid3 = threadIdx.x;
  asm volatile("" : "+v"(tid3));
  const int lane = tid3 & 63, wid = tid3 >> 6, wr = wid >> 1, wc = wid & 1, r = lane & 31, hl = lane >> 5;
#pragma unroll
  for (int i = 0; i < 2; ++i)
#pragma unroll
    for (int j = 0; j < 4; ++j)
#pragma unroll
      for (int q = 0; q < 16; ++q) {
        int row = m0 + wr * 64 + i * 32 + crow(q, hl);
        int col = n0 + wc * 128 + j * 32 + r;
        epi(row, col, acc[i][j][q]);
      }
}

template <bool RS, class Epi, class RowF>
DI void gemm_sample(const bfr* __restrict__ A, int lda, const bfr* __restrict__ Bt, int ldb, int K, int N, char* smem, Epi epi, RowF rowf) {
  const int tid = threadIdx.x, lane = tid & 63, wid = tid >> 6, r = lane & 31, hl = lane >> 5;
  float* red = (float*)smem;
  const int nun = 4 * (N >> 5);
  for (int u = blockIdx.x; u < nun; u += gridDim.x) {
    const int mu = u & 3, nu = u >> 2;
    const int kq = K >> 2, k0 = wid * kq;
    const bfr* ap = A + (size_t)(NPR + mu * 32 + r) * lda + k0 + hl * 8;
    const bfr* bp = Bt + ((size_t)(k0 >> 5) * ldb + nu * 32 + r) * 32 + hl * 8;
    f32x16 acc;
#pragma unroll
    for (int q = 0; q < 16; ++q) acc[q] = 0.f;
    if (K == 1024) {
#pragma unroll
      for (int ks = 0; ks < 16; ++ks) {
        bf16x8 af = *(const bf16x8*)(ap + ks * 16);
        bf16x8 bf = *(const bf16x8*)(bp + (size_t)(ks >> 1) * ldb * 32 + (ks & 1) * 16);
        acc = MFMA32(af, bf, acc);
      }
    } else {
      for (int ks = 0; ks < (kq >> 4); ++ks) {
        bf16x8 af = *(const bf16x8*)(ap + ks * 16);
        bf16x8 bf = *(const bf16x8*)(bp + (size_t)(ks >> 1) * ldb * 32 + (ks & 1) * 16);
        acc = MFMA32(af, bf, acc);
      }
    }
#pragma unroll
    for (int q = 0; q < 16; ++q) red[(wid * 16 + q) * 64 + lane] = acc[q];
    __syncthreads();
#pragma unroll
    for (int e = 0; e < 4; ++e) {
      const int q = wid + e * 4;
      const float v = red[q * 64 + lane] + red[(16 + q) * 64 + lane] + red[(32 + q) * 64 + lane] + red[(48 + q) * 64 + lane];
      const int row = NPR + mu * 32 + crow(q, hl), col = nu * 32 + r;
      float x = epi(row, col, v);
      if (RS) {
        float s2 = half32_sum_hi(x * x);
        if (r == 31) rowf(row, s2);
      }
    }
    __syncthreads();
  }
}

DI void transpose_tile(const float* __restrict__ W, int ldw, bfr* __restrict__ Wt, int NB, int k0, int n0, float* sm, int nvalid = 1 << 30) {
  const int tid = threadIdx.x;
#pragma unroll
  for (int i = 0; i < 16; ++i) {
    int idx = tid + i * 256, kk = idx >> 6, nn = idx & 63;
    sm[kk * 65 + nn] = (n0 + nn < nvalid) ? W[(size_t)(k0 + kk) * ldw + n0 + nn] : 0.f;
  }
  __syncthreads();
#pragma unroll
  for (int i = 0; i < 8; ++i) {
    int idx = tid + i * 256, nn = idx >> 5, kp = idx & 31;
    float a = sm[(2 * kp) * 65 + nn], b = sm[(2 * kp + 1) * 65 + nn];
    { const int k = k0 + 2 * kp; *(unsigned*)(Wt + ((size_t)(k >> 5) * NB + n0 + nn) * 32 + (k & 31)) = pack2(a, b); }
  }
  __syncthreads();
}

DI void transpose_item(const Params& p, int tt, float* sm) {
  const int t = tt - 32;
  if (tt < 928) {
    int kt = tt / 58, nt = tt % 58;
    transpose_tile(p.w_in_even, EIN, p.WtInE, 3712, kt * 64, nt * 64, sm, EIN);
  } else if (t < 1152) {
    int u = t - 896;
    transpose_tile(p.w_out_even, 1024, p.WtOutE, 1024, (u >> 4) * 64, (u & 15) * 64, sm);
  } else if (t < 1664) {
    int u = t - 1152;
    transpose_tile(p.w_in_odd, 2048, p.WtInO, 2048, (u >> 5) * 64, (u & 31) * 64, sm);
  } else if (t < 1728) {
    int u = t - 1664, g = u >> 4, v = u & 15;
    transpose_tile(p.w_pool + (size_t)g * 65536, 256, p.WtPool + (size_t)g * 65536, 256, (v >> 2) * 64, (v & 3) * 64, sm);
  } else if (t < 1984) {
    int u = t - 1728;
    transpose_tile(p.w_out_odd, 1024, p.WtOutO, 1024, (u >> 4) * 64, (u & 15) * 64, sm);
  } else {
    int u = t - 1984, m = u >> 8, v = u & 255;
    int which = m >> 1, l = m & 1;
    const float* src = (which == 0 ? p.w_xq : which == 1 ? p.w_xk : which == 2 ? p.w_xv : p.w_xo) + (size_t)l * 1048576;
    bfr* dst = (which == 0 ? p.WtXq : which == 1 ? p.WtXk : which == 2 ? p.WtXv : p.WtXo) + (size_t)l * 1048576;
    transpose_tile(src, 1024, dst, 1024, (v >> 4) * 64, (v & 15) * 64, sm);
  }
}
DI int transpose_early(int i) { return i < 928 ? i : (2016 + 512) + (i - 928); }
DI int transpose_late(int i) { return i < 1600 ? 928 + i : (2016 + 1536) + (i - 1600); }

DI void phase_prep(const Params& p, char* smem) {
  float* sm = (float*)smem;
  for (int i = blockIdx.x; i < 1952; i += gridDim.x) transpose_item(p, transpose_early(i), sm);
  {
    for (int i = blockIdx.x * 256 + threadIdx.x; i < 4 * NROW; i += gridDim.x * 256) p.SS[i] = 0.f;
    const int n4 = 2048 * 1024 / 4;
    for (int i = blockIdx.x * 256 + threadIdx.x; i < n4; i += gridDim.x * 256) {
      float4 v = ((const float4*)p.mem_prompt)[i];
      uint2 o;
      o.x = pack2(v.x, v.y);
      o.y = pack2(v.z, v.w);
      ((uint2*)p.MPB)[i] = o;
    }
  }
  {
    const int lane = threadIdx.x & 63, wid = threadIdx.x >> 6;
    float* wT = (float*)smem;
    for (int i = opaque_tid(); i < 2048; i += 256) {
      const int k = i >> 1, hf = i & 1;
      float4 w = *(const float4*)(p.w_in_even + (size_t)k * EIN + EINP + hf * 4);
      wT[(hf * 4 + 0) * 1024 + k] = w.x; wT[(hf * 4 + 1) * 1024 + k] = w.y;
      wT[(hf * 4 + 2) * 1024 + k] = w.z; wT[(hf * 4 + 3) * 1024 + k] = w.w;
    }
    __syncthreads();
    for (int row = blockIdx.x * 4 + wid; row < NROW; row += gridDim.x * 4) {
      const float* xr = row < NPR ? p.x_prompt + (size_t)row * DM : p.x_sample + (size_t)(row - NPR) * DM;
      float4 v[4];
      float ss = 0.f;
#pragma unroll
      for (int j = 0; j < 4; ++j) {
        v[j] = ((const float4*)xr)[j * 64 + lane];
        ss += v[j].x * v[j].x + v[j].y * v[j].y + v[j].z * v[j].z + v[j].w * v[j].w;
      }
      ss = wave_sum(ss);
      float inv = rsqrtf(ss * (1.0f / 1024.0f) + EPSF);
      float part[8];
#pragma unroll
      for (int c = 0; c < 8; ++c) part[c] = 0.f;
#pragma unroll
      for (int j = 0; j < 4; ++j) {
        float4 g = ((const float4*)p.norm_mix)[j * 64 + lane];
        uint2 o;
        const float h0 = v[j].x * inv * g.x, h1 = v[j].y * inv * g.y, h2 = v[j].z * inv * g.z, h3 = v[j].w * inv * g.w;
        o.x = pack2(h0, h1);
        o.y = pack2(h2, h3);
        ((uint2*)(p.H + (size_t)row * DM))[j * 64 + lane] = o;
#pragma unroll
        for (int c = 0; c < 8; ++c) {
          float4 w = ((const float4*)(wT + c * 1024))[j * 64 + lane];
          part[c] += h0 * w.x + h1 * w.y + h2 * w.z + h3 * w.w;
        }
      }
#pragma unroll
      for (int c = 0; c < 8; ++c) part[c] = wave_sum(part[c]);
      if (lane == 0) {
        float4 a = {part[0], part[1], part[2], part[3]}, b = {part[4], part[5], part[6], part[7]};
        ((float4*)(p.BGR + (size_t)row * 8))[0] = a;
        ((float4*)(p.BGR + (size_t)row * 8))[1] = b;
      }
    }
    __syncthreads();
  }
}

DI void phase_rmsnorm(const Params& p, const float* g) {
  const int lane = threadIdx.x & 63, wid = threadIdx.x >> 6;
  for (int row = blockIdx.x * 4 + wid; row < NROW; row += gridDim.x * 4) {
    const float* xr = p.X + (size_t)row * DM;
    float4 v[4];
    float ss = 0.f;
#pragma unroll
    for (int j = 0; j < 4; ++j) {
      v[j] = ((const float4*)xr)[j * 64 + lane];
      ss += v[j].x * v[j].x + v[j].y * v[j].y + v[j].z * v[j].z + v[j].w * v[j].w;
    }
    ss = wave_sum(ss);
    float inv = rsqrtf(ss * (1.0f / 1024.0f) + EPSF);
#pragma unroll
    for (int j = 0; j < 4; ++j) {
      float4 gg = ((const float4*)g)[j * 64 + lane];
      uint2 o;
      o.x = pack2(v[j].x * inv * gg.x, v[j].y * inv * gg.y);
      o.y = pack2(v[j].z * inv * gg.z, v[j].w * inv * gg.w);
      ((uint2*)(p.H + (size_t)row * DM))[j * 64 + lane] = o;
    }
  }
}

DI void phase_final_norm(const Params& p) {
  const float* ss = p.SS + 3 * NROW;
  for (int i = blockIdx.x * 256 + threadIdx.x; i < NROW * 256; i += gridDim.x * 256) {
    const int row = i >> 8, c4 = i & 255;
    float4 v = ((const float4*)p.X)[i];
    float4 g = ((const float4*)p.norm_final)[c4];
    const float inv = rsqrtf(ss[row] * (1.0f / 1024.0f) + EPSF);
    float4 o = {v.x * inv * g.x, v.y * inv * g.y, v.z * inv * g.z, v.w * inv * g.w};
    ((float4*)(p.out + O_Y))[i] = o;
  }
}

DI void phase_gemm_in_even(const Params& p, char* smem) {
  const int NT1 = 128 * 14, NT2 = 4 * 64;
  {
    bfr* PB = p.PB;
    gemm_sample<false>(p.H, 1024, p.WtInE, 3712, 1024, EINP, smem,
                       [=](int row, int col, float v) -> float { PB[(size_t)row * EINP + col] = f2bf(v); return 0.f; },
                       [=](int, float) {});
  }
  for (int t = blockIdx.x; t < NT1 + NT2; t += gridDim.x) {
    if (t < NT1) {
      int mt = t / 14, nt = t % 14;
      bfr* PB = p.PB;
      gemm_tile<1024>(p.H, p.WtInE, 3712, 1024, mt * 128, nt * 256, smem,
                [=](int row, int col, float v) { PB[(size_t)row * EINP + col] = f2bf(v); });
    } else {
      int u = t - NT1, gsel = u >> 6, v = u & 63, mt = v >> 2, nt = v & 3;
      int isv = gsel >> 1, l = gsel & 1;
      if (!isv) {
        float* o = p.out + O_MEMK + (size_t)l * 2097152;
        bfr* kb = p.KB + (size_t)l * 2097152;
        gemm_tile<1024>(p.MPB, p.WtXk + (size_t)l * 1048576, 1024, 1024, mt * 128, nt * 256, smem,
                  [=](int row, int col, float v) {
                    o[(size_t)row * 1024 + col] = v;
                    kb[(size_t)row * 1024 + col] = f2bf(v);
                  });
      } else {
        float* o = p.out + O_MEMV + (size_t)l * 2097152;
        bfr* vt = p.VT + (size_t)l * 2097152;
        gemm_tile<1024>(p.MPB, p.WtXv + (size_t)l * 1048576, 1024, 1024, mt * 128, nt * 256, smem,
                  [=](int row, int col, float v) {
                    o[(size_t)row * 1024 + col] = v;
                    const int ml = row & 15;
                    const int rowpart = (row >> 8) * 262144 + ((row & 255) >> 4) * 512 + ((ml >> 2) & 1) * 256 + (((ml >> 3) << 2) | (ml & 3));
                    const int colpart = (col >> 8) * 65536 + ((col & 255) >> 5) * 8192 + (col & 31) * 8;
                    vt[rowpart + colpart] = f2bf(v);
                  });
      }
    }
  }
}

template <bool IS_P, bool EDGE>
DI void qkv_token(const Params& p, int row, int lane) {
  const int t = row & 2047, b = row >> 11, s = row - NPR;
#pragma unroll 6
  for (int grp = 0; grp < 12; ++grp) {
    const int ch = grp * 128 + lane * 2;
    float x0[4], x1[4];
    if (IS_P) {
      unsigned u[4];
#pragma unroll
      for (int j = 0; j < 4; ++j) {
        const int rc = (!EDGE || t - 3 + j >= 0) ? (row - 3 + j) : row;
        u[j] = *(const unsigned*)(p.PB + (size_t)rc * EINP + 1536 + ch);
      }
#pragma unroll
      for (int j = 0; j < 4; ++j) {
        const bool ok = (!EDGE || t - 3 + j >= 0);
        x0[j] = ok ? bflo(u[j]) : 0.f;
        x1[j] = ok ? bfhi(u[j]) : 0.f;
      }
    } else {
#pragma unroll
      for (int j = 0; j < 3; ++j) {
        float2 f = *(const float2*)(p.state_qkv_conv + ((size_t)s * 3 + j) * 1536 + ch);
        x0[j] = f.x; x1[j] = f.y;
      }
      unsigned u = *(const unsigned*)(p.PB + (size_t)row * EINP + 1536 + ch);
      x0[3] = bflo(u); x1[3] = bfhi(u);
    }
    float a0 = 0.f, a1 = 0.f;
#pragma unroll
    for (int j = 0; j < 4; ++j) {
      float2 w = *(const float2*)(p.sc_w + (size_t)j * 1536 + ch);
      a0 += w.x * x0[j]; a1 += w.y * x1[j];
    }
    float y0 = siluf_(a0), y1 = siluf_(a1);
    if (grp < 8) {
      float ss = wave_sum(y0 * y0 + y1 * y1);
      float inv = rsqrtf(ss + EPSF);
      if (grp < 4) inv *= 0.08838834764831845f;
      y0 *= inv; y1 *= inv;
    }
    float2 o = {y0, y1};
    *(float2*)(p.QKV + (size_t)row * 1536 + ch) = o;
    if (IS_P) {
      if (t >= 2045) {
        float2 c = {x0[3], x1[3]};
        *(float2*)(p.out + O_QKVP + ((size_t)b * 3 + (t - 2045)) * 1536 + ch) = c;
      }
    } else {
      float2 c0 = {x0[1], x1[1]}, c1 = {x0[2], x1[2]}, c2 = {x0[3], x1[3]};
      *(float2*)(p.out + O_QKVS + ((size_t)s * 3 + 0) * 1536 + ch) = c0;
      *(float2*)(p.out + O_QKVS + ((size_t)s * 3 + 1) * 1536 + ch) = c1;
      *(float2*)(p.out + O_QKVS + ((size_t)s * 3 + 2) * 1536 + ch) = c2;
    }
  }
  if (lane < 4) {
    float bl = p.BGR[(size_t)row * 8 + lane], al = p.BGR[(size_t)row * 8 + 4 + lane];
    float beta = sigmoidf_(bl);
    float xx = al + p.dt_bias[lane];
    float sp = xx > 20.f ? xx : log1pf(__expf(xx));
    float g = -__expf(p.a_log[lane]) * sp;
    p.BG[(size_t)row * 8 + lane] = beta;
    p.BG[(size_t)row * 8 + 4 + lane] = g;
  }
}

template <int G0>
DI void qkv_run4_half(const Params& p, int row0, int lane) {
  const int t0 = row0 & 2047, b = row0 >> 11;
  unsigned u[4][7];
  float2 w[4][4];
#pragma unroll
  for (int i = 0; i < 7; ++i) {
    const int rr = (i >= 3 || t0 > 0) ? (row0 - 3 + i) : row0;
    const bfr* rp = p.PB + (size_t)rr * EINP + 1536 + G0 * 128 + lane * 2;
#pragma unroll
    for (int g = 0; g < 4; ++g) u[g][i] = *(const unsigned*)(rp + g * 128);
  }
#pragma unroll
  for (int j = 0; j < 4; ++j) {
    const float* wp = p.sc_w + (size_t)j * 1536 + G0 * 128 + lane * 2;
#pragma unroll
    for (int g = 0; g < 4; ++g) w[g][j] = *(const float2*)(wp + g * 128);
  }
  const float hm = (t0 > 0) ? 1.f : 0.f;
#pragma unroll
  for (int k = 0; k < 4; ++k) {
    const int row = row0 + k;
#pragma unroll
    for (int g = 0; g < 4; ++g) {
      const int grp = G0 + g;
      const int ch = grp * 128 + lane * 2;
      float a0 = 0.f, a1 = 0.f;
#pragma unroll
      for (int j = 0; j < 4; ++j) {
        const int i = k + j;
        const float m = (i >= 3) ? 1.f : hm;
        a0 += w[g][j].x * (bflo(u[g][i]) * m);
        a1 += w[g][j].y * (bfhi(u[g][i]) * m);
      }
      float y0 = siluf_(a0), y1 = siluf_(a1);
      if (grp < 8) {
        float ss = wave_sum(y0 * y0 + y1 * y1);
        float inv = rsqrtf(ss + EPSF);
        if (grp < 4) inv *= 0.08838834764831845f;
        y0 *= inv; y1 *= inv;
      }
      float2 o = {y0, y1};
      *(float2*)(p.QKV + (size_t)row * 1536 + ch) = o;
      if (t0 == 2044 && k >= 1) {
        float2 c = {bflo(u[g][k + 3]), bfhi(u[g][k + 3])};
        *(float2*)(p.out + O_QKVP + ((size_t)b * 3 + (k - 1)) * 1536 + ch) = c;
      }
    }
  }
}
DI void qkv_run4(const Params& p, int row0, int lane) {
  qkv_run4_half<0>(p, row0, lane);
  qkv_run4_half<4>(p, row0, lane);
  qkv_run4_half<8>(p, row0, lane);
  if (lane < 16) {
    const int row = row0 + (lane >> 2), hd = lane & 3;
    float bl = p.BGR[(size_t)row * 8 + hd], al = p.BGR[(size_t)row * 8 + 4 + hd];
    float beta = sigmoidf_(bl);
    float xx = al + p.dt_bias[hd];
    float sp = xx > 20.f ? xx : log1pf(__expf(xx));
    float g = -__expf(p.a_log[hd]) * sp;
    p.BG[(size_t)row * 8 + hd] = beta;
    p.BG[(size_t)row * 8 + 4 + hd] = g;
  }
}

DI void conv_a_prompt_item(const Params& p, int item, float* sm) {
  const int half = item & 1, tile = (item >> 1) & 63, b = item >> 7;
  const int tid = threadIdx.x, c = half * 256 + tid, t0 = tile * 32;
  {
    const int tg = tid >> 5, c8 = tid & 31;
    u32x4 vv[8], gg[8];
#pragma unroll
    for (int ps = 0; ps < 8; ++ps) {
      const int i = tg + 8 * ps;
      const int tt = t0 - 30 + i;
      const size_t row = (size_t)b * 2048 + ((tt >= 0 && i < 62) ? tt : t0);
      vv[ps] = *(const u32x4*)(p.PB + row * EINP + half * 256 + c8 * 8);
      gg[ps] = *(const u32x4*)(p.PB + row * EINP + 512 + half * 256 + c8 * 8);
    }
#pragma unroll
    for (int ps = 0; ps < 8; ++ps) {
      const int i = tg + 8 * ps;
      const int tt = t0 - 30 + i;
      const float msk = (tt >= 0) ? 1.f : 0.f;
      float o8[8];
#pragma unroll
      for (int e = 0; e < 4; ++e) {
        o8[2 * e] = bflo(vv[ps][e]) * sigmoidf_(bflo(gg[ps][e])) * msk;
        o8[2 * e + 1] = bfhi(vv[ps][e]) * sigmoidf_(bfhi(gg[ps][e])) * msk;
      }
      if (i < 62) {
        float4 a0 = {o8[0], o8[1], o8[2], o8[3]}, a1 = {o8[4], o8[5], o8[6], o8[7]};
        *(float4*)(sm + i * 256 + c8 * 8) = a0;
        *(float4*)(sm + i * 256 + c8 * 8 + 4) = a1;
      }
    }
    __syncthreads();
  }
  float w[31];
#pragma unroll
  for (int j = 0; j < 31; ++j) w[j] = p.dw_w[j * 512 + c];
  const float bias = p.dw_b[c];
#pragma unroll 1
  for (int o = 0; o < 32; ++o) {
    float acc = bias;
#pragma unroll
    for (int j = 0; j < 31; ++j) acc += w[j] * sm[(o + j) * 256 + tid];
    p.CONV[((size_t)b * 2048 + t0 + o) * 512 + c] = acc;
  }
  if (tile == 63) {
#pragma unroll 1
    for (int j = 0; j < 30; ++j) p.out[O_CONVP + ((size_t)b * 30 + j) * 512 + c] = sm[(32 + j) * 256 + tid];
  }
  __syncthreads();
}

DI void conv_a_sample_item(const Params& p, int s) {
  const int tid = threadIdx.x;
  const size_t row = NPR + s;
#pragma unroll
  for (int cc = 0; cc < 2; ++cc) {
    int c = tid + cc * 256;
    float val = bf2f(p.PB[row * EINP + c]);
    float gate = bf2f(p.PB[row * EINP + 512 + c]);
    float gl = val * sigmoidf_(gate);
    float acc = p.dw_b[c] + p.dw_w[30 * 512 + c] * gl;
#pragma unroll 6
    for (int j = 0; j < 30; ++j) {
      float st = p.state_conv_a[((size_t)s * 30 + j) * 512 + c];
      acc += p.dw_w[j * 512 + c] * st;
      if (j >= 1) p.out[O_CONVS + ((size_t)s * 30 + j - 1) * 512 + c] = st;
    }
    p.out[O_CONVS + ((size_t)s * 30 + 29) * 512 + c] = gl;
    p.CONV[row * 512 + c] = acc;
  }
}

DI void phase_even_pw_conv(const Params& p, char* smem) {
  for (int it = blockIdx.x; it < 1024 + 128; it += gridDim.x) {
    if (it < 1024) conv_a_prompt_item(p, it, (float*)smem);
    else conv_a_sample_item(p, it - 1024);
  }
}
DI void phase_even_pw_qkv(const Params& p) {
  const int lane = threadIdx.x & 63, wid = threadIdx.x >> 6;
  for (int run = blockIdx.x * 4 + wid; run < NPR / 4; run += gridDim.x * 4) qkv_run4(p, run * 4, lane);
  for (int row = NPR + blockIdx.x * 4 + wid; row < NROW; row += gridDim.x * 4) qkv_token<false, false>(p, row, lane);
}
DI void phase_even_pointwise(const Params& p, char* smem) {
  phase_even_pw_conv(p, smem);
  phase_even_pw_qkv(p);
}

DI void chunk_prep(const Params& p, int item, char* smem) {
  const int tid = threadIdx.x, lane = tid & 63, wid = tid >> 6, r = lane & 31, hl = lane >> 5;
  const int n = item & 31, hh = (item >> 5) & 3, b = item >> 7;
  const size_t row0 = (size_t)b * 2048 + n * 64;
  float* gcs = (float*)smem;
  float* betas = gcs + 64;
  float* egs = betas + 64;
  float* kscale = egs + 64;
  bfr* qs = (bfr*)(smem + 1024);
  bfr* ks_ = qs + 64 * 136;
  float* Am = (float*)(smem + 1024 + 2 * 64 * 136 * 2);
  bfr* wsb = qs;
  if (tid < 64) {
    float beta = p.BG[(row0 + tid) * 8 + hh];
    float g = p.BG[(row0 + tid) * 8 + 4 + hh];
    float v = g;
#pragma unroll
    for (int off = 1; off < 64; off <<= 1) {
      float t = __shfl_up(v, off);
      if (lane >= off) v += t;
    }
    float gl = __shfl(v, 63);
    gcs[tid] = v;
    betas[tid] = beta;
    egs[tid] = __expf(v);
    kscale[tid] = __expf(gl - v);
    if (tid == 63) p.GL[item] = __expf(gl);
  }
#pragma unroll
  for (int i = 0; i < 8; ++i) {
    int idx = tid + i * 256, row = idx >> 5, c4 = idx & 31;
    float4 q = *(const float4*)(p.QKV + (row0 + row) * 1536 + hh * 128 + c4 * 4);
    float4 k = *(const float4*)(p.QKV + (row0 + row) * 1536 + 512 + hh * 128 + c4 * 4);
    uint2 qo, ko;
    qo.x = pack2(q.x, q.y); qo.y = pack2(q.z, q.w);
    ko.x = pack2(k.x, k.y); ko.y = pack2(k.z, k.w);
    *(uint2*)(qs + row * 136 + c4 * 4) = qo;
    *(uint2*)(ks_ + row * 136 + c4 * 4) = ko;
  }
  __syncthreads();
  {
    const int mi = wid >> 1, ni = wid & 1;
    f32x16 akk, aqk;
#pragma unroll
    for (int q = 0; q < 16; ++q) { akk[q] = 0.f; aqk[q] = 0.f; }
#pragma unroll
    for (int ks = 0; ks < 8; ++ks) {
      bf16x8 ka = *(const bf16x8*)(ks_ + (mi * 32 + r) * 136 + ks * 16 + hl * 8);
      bf16x8 qa = *(const bf16x8*)(qs + (mi * 32 + r) * 136 + ks * 16 + hl * 8);
      bf16x8 kb = *(const bf16x8*)(ks_ + (ni * 32 + r) * 136 + ks * 16 + hl * 8);
      akk = MFMA32(ka, kb, akk);
      aqk = MFMA32(qa, kb, aqk);
    }
    bfr* qkf = (bfr*)(p.QKF + (size_t)item * 512);
#pragma unroll
    for (int q = 0; q < 16; ++q) {
      int i = mi * 32 + crow(q, hl), j = ni * 32 + r;
      float dec = (i >= j) ? __expf(gcs[i] - gcs[j]) : 0.f;
      Am[i * 68 + j] = (i > j) ? akk[q] * betas[i] * dec : 0.f;
      float qv = (i >= j) ? aqk[q] * dec : 0.f;
      int ksj = j >> 4, jl = j & 15, h2 = (jl >> 2) & 1, jj = ((jl >> 3) << 2) | (jl & 3);
      qkf[((mi * 4 + ksj) * 64 + h2 * 32 + (i & 31)) * 8 + jj] = f2bf(qv);
    }
  }
  {
    uint4* QD = p.QD + (size_t)item * 1024;
#pragma unroll
    for (int i = 0; i < 4; ++i) {
      int idx = tid + i * 256, f = idx >> 6, ln = idx & 63, mt = f >> 3, ks = f & 7, m = ln & 31, h2 = ln >> 5;
      int ri = mt * 32 + m, d0 = ks * 16 + h2 * 4;
      float sc = egs[ri];
      const float* src = p.QKV + (row0 + ri) * 1536 + hh * 128 + d0;
      float4 a = *(const float4*)src, c = *(const float4*)(src + 8);
      uint4 o;
      o.x = pack2(a.x * sc, a.y * sc); o.y = pack2(a.z * sc, a.w * sc);
      o.z = pack2(c.x * sc, c.y * sc); o.w = pack2(c.z * sc, c.w * sc);
      QD[f * 64 + ln] = o;
    }
    uint4* KD = p.KD + (size_t)item * 1024;
#pragma unroll
    for (int i = 0; i < 4; ++i) {
      int idx = tid + i * 256, f = idx >> 6, ln = idx & 63, mt = f >> 2, ks = f & 3, m = ln & 31, h2 = ln >> 5;
      int d = mt * 32 + m;
      float vals[8];
#pragma unroll
      for (int j = 0; j < 8; ++j) {
        int c = ks * 16 + 8 * (j >> 2) + 4 * h2 + (j & 3);
        vals[j] = p.QKV[(row0 + c) * 1536 + 512 + hh * 128 + d] * kscale[c];
      }
      uint4 o;
      o.x = pack2(vals[0], vals[1]); o.y = pack2(vals[2], vals[3]);
      o.z = pack2(vals[4], vals[5]); o.w = pack2(vals[6], vals[7]);
      KD[f * 64 + ln] = o;
    }
  }
  __syncthreads();
  {
    const int c = tid;
    const float* src = (c < 128) ? (p.QKV + row0 * 1536 + 1024 + hh * 128 + c) : (p.QKV + row0 * 1536 + 512 + hh * 128 + (c - 128));
    float sol[64];
#pragma unroll
    for (int i = 0; i < 64; ++i) {
      float rhs = src[(size_t)i * 1536] * betas[i];
      if (c >= 128) rhs *= egs[i];
      float acc = rhs, acc1 = 0.f;
#pragma unroll
      for (int j = 0; j < i; ++j) {
        if (j & 1) acc1 -= Am[i * 68 + j] * sol[j];
        else acc -= Am[i * 68 + j] * sol[j];
      }
      sol[i] = acc + acc1;
    }
    if (c < 128) {
      float* U = p.U + (size_t)item * 8192;
#pragma unroll
      for (int i = 0; i < 64; ++i) U[i * 128 + c] = sol[i];
    } else {
#pragma unroll
      for (int i = 0; i < 64; ++i) wsb[i * 136 + (c - 128)] = f2bf(-sol[i]);
    }
  }
  __syncthreads();
  {
    uint4* WN = p.WN + (size_t)item * 1024;
#pragma unroll
    for (int i = 0; i < 4; ++i) {
      int idx = tid + i * 256, f = idx >> 6, ln = idx & 63, mt = f >> 3, ks = f & 7, m = ln & 31, h2 = ln >> 5;
      int ri = mt * 32 + m, d0 = ks * 16 + h2 * 4;
      uint2 a = *(const uint2*)(wsb + ri * 136 + d0), c = *(const uint2*)(wsb + ri * 136 + d0 + 8);
      uint4 o = {a.x, a.y, c.x, c.y};
      WN[f * 64 + ln] = o;
    }
  }
  __syncthreads();
}

DI void branch_a_final_row(const Params& p, int row, int lane) {
  const float* cr = p.CONV + (size_t)row * 512;
  float4 v[2];
  float s = 0.f;
#pragma unroll
  for (int j = 0; j < 2; ++j) {
    v[j] = ((const float4*)cr)[j * 64 + lane];
    s += v[j].x + v[j].y + v[j].z + v[j].w;
  }
  float mean = wave_sum(s) * (1.0f / 512.0f);
  float vs = 0.f;
#pragma unroll
  for (int j = 0; j < 2; ++j) {
    v[j].x -= mean; v[j].y -= mean; v[j].z -= mean; v[j].w -= mean;
    vs += v[j].x * v[j].x + v[j].y * v[j].y + v[j].z * v[j].z + v[j].w * v[j].w;
  }
  float inv = rsqrtf(wave_sum(vs) * (1.0f / 512.0f) + EPSF);
#pragma unroll
  for (int j = 0; j < 2; ++j) {
    int c = (j * 64 + lane) * 4;
    float4 g = *(const float4*)(p.ln_a_g + c), bb = *(const float4*)(p.ln_a_b + c);
    uint2 gu = *(const uint2*)(p.PB + (size_t)row * EINP + 1024 + c);
    float y0 = siluf_(v[j].x * inv * g.x + bb.x) * siluf_(bflo(gu.x));
    float y1 = siluf_(v[j].y * inv * g.y + bb.y) * siluf_(bfhi(gu.x));
    float y2 = siluf_(v[j].z * inv * g.z + bb.z) * siluf_(bflo(gu.y));
    float y3 = siluf_(v[j].w * inv * g.w + bb.w) * siluf_(bfhi(gu.y));
    uint2 o;
    o.x = pack2(y0, y1); o.y = pack2(y2, y3);
    *(uint2*)(p.MIX + (size_t)row * 1024 + c) = o;
  }
}

DI void delta_sample_item(const Params& p, int item, char* smem) {
  const int s = item >> 2, hh = item & 3, tid = threadIdx.x;
  const size_t row = NPR + s;
  float* ksm = (float*)smem;
  float* qsm = ksm + 128;
  float* part = qsm + 128;
  if (tid < 128) ksm[tid] = p.QKV[row * 1536 + 512 + hh * 128 + tid];
  else qsm[tid - 128] = p.QKV[row * 1536 + hh * 128 + (tid - 128)];
  const float beta = p.BG[row * 8 + hh], a = __expf(p.BG[row * 8 + 4 + hh]);
  __syncthreads();
  const int e = tid & 127, half = tid >> 7, d0 = half * 64;
  const float* S0 = p.state_delta + (((size_t)s * 4 + hh) * 128 + d0) * 128 + e;
  float* So = p.out + O_DELTAS + (((size_t)s * 4 + hh) * 128 + d0) * 128 + e;
  float Sr[64];
  float ksum = 0.f;
#pragma unroll
  for (int i = 0; i < 64; ++i) {
    Sr[i] = S0[(size_t)i * 128] * a;
    ksum += ksm[d0 + i] * Sr[i];
  }
  part[half * 128 + e] = ksum;
  __syncthreads();
  const float kS = part[e] + part[128 + e];
  const float v = p.QKV[row * 1536 + 1024 + hh * 128 + e];
  const float vnew = (v - kS) * beta;
  float oo = 0.f;
#pragma unroll
  for (int i = 0; i < 64; ++i) {
    Sr[i] += ksm[d0 + i] * vnew;
    So[(size_t)i * 128] = Sr[i];
    oo += qsm[d0 + i] * Sr[i];
  }
  __syncthreads();
  part[half * 128 + e] = oo;
  __syncthreads();
  if (half == 0) p.ODN[row * 512 + hh * 128 + e] = part[e] + part[128 + e];
  __syncthreads();
}

DI void phase_chunk_prep(const Params& p, char* smem) {
  for (int it = blockIdx.x; it < 1024; it += gridDim.x) chunk_prep(p, it, smem);
}

DI void scan_item(const Params& p, int item, char* smem) {
  const int tid = threadIdx.x, lane = tid & 63, es = tid >> 6, r = lane & 31, hl = lane >> 5;
  const int b = item >> 2, hh = item & 3;
  u32x4* bufA = (u32x4*)smem;
  u32x4* bufB = (u32x4*)(smem + 32768);
  const u32x4* gWN = (const u32x4*)p.WN + (size_t)item * 32 * 1024;
  const u32x4* gQD = (const u32x4*)p.QD + (size_t)item * 32 * 1024;
  const u32x4* gKD = (const u32x4*)p.KD + (size_t)item * 32 * 1024;
  const u32x4* gQK = (const u32x4*)p.QKF + (size_t)item * 32 * 512;
  const float* gU = p.U + (size_t)item * 32 * 8192;
  const int uo = hl * 4 * 128 + es * 32 + r;
  const int oo = hl * 4 * 512 + es * 32 + r;
#define GLDS(gp, lp) __builtin_amdgcn_global_load_lds((const unsigned*)(gp), (unsigned*)(lp), 16, 0, 0)
  f32x16 S[4];
#pragma unroll
  for (int d = 0; d < 4; ++d)
#pragma unroll
    for (int q = 0; q < 16; ++q) S[d][q] = 0.f;
  f32x16 vn[2], o[2], op[2];
#pragma unroll
  for (int i = 0; i < 4; ++i) {
    GLDS(gWN + tid + i * 256, bufA + tid + i * 256);
    GLDS(gQD + tid + i * 256, bufA + 1024 + tid + i * 256);
  }
#pragma unroll
  for (int ct = 0; ct < 2; ++ct)
#pragma unroll
    for (int q = 0; q < 16; ++q) vn[ct][q] = gU[(ct * 32 + crow(q, 0)) * 128 + uo];
  asm volatile("s_waitcnt vmcnt(0)" ::: "memory");
  __syncthreads();
#pragma unroll 1
  for (int n = 0; n < 32; ++n) {
    const int chunk = item * 32 + n;
    const float gl = p.GL[chunk];
    const int n1 = (n + 1 < 32) ? n + 1 : 31;
    if (n > 0) {
      float* odp = p.ODN + ((size_t)b * 2048 + (n - 1) * 64) * 512 + hh * 128;
#pragma unroll
      for (int ct = 0; ct < 2; ++ct)
#pragma unroll
        for (int q = 0; q < 16; ++q) odp[(ct * 32 + crow(q, 0)) * 512 + oo] = op[ct][q];
    }
    {
      const u32x4* k0 = gQK + n * 512;
      const u32x4* d0 = gKD + n * 1024;
#pragma unroll
      for (int i = 0; i < 2; ++i) GLDS(k0 + tid + i * 256, bufB + tid + i * 256);
#pragma unroll
      for (int i = 0; i < 4; ++i) GLDS(d0 + tid + i * 256, bufB + 512 + tid + i * 256);
    }
    {
      bf16x8 Sb[4][2];
#pragma unroll
      for (int d = 0; d < 4; ++d) { Sb[d][0] = pack8(S[d], 0); Sb[d][1] = pack8(S[d], 1); }
#pragma unroll
      for (int ct = 0; ct < 2; ++ct)
#pragma unroll
        for (int q = 0; q < 16; ++q) o[ct][q] = 0.f;
#pragma unroll
      for (int ct = 0; ct < 2; ++ct)
#pragma unroll
        for (int ks = 0; ks < 8; ++ks) {
          bf16x8 aw = __builtin_bit_cast(bf16x8, bufA[(ct * 8 + ks) * 64 + lane]);
          bf16x8 aq = __builtin_bit_cast(bf16x8, bufA[1024 + (ct * 8 + ks) * 64 + lane]);
          vn[ct] = MFMA32(aw, Sb[ks >> 1][ks & 1], vn[ct]);
          o[ct] = MFMA32(aq, Sb[ks >> 1][ks & 1], o[ct]);
        }
    }
    bf16x8 Vb[2][2];
#pragma unroll
    for (int ct = 0; ct < 2; ++ct) { Vb[ct][0] = pack8(vn[ct], 0); Vb[ct][1] = pack8(vn[ct], 1); }
    asm volatile("s_waitcnt vmcnt(0)" ::: "memory");
    __syncthreads();
    {
      const u32x4* w1 = gWN + n1 * 1024;
      const u32x4* q1 = gQD + n1 * 1024;
#pragma unroll
      for (int i = 0; i < 4; ++i) {
        GLDS(w1 + tid + i * 256, bufA + tid + i * 256);
        GLDS(q1 + tid + i * 256, bufA + 1024 + tid + i * 256);
      }
      const float* u1 = gU + n1 * 8192;
#pragma unroll
      for (int ct = 0; ct < 2; ++ct)
#pragma unroll
        for (int q = 0; q < 16; ++q) vn[ct][q] = u1[(ct * 32 + crow(q, 0)) * 128 + uo];
    }
#pragma unroll
    for (int ct = 0; ct < 2; ++ct)
#pragma unroll
      for (int ks = 0; ks < 4; ++ks) {
        bf16x8 a = __builtin_bit_cast(bf16x8, bufB[(ct * 4 + ks) * 64 + lane]);
        o[ct] = MFMA32(a, Vb[ks >> 1][ks & 1], o[ct]);
      }
#pragma unroll
    for (int d = 0; d < 4; ++d) {
#pragma unroll
      for (int q = 0; q < 16; ++q) S[d][q] *= gl;
#pragma unroll
      for (int ks = 0; ks < 4; ++ks) {
        bf16x8 a = __builtin_bit_cast(bf16x8, bufB[512 + (d * 4 + ks) * 64 + lane]);
        S[d] = MFMA32(a, Vb[ks >> 1][ks & 1], S[d]);
      }
    }
#pragma unroll
    for (int ct = 0; ct < 2; ++ct) op[ct] = o[ct];
    asm volatile("s_waitcnt vmcnt(0)" ::: "memory");
    __syncthreads();
  }
  {
    float* odp = p.ODN + ((size_t)b * 2048 + 31 * 64) * 512 + hh * 128;
#pragma unroll
    for (int ct = 0; ct < 2; ++ct)
#pragma unroll
      for (int q = 0; q < 16; ++q) odp[(ct * 32 + crow(q, 0)) * 512 + oo] = op[ct][q];
  }
#undef GLDS
  float* so = p.out + O_DELTAP + ((size_t)(b * 4 + hh) * 128) * 128;
#pragma unroll
  for (int d = 0; d < 4; ++d)
#pragma unroll
    for (int q = 0; q < 16; ++q) so[(d * 32 + crow(q, 0)) * 128 + uo] = S[d][q];
  __syncthreads();
}

DI void phase_scan(const Params& p, char* smem) {
  const int lane = threadIdx.x & 63, wid = threadIdx.x >> 6;
  if (gridDim.x >= 64) {
    if (blockIdx.x < 32) {
      scan_item(p, blockIdx.x, smem);
    } else {
      const int nb = gridDim.x - 32, bi = blockIdx.x - 32;
      for (int it = bi; it < 512; it += nb) delta_sample_item(p, it, smem);
      for (int row = bi * 4 + wid; row < NROW; row += nb * 4) branch_a_final_row(p, row, lane);
      __syncthreads();
      for (int i = bi; i < 2112; i += nb) transpose_item(p, transpose_late(i), (float*)smem);
    }
  } else {
    for (int it = blockIdx.x; it < 32; it += gridDim.x) scan_item(p, it, smem);
    for (int it = blockIdx.x; it < 512; it += gridDim.x) delta_sample_item(p, it, smem);
    for (int row = blockIdx.x * 4 + wid; row < NROW; row += gridDim.x * 4) branch_a_final_row(p, row, lane);
    __syncthreads();
    for (int i = blockIdx.x; i < 2112; i += gridDim.x) transpose_item(p, transpose_late(i), (float*)smem);
  }
}

DI void phase_delta_post(const Params& p) {
  const int lane = threadIdx.x & 63, wid = threadIdx.x >> 6;
  const int stride = gridDim.x * 4;
  const float2 g = *(const float2*)(p.dn_norm_g + lane * 2);
  for (int row = blockIdx.x * 4 + wid; row < NROW; row += 2 * stride) {
    const int r1 = row + stride;
    const bool has1 = r1 < NROW;
    const int rows[2] = {row, has1 ? r1 : row};
    float2 o[2][4];
    unsigned zu[2][4];
#pragma unroll
    for (int k = 0; k < 2; ++k)
#pragma unroll
      for (int hh = 0; hh < 4; ++hh) {
        const int ch = hh * 128 + lane * 2;
        o[k][hh] = *(const float2*)(p.ODN + (size_t)rows[k] * 512 + ch);
        zu[k][hh] = *(const unsigned*)(p.PB + (size_t)rows[k] * EINP + 3072 + ch);
      }
#pragma unroll
    for (int k = 0; k < 2; ++k)
#pragma unroll
      for (int hh = 0; hh < 4; ++hh) {
        const int ch = hh * 128 + lane * 2;
        float ss = wave_sum(o[k][hh].x * o[k][hh].x + o[k][hh].y * o[k][hh].y);
        float inv = rsqrtf(ss * (1.0f / 128.0f) + EPSF);
        float y0 = o[k][hh].x * inv * g.x * siluf_(bflo(zu[k][hh]));
        float y1 = o[k][hh].y * inv * g.y * siluf_(bfhi(zu[k][hh]));
        if (k == 0 || has1) *(unsigned*)(p.MIX + (size_t)rows[k] * 1024 + 512 + ch) = pack2(y0, y1);
      }
  }
}

template <bool FIRST, bool HAS_H>
DI void phase_gemm_resid(const Params& p, const bfr* A, const bfr* Wt, const float* gnext, float* ss, char* smem) {
  float* X = p.X;
  bfr* Hn = p.H;
  {
    const float* xs = p.x_sample - (size_t)NPR * 1024;
    gemm_sample<true>(A, 1024, Wt, 1024, 1024, 1024, smem,
                      [=](int row, int col, float v) -> float {
                        const size_t o = (size_t)row * 1024 + col;
                        const float xn = (FIRST ? xs[o] : X[o]) + v;
                        X[o] = xn;
                        if (HAS_H) Hn[o] = f2bf(xn * gnext[col]);
                        return xn;
                      },
                      [=](int row, float s2) { unsafeAtomicAdd(ss + row, s2); });
  }
  for (int t = blockIdx.x; t < 128 * 4; t += gridDim.x) {
    const int mt = t >> 2, nt = t & 3, m0 = mt * 128, n0 = nt * 256;
    f32x16 acc[2][4];
    gemm_mainloop<1024>(A, Wt, 1024, 1024, m0, n0, smem, acc);
    int tid2 = threadIdx.x;
    asm volatile("" : "+v"(tid2));
    const int lane = tid2 & 63, wid = tid2 >> 6, wr = wid >> 1, wc = wid & 1, r = lane & 31, hl = lane >> 5;
    const float* xsrc = FIRST ? p.x_prompt : X;
    const int rbase = m0 + wr * 64 + 4 * hl, cbase = n0 + wc * 128 + r;
#pragma unroll
    for (int i = 0; i < 2; ++i) {
#pragma unroll
      for (int qh = 0; qh < 2; ++qh) {
        float rs[8];
#pragma unroll
        for (int q = 0; q < 8; ++q) rs[q] = 0.f;
#pragma unroll
        for (int jh = 0; jh < 2; ++jh) {
          float xo[2][8];
#pragma unroll
          for (int jj = 0; jj < 2; ++jj)
#pragma unroll
            for (int q = 0; q < 8; ++q)
              xo[jj][q] = xsrc[(rbase + i * 32 + crow(qh * 8 + q, 0)) * 1024 + cbase + (jh * 2 + jj) * 32];
#pragma unroll
          for (int q = 0; q < 8; ++q) {
            const int o = (rbase + i * 32 + crow(qh * 8 + q, 0)) * 1024 + cbase;
#pragma unroll
            for (int jj = 0; jj < 2; ++jj) {
              const int j = jh * 2 + jj;
              const float xn = xo[jj][q] + acc[i][j][qh * 8 + q];
              X[o + j * 32] = xn;
              if (HAS_H) Hn[o + j * 32] = f2bf(xn * gnext[cbase + j * 32]);
              rs[q] += xn * xn;
            }
          }
        }
#pragma unroll
        for (int q = 0; q < 8; ++q) rs[q] = half32_sum_hi(rs[q]);
        if (r == 31) {
#pragma unroll
          for (int q = 0; q < 8; ++q) unsafeAtomicAdd(ss + rbase + i * 32 + crow(qh * 8 + q, 0), rs[q]);
        }
      }
    }
  }
}
DI void phase_gemm_bf16out(const Params& p, const bfr* A, const bfr* Wt, bfr* C, int N, const float* ss, char* smem) {
  const int ntn = N >> 8;
  gemm_sample<false>(A, 1024, Wt, N, 1024, N, smem,
                     [=](int row, int col, float v) -> float {
                       float inv = rsqrtf(ss[row] * (1.0f / 1024.0f) + EPSF);
                       C[(size_t)row * N + col] = f2bf(v * inv);
                       return 0.f;
                     },
                     [=](int, float) {});
  for (int t = blockIdx.x; t < 128 * ntn; t += gridDim.x) {
    int mt = t / ntn, nt = t % ntn;
    gemm_tile<1024>(A, Wt, N, 1024, mt * 128, nt * 256, smem,
              [=](int row, int col, float v) {
                float inv = rsqrtf(ss[row] * (1.0f / 1024.0f) + EPSF);
                C[(size_t)row * N + col] = f2bf(v * inv);
              });
  }
}

DI void attn_prompt_wave(const Params& p, int l, int b, int hh, int tt, bfr* Obuf) {
  const int lane = threadIdx.x & 63, r = lane & 31, hl = lane >> 5;
  const size_t row0 = (size_t)b * 2048 + tt * 32;
  const bfr* Qp = p.ACT2 + (row0 + r) * 1024 + hh * 256 + hl * 8;
  const bfr* Kp = p.KB + (size_t)l * 2097152 + ((size_t)b * 256 + r) * 1024 + hh * 256 + hl * 8;
  f32x16 st[8];
#pragma unroll
  for (int m = 0; m < 8; ++m)
#pragma unroll
    for (int q = 0; q < 16; ++q) st[m][q] = 0.f;
#pragma unroll 2
  for (int ks = 0; ks < 16; ++ks) {
    bf16x8 qf = *(const bf16x8*)(Qp + ks * 16);
#pragma unroll
    for (int m = 0; m < 8; ++m) {
      bf16x8 kf = *(const bf16x8*)(Kp + (size_t)m * 32 * 1024 + ks * 16);
      st[m] = MFMA32(kf, qf, st[m]);
    }
  }
  float mx = -3.0e38f;
#pragma unroll
  for (int m = 0; m < 8; ++m)
#pragma unroll
    for (int q = 0; q < 16; ++q) mx = fmaxf(mx, st[m][q]);
  mx = fmaxf(mx, __shfl_xor(mx, 32));
  float sum = 0.f;
#pragma unroll
  for (int m = 0; m < 8; ++m)
#pragma unroll
    for (int q = 0; q < 16; ++q) {
      float e = __expf((st[m][q] - mx) * 0.0625f);
      st[m][q] = e;
      sum += e;
    }
  sum += __shfl_xor(sum, 32);
  const float inv = 1.0f / sum;
  bf16x8 pb[8][2];
#pragma unroll
  for (int m = 0; m < 8; ++m) { pb[m][0] = pack8(st[m], 0); pb[m][1] = pack8(st[m], 1); }
  const uint4* VT = (const uint4*)(p.VT + (size_t)l * 2097152) + ((size_t)(b * 4 + hh) * 8) * 16 * 64 + lane;
  bfr* Op = Obuf + (row0 + r) * 1024 + hh * 256;
#pragma unroll 1
  for (int half = 0; half < 2; ++half) {
    f32x16 o[4];
#pragma unroll
    for (int d = 0; d < 4; ++d)
#pragma unroll
      for (int q = 0; q < 16; ++q) o[d][q] = 0.f;
#pragma unroll
    for (int ks = 0; ks < 16; ++ks) {
#pragma unroll
      for (int d = 0; d < 4; ++d) {
        bf16x8 vf = ldfrag(VT + ((size_t)(half * 4 + d) * 16 + ks) * 64);
        o[d] = MFMA32(vf, pb[ks >> 1][ks & 1], o[d]);
      }
    }
#pragma unroll
    for (int d = 0; d < 4; ++d)
#pragma unroll
      for (int g4 = 0; g4 < 4; ++g4) {
        int dim = (half * 4 + d) * 32 + 8 * g4 + 4 * hl;
        uint2 ov;
        ov.x = pack2(o[d][g4 * 4 + 0] * inv, o[d][g4 * 4 + 1] * inv);
        ov.y = pack2(o[d][g4 * 4 + 2] * inv, o[d][g4 * 4 + 3] * inv);
        *(uint2*)(Op + dim) = ov;
      }
  }
}

DI void attn_prompt_block(const Params& p, int l, int b, int hh, int tt4, char* smem, bfr* Obuf) {
  int tid = threadIdx.x;
  asm volatile("" : "+v"(tid));
  const int lane = tid & 63, wid = tid >> 6, r = lane & 31, hl = lane >> 5;
  const int row0 = b * 2048 + (tt4 * 4 + wid) * 32;
  const int qoff = (row0 + r) * 1024 + hh * 256 + hl * 8;
  const bfr* Kg = p.KB + (size_t)l * 2097152 + (size_t)(b * 256) * 1024 + hh * 256;
  const u32x4* VTg = (const u32x4*)(p.VT + (size_t)l * 2097152) + (size_t)((b * 4 + hh) * 8) * 16 * 64;
  bfr* kbuf = (bfr*)smem;
  u32x4* vbuf = (u32x4*)smem;
  u32x4 sr[8];
#define LOADK(c_) do { _Pragma("unroll") for (int i = 0; i < 4; ++i) { const int ch = tid + i * 256; \
    sr[i] = *(const u32x4*)(Kg + (ch >> 2) * 1024 + (c_) * 32 + (ch & 3) * 8); } } while (0)
#define STOREK() do { _Pragma("unroll") for (int i = 0; i < 4; ++i) { const int ch = tid + i * 256; \
    *(u32x4*)(kbuf + (ch >> 2) * 40 + (ch & 3) * 8) = sr[i]; } } while (0)
#define LOADV(v_, tid) do { _Pragma("unroll") for (int i = 0; i < 8; ++i) { const int idx = tid + i * 256, f = idx >> 6; \
    sr[i] = VTg[(((v_) >> 1) * 4 + (f >> 3)) * 1024 + (((v_) & 1) * 8 + (f & 7)) * 64 + (idx & 63)]; } } while (0)
#define STOREV(tid) do { _Pragma("unroll") for (int i = 0; i < 8; ++i) vbuf[tid + i * 256] = sr[i]; } while (0)
  f32x16 st[8];
#pragma unroll
  for (int m = 0; m < 8; ++m)
#pragma unroll
    for (int q = 0; q < 16; ++q) st[m][q] = 0.f;
  LOADK(0);
  STOREK();
  __syncthreads();
#pragma unroll
  for (int c = 0; c < 8; ++c) {
    if (c < 7) LOADK(c + 1); else LOADV(0, tid);
    bf16x8 qf[2];
#pragma unroll
    for (int ksl = 0; ksl < 2; ++ksl) qf[ksl] = *(const bf16x8*)(p.ACT2 + qoff + (c * 2 + ksl) * 16);
#pragma unroll
    for (int ksl = 0; ksl < 2; ++ksl)
#pragma unroll
      for (int m = 0; m < 8; ++m) {
        bf16x8 kf = *(const bf16x8*)(kbuf + (m * 32 + r) * 40 + ksl * 16 + hl * 8);
        st[m] = MFMA32(kf, qf[ksl], st[m]);
      }
    __syncthreads();
    if (c < 7) STOREK(); else STOREV(tid);
    __syncthreads();
  }
  float mx = -3.0e38f;
#pragma unroll
  for (int m = 0; m < 8; ++m)
#pragma unroll
    for (int q = 0; q < 16; ++q) mx = fmaxf(mx, st[m][q]);
  mx = fmaxf(mx, __shfl_xor(mx, 32));
  float sum = 0.f;
#pragma unroll
  for (int m = 0; m < 8; ++m)
#pragma unroll
    for (int q = 0; q < 16; ++q) {
      float e = __expf((st[m][q] - mx) * 0.0625f);
      st[m][q] = e;
      sum += e;
    }
  sum += __shfl_xor(sum, 32);
  const float inv = 1.0f / sum;
  bf16x8 pb[8][2];
#pragma unroll
  for (int m = 0; m < 8; ++m) { pb[m][0] = pack8(st[m], 0); pb[m][1] = pack8(st[m], 1); }
  int tidv = threadIdx.x;
  asm volatile("" : "+v"(tidv));
  const int lanev = tidv & 63, rv = lanev & 31, hlv = lanev >> 5;
  const int ooff = (b * 2048 + (tt4 * 4 + (tidv >> 6)) * 32 + rv) * 1024 + hh * 256;
  f32x16 o[4];
#pragma unroll
  for (int v = 0; v < 4; ++v) {
    if (v < 3) LOADV(v + 1, tidv);
    if ((v & 1) == 0) {
#pragma unroll
      for (int d = 0; d < 4; ++d)
#pragma unroll
        for (int q = 0; q < 16; ++q) o[d][q] = 0.f;
    }
#pragma unroll
    for (int kk = 0; kk < 8; ++kk)
#pragma unroll
      for (int d = 0; d < 4; ++d) {
        bf16x8 vf = __builtin_bit_cast(bf16x8, vbuf[(d * 8 + kk) * 64 + lanev]);
        o[d] = MFMA32(vf, pb[((v & 1) * 8 + kk) >> 1][kk & 1], o[d]);
        if (d == 3) __builtin_amdgcn_sched_barrier(0);
      }
    if (v & 1) {
#pragma unroll
      for (int d = 0; d < 4; ++d)
#pragma unroll
        for (int g4 = 0; g4 < 4; ++g4) {
          int dim = ((v >> 1) * 4 + d) * 32 + 8 * g4 + 4 * hlv;
          uint2 ov;
          ov.x = pack2(o[d][g4 * 4 + 0] * inv, o[d][g4 * 4 + 1] * inv);
          ov.y = pack2(o[d][g4 * 4 + 2] * inv, o[d][g4 * 4 + 3] * inv);
          *(uint2*)(Obuf + ooff + dim) = ov;
        }
    }
    __syncthreads();
    if (v < 3) { STOREV(tidv); __syncthreads(); }
  }
#undef LOADK
#undef STOREK
#undef LOADV
#undef STOREV
}

DI void attn_sample_item(const Params& p, int l, int item, char* smem, bfr* Obuf) {
  const int s = item >> 2, hh = item & 3, tid = threadIdx.x, lane = tid & 63, wid = tid >> 6;
  float* qsm = (float*)smem;
  float* sc = qsm + 256;
  float* red = sc + 256;
  const size_t row = NPR + s;
  qsm[tid] = bf2f(p.ACT2[row * 1024 + hh * 256 + tid]);
  __syncthreads();
  const int grp = lane >> 4, l16 = lane & 15;
  float4 q4[4];
#pragma unroll
  for (int j = 0; j < 4; ++j) q4[j] = ((const float4*)qsm)[j * 16 + l16];
  const float* Kb = p.cache_k + ((((size_t)l * 128 + s) * 256) * 4 + hh) * 256;
  const float* Vb = p.cache_v + ((((size_t)l * 128 + s) * 256) * 4 + hh) * 256;
#pragma unroll 8
  for (int ps = 0; ps < 16; ++ps) {
    int mem = wid * 64 + ps * 4 + grp;
    const float4* kr = (const float4*)(Kb + (size_t)mem * 1024);
    float d = 0.f;
#pragma unroll
    for (int j = 0; j < 4; ++j) {
      float4 k4 = kr[j * 16 + l16];
      d += k4.x * q4[j].x + k4.y * q4[j].y + k4.z * q4[j].z + k4.w * q4[j].w;
    }
    d += __shfl_xor(d, 8);
    d += __shfl_xor(d, 4);
    d += __shfl_xor(d, 2);
    d += __shfl_xor(d, 1);
    if (l16 == 0) sc[mem] = d * 0.0625f;
  }
  __syncthreads();
  float sv = sc[tid];
  float m = wave_max(sv);
  if (lane == 0) red[wid] = m;
  __syncthreads();
  m = fmaxf(fmaxf(red[0], red[1]), fmaxf(red[2], red[3]));
  float e = __expf(sv - m);
  float sm_ = wave_sum(e);
  if (lane == 0) red[4 + wid] = sm_;
  sc[tid] = e;
  __syncthreads();
  const float inv = 1.0f / (red[4] + red[5] + red[6] + red[7]);
  float4 acc = {0.f, 0.f, 0.f, 0.f};
  float* partial = (float*)smem + 1024;
#pragma unroll 16
  for (int i = 0; i < 64; ++i) {
    const int mem = wid * 64 + i;
    float4 v4 = *(const float4*)(Vb + (size_t)mem * 1024 + lane * 4);
    const float pm = sc[mem];
    acc.x += pm * v4.x; acc.y += pm * v4.y; acc.z += pm * v4.z; acc.w += pm * v4.w;
  }
  *(float4*)(partial + wid * 256 + lane * 4) = acc;
  __syncthreads();
  const float ov = partial[tid] + partial[256 + tid] + partial[512 + tid] + partial[768 + tid];
  Obuf[row * 1024 + hh * 256 + tid] = f2bf(ov * inv);
  __syncthreads();
}

DI void phase_attn(const Params& p, int l, char* smem) {
  bfr* Obuf = p.ACT3;
  const int half = gridDim.x >> 1;
  const bool upper = (int)blockIdx.x >= half;
  const int bi = upper ? (int)blockIdx.x - half : (int)blockIdx.x;
  const int nb = upper ? (int)gridDim.x - half : half;
  for (int pass = 0; pass < 2; ++pass) {
    const bool do_sample = (pass == 0) != upper;
    if (do_sample) {
      for (int k = bi; k < 256; k += nb) attn_sample_item(p, l, 2 * k + (upper ? 1 : 0), smem, Obuf);
    } else {
      for (int k = bi; k < 256; k += nb) {
        const int u = 2 * k + (upper ? 1 : 0), tt4 = u & 15, hh = (u >> 4) & 3, b = u >> 6;
        attn_prompt_block(p, l, b, hh, tt4, smem, Obuf);
      }
    }
  }
}

template <int WIN>
DI void pool_elem(const Params& p, int row, int c) {
  const bfr* P2 = p.PB;
  unsigned uu = *(const unsigned*)(P2 + (size_t)row * 2048 + c);
  const float u0 = bflo(uu), u1 = bfhi(uu);
  float s0 = u0, s1 = u1, cnt;
  if (row < NPR) {
    const int t = row & 2047, b = row >> 11;
    if (t >= WIN - 1) {
      cnt = (float)WIN;
      unsigned w[WIN - 1];
#pragma unroll
      for (int j = 1; j < WIN; ++j) w[j - 1] = *(const unsigned*)(P2 + (size_t)(row - j) * 2048 + c);
#pragma unroll
      for (int j = 1; j < WIN; ++j) { s0 += bflo(w[j - 1]); s1 += bfhi(w[j - 1]); }
    } else {
      cnt = (float)(t + 1);
      for (int j = 1; j <= t; ++j) {
        unsigned w = *(const unsigned*)(P2 + (size_t)(row - j) * 2048 + c);
        s0 += bflo(w); s1 += bfhi(w);
      }
    }
    if (t >= 2033) {
      float2 o = {u0, u1};
      *(float2*)(p.out + O_POOLP + ((size_t)b * 15 + (t - 2033)) * 1024 + c) = o;
    }
  } else {
    const int s = row - NPR;
    cnt = (float)WIN;
    const float* sp = p.state_pool + (size_t)s * 15 * 1024 + c;
    float2 st[15];
#pragma unroll
    for (int j = 0; j < 15; ++j) st[j] = *(const float2*)(sp + (size_t)j * 1024);
#pragma unroll
    for (int j = 1; j < WIN; ++j) { s0 += st[15 - j].x; s1 += st[15 - j].y; }
    float* op = p.out + O_POOLS + (size_t)s * 15 * 1024 + c;
#pragma unroll
    for (int j = 0; j < 14; ++j) *(float2*)(op + (size_t)j * 1024) = st[j + 1];
    float2 o = {u0, u1};
    *(float2*)(op + (size_t)14 * 1024) = o;
  }
  *(unsigned*)(p.MIX + (size_t)row * 1024 + c) = pack2(s0 / cnt - u0, s1 / cnt - u1);
}
DI void phase_pool(const Params& p) {
  for (int idx = blockIdx.x * 256 + threadIdx.x; idx < NROW * 512; idx += gridDim.x * 256) {
    const int row = idx >> 9, c = (idx & 511) * 2;
    const int gi = c >> 8;
    if (gi == 0) pool_elem<2>(p, row, c);
    else if (gi == 1) pool_elem<4>(p, row, c);
    else if (gi == 2) pool_elem<8>(p, row, c);
    else pool_elem<16>(p, row, c);
  }
}

DI void phase_gemm_pool(const Params& p, char* smem) {
  const bfr* P2 = p.PB;
  bfr* Z = p.ACT3;
  for (int g = 0; g < 4; ++g) {
    const float* bp = p.b_pool + g * 256;
    const float* sc = p.pool_scale + g * 256;
    gemm_sample<false>(p.MIX + g * 256, 1024, p.WtPool + (size_t)g * 65536, 256, 256, 256, smem,
                       [=](int row, int col, float v) -> float {
                         float gate = bf2f(P2[(size_t)row * 2048 + 1024 + g * 256 + col]);
                         float z = (v + bp[col]) * sc[col] * siluf_(gate);
                         Z[(size_t)row * 1024 + g * 256 + col] = f2bf(z);
                         return 0.f;
                       },
                       [=](int, float) {});
  }
  for (int t = blockIdx.x; t < 128 * 4; t += gridDim.x) {
    int mt = t >> 2, g = t & 3, nt = 0;
    const float* bp = p.b_pool + g * 256;
    const float* sc = p.pool_scale + g * 256;
    gemm_tile<1024>(p.MIX + g * 256, p.WtPool + (size_t)g * 65536, 256, 256, mt * 128, nt * 256, smem,
              [=](int row, int col, float v) {
                float gate = bf2f(P2[(size_t)row * 2048 + 1024 + g * 256 + col]);
                float z = (v + bp[col]) * sc[col] * siluf_(gate);
                Z[(size_t)row * 1024 + g * 256 + col] = f2bf(z);
              });
  }
}

#ifndef ONLY_PHASE
#define ONLY_PHASE -1
#endif
#define PON(n) (ONLY_PHASE < 0 || ONLY_PHASE == (n))
__global__ void __launch_bounds__(256, 2) mega(Params p) {
  __shared__ __attribute__((aligned(16))) char smem[65536];
  cg::grid_group grid = cg::this_grid();
  if (p.phase_lo < -1000) grid.sync();
  volatile LAS unsigned* xst = (volatile LAS unsigned*)(smem + 65520);
  if (threadIdx.x < 4) xst[threadIdx.x] = 0u;
  __syncthreads();
  (void)xcd_barrier_post(p.bar, xst);
#define XB_NOW() do { XcdBarrier b_; b_.bar = p.bar; b_.x = xb_xcc_id(); b_.st = (volatile LAS unsigned*)(smem + 65520); xcd_barrier(b_); } while (0)
#ifndef DUPMASK
#define DUPMASK 0
#endif
#define RUN(n, call) do { if (PON(n) && p.phase_lo <= (n) && (n) <= p.phase_hi) { call; if ((DUPMASK >> (n)) & 1) { XB_NOW(); call; } } if (p.phase_lo <= (n) && (n) < p.phase_hi) XB_NOW(); } while (0)
  RUN(0, phase_prep(p, smem));
  RUN(1, phase_gemm_in_even(p, smem));
  RUN(2, phase_even_pointwise(p, smem));
  RUN(3, phase_chunk_prep(p, smem));
  RUN(4, phase_scan(p, smem));
  RUN(5, phase_delta_post(p));
  RUN(6, (phase_gemm_resid<true, true>(p, p.MIX, p.WtOutE, p.norm_xattn, p.SS, smem)));
  RUN(8, phase_gemm_bf16out(p, p.H, p.WtXq, p.ACT2, 1024, p.SS, smem));
  RUN(9, phase_attn(p, 0, smem));
  RUN(10, (phase_gemm_resid<false, true>(p, p.ACT3, p.WtXo, p.norm_mix + 1024, p.SS + NROW, smem)));
  RUN(12, phase_gemm_bf16out(p, p.H, p.WtInO, p.PB, 2048, p.SS + NROW, smem));
  RUN(13, phase_pool(p));
  RUN(14, phase_gemm_pool(p, smem));
  RUN(15, (phase_gemm_resid<false, true>(p, p.ACT3, p.WtOutO, p.norm_xattn + 1024, p.SS + 2 * NROW, smem)));
  RUN(17, phase_gemm_bf16out(p, p.H, p.WtXq + 1048576, p.ACT2, 1024, p.SS + 2 * NROW, smem));
  RUN(18, phase_attn(p, 1, smem));
  RUN(19, (phase_gemm_resid<false, false>(p, p.ACT3, p.WtXo + 1048576, p.norm_final, p.SS + 3 * NROW, smem)));
  RUN(20, phase_final_norm(p));
}

extern "C" void kernel_launch(void* const* d_in, const int* in_sizes, int n_in, void* d_out, int out_size, void* d_ws,
                              size_t ws_size, hipStream_t stream) {
  static int grid_blocks = 0;
  if (!grid_blocks) {
    int dev = 0, cus = 0, per_cu = 0;
    (void)hipGetDevice(&dev);
    (void)hipDeviceGetAttribute(&cus, hipDeviceAttributeMultiprocessorCount, dev);
    (void)hipOccupancyMaxActiveBlocksPerMultiprocessor(&per_cu, mega, 256, 0);
    if (per_cu < 1) per_cu = 1;
    if (per_cu > 2) per_cu = 2;
    grid_blocks = cus * per_cu;
  }
  Params p{};
  const float** ins = (const float**)&p.x_prompt;
  for (int i = 0; i < 31; ++i) ins[i] = (const float*)d_in[i];
  p.out = (float*)d_out;
  char* w = (char*)d_ws;
  size_t off = 0;
  auto take = [&](size_t bytes) { char* r = w + off; off += (bytes + 255) & ~(size_t)255; return r; };
  p.X = (float*)take((size_t)NROW * 1024 * 4);
  p.QKV = (float*)take((size_t)NROW * 1536 * 4);
  p.BGR = (float*)take((size_t)NROW * 8 * 4);
  p.BG = (float*)take((size_t)NROW * 8 * 4);
  p.CONV = (float*)take((size_t)NROW * 512 * 4);
  p.ODN = (float*)take((size_t)NROW * 512 * 4);
  p.U = (float*)take((size_t)1024 * 8192 * 4);
  p.GL = (float*)take(4096);
  p.SS = (float*)take((size_t)4 * NROW * 4);
  p.H = (bfr*)take((size_t)NROW * 1024 * 2);
  p.PB = (bfr*)take((size_t)NROW * 3584 * 2);
  p.MIX = (bfr*)take((size_t)NROW * 1024 * 2);
  p.ACT2 = (bfr*)take((size_t)NROW * 1024 * 2);
  p.ACT3 = (bfr*)take((size_t)NROW * 1024 * 2);
  p.KB = (bfr*)take((size_t)2 * 2048 * 1024 * 2);
  p.VT = (bfr*)take((size_t)2 * 2048 * 1024 * 2);
  p.MPB = (bfr*)take((size_t)2048 * 1024 * 2);
  p.WtInE = (bfr*)take((size_t)3712 * 1024 * 2);
  p.WtOutE = (bfr*)take((size_t)1024 * 1024 * 2);
  p.WtInO = (bfr*)take((size_t)2048 * 1024 * 2);
  p.WtPool = (bfr*)take((size_t)4 * 256 * 256 * 2);
  p.WtOutO = (bfr*)take((size_t)1024 * 1024 * 2);
  p.WtXq = (bfr*)take((size_t)2 * 1024 * 1024 * 2);
  p.WtXk = (bfr*)take((size_t)2 * 1024 * 1024 * 2);
  p.WtXv = (bfr*)take((size_t)2 * 1024 * 1024 * 2);
  p.WtXo = (bfr*)take((size_t)2 * 1024 * 1024 * 2);
  p.WN = (uint4*)take((size_t)1024 * 1024 * 16);
  p.QD = (uint4*)take((size_t)1024 * 1024 * 16);
  p.KD = (uint4*)take((size_t)1024 * 1024 * 16);
  p.QKF = (uint4*)take((size_t)1024 * 512 * 16);
  p.bar = (unsigned*)take((size_t)XCD_BAR_WORDS * 4);
  if (off > ws_size) {
    fprintf(stderr, "kernel_launch: workspace too small: need %zu have %zu\n", off, ws_size);
    return;
  }
  p.phase_lo = 0;
  p.phase_hi = 20;
  if (hipMemsetAsync(p.bar, 0, (size_t)XCD_BAR_WORDS * 4, stream) != hipSuccess) { fprintf(stderr, "memset failed\n"); return; }
  void* args[] = {&p};
  hipError_t e = hipLaunchCooperativeKernel((void*)mega, dim3(grid_blocks), dim3(256), args, 0, stream);
  if (e != hipSuccess) fprintf(stderr, "cooperative launch failed: %s (grid %d)\n", hipGetErrorString(e), grid_blocks);
}
```

```cpp
#include <hip/hip_runtime.h>
#include <hip/hip_cooperative_groups.h>
#include <cstdio>
namespace cg = cooperative_groups;

#define DI __device__ __forceinline__
typedef unsigned short bfr;
using bf16x8 = __attribute__((ext_vector_type(8))) short;
using f32x16 = __attribute__((ext_vector_type(16))) float;
typedef __bf16 bf2_t __attribute__((ext_vector_type(2)));
typedef float fl2_t __attribute__((ext_vector_type(2)));
typedef unsigned u32x4 __attribute__((ext_vector_type(4)));
#define MFMA32(a, b, c) __builtin_amdgcn_mfma_f32_32x32x16_bf16((a), (b), (c), 0, 0, 0)

constexpr int NROW = 16512;
constexpr int NPR = 16384;
constexpr int DM = 1024;
constexpr int EIN = 3592, EINP = 3584;
constexpr float EPSF = 1e-6f;

constexpr size_t O_Y = 0;
constexpr size_t O_CONVP = 16777216 + 131072;
constexpr size_t O_QKVP = O_CONVP + 122880;
constexpr size_t O_DELTAP = O_QKVP + 36864;
constexpr size_t O_POOLP = O_DELTAP + 524288;
constexpr size_t O_MEMK = O_POOLP + 122880;
constexpr size_t O_MEMV = O_MEMK + 4194304;
constexpr size_t O_CONVS = O_MEMV + 4194304;
constexpr size_t O_QKVS = O_CONVS + 1966080;
constexpr size_t O_DELTAS = O_QKVS + 589824;
constexpr size_t O_POOLS = O_DELTAS + 8388608;

struct Params {
  const float *x_prompt, *x_sample, *state_conv_a, *state_qkv_conv, *state_delta, *state_pool, *cache_k, *cache_v, *mem_prompt;
  const float *norm_mix, *norm_xattn, *norm_final, *w_in_even, *w_out_even, *dw_w, *dw_b, *ln_a_g, *ln_a_b, *sc_w, *a_log,
      *dt_bias, *dn_norm_g, *w_in_odd, *w_pool, *b_pool, *pool_scale, *w_out_odd, *w_xq, *w_xk, *w_xv, *w_xo;
  float* out;
  float *X, *QKV, *BGR, *BG, *CONV, *ODN, *U, *GL, *SS;
  bfr *H, *PB, *MIX, *ACT2, *ACT3, *KB, *VT, *MPB;
  bfr *WtInE, *WtOutE, *WtInO, *WtPool, *WtOutO, *WtXq, *WtXk, *WtXv, *WtXo;
  uint4 *WN, *QD, *KD, *QKF;
  unsigned* bar;
  int phase_lo, phase_hi;
};

DI int opaque_tid() { int t = threadIdx.x; asm volatile("" : "+v"(t)); return t; }
DI unsigned pack2(float a, float b) {
  fl2_t f = {a, b};
  bf2_t r = __builtin_convertvector(f, bf2_t);
  return __builtin_bit_cast(unsigned, r);
}
DI bfr f2bf(float a) { return (bfr)(pack2(a, 0.f) & 0xffffu); }
DI float bf2f(bfr u) { return __uint_as_float(((unsigned)u) << 16); }
DI float bflo(unsigned u) { return __uint_as_float(u << 16); }
DI float bfhi(unsigned u) { return __uint_as_float(u & 0xffff0000u); }
DI float sigmoidf_(float x) { return 1.0f / (1.0f + __expf(-x)); }
DI float siluf_(float x) { return x / (1.0f + __expf(-x)); }
#define DPPF(v, ctrl, rmask) __builtin_bit_cast(float, __builtin_amdgcn_update_dpp(0, __builtin_bit_cast(int, (v)), (ctrl), (rmask), 0xf, false))
DI float row16_sum(float v) {
  v += DPPF(v, 0xB1, 0xf);
  v += DPPF(v, 0x4E, 0xf);
  v += DPPF(v, 0x141, 0xf);
  v += DPPF(v, 0x140, 0xf);
  return v;
}
DI float half32_sum_hi(float v) {
  v = row16_sum(v);
  v += DPPF(v, 0x142, 0xa);
  return v;
}
DI float wave_sum(float v) {
  v = row16_sum(v);
  v += DPPF(v, 0x142, 0xa);
  v += DPPF(v, 0x143, 0xc);
  return __builtin_bit_cast(float, __builtin_amdgcn_readlane(__builtin_bit_cast(int, v), 63));
}
DI float wave_max(float v) {
#pragma unroll
  for (int o = 32; o >= 1; o >>= 1) v = fmaxf(v, __shfl_xor(v, o));
  return v;
}
DI int crow(int reg, int h) { return (reg & 3) + 8 * (reg >> 2) + 4 * h; }
DI bf16x8 pack8(const f32x16& x, int s) {
  uint4 p;
  p.x = pack2(x[8 * s + 0], x[8 * s + 1]);
  p.y = pack2(x[8 * s + 2], x[8 * s + 3]);
  p.z = pack2(x[8 * s + 4], x[8 * s + 5]);
  p.w = pack2(x[8 * s + 6], x[8 * s + 7]);
  return __builtin_bit_cast(bf16x8, p);
}
DI bf16x8 ldfrag(const uint4* p) { uint4 v = *p; return __builtin_bit_cast(bf16x8, v); }


#define XB_TMO      128
#define XB_XCNT(j)  (256  + 64 * (j))
#define XB_XSUB(j)  (1280 + 64 * (j))
#define XB_XGEN(j)  (2304 + 64 * (j))
#define XB_TOP      3328
#define XB_TOPGEN   3392
#define XCD_BAR_WORDS 3456
#define XB_SPIN_CAP (1u << 18)
#define LAS __attribute__((address_space(3)))
DI unsigned xb_ld(unsigned* p) { return __hip_atomic_load(p, __ATOMIC_RELAXED, __HIP_MEMORY_SCOPE_AGENT); }
DI unsigned xb_add(unsigned* p, unsigned v) { return __hip_atomic_fetch_add(p, v, __ATOMIC_RELAXED, __HIP_MEMORY_SCOPE_AGENT); }
DI unsigned xb_xcc_id() { return (unsigned)__builtin_amdgcn_s_getreg((3 << 11) | 20) & 0xFu; }
#define XB_SPIN(cond, bar) do { unsigned _sp = 0; while (cond) { __builtin_amdgcn_s_sleep(1); \
    if ((++_sp & 255u) == 0u) { if (xb_ld(&(bar)[XB_TMO])) break; if (_sp > XB_SPIN_CAP) { atomicAdd(&(bar)[XB_TMO], 1u); break; } } } } while (0)
struct XcdBarrier { unsigned* bar; unsigned x; volatile LAS unsigned* st; };
DI XcdBarrier xcd_barrier_post(unsigned* bar, volatile LAS unsigned* st) {
  XcdBarrier b; b.bar = bar; b.x = xb_xcc_id(); b.st = st;
  if (threadIdx.x == 0) (void)xb_add(&bar[XB_XCNT(b.x)], 1u);
  return b;
}
DI void xcd_barrier_complete(unsigned* bar, unsigned x, unsigned& nloc, unsigned& nx) {
  const unsigned G = gridDim.x * gridDim.y * gridDim.z;
  unsigned sum, cnt, mine, sp = 0u;
  for (;;) {
    sum = 0u; cnt = 0u; mine = 0u;
#pragma unroll
    for (unsigned j = 0; j < 16; ++j) { const unsigned c = xb_ld(&bar[XB_XCNT(j)]); sum += c; cnt += (c > 0u) ? 1u : 0u; mine = (j == x) ? c : mine; }
    if (sum == G) break;
    __builtin_amdgcn_s_sleep(1);
    if ((++sp & 255u) == 0u) { if (xb_ld(&bar[XB_TMO])) break; if (sp > XB_SPIN_CAP) { atomicAdd(&bar[XB_TMO], 1u); break; } }
  }
  nloc = mine > 0u ? mine : 1u; nx = cnt > 0u ? cnt : 1u;
}
DI void xcd_barrier(const XcdBarrier& b) {
  asm volatile("s_waitcnt vmcnt(0)" ::: "memory");
  __syncthreads();
  if (threadIdx.x == 0) {
    unsigned* bar = b.bar;
    __builtin_amdgcn_s_waitcnt(0);
    unsigned nloc = b.st[0], nx = b.st[1];
    if (nloc == 0u) { xcd_barrier_complete(bar, b.x, nloc, nx); b.st[0] = nloc; b.st[1] = nx; }
    const unsigned old = xb_add(&bar[XB_XSUB(b.x)], 1u);
    const unsigned gen = old / nloc;
    if (old + 1u == (gen + 1u) * nloc) {
      __builtin_amdgcn_fence(__ATOMIC_RELEASE, "agent");
      asm volatile("s_waitcnt vmcnt(0)" ::: "memory");
      const unsigned og = xb_add(&bar[XB_TOP], 1u);
      const unsigned tg = og / nx;
      if (og + 1u == (tg + 1u) * nx) xb_add(&bar[XB_TOPGEN], 1u);
      else XB_SPIN(xb_ld(&bar[XB_TOPGEN]) == tg, bar);
      __builtin_amdgcn_fence(__ATOMIC_ACQUIRE, "agent");
      xb_add(&bar[XB_XGEN(b.x)], 1u);
      asm volatile("s_waitcnt vmcnt(0)" ::: "memory");
    } else {
      XB_SPIN(xb_ld(&bar[XB_XGEN(b.x)]) == gen, bar);
      __builtin_amdgcn_fence(__ATOMIC_ACQUIRE, "agent");
      asm volatile("s_waitcnt vmcnt(0)" ::: "memory");
    }
  }
  __syncthreads();
}

constexpr int GSTAGE = (128 + 256) * 40;
template <int lda>
DI void gemm_mainloop(const bfr* __restrict__ A, const bfr* __restrict__ Bt, int NB, int K, int m0, int n0, char* smem, f32x16 (&acc)[2][4]) {
  bfr* S0 = (bfr*)smem;
  int tid = threadIdx.x;
  asm volatile("" : "+v"(tid));
  const int lane = tid & 63, wid = tid >> 6, wr = wid >> 1, wc = wid & 1;
  const int r = lane & 31, hl = lane >> 5;
#pragma unroll
  for (int i = 0; i < 2; ++i)
#pragma unroll
    for (int j = 0; j < 4; ++j)
#pragma unroll
      for (int q = 0; q < 16; ++q) acc[i][j][q] = 0.f;
  u32x4 ra[4], rb[4];
  const int nk = K >> 5;
  const int arow = tid >> 3, ac8 = tid & 7, apar = ac8 >> 2;
  const bfr* Ab = A + (m0 + arow) * lda + ac8 * 8;
  const int asoff = arow * 40 + (ac8 & 3) * 8;
  const int brow = tid >> 2, bc4 = tid & 3;
  const bfr* Bb = Bt + (n0 + brow) * 32 + bc4 * 8;
  const int bsoff = brow * 40 + bc4 * 8;
#define GA_LOAD(pr_) do { _Pragma("unroll") for (int i = 0; i < 4; ++i) ra[i] = *(const u32x4*)(Ab + (i * 32) * lda + (pr_) * 64); } while (0)
#define GB_LOAD(kt_) do { const bfr* bk_ = Bb + (kt_) * NB * 32; \
    _Pragma("unroll") for (int i = 0; i < 4; ++i) rb[i] = *(const u32x4*)(bk_ + (i * 64) * 32); } while (0)
#define G_STORE(kt_) do { bfr* as_ = S0 + ((kt_) & 1) * GSTAGE; bfr* bs_ = as_ + 128 * 40; \
    if (apar == ((kt_) & 1)) { _Pragma("unroll") for (int i = 0; i < 4; ++i) *(u32x4*)(as_ + asoff + i * 32 * 40) = ra[i]; } \
    _Pragma("unroll") for (int i = 0; i < 4; ++i) *(u32x4*)(bs_ + bsoff + i * 64 * 40) = rb[i]; } while (0)
  GA_LOAD(0);
  GB_LOAD(0);
  G_STORE(0);
  GB_LOAD(1);
  __syncthreads();
  for (int kt = 0; kt < nk; ++kt) {
    if (kt + 1 < nk) G_STORE(kt + 1);
    if (kt + 2 < nk) {
      GB_LOAD(kt + 2);
      if ((kt & 1) == 0) GA_LOAD((kt >> 1) + 1);
    }
    const bfr* As = S0 + (kt & 1) * GSTAGE;
    const bfr* Bs = As + 128 * 40;
#pragma unroll
    for (int ks = 0; ks < 2; ++ks) {
      bf16x8 af[2], bfg[4];
#pragma unroll
      for (int i = 0; i < 2; ++i) af[i] = *(const bf16x8*)(As + (wr * 64 + i * 32 + r) * 40 + ks * 16 + hl * 8);
#pragma unroll
      for (int j = 0; j < 4; ++j) bfg[j] = *(const bf16x8*)(Bs + (wc * 128 + j * 32 + r) * 40 + ks * 16 + hl * 8);
#pragma unroll
      for (int i = 0; i < 2; ++i)
#pragma unroll
        for (int j = 0; j < 4; ++j) acc[i][j] = MFMA32(af[i], bfg[j], acc[i][j]);
    }
    __syncthreads();
  }
#undef GA_LOAD
#undef GB_LOAD
#undef G_STORE
}

template <int lda, class Epi>
DI void gemm_tile(const bfr* __restrict__ A, const bfr* __restrict__ Bt, int NB, int K, int m0, int n0, char* smem, Epi epi) {
  f32x16 acc[2][4];
  gemm_mainloop<lda>(A, Bt, NB, K, m0, n0, smem, acc);
  int tid3 = threadIdx.x;
  asm volatile("" : "+v"(tid3));
  const int lane = tid3 & 63, wid = tid3 >> 6, wr = wid >> 1, wc = wid & 1, r = lane & 31, hl = lane >> 5;
#pragma unroll
  for (int i = 0; i < 2; ++i)
#pragma unroll
    for (int j = 0; j < 4; ++j)
#pragma unroll
      for (int q = 0; q < 16; ++q) {
        int row = m0 + wr * 64 + i * 32 + crow(q, hl);
        int col = n0 + wc * 128 + j * 32 + r;
        epi(row, col, acc[i][j][q]);
      }
}

template <bool RS, class Epi, class RowF>
DI void gemm_sample(const bfr* __restrict__ A, int lda, const bfr* __restrict__ Bt, int ldb, int K, int N, char* smem, Epi epi, RowF rowf) {
  const int tid = threadIdx.x, lane = tid & 63, wid = tid >> 6, r = lane & 31, hl = lane >> 5;
  float* red = (float*)smem;
  const int nun = 4 * (N >> 5);
  for (int u = blockIdx.x; u < nun; u += gridDim.x) {
    const int mu = u & 3, nu = u >> 2;
    const int kq = K >> 2, k0 = wid * kq;
    const bfr* ap = A + (size_t)(NPR + mu * 32 + r) * lda + k0 + hl * 8;
    const bfr* bp = Bt + ((size_t)(k0 >> 5) * ldb + nu * 32 + r) * 32 + hl * 8;
    f32x16 acc;
#pragma unroll
    for (int q = 0; q < 16; ++q) acc[q] = 0.f;
    if (K == 1024) {
#pragma unroll
      for (int ks = 0; ks < 16; ++ks) {
        bf16x8 af = *(const bf16x8*)(ap + ks * 16);
        bf16x8 bf = *(const bf16x8*)(bp + (size_t)(ks >> 1) * ldb * 32 + (ks & 1) * 16);
        acc = MFMA32(af, bf, acc);
      }
    } else {
      for (int ks = 0; ks < (kq >> 4); ++ks) {
        bf16x8 af = *(const bf16x8*)(ap + ks * 16);
        bf16x8 bf = *(const bf16x8*)(bp + (size_t)(ks >> 1) * ldb * 32 + (ks & 1) * 16);
        acc = MFMA32(af, bf, acc);
      }
    }
#pragma unroll
    for (int q = 0; q < 16; ++q) red[(wid * 16 + q) * 64 + lane] = acc[q];
    __syncthreads();
#pragma unroll
    for (int e = 0; e < 4; ++e) {
      const int q = wid + e * 4;
      const float v = red[q * 64 + lane] + red[(16 + q) * 64 + lane] + red[(32 + q) * 64 + lane] + red[(48 + q) * 64 + lane];
      const int row = NPR + mu * 32 + crow(q, hl), col = nu * 32 + r;
      float x = epi(row, col, v);
      if (RS) {
        float s2 = half32_sum_hi(x * x);
        if (r == 31) rowf(row, s2);
      }
    }
    __syncthreads();
  }
}

DI void transpose_tile(const float* __restrict__ W, int ldw, bfr* __restrict__ Wt, int NB, int k0, int n0, float* sm, int nvalid = 1 << 30) {
  const int tid = threadIdx.x;
#pragma unroll
  for (int i = 0; i < 16; ++i) {
    int idx = tid + i * 256, kk = idx >> 6, nn = idx & 63;
    sm[kk * 65 + nn] = (n0 + nn < nvalid) ? W[(size_t)(k0 + kk) * ldw + n0 + nn] : 0.f;
  }
  __syncthreads();
#pragma unroll
  for (int i = 0; i < 8; ++i) {
    int idx = tid + i * 256, nn = idx >> 5, kp = idx & 31;
    float a = sm[(2 * kp) * 65 + nn], b = sm[(2 * kp + 1) * 65 + nn];
    { const int k = k0 + 2 * kp; *(unsigned*)(Wt + ((size_t)(k >> 5) * NB + n0 + nn) * 32 + (k & 31)) = pack2(a, b); }
  }
  __syncthreads();
}

DI void transpose_item(const Params& p, int tt, float* sm) {
  const int t = tt - 32;
  if (tt < 928) {
    int kt = tt / 58, nt = tt % 58;
    transpose_tile(p.w_in_even, EIN, p.WtInE, 3712, kt * 64, nt * 64, sm, EIN);
  } else if (t < 1152) {
    int u = t - 896;
    transpose_tile(p.w_out_even, 1024, p.WtOutE, 1024, (u >> 4) * 64, (u & 15) * 64, sm);
  } else if (t < 1664) {
    int u = t - 1152;
    transpose_tile(p.w_in_odd, 2048, p.WtInO, 2048, (u >> 5) * 64, (u & 31) * 64, sm);
  } else if (t < 1728) {
    int u = t - 1664, g = u >> 4, v = u & 15;
    transpose_tile(p.w_pool + (size_t)g * 65536, 256, p.WtPool + (size_t)g * 65536, 256, (v >> 2) * 64, (v & 3) * 64, sm);
  } else if (t < 1984) {
    int u = t - 1728;
    transpose_tile(p.w_out_odd, 1024, p.WtOutO, 1024, (u >> 4) * 64, (u & 15) * 64, sm);
  } else {
    int u = t - 1984, m = u >> 8, v = u & 255;
    int which = m >> 1, l = m & 1;
    const float* src = (which == 0 ? p.w_xq : which == 1 ? p.w_xk : which == 2 ? p.w_xv : p.w_xo) + (size_t)l * 1048576;
    bfr* dst = (which == 0 ? p.WtXq : which == 1 ? p.WtXk : which == 2 ? p.WtXv : p.WtXo) + (size_t)l * 1048576;
    transpose_tile(src, 1024, dst, 1024, (v >> 4) * 64, (v & 15) * 64, sm);
  }
}
DI int transpose_early(int i) { return i < 928 ? i : (2016 + 512) + (i - 928); }
DI int transpose_late(int i) { return i < 1600 ? 928 + i : (2016 + 1536) + (i - 1600); }

DI void phase_prep(const Params& p, char* smem) {
  float* sm = (float*)smem;
  for (int i = blockIdx.x; i < 1952; i += gridDim.x) transpose_item(p, transpose_early(i), sm);
  {
    for (int i = blockIdx.x * 256 + threadIdx.x; i < 4 * NROW; i += gridDim.x * 256) p.SS[i] = 0.f;
    const int n4 = 2048 * 1024 / 4;
    for (int i = blockIdx.x * 256 + threadIdx.x; i < n4; i += gridDim.x * 256) {
      float4 v = ((const float4*)p.mem_prompt)[i];
      uint2 o;
      o.x = pack2(v.x, v.y);
      o.y = pack2(v.z, v.w);
      ((uint2*)p.MPB)[i] = o;
    }
  }
  {
    const int lane = threadIdx.x & 63, wid = threadIdx.x >> 6;
    float* wT = (float*)smem;
    for (int i = opaque_tid(); i < 2048; i += 256) {
      const int k = i >> 1, hf = i & 1;
      float4 w = *(const float4*)(p.w_in_even + (size_t)k * EIN + EINP + hf * 4);
      wT[(hf * 4 + 0) * 1024 + k] = w.x; wT[(hf * 4 + 1) * 1024 + k] = w.y;
      wT[(hf * 4 + 2) * 1024 + k] = w.z; wT[(hf * 4 + 3) * 1024 + k] = w.w;
    }
    __syncthreads();
    for (int row = blockIdx.x * 4 + wid; row < NROW; row += gridDim.x * 4) {
      const float* xr = row < NPR ? p.x_prompt + (size_t)row * DM : p.x_sample + (size_t)(row - NPR) * DM;
      float4 v[4];
      float ss = 0.f;
#pragma unroll
      for (int j = 0; j < 4; ++j) {
        v[j] = ((const float4*)xr)[j * 64 + lane];
        ss += v[j].x * v[j].x + v[j].y * v[j].y + v[j].z * v[j].z + v[j].w * v[j].w;
      }
      ss = wave_sum(ss);
      float inv = rsqrtf(ss * (1.0f / 1024.0f) + EPSF);
      float part[8];
#pragma unroll
      for (int c = 0; c < 8; ++c) part[c] = 0.f;
#pragma unroll
      for (int j = 0; j < 4; ++j) {
        float4 g = ((const float4*)p.norm_mix)[j * 64 + lane];
        uint2 o;
        const float h0 = v[j].x * inv * g.x, h1 = v[j].y * inv * g.y, h2 = v[j].z * inv * g.z, h3 = v[j].w * inv * g.w;
        o.x = pack2(h0, h1);
        o.y = pack2(h2, h3);
        ((uint2*)(p.H + (size_t)row * DM))[j * 64 + lane] = o;
#pragma unroll
        for (int c = 0; c < 8; ++c) {
          float4 w = ((const float4*)(wT + c * 1024))[j * 64 + lane];
          part[c] += h0 * w.x + h1 * w.y + h2 * w.z + h3 * w.w;
        }
      }
#pragma unroll
      for (int c = 0; c < 8; ++c) part[c] = wave_sum(part[c]);
      if (lane == 0) {
        float4 a = {part[0], part[1], part[2], part[3]}, b = {part[4], part[5], part[6], part[7]};
        ((float4*)(p.BGR + (size_t)row * 8))[0] = a;
        ((float4*)(p.BGR + (size_t)row * 8))[1] = b;
      }
    }
    __syncthreads();
  }
}

DI void phase_rmsnorm(const Params& p, const float* g) {
  const int lane = threadIdx.x & 63, wid = threadIdx.x >> 6;
  for (int row = blockIdx.x * 4 + wid; row < NROW; row += gridDim.x * 4) {
    const float* xr = p.X + (size_t)row * DM;
    float4 v[4];
    float ss = 0.f;
#pragma unroll
    for (int j = 0; j < 4; ++j) {
      v[j] = ((const float4*)xr)[j * 64 + lane];
      ss += v[j].x * v[j].x + v[j].y * v[j].y + v[j].z * v[j].z + v[j].w * v[j].w;
    }
    ss = wave_sum(ss);
    float inv = rsqrtf(ss * (1.0f / 1024.0f) + EPSF);
#pragma unroll
    for (int j = 0; j < 4; ++j) {
      float4 gg = ((const float4*)g)[j * 64 + lane];
      uint2 o;
      o.x = pack2(v[j].x * inv * gg.x, v[j].y * inv * gg.y);
      o.y = pack2(v[j].z * inv * gg.z, v[j].w * inv * gg.w);
      ((uint2*)(p.H + (size_t)row * DM))[j * 64 + lane] = o;
    }
  }
}

DI void phase_final_norm(const Params& p) {
  const float* ss = p.SS + 3 * NROW;
  for (int i = blockIdx.x * 256 + threadIdx.x; i < NROW * 256; i += gridDim.x * 256) {
    const int row = i >> 8, c4 = i & 255;
    float4 v = ((const float4*)p.X)[i];
    float4 g = ((const float4*)p.norm_final)[c4];
    const float inv = rsqrtf(ss[row] * (1.0f / 1024.0f) + EPSF);
    float4 o = {v.x * inv * g.x, v.y * inv * g.y, v.z * inv * g.z, v.w * inv * g.w};
    ((float4*)(p.out + O_Y))[i] = o;
  }
}

DI void phase_gemm_in_even(const Params& p, char* smem) {
  const int NT1 = 128 * 14, NT2 = 4 * 64;
  {
    bfr* PB = p.PB;
    gemm_sample<false>(p.H, 1024, p.WtInE, 3712, 1024, EINP, smem,
                       [=](int row, int col, float v) -> float { PB[(size_t)row * EINP + col] = f2bf(v); return 0.f; },
                       [=](int, float) {});
  }
  for (int t = blockIdx.x; t < NT1 + NT2; t += gridDim.x) {
    if (t < NT1) {
      int mt = t / 14, nt = t % 14;
      bfr* PB = p.PB;
      gemm_tile<1024>(p.H, p.WtInE, 3712, 1024, mt * 128, nt * 256, smem,
                [=](int row, int col, float v) { PB[(size_t)row * EINP + col] = f2bf(v); });
    } else {
      int u = t - NT1, gsel = u >> 6, v = u & 63, mt = v >> 2, nt = v & 3;
      int isv = gsel >> 1, l = gsel & 1;
      if (!isv) {
        float* o = p.out + O_MEMK + (size_t)l * 2097152;
        bfr* kb = p.KB + (size_t)l * 2097152;
        gemm_tile<1024>(p.MPB, p.WtXk + (size_t)l * 1048576, 1024, 1024, mt * 128, nt * 256, smem,
                  [=](int row, int col, float v) {
                    o[(size_t)row * 1024 + col] = v;
                    kb[(size_t)row * 1024 + col] = f2bf(v);
                  });
      } else {
        float* o = p.out + O_MEMV + (size_t)l * 2097152;
        bfr* vt = p.VT + (size_t)l * 2097152;
        gemm_tile<1024>(p.MPB, p.WtXv + (size_t)l * 1048576, 1024, 1024, mt * 128, nt * 256, smem,
                  [=](int row, int col, float v) {
                    o[(size_t)row * 1024 + col] = v;
                    const int ml = row & 15;
                    const int rowpart = (row >> 8) * 262144 + ((row & 255) >> 4) * 512 + ((ml >> 2) & 1) * 256 + (((ml >> 3) << 2) | (ml & 3));
                    const int colpart = (col >> 8) * 65536 + ((col & 255) >> 5) * 8192 + (col & 31) * 8;
                    vt[rowpart + colpart] = f2bf(v);
                  });
      }
    }
  }
}

template <bool IS_P, bool EDGE>
DI void qkv_token(const Params& p, int row, int lane) {
  const int t = row & 2047, b = row >> 11, s = row - NPR;
#pragma unroll 6
  for (int grp = 0; grp < 12; ++grp) {
    const int ch = grp * 128 + lane * 2;
    float x0[4], x1[4];
    if (IS_P) {
      unsigned u[4];
#pragma unroll
      for (int j = 0; j < 4; ++j) {
        const int rc = (!EDGE || t - 3 + j >= 0) ? (row - 3 + j) : row;
        u[j] = *(const unsigned*)(p.PB + (size_t)rc * EINP + 1536 + ch);
      }
#pragma unroll
      for (int j = 0; j < 4; ++j) {
        const bool ok = (!EDGE || t - 3 + j >= 0);
        x0[j] = ok ? bflo(u[j]) : 0.f;
        x1[j] = ok ? bfhi(u[j]) : 0.f;
      }
    } else {
#pragma unroll
      for (int j = 0; j < 3; ++j) {
        float2 f = *(const float2*)(p.state_qkv_conv + ((size_t)s * 3 + j) * 1536 + ch);
        x0[j] = f.x; x1[j] = f.y;
      }
      unsigned u = *(const unsigned*)(p.PB + (size_t)row * EINP + 1536 + ch);
      x0[3] = bflo(u); x1[3] = bfhi(u);
    }
    float a0 = 0.f, a1 = 0.f;
#pragma unroll
    for (int j = 0; j < 4; ++j) {
      float2 w = *(const float2*)(p.sc_w + (size_t)j * 1536 + ch);
      a0 += w.x * x0[j]; a1 += w.y * x1[j];
    }
    float y0 = siluf_(a0), y1 = siluf_(a1);
    if (grp < 8) {
      float ss = wave_sum(y0 * y0 + y1 * y1);
      float inv = rsqrtf(ss + EPSF);
      if (grp < 4) inv *= 0.08838834764831845f;
      y0 *= inv; y1 *= inv;
    }
    float2 o = {y0, y1};
    *(float2*)(p.QKV + (size_t)row * 1536 + ch) = o;
    if (IS_P) {
      if (t >= 2045) {
        float2 c = {x0[3], x1[3]};
        *(float2*)(p.out + O_QKVP + ((size_t)b * 3 + (t - 2045)) * 1536 + ch) = c;
      }
    } else {
      float2 c0 = {x0[1], x1[1]}, c1 = {x0[2], x1[2]}, c2 = {x0[3], x1[3]};
      *(float2*)(p.out + O_QKVS + ((size_t)s * 3 + 0) * 1536 + ch) = c0;
      *(float2*)(p.out + O_QKVS + ((size_t)s * 3 + 1) * 1536 + ch) = c1;
      *(float2*)(p.out + O_QKVS + ((size_t)s * 3 + 2) * 1536 + ch) = c2;
    }
  }
  if (lane < 4) {
    float bl = p.BGR[(size_t)row * 8 + lane], al = p.BGR[(size_t)row * 8 + 4 + lane];
    float beta = sigmoidf_(bl);
    float xx = al + p.dt_bias[lane];
    float sp = xx > 20.f ? xx : log1pf(__expf(xx));
    float g = -__expf(p.a_log[lane]) * sp;
    p.BG[(size_t)row * 8 + lane] = beta;
    p.BG[(size_t)row * 8 + 4 + lane] = g;
  }
}

template <int G0>
DI void qkv_run4_half(const Params& p, int row0, int lane) {
  const int t0 = row0 & 2047, b = row0 >> 11;
  unsigned u[4][7];
  float2 w[4][4];
#pragma unroll
  for (int i = 0; i < 7; ++i) {
    const int rr = (i >= 3 || t0 > 0) ? (row0 - 3 + i) : row0;
    const bfr* rp = p.PB + (size_t)rr * EINP + 1536 + G0 * 128 + lane * 2;
#pragma unroll
    for (int g = 0; g < 4; ++g) u[g][i] = *(const unsigned*)(rp + g * 128);
  }
#pragma unroll
  for (int j = 0; j < 4; ++j) {
    const float* wp = p.sc_w + (size_t)j * 1536 + G0 * 128 + lane * 2;
#pragma unroll
    for (int g = 0; g < 4; ++g) w[g][j] = *(const float2*)(wp + g * 128);
  }
  const float hm = (t0 > 0) ? 1.f : 0.f;
#pragma unroll
  for (int k = 0; k < 4; ++k) {
    const int row = row0 + k;
#pragma unroll
    for (int g = 0; g < 4; ++g) {
      const int grp = G0 + g;
      const int ch = grp * 128 + lane * 2;
      float a0 = 0.f, a1 = 0.f;
#pragma unroll
      for (int j = 0; j < 4; ++j) {
        const int i = k + j;
        const float m = (i >= 3) ? 1.f : hm;
        a0 += w[g][j].x * (bflo(u[g][i]) * m);
        a1 += w[g][j].y * (bfhi(u[g][i]) * m);
      }
      float y0 = siluf_(a0), y1 = siluf_(a1);
      if (grp < 8) {
        float ss = wave_sum(y0 * y0 + y1 * y1);
        float inv = rsqrtf(ss + EPSF);
        if (grp < 4) inv *= 0.08838834764831845f;
        y0 *= inv; y1 *= inv;
      }
      float2 o = {y0, y1};
      *(float2*)(p.QKV + (size_t)row * 1536 + ch) = o;
      if (t0 == 2044 && k >= 1) {
        float2 c = {bflo(u[g][k + 3]), bfhi(u[g][k + 3])};
        *(float2*)(p.out + O_QKVP + ((size_t)b * 3 + (k - 1)) * 1536 + ch) = c;
      }
    }
  }
}
DI void qkv_run4(const Params& p, int row0, int lane) {
  qkv_run4_half<0>(p, row0, lane);
  qkv_run4_half<4>(p, row0, lane);
  qkv_run4_half<8>(p, row0, lane);
  if (lane < 16) {
    const int row = row0 + (lane >> 2), hd = lane & 3;
    float bl = p.BGR[(size_t)row * 8 + hd], al = p.BGR[(size_t)row * 8 + 4 + hd];
    float beta = sigmoidf_(bl);
    float xx = al + p.dt_bias[hd];
    float sp = xx > 20.f ? xx : log1pf(__expf(xx));
    float g = -__expf(p.a_log[hd]) * sp;
    p.BG[(size_t)row * 8 + hd] = beta;
    p.BG[(size_t)row * 8 + 4 + hd] = g;
  }
}

DI void conv_a_prompt_item(const Params& p, int item, float* sm) {
  const int half = item & 1, tile = (item >> 1) & 63, b = item >> 7;
  int tid = threadIdx.x;
  asm volatile("" : "+v"(tid));
  const int c = half * 256 + tid, t0 = tile * 32;
  {
    const int tg = tid >> 5, c8 = tid & 31;
    u32x4 vv[8], gg[8];
#pragma unroll
    for (int ps = 0; ps < 8; ++ps) {
      const int i = tg + 8 * ps;
      const int tt = t0 - 30 + i;
      const size_t row = (size_t)b * 2048 + ((tt >= 0 && i < 62) ? tt : t0);
      vv[ps] = *(const u32x4*)(p.PB + row * EINP + half * 256 + c8 * 8);
      gg[ps] = *(const u32x4*)(p.PB + row * EINP + 512 + half * 256 + c8 * 8);
    }
#pragma unroll
    for (int ps = 0; ps < 8; ++ps) {
      const int i = tg + 8 * ps;
      const int tt = t0 - 30 + i;
      const float msk = (tt >= 0) ? 1.f : 0.f;
      float o8[8];
#pragma unroll
      for (int e = 0; e < 4; ++e) {
        o8[2 * e] = bflo(vv[ps][e]) * sigmoidf_(bflo(gg[ps][e])) * msk;
        o8[2 * e + 1] = bfhi(vv[ps][e]) * sigmoidf_(bfhi(gg[ps][e])) * msk;
      }
      if (i < 62) {
        float4 a0 = {o8[0], o8[1], o8[2], o8[3]}, a1 = {o8[4], o8[5], o8[6], o8[7]};
        *(float4*)(sm + i * 256 + c8 * 8) = a0;
        *(float4*)(sm + i * 256 + c8 * 8 + 4) = a1;
      }
    }
    __syncthreads();
  }
  float w[31];
#pragma unroll
  for (int j = 0; j < 31; ++j) w[j] = p.dw_w[j * 512 + c];
  const float bias = p.dw_b[c];
#pragma unroll 1
  for (int o = 0; o < 32; ++o) {
    float acc = bias;
#pragma unroll
    for (int j = 0; j < 31; ++j) acc += w[j] * sm[(o + j) * 256 + tid];
    p.CONV[((size_t)b * 2048 + t0 + o) * 512 + c] = acc;
  }
  if (tile == 63) {
#pragma unroll 1
    for (int j = 0; j < 30; ++j) p.out[O_CONVP + ((size_t)b * 30 + j) * 512 + c] = sm[(32 + j) * 256 + tid];
  }
  __syncthreads();
}

DI void conv_a_sample_item(const Params& p, int s) {
  const int tid = threadIdx.x;
  const size_t row = NPR + s;
#pragma unroll
  for (int cc = 0; cc < 2; ++cc) {
    int c = tid + cc * 256;
    float val = bf2f(p.PB[row * EINP + c]);
    float gate = bf2f(p.PB[row * EINP + 512 + c]);
    float gl = val * sigmoidf_(gate);
    float acc = p.dw_b[c] + p.dw_w[30 * 512 + c] * gl;
#pragma unroll 6
    for (int j = 0; j < 30; ++j) {
      float st = p.state_conv_a[((size_t)s * 30 + j) * 512 + c];
      acc += p.dw_w[j * 512 + c] * st;
      if (j >= 1) p.out[O_CONVS + ((size_t)s * 30 + j - 1) * 512 + c] = st;
    }
    p.out[O_CONVS + ((size_t)s * 30 + 29) * 512 + c] = gl;
    p.CONV[row * 512 + c] = acc;
  }
}

DI void phase_even_pw_conv(const Params& p, char* smem) {
  for (int it = blockIdx.x; it < 1024 + 128; it += gridDim.x) {
    if (it < 1024) conv_a_prompt_item(p, it, (float*)smem);
    else conv_a_sample_item(p, it - 1024);
  }
}
DI void phase_even_pw_qkv(const Params& p) {
  const int lane = threadIdx.x & 63, wid = threadIdx.x >> 6;
  for (int run = blockIdx.x * 4 + wid; run < NPR / 4; run += gridDim.x * 4) qkv_run4(p, run * 4, lane);
  for (int row = NPR + blockIdx.x * 4 + wid; row < NROW; row += gridDim.x * 4) qkv_token<false, false>(p, row, lane);
}
DI void phase_even_pointwise(const Params& p, char* smem) {
  phase_even_pw_qkv(p);
}

DI void chunk_prep(const Params& p, int item, char* smem) {
  const int tid = threadIdx.x, lane = tid & 63, wid = tid >> 6, r = lane & 31, hl = lane >> 5;
  const int n = item & 31, hh = (item >> 5) & 3, b = item >> 7;
  const size_t row0 = (size_t)b * 2048 + n * 64;
  float* gcs = (float*)smem;
  float* betas = gcs + 64;
  float* egs = betas + 64;
  float* kscale = egs + 64;
  bfr* qs = (bfr*)(smem + 1024);
  bfr* ks_ = qs + 64 * 136;
  float* Am = (float*)(smem + 1024 + 2 * 64 * 136 * 2);
  bfr* wsb = qs;
  if (tid < 64) {
    float beta = p.BG[(row0 + tid) * 8 + hh];
    float g = p.BG[(row0 + tid) * 8 + 4 + hh];
    float v = g;
#pragma unroll
    for (int off = 1; off < 64; off <<= 1) {
      float t = __shfl_up(v, off);
      if (lane >= off) v += t;
    }
    float gl = __shfl(v, 63);
    gcs[tid] = v;
    betas[tid] = beta;
    egs[tid] = __expf(v);
    kscale[tid] = __expf(gl - v);
    if (tid == 63) p.GL[item] = __expf(gl);
  }
#pragma unroll
  for (int i = 0; i < 8; ++i) {
    int idx = tid + i * 256, row = idx >> 5, c4 = idx & 31;
    float4 q = *(const float4*)(p.QKV + (row0 + row) * 1536 + hh * 128 + c4 * 4);
    float4 k = *(const float4*)(p.QKV + (row0 + row) * 1536 + 512 + hh * 128 + c4 * 4);
    uint2 qo, ko;
    qo.x = pack2(q.x, q.y); qo.y = pack2(q.z, q.w);
    ko.x = pack2(k.x, k.y); ko.y = pack2(k.z, k.w);
    *(uint2*)(qs + row * 136 + c4 * 4) = qo;
    *(uint2*)(ks_ + row * 136 + c4 * 4) = ko;
  }
  __syncthreads();
  {
    const int mi = wid >> 1, ni = wid & 1;
    f32x16 akk, aqk;
#pragma unroll
    for (int q = 0; q < 16; ++q) { akk[q] = 0.f; aqk[q] = 0.f; }
#pragma unroll
    for (int ks = 0; ks < 8; ++ks) {
      bf16x8 ka = *(const bf16x8*)(ks_ + (mi * 32 + r) * 136 + ks * 16 + hl * 8);
      bf16x8 qa = *(const bf16x8*)(qs + (mi * 32 + r) * 136 + ks * 16 + hl * 8);
      bf16x8 kb = *(const bf16x8*)(ks_ + (ni * 32 + r) * 136 + ks * 16 + hl * 8);
      akk = MFMA32(ka, kb, akk);
      aqk = MFMA32(qa, kb, aqk);
    }
    bfr* qkf = (bfr*)(p.QKF + (size_t)item * 512);
#pragma unroll
    for (int q = 0; q < 16; ++q) {
      int i = mi * 32 + crow(q, hl), j = ni * 32 + r;
      float dec = (i >= j) ? __expf(gcs[i] - gcs[j]) : 0.f;
      Am[i * 68 + j] = (i > j) ? akk[q] * betas[i] * dec : 0.f;
      float qv = (i >= j) ? aqk[q] * dec : 0.f;
      int ksj = j >> 4, jl = j & 15, h2 = (jl >> 2) & 1, jj = ((jl >> 3) << 2) | (jl & 3);
      qkf[((mi * 4 + ksj) * 64 + h2 * 32 + (i & 31)) * 8 + jj] = f2bf(qv);
    }
  }
  {
    uint4* QD = p.QD + (size_t)item * 1024;
#pragma unroll
    for (int i = 0; i < 4; ++i) {
      int idx = tid + i * 256, f = idx >> 6, ln = idx & 63, mt = f >> 3, ks = f & 7, m = ln & 31, h2 = ln >> 5;
      int ri = mt * 32 + m, d0 = ks * 16 + h2 * 4;
      float sc = egs[ri];
      const float* src = p.QKV + (row0 + ri) * 1536 + hh * 128 + d0;
      float4 a = *(const float4*)src, c = *(const float4*)(src + 8);
      uint4 o;
      o.x = pack2(a.x * sc, a.y * sc); o.y = pack2(a.z * sc, a.w * sc);
      o.z = pack2(c.x * sc, c.y * sc); o.w = pack2(c.z * sc, c.w * sc);
      QD[f * 64 + ln] = o;
    }
    uint4* KD = p.KD + (size_t)item * 1024;
#pragma unroll
    for (int i = 0; i < 4; ++i) {
      int idx = tid + i * 256, f = idx >> 6, ln = idx & 63, mt = f >> 2, ks = f & 3, m = ln & 31, h2 = ln >> 5;
      int d = mt * 32 + m;
      float vals[8];
#pragma unroll
      for (int j = 0; j < 8; ++j) {
        int c = ks * 16 + 8 * (j >> 2) + 4 * h2 + (j & 3);
        vals[j] = p.QKV[(row0 + c) * 1536 + 512 + hh * 128 + d] * kscale[c];
      }
      uint4 o;
      o.x = pack2(vals[0], vals[1]); o.y = pack2(vals[2], vals[3]);
      o.z = pack2(vals[4], vals[5]); o.w = pack2(vals[6], vals[7]);
      KD[f * 64 + ln] = o;
    }
  }
  __syncthreads();
  {
    const int c = tid;
    const float* src = (c < 128) ? (p.QKV + row0 * 1536 + 1024 + hh * 128 + c) : (p.QKV + row0 * 1536 + 512 + hh * 128 + (c - 128));
    float sol[64];
#pragma unroll
    for (int i = 0; i < 64; ++i) {
      float rhs = src[(size_t)i * 1536] * betas[i];
      if (c >= 128) rhs *= egs[i];
      float acc = rhs, acc1 = 0.f;
#pragma unroll
      for (int j = 0; j < i; ++j) {
        if (j & 1) acc1 -= Am[i * 68 + j] * sol[j];
        else acc -= Am[i * 68 + j] * sol[j];
      }
      sol[i] = acc + acc1;
    }
    if (c < 128) {
      float* U = p.U + (size_t)item * 8192;
#pragma unroll
      for (int i = 0; i < 64; ++i) U[i * 128 + c] = sol[i];
    } else {
#pragma unroll
      for (int i = 0; i < 64; ++i) wsb[i * 136 + (c - 128)] = f2bf(-sol[i]);
    }
  }
  __syncthreads();
  {
    uint4* WN = p.WN + (size_t)item * 1024;
#pragma unroll
    for (int i = 0; i < 4; ++i) {
      int idx = tid + i * 256, f = idx >> 6, ln = idx & 63, mt = f >> 3, ks = f & 7, m = ln & 31, h2 = ln >> 5;
      int ri = mt * 32 + m, d0 = ks * 16 + h2 * 4;
      uint2 a = *(const uint2*)(wsb + ri * 136 + d0), c = *(const uint2*)(wsb + ri * 136 + d0 + 8);
      uint4 o = {a.x, a.y, c.x, c.y};
      WN[f * 64 + ln] = o;
    }
  }
  __syncthreads();
}

DI void branch_a_final_row(const Params& p, int row, int lane) {
  const float* cr = p.CONV + (size_t)row * 512;
  float4 v[2];
  float s = 0.f;
#pragma unroll
  for (int j = 0; j < 2; ++j) {
    v[j] = ((const float4*)cr)[j * 64 + lane];
    s += v[j].x + v[j].y + v[j].z + v[j].w;
  }
  float mean = wave_sum(s) * (1.0f / 512.0f);
  float vs = 0.f;
#pragma unroll
  for (int j = 0; j < 2; ++j) {
    v[j].x -= mean; v[j].y -= mean; v[j].z -= mean; v[j].w -= mean;
    vs += v[j].x * v[j].x + v[j].y * v[j].y + v[j].z * v[j].z + v[j].w * v[j].w;
  }
  float inv = rsqrtf(wave_sum(vs) * (1.0f / 512.0f) + EPSF);
#pragma unroll
  for (int j = 0; j < 2; ++j) {
    int c = (j * 64 + lane) * 4;
    float4 g = *(const float4*)(p.ln_a_g + c), bb = *(const float4*)(p.ln_a_b + c);
    uint2 gu = *(const uint2*)(p.PB + (size_t)row * EINP + 1024 + c);
    float y0 = siluf_(v[j].x * inv * g.x + bb.x) * siluf_(bflo(gu.x));
    float y1 = siluf_(v[j].y * inv * g.y + bb.y) * siluf_(bfhi(gu.x));
    float y2 = siluf_(v[j].z * inv * g.z + bb.z) * siluf_(bflo(gu.y));
    float y3 = siluf_(v[j].w * inv * g.w + bb.w) * siluf_(bfhi(gu.y));
    uint2 o;
    o.x = pack2(y0, y1); o.y = pack2(y2, y3);
    *(uint2*)(p.MIX + (size_t)row * 1024 + c) = o;
  }
}

DI void delta_sample_item(const Params& p, int item, char* smem) {
  const int s = item >> 2, hh = item & 3, tid = threadIdx.x;
  const size_t row = NPR + s;
  float* ksm = (float*)smem;
  float* qsm = ksm + 128;
  float* part = qsm + 128;
  if (tid < 128) ksm[tid] = p.QKV[row * 1536 + 512 + hh * 128 + tid];
  else qsm[tid - 128] = p.QKV[row * 1536 + hh * 128 + (tid - 128)];
  const float beta = p.BG[row * 8 + hh], a = __expf(p.BG[row * 8 + 4 + hh]);
  __syncthreads();
  const int e = tid & 127, half = tid >> 7, d0 = half * 64;
  const float* S0 = p.state_delta + (((size_t)s * 4 + hh) * 128 + d0) * 128 + e;
  float* So = p.out + O_DELTAS + (((size_t)s * 4 + hh) * 128 + d0) * 128 + e;
  float Sr[64];
  float ksum = 0.f;
#pragma unroll
  for (int i = 0; i < 64; ++i) {
    Sr[i] = S0[(size_t)i * 128] * a;
    ksum += ksm[d0 + i] * Sr[i];
  }
  part[half * 128 + e] = ksum;
  __syncthreads();
  const float kS = part[e] + part[128 + e];
  const float v = p.QKV[row * 1536 + 1024 + hh * 128 + e];
  const float vnew = (v - kS) * beta;
  float oo = 0.f;
#pragma unroll
  for (int i = 0; i < 64; ++i) {
    Sr[i] += ksm[d0 + i] * vnew;
    So[(size_t)i * 128] = Sr[i];
    oo += qsm[d0 + i] * Sr[i];
  }
  __syncthreads();
  part[half * 128 + e] = oo;
  __syncthreads();
  if (half == 0) p.ODN[row * 512 + hh * 128 + e] = part[e] + part[128 + e];
  __syncthreads();
}

DI void phase_chunk_prep(const Params& p, char* smem) {
  for (int it = blockIdx.x; it < 1024; it += gridDim.x) chunk_prep(p, it, smem);
}

DI void scan_item(const Params& p, int item, char* smem) {
  const int tid = threadIdx.x, lane = tid & 63, es = tid >> 6, r = lane & 31, hl = lane >> 5;
  const int b = item >> 2, hh = item & 3;
  u32x4* bufA = (u32x4*)smem;
  u32x4* bufB = (u32x4*)(smem + 32768);
  const u32x4* gWN = (const u32x4*)p.WN + (size_t)item * 32 * 1024;
  const u32x4* gQD = (const u32x4*)p.QD + (size_t)item * 32 * 1024;
  const u32x4* gKD = (const u32x4*)p.KD + (size_t)item * 32 * 1024;
  const u32x4* gQK = (const u32x4*)p.QKF + (size_t)item * 32 * 512;
  const float* gU = p.U + (size_t)item * 32 * 8192;
  const int uo = hl * 4 * 128 + es * 32 + r;
  const int oo = hl * 4 * 512 + es * 32 + r;
#define GLDS(gp, lp) __builtin_amdgcn_global_load_lds((const unsigned*)(gp), (unsigned*)(lp), 16, 0, 0)
  f32x16 S[4];
#pragma unroll
  for (int d = 0; d < 4; ++d)
#pragma unroll
    for (int q = 0; q < 16; ++q) S[d][q] = 0.f;
  f32x16 vn[2], o[2], op[2];
#pragma unroll
  for (int i = 0; i < 4; ++i) {
    GLDS(gWN + tid + i * 256, bufA + tid + i * 256);
    GLDS(gQD + tid + i * 256, bufA + 1024 + tid + i * 256);
  }
#pragma unroll
  for (int ct = 0; ct < 2; ++ct)
#pragma unroll
    for (int q = 0; q < 16; ++q) vn[ct][q] = gU[(ct * 32 + crow(q, 0)) * 128 + uo];
  asm volatile("s_waitcnt vmcnt(0)" ::: "memory");
  __syncthreads();
#pragma unroll 1
  for (int n = 0; n < 32; ++n) {
    const int chunk = item * 32 + n;
    const float gl = p.GL[chunk];
    const int n1 = (n + 1 < 32) ? n + 1 : 31;
    if (n > 0) {
      float* odp = p.ODN + ((size_t)b * 2048 + (n - 1) * 64) * 512 + hh * 128;
#pragma unroll
      for (int ct = 0; ct < 2; ++ct)
#pragma unroll
        for (int q = 0; q < 16; ++q) odp[(ct * 32 + crow(q, 0)) * 512 + oo] = op[ct][q];
    }
    {
      const u32x4* k0 = gQK + n * 512;
      const u32x4* d0 = gKD + n * 1024;
#pragma unroll
      for (int i = 0; i < 2; ++i) GLDS(k0 + tid + i * 256, bufB + tid + i * 256);
#pragma unroll
      for (int i = 0; i < 4; ++i) GLDS(d0 + tid + i * 256, bufB + 512 + tid + i * 256);
    }
    {
      bf16x8 Sb[4][2];
#pragma unroll
      for (int d = 0; d < 4; ++d) { Sb[d][0] = pack8(S[d], 0); Sb[d][1] = pack8(S[d], 1); }
#pragma unroll
      for (int ct = 0; ct < 2; ++ct)
#pragma unroll
        for (int q = 0; q < 16; ++q) o[ct][q] = 0.f;
#pragma unroll
      for (int ct = 0; ct < 2; ++ct)
#pragma unroll
        for (int ks = 0; ks < 8; ++ks) {
          bf16x8 aw = __builtin_bit_cast(bf16x8, bufA[(ct * 8 + ks) * 64 + lane]);
          bf16x8 aq = __builtin_bit_cast(bf16x8, bufA[1024 + (ct * 8 + ks) * 64 + lane]);
          vn[ct] = MFMA32(aw, Sb[ks >> 1][ks & 1], vn[ct]);
          o[ct] = MFMA32(aq, Sb[ks >> 1][ks & 1], o[ct]);
        }
    }
    bf16x8 Vb[2][2];
#pragma unroll
    for (int ct = 0; ct < 2; ++ct) { Vb[ct][0] = pack8(vn[ct], 0); Vb[ct][1] = pack8(vn[ct], 1); }
    asm volatile("s_waitcnt vmcnt(0)" ::: "memory");
    __syncthreads();
    {
      const u32x4* w1 = gWN + n1 * 1024;
      const u32x4* q1 = gQD + n1 * 1024;
#pragma unroll
      for (int i = 0; i < 4; ++i) {
        GLDS(w1 + tid + i * 256, bufA + tid + i * 256);
        GLDS(q1 + tid + i * 256, bufA + 1024 + tid + i * 256);
      }
      const float* u1 = gU + n1 * 8192;
#pragma unroll
      for (int ct = 0; ct < 2; ++ct)
#pragma unroll
        for (int q = 0; q < 16; ++q) vn[ct][q] = u1[(ct * 32 + crow(q, 0)) * 128 + uo];
    }
#pragma unroll
    for (int ct = 0; ct < 2; ++ct)
#pragma unroll
      for (int ks = 0; ks < 4; ++ks) {
        bf16x8 a = __builtin_bit_cast(bf16x8, bufB[(ct * 4 + ks) * 64 + lane]);
        o[ct] = MFMA32(a, Vb[ks >> 1][ks & 1], o[ct]);
      }
#pragma unroll
    for (int d = 0; d < 4; ++d) {
#pragma unroll
      for (int q = 0; q < 16; ++q) S[d][q] *= gl;
#pragma unroll
      for (int ks = 0; ks < 4; ++ks) {
        bf16x8 a = __builtin_bit_cast(bf16x8, bufB[512 + (d * 4 + ks) * 64 + lane]);
        S[d] = MFMA32(a, Vb[ks >> 1][ks & 1], S[d]);
      }
    }
#pragma unroll
    for (int ct = 0; ct < 2; ++ct) op[ct] = o[ct];
    asm volatile("s_waitcnt vmcnt(0)" ::: "memory");
    __syncthreads();
  }
  {
    float* odp = p.ODN + ((size_t)b * 2048 + 31 * 64) * 512 + hh * 128;
#pragma unroll
    for (int ct = 0; ct < 2; ++ct)
#pragma unroll
      for (int q = 0; q < 16; ++q) odp[(ct * 32 + crow(q, 0)) * 512 + oo] = op[ct][q];
  }
#undef GLDS
  float* so = p.out + O_DELTAP + ((size_t)(b * 4 + hh) * 128) * 128;
#pragma unroll
  for (int d = 0; d < 4; ++d)
#pragma unroll
    for (int q = 0; q < 16; ++q) so[(d * 32 + crow(q, 0)) * 128 + uo] = S[d][q];
  __syncthreads();
}

DI void branch_a_unit(const Params& p, int u, char* smem) {
  int tidu = threadIdx.x;
  asm volatile("" : "+v"(tidu));
  const int lane = tidu & 63, wid = tidu >> 6;
  if (u < 512) {
    conv_a_prompt_item(p, u * 2, (float*)smem);
    conv_a_prompt_item(p, u * 2 + 1, (float*)smem);
    __syncthreads();
    const int row0 = (u >> 6) * 2048 + (u & 63) * 32;
    for (int k = wid; k < 32; k += 4) branch_a_final_row(p, row0 + k, lane);
  } else {
    conv_a_sample_item(p, u - 512);
    __syncthreads();
    if (wid == 0) branch_a_final_row(p, NPR + (u - 512), lane);
  }
  __syncthreads();
}

DI void phase_scan(const Params& p, char* smem) {
  const int lane = threadIdx.x & 63, wid = threadIdx.x >> 6;
  if (gridDim.x >= 64) {
    if (blockIdx.x < 32) {
      scan_item(p, blockIdx.x, smem);
    } else {
      const int nb = gridDim.x - 32, bi = blockIdx.x - 32;
      for (int w = bi; w < 640 + 512 + 2112; w += nb) {
        if (w < 640) branch_a_unit(p, w, smem);
        else if (w < 1152) delta_sample_item(p, w - 640, smem);
        else transpose_item(p, transpose_late(w - 1152), (float*)smem);
      }
    }
  } else {
    for (int it = blockIdx.x; it < 32; it += gridDim.x) scan_item(p, it, smem);
    for (int it = blockIdx.x; it < 512; it += gridDim.x) delta_sample_item(p, it, smem);
    for (int u = blockIdx.x; u < 640; u += gridDim.x) branch_a_unit(p, u, smem);
    for (int i = blockIdx.x; i < 2112; i += gridDim.x) transpose_item(p, transpose_late(i), (float*)smem);
  }
}

DI void phase_delta_post(const Params& p) {
  const int lane = threadIdx.x & 63, wid = threadIdx.x >> 6;
  const int stride = gridDim.x * 4;
  const float2 g = *(const float2*)(p.dn_norm_g + lane * 2);
  for (int row = blockIdx.x * 4 + wid; row < NROW; row += 2 * stride) {
    const int r1 = row + stride;
    const bool has1 = r1 < NROW;
    const int rows[2] = {row, has1 ? r1 : row};
    float2 o[2][4];
    unsigned zu[2][4];
#pragma unroll
    for (int k = 0; k < 2; ++k)
#pragma unroll
      for (int hh = 0; hh < 4; ++hh) {
        const int ch = hh * 128 + lane * 2;
        o[k][hh] = *(const float2*)(p.ODN + (size_t)rows[k] * 512 + ch);
        zu[k][hh] = *(const unsigned*)(p.PB + (size_t)rows[k] * EINP + 3072 + ch);
      }
#pragma unroll
    for (int k = 0; k < 2; ++k)
#pragma unroll
      for (int hh = 0; hh < 4; ++hh) {
        const int ch = hh * 128 + lane * 2;
        float ss = wave_sum(o[k][hh].x * o[k][hh].x + o[k][hh].y * o[k][hh].y);
        float inv = rsqrtf(ss * (1.0f / 128.0f) + EPSF);
        float y0 = o[k][hh].x * inv * g.x * siluf_(bflo(zu[k][hh]));
        float y1 = o[k][hh].y * inv * g.y * siluf_(bfhi(zu[k][hh]));
        if (k == 0 || has1) *(unsigned*)(p.MIX + (size_t)rows[k] * 1024 + 512 + ch) = pack2(y0, y1);
      }
  }
}

template <bool FIRST, bool HAS_H>
DI void phase_gemm_resid(const Params& p, const bfr* A, const bfr* Wt, const float* gnext, float* ss, char* smem) {
  float* X = p.X;
  bfr* Hn = p.H;
  {
    const float* xs = p.x_sample - (size_t)NPR * 1024;
    gemm_sample<true>(A, 1024, Wt, 1024, 1024, 1024, smem,
                      [=](int row, int col, float v) -> float {
                        const size_t o = (size_t)row * 1024 + col;
                        const float xn = (FIRST ? xs[o] : X[o]) + v;
                        X[o] = xn;
                        if (HAS_H) Hn[o] = f2bf(xn * gnext[col]);
                        return xn;
                      },
                      [=](int row, float s2) { unsafeAtomicAdd(ss + row, s2); });
  }
  for (int t = blockIdx.x; t < 128 * 4; t += gridDim.x) {
    const int mt = t >> 2, nt = t & 3, m0 = mt * 128, n0 = nt * 256;
    f32x16 acc[2][4];
    gemm_mainloop<1024>(A, Wt, 1024, 1024, m0, n0, smem, acc);
    int tid2 = threadIdx.x;
    asm volatile("" : "+v"(tid2));
    const int lane = tid2 & 63, wid = tid2 >> 6, wr = wid >> 1, wc = wid & 1, r = lane & 31, hl = lane >> 5;
    const float* xsrc = FIRST ? p.x_prompt : X;
    const int rbase = m0 + wr * 64 + 4 * hl, cbase = n0 + wc * 128 + r;
#pragma unroll
    for (int i = 0; i < 2; ++i) {
#pragma unroll
      for (int qh = 0; qh < 2; ++qh) {
        float rs[8];
#pragma unroll
        for (int q = 0; q < 8; ++q) rs[q] = 0.f;
#pragma unroll
        for (int jh = 0; jh < 2; ++jh) {
          float xo[2][8];
#pragma unroll
          for (int jj = 0; jj < 2; ++jj)
#pragma unroll
            for (int q = 0; q < 8; ++q)
              xo[jj][q] = xsrc[(rbase + i * 32 + crow(qh * 8 + q, 0)) * 1024 + cbase + (jh * 2 + jj) * 32];
#pragma unroll
          for (int q = 0; q < 8; ++q) {
            const int o = (rbase + i * 32 + crow(qh * 8 + q, 0)) * 1024 + cbase;
#pragma unroll
            for (int jj = 0; jj < 2; ++jj) {
              const int j = jh * 2 + jj;
              const float xn = xo[jj][q] + acc[i][j][qh * 8 + q];
              X[o + j * 32] = xn;
              if (HAS_H) Hn[o + j * 32] = f2bf(xn * gnext[cbase + j * 32]);
              rs[q] += xn * xn;
            }
          }
        }
#pragma unroll
        for (int q = 0; q < 8; ++q) rs[q] = half32_sum_hi(rs[q]);
        if (r == 31) {
#pragma unroll
          for (int q = 0; q < 8; ++q) unsafeAtomicAdd(ss + rbase + i * 32 + crow(qh * 8 + q, 0), rs[q]);
        }
      }
    }
  }
}
DI void phase_gemm_bf16out(const Params& p, const bfr* A, const bfr* Wt, bfr* C, int N, const float* ss, char* smem) {
  const int ntn = N >> 8;
  gemm_sample<false>(A, 1024, Wt, N, 1024, N, smem,
                     [=](int row, int col, float v) -> float {
                       float inv = rsqrtf(ss[row] * (1.0f / 1024.0f) + EPSF);
                       C[(size_t)row * N + col] = f2bf(v * inv);
                       return 0.f;
                     },
                     [=](int, float) {});
  for (int t = blockIdx.x; t < 128 * ntn; t += gridDim.x) {
    int mt = t / ntn, nt = t % ntn;
    gemm_tile<1024>(A, Wt, N, 1024, mt * 128, nt * 256, smem,
              [=](int row, int col, float v) {
                float inv = rsqrtf(ss[row] * (1.0f / 1024.0f) + EPSF);
                C[(size_t)row * N + col] = f2bf(v * inv);
              });
  }
}

DI void attn_prompt_wave(const Params& p, int l, int b, int hh, int tt, bfr* Obuf) {
  const int lane = threadIdx.x & 63, r = lane & 31, hl = lane >> 5;
  const size_t row0 = (size_t)b * 2048 + tt * 32;
  const bfr* Qp = p.ACT2 + (row0 + r) * 1024 + hh * 256 + hl * 8;
  const bfr* Kp = p.KB + (size_t)l * 2097152 + ((size_t)b * 256 + r) * 1024 + hh * 256 + hl * 8;
  f32x16 st[8];
#pragma unroll
  for (int m = 0; m < 8; ++m)
#pragma unroll
    for (int q = 0; q < 16; ++q) st[m][q] = 0.f;
#pragma unroll 2
  for (int ks = 0; ks < 16; ++ks) {
    bf16x8 qf = *(const bf16x8*)(Qp + ks * 16);
#pragma unroll
    for (int m = 0; m < 8; ++m) {
      bf16x8 kf = *(const bf16x8*)(Kp + (size_t)m * 32 * 1024 + ks * 16);
      st[m] = MFMA32(kf, qf, st[m]);
    }
  }
  float mx = -3.0e38f;
#pragma unroll
  for (int m = 0; m < 8; ++m)
#pragma unroll
    for (int q = 0; q < 16; ++q) mx = fmaxf(mx, st[m][q]);
  mx = fmaxf(mx, __shfl_xor(mx, 32));
  float sum = 0.f;
#pragma unroll
  for (int m = 0; m < 8; ++m)
#pragma unroll
    for (int q = 0; q < 16; ++q) {
      float e = __expf((st[m][q] - mx) * 0.0625f);
      st[m][q] = e;
      sum += e;
    }
  sum += __shfl_xor(sum, 32);
  const float inv = 1.0f / sum;
  bf16x8 pb[8][2];
#pragma unroll
  for (int m = 0; m < 8; ++m) { pb[m][0] = pack8(st[m], 0); pb[m][1] = pack8(st[m], 1); }
  const uint4* VT = (const uint4*)(p.VT + (size_t)l * 2097152) + ((size_t)(b * 4 + hh) * 8) * 16 * 64 + lane;
  bfr* Op = Obuf + (row0 + r) * 1024 + hh * 256;
#pragma unroll 1
  for (int half = 0; half < 2; ++half) {
    f32x16 o[4];
#pragma unroll
    for (int d = 0; d < 4; ++d)
#pragma unroll
      for (int q = 0; q < 16; ++q) o[d][q] = 0.f;
#pragma unroll
    for (int ks = 0; ks < 16; ++ks) {
#pragma unroll
      for (int d = 0; d < 4; ++d) {
        bf16x8 vf = ldfrag(VT + ((size_t)(half * 4 + d) * 16 + ks) * 64);
        o[d] = MFMA32(vf, pb[ks >> 1][ks & 1], o[d]);
      }
    }
#pragma unroll
    for (int d = 0; d < 4; ++d)
#pragma unroll
      for (int g4 = 0; g4 < 4; ++g4) {
        int dim = (half * 4 + d) * 32 + 8 * g4 + 4 * hl;
        uint2 ov;
        ov.x = pack2(o[d][g4 * 4 + 0] * inv, o[d][g4 * 4 + 1] * inv);
        ov.y = pack2(o[d][g4 * 4 + 2] * inv, o[d][g4 * 4 + 3] * inv);
        *(uint2*)(Op + dim) = ov;
      }
  }
}

DI void attn_prompt_block(const Params& p, int l, int b, int hh, int tt4, char* smem, bfr* Obuf) {
  int tid = threadIdx.x;
  asm volatile("" : "+v"(tid));
  const int lane = tid & 63, wid = tid >> 6, r = lane & 31, hl = lane >> 5;
  const int row0 = b * 2048 + (tt4 * 4 + wid) * 32;
  const int qoff = (row0 + r) * 1024 + hh * 256 + hl * 8;
  const bfr* Kg = p.KB + (size_t)l * 2097152 + (size_t)(b * 256) * 1024 + hh * 256;
  const u32x4* VTg = (const u32x4*)(p.VT + (size_t)l * 2097152) + (size_t)((b * 4 + hh) * 8) * 16 * 64;
  bfr* kbuf = (bfr*)smem;
  u32x4* vbuf = (u32x4*)smem;
  u32x4 sr[8];
#define LOADK(c_) do { _Pragma("unroll") for (int i = 0; i < 4; ++i) { const int ch = tid + i * 256; \
    sr[i] = *(const u32x4*)(Kg + (ch >> 2) * 1024 + (c_) * 32 + (ch & 3) * 8); } } while (0)
#define STOREK() do { _Pragma("unroll") for (int i = 0; i < 4; ++i) { const int ch = tid + i * 256; \
    *(u32x4*)(kbuf + (ch >> 2) * 40 + (ch & 3) * 8) = sr[i]; } } while (0)
#define LOADV(v_, tid) do { _Pragma("unroll") for (int i = 0; i < 8; ++i) { const int idx = tid + i * 256, f = idx >> 6; \
    sr[i] = VTg[(((v_) >> 1) * 4 + (f >> 3)) * 1024 + (((v_) & 1) * 8 + (f & 7)) * 64 + (idx & 63)]; } } while (0)
#define STOREV(tid) do { _Pragma("unroll") for (int i = 0; i < 8; ++i) vbuf[tid + i * 256] = sr[i]; } while (0)
  f32x16 st[8];
#pragma unroll
  for (int m = 0; m < 8; ++m)
#pragma unroll
    for (int q = 0; q < 16; ++q) st[m][q] = 0.f;
  LOADK(0);
  STOREK();
  __syncthreads();
#pragma unroll
  for (int c = 0; c < 8; ++c) {
    if (c < 7) LOADK(c + 1); else LOADV(0, tid);
    bf16x8 qf[2];
#pragma unroll
    for (int ksl = 0; ksl < 2; ++ksl) qf[ksl] = *(const bf16x8*)(p.ACT2 + qoff + (c * 2 + ksl) * 16);
#pragma unroll
    for (int ksl = 0; ksl < 2; ++ksl)
#pragma unroll
      for (int m = 0; m < 8; ++m) {
        bf16x8 kf = *(const bf16x8*)(kbuf + (m * 32 + r) * 40 + ksl * 16 + hl * 8);
        st[m] = MFMA32(kf, qf[ksl], st[m]);
      }
    __syncthreads();
    if (c < 7) STOREK(); else STOREV(tid);
    __syncthreads();
  }
  float mx = -3.0e38f;
#pragma unroll
  for (int m = 0; m < 8; ++m)
#pragma unroll
    for (int q = 0; q < 16; ++q) mx = fmaxf(mx, st[m][q]);
  mx = fmaxf(mx, __shfl_xor(mx, 32));
  float sum = 0.f;
#pragma unroll
  for (int m = 0; m < 8; ++m)
#pragma unroll
    for (int q = 0; q < 16; ++q) {
      float e = __expf((st[m][q] - mx) * 0.0625f);
      st[m][q] = e;
      sum += e;
    }
  sum += __shfl_xor(sum, 32);
  const float inv = 1.0f / sum;
  bf16x8 pb[8][2];
#pragma unroll
  for (int m = 0; m < 8; ++m) { pb[m][0] = pack8(st[m], 0); pb[m][1] = pack8(st[m], 1); }
  int tidv = threadIdx.x;
  asm volatile("" : "+v"(tidv));
  const int lanev = tidv & 63, rv = lanev & 31, hlv = lanev >> 5;
  const int ooff = (b * 2048 + (tt4 * 4 + (tidv >> 6)) * 32 + rv) * 1024 + hh * 256;
  f32x16 o[4];
#pragma unroll
  for (int v = 0; v < 4; ++v) {
    if (v < 3) LOADV(v + 1, tidv);
    if ((v & 1) == 0) {
#pragma unroll
      for (int d = 0; d < 4; ++d)
#pragma unroll
        for (int q = 0; q < 16; ++q) o[d][q] = 0.f;
    }
#pragma unroll
    for (int kk = 0; kk < 8; ++kk)
#pragma unroll
      for (int d = 0; d < 4; ++d) {
        bf16x8 vf = __builtin_bit_cast(bf16x8, vbuf[(d * 8 + kk) * 64 + lanev]);
        o[d] = MFMA32(vf, pb[((v & 1) * 8 + kk) >> 1][kk & 1], o[d]);
        if (d == 3) __builtin_amdgcn_sched_barrier(0);
      }
    if (v & 1) {
#pragma unroll
      for (int d = 0; d < 4; ++d)
#pragma unroll
        for (int g4 = 0; g4 < 4; ++g4) {
          int dim = ((v >> 1) * 4 + d) * 32 + 8 * g4 + 4 * hlv;
          uint2 ov;
          ov.x = pack2(o[d][g4 * 4 + 0] * inv, o[d][g4 * 4 + 1] * inv);
          ov.y = pack2(o[d][g4 * 4 + 2] * inv, o[d][g4 * 4 + 3] * inv);
          *(uint2*)(Obuf + ooff + dim) = ov;
        }
    }
    __syncthreads();
    if (v < 3) { STOREV(tidv); __syncthreads(); }
  }
#undef LOADK
#undef STOREK
#undef LOADV
#undef STOREV
}

DI void attn_sample_item(const Params& p, int l, int item, char* smem, bfr* Obuf) {
  const int s = item >> 2, hh = item & 3, tid = threadIdx.x, lane = tid & 63, wid = tid >> 6;
  float* qsm = (float*)smem;
  float* sc = qsm + 256;
  float* red = sc + 256;
  const size_t row = NPR + s;
  qsm[tid] = bf2f(p.ACT2[row * 1024 + hh * 256 + tid]);
  __syncthreads();
  const int grp = lane >> 4, l16 = lane & 15;
  float4 q4[4];
#pragma unroll
  for (int j = 0; j < 4; ++j) q4[j] = ((const float4*)qsm)[j * 16 + l16];
  const float* Kb = p.cache_k + ((((size_t)l * 128 + s) * 256) * 4 + hh) * 256;
  const float* Vb = p.cache_v + ((((size_t)l * 128 + s) * 256) * 4 + hh) * 256;
#pragma unroll 8
  for (int ps = 0; ps < 16; ++ps) {
    int mem = wid * 64 + ps * 4 + grp;
    const float4* kr = (const float4*)(Kb + (size_t)mem * 1024);
    float d = 0.f;
#pragma unroll
    for (int j = 0; j < 4; ++j) {
      float4 k4 = kr[j * 16 + l16];
      d += k4.x * q4[j].x + k4.y * q4[j].y + k4.z * q4[j].z + k4.w * q4[j].w;
    }
    d += __shfl_xor(d, 8);
    d += __shfl_xor(d, 4);
    d += __shfl_xor(d, 2);
    d += __shfl_xor(d, 1);
    if (l16 == 0) sc[mem] = d * 0.0625f;
  }
  __syncthreads();
  float sv = sc[tid];
  float m = wave_max(sv);
  if (lane == 0) red[wid] = m;
  __syncthreads();
  m = fmaxf(fmaxf(red[0], red[1]), fmaxf(red[2], red[3]));
  float e = __expf(sv - m);
  float sm_ = wave_sum(e);
  if (lane == 0) red[4 + wid] = sm_;
  sc[tid] = e;
  __syncthreads();
  const float inv = 1.0f / (red[4] + red[5] + red[6] + red[7]);
  float4 acc = {0.f, 0.f, 0.f, 0.f};
  float* partial = (float*)smem + 1024;
#pragma unroll 16
  for (int i = 0; i < 64; ++i) {
    const int mem = wid * 64 + i;
    float4 v4 = *(const float4*)(Vb + (size_t)mem * 1024 + lane * 4);
    const float pm = sc[mem];
    acc.x += pm * v4.x; acc.y += pm * v4.y; acc.z += pm * v4.z; acc.w += pm * v4.w;
  }
  *(float4*)(partial + wid * 256 + lane * 4) = acc;
  __syncthreads();
  const float ov = partial[tid] + partial[256 + tid] + partial[512 + tid] + partial[768 + tid];
  Obuf[row * 1024 + hh * 256 + tid] = f2bf(ov * inv);
  __syncthreads();
}

DI void phase_attn(const Params& p, int l, char* smem) {
  bfr* Obuf = p.ACT3;
  const int half = gridDim.x >> 1;
  const bool upper = (int)blockIdx.x >= half;
  const int bi = upper ? (int)blockIdx.x - half : (int)blockIdx.x;
  const int nb = upper ? (int)gridDim.x - half : half;
  for (int pass = 0; pass < 2; ++pass) {
    const bool do_sample = (pass == 0) != upper;
    if (do_sample) {
      for (int k = bi; k < 256; k += nb) attn_sample_item(p, l, 2 * k + (upper ? 1 : 0), smem, Obuf);
    } else {
      for (int k = bi; k < 256; k += nb) {
        const int u = 2 * k + (upper ? 1 : 0), tt4 = u & 15, hh = (u >> 4) & 3, b = u >> 6;
        attn_prompt_block(p, l, b, hh, tt4, smem, Obuf);
      }
    }
  }
}

template <int WIN>
DI void pool_elem(const Params& p, int row, int c) {
  const bfr* P2 = p.PB;
  unsigned uu = *(const unsigned*)(P2 + (size_t)row * 2048 + c);
  const float u0 = bflo(uu), u1 = bfhi(uu);
  float s0 = u0, s1 = u1, cnt;
  if (row < NPR) {
    const int t = row & 2047, b = row >> 11;
    if (t >= WIN - 1) {
      cnt = (float)WIN;
      unsigned w[WIN - 1];
#pragma unroll
      for (int j = 1; j < WIN; ++j) w[j - 1] = *(const unsigned*)(P2 + (size_t)(row - j) * 2048 + c);
#pragma unroll
      for (int j = 1; j < WIN; ++j) { s0 += bflo(w[j - 1]); s1 += bfhi(w[j - 1]); }
    } else {
      cnt = (float)(t + 1);
      for (int j = 1; j <= t; ++j) {
        unsigned w = *(const unsigned*)(P2 + (size_t)(row - j) * 2048 + c);
        s0 += bflo(w); s1 += bfhi(w);
      }
    }
    if (t >= 2033) {
      float2 o = {u0, u1};
      *(float2*)(p.out + O_POOLP + ((size_t)b * 15 + (t - 2033)) * 1024 + c) = o;
    }
  } else {
    const int s = row - NPR;
    cnt = (float)WIN;
    const float* sp = p.state_pool + (size_t)s * 15 * 1024 + c;
    float2 st[15];
#pragma unroll
    for (int j = 0; j < 15; ++j) st[j] = *(const float2*)(sp + (size_t)j * 1024);
#pragma unroll
    for (int j = 1; j < WIN; ++j) { s0 += st[15 - j].x; s1 += st[15 - j].y; }
    float* op = p.out + O_POOLS + (size_t)s * 15 * 1024 + c;
#pragma unroll
    for (int j = 0; j < 14; ++j) *(float2*)(op + (size_t)j * 1024) = st[j + 1];
    float2 o = {u0, u1};
    *(float2*)(op + (size_t)14 * 1024) = o;
  }
  *(unsigned*)(p.MIX + (size_t)row * 1024 + c) = pack2(s0 / cnt - u0, s1 / cnt - u1);
}
DI void phase_pool(const Params& p) {
  for (int idx = blockIdx.x * 256 + threadIdx.x; idx < NROW * 512; idx += gridDim.x * 256) {
    const int row = idx >> 9, c = (idx & 511) * 2;
    const int gi = c >> 8;
    if (gi == 0) pool_elem<2>(p, row, c);
    else if (gi == 1) pool_elem<4>(p, row, c);
    else if (gi == 2) pool_elem<8>(p, row, c);
    else pool_elem<16>(p, row, c);
  }
}

DI void phase_gemm_pool(const Params& p, char* smem) {
  const bfr* P2 = p.PB;
  bfr* Z = p.ACT3;
  for (int g = 0; g < 4; ++g) {
    const float* bp = p.b_pool + g * 256;
    const float* sc = p.pool_scale + g * 256;
    gemm_sample<false>(p.MIX + g * 256, 1024, p.WtPool + (size_t)g * 65536, 256, 256, 256, smem,
                       [=](int row, int col, float v) -> float {
                         float gate = bf2f(P2[(size_t)row * 2048 + 1024 + g * 256 + col]);
                         float z = (v + bp[col]) * sc[col] * siluf_(gate);
                         Z[(size_t)row * 1024 + g * 256 + col] = f2bf(z);
                         return 0.f;
                       },
                       [=](int, float) {});
  }
  for (int t = blockIdx.x; t < 128 * 4; t += gridDim.x) {
    int mt = t >> 2, g = t & 3, nt = 0;
    const float* bp = p.b_pool + g * 256;
    const float* sc = p.pool_scale + g * 256;
    gemm_tile<1024>(p.MIX + g * 256, p.WtPool + (size_t)g * 65536, 256, 256, mt * 128, nt * 256, smem,
              [=](int row, int col, float v) {
                float gate = bf2f(P2[(size_t)row * 2048 + 1024 + g * 256 + col]);
                float z = (v + bp[col]) * sc[col] * siluf_(gate);
                Z[(size_t)row * 1024 + g * 256 + col] = f2bf(z);
              });
  }
}

#ifndef ONLY_PHASE
#define ONLY_PHASE -1
#endif
#define PON(n) (ONLY_PHASE < 0 || ONLY_PHASE == (n))
__global__ void __launch_bounds__(256, 2) mega(Params p) {
  __shared__ __attribute__((aligned(16))) char smem[65536];
  cg::grid_group grid = cg::this_grid();
  if (p.phase_lo < -1000) grid.sync();
  volatile LAS unsigned* xst = (volatile LAS unsigned*)(smem + 65520);
  if (threadIdx.x < 4) xst[threadIdx.x] = 0u;
  __syncthreads();
  (void)xcd_barrier_post(p.bar, xst);
#define XB_NOW() do { XcdBarrier b_; b_.bar = p.bar; b_.x = xb_xcc_id(); b_.st = (volatile LAS unsigned*)(smem + 65520); xcd_barrier(b_); } while (0)
#ifndef DUPMASK
#define DUPMASK 0
#endif
#define RUN(n, call) do { if (PON(n) && p.phase_lo <= (n) && (n) <= p.phase_hi) { call; if ((DUPMASK >> (n)) & 1) { XB_NOW(); call; } } if (p.phase_lo <= (n) && (n) < p.phase_hi) XB_NOW(); } while (0)
  RUN(0, phase_prep(p, smem));
  RUN(1, phase_gemm_in_even(p, smem));
  RUN(2, phase_even_pointwise(p, smem));
  RUN(3, phase_chunk_prep(p, smem));
  RUN(4, phase_scan(p, smem));
  RUN(5, phase_delta_post(p));
  RUN(6, (phase_gemm_resid<true, true>(p, p.MIX, p.WtOutE, p.norm_xattn, p.SS, smem)));
  RUN(8, phase_gemm_bf16out(p, p.H, p.WtXq, p.ACT2, 1024, p.SS, smem));
  RUN(9, phase_attn(p, 0, smem));
  RUN(10, (phase_gemm_resid<false, true>(p, p.ACT3, p.WtXo, p.norm_mix + 1024, p.SS + NROW, smem)));
  RUN(12, phase_gemm_bf16out(p, p.H, p.WtInO, p.PB, 2048, p.SS + NROW, smem));
  RUN(13, phase_pool(p));
  RUN(14, phase_gemm_pool(p, smem));
  RUN(15, (phase_gemm_resid<false, true>(p, p.ACT3, p.WtOutO, p.norm_xattn + 1024, p.SS + 2 * NROW, smem)));
  RUN(17, phase_gemm_bf16out(p, p.H, p.WtXq + 1048576, p.ACT2, 1024, p.SS + 2 * NROW, smem));
  RUN(18, phase_attn(p, 1, smem));
  RUN(19, (phase_gemm_resid<false, false>(p, p.ACT3, p.WtXo + 1048576, p.norm_final, p.SS + 3 * NROW, smem)));
  RUN(20, phase_final_norm(p));
}

extern "C" void kernel_launch(void* const* d_in, const int* in_sizes, int n_in, void* d_out, int out_size, void* d_ws,
                              size_t ws_size, hipStream_t stream) {
  static int grid_blocks = 0;
  if (!grid_blocks) {
    int dev = 0, cus = 0, per_cu = 0;
    (void)hipGetDevice(&dev);
    (void)hipDeviceGetAttribute(&cus, hipDeviceAttributeMultiprocessorCount, dev);
    (void)hipOccupancyMaxActiveBlocksPerMultiprocessor(&per_cu, mega, 256, 0);
    if (per_cu < 1) per_cu = 1;
    if (per_cu > 2) per_cu = 2;
    grid_blocks = cus * per_cu;
  }
  Params p{};
  const float** ins = (const float**)&p.x_prompt;
  for (int i = 0; i < 31; ++i) ins[i] = (const float*)d_in[i];
  p.out = (float*)d_out;
  char* w = (char*)d_ws;
  size_t off = 0;
  auto take = [&](size_t bytes) { char* r = w + off; off += (bytes + 255) & ~(size_t)255; return r; };
  p.X = (float*)take((size_t)NROW * 1024 * 4);
  p.QKV = (float*)take((size_t)NROW * 1536 * 4);
  p.BGR = (float*)take((size_t)NROW * 8 * 4);
  p.BG = (float*)take((size_t)NROW * 8 * 4);
  p.CONV = (float*)take((size_t)NROW * 512 * 4);
  p.ODN = (float*)take((size_t)NROW * 512 * 4);
  p.U = (float*)take((size_t)1024 * 8192 * 4);
  p.GL = (float*)take(4096);
  p.SS = (float*)take((size_t)4 * NROW * 4);
  p.H = (bfr*)take((size_t)NROW * 1024 * 2);
  p.PB = (bfr*)take((size_t)NROW * 3584 * 2);
  p.MIX = (bfr*)take((size_t)NROW * 1024 * 2);
  p.ACT2 = (bfr*)take((size_t)NROW * 1024 * 2);
  p.ACT3 = (bfr*)take((size_t)NROW * 1024 * 2);
  p.KB = (bfr*)take((size_t)2 * 2048 * 1024 * 2);
  p.VT = (bfr*)take((size_t)2 * 2048 * 1024 * 2);
  p.MPB = (bfr*)take((size_t)2048 * 1024 * 2);
  p.WtInE = (bfr*)take((size_t)3712 * 1024 * 2);
  p.WtOutE = (bfr*)take((size_t)1024 * 1024 * 2);
  p.WtInO = (bfr*)take((size_t)2048 * 1024 * 2);
  p.WtPool = (bfr*)take((size_t)4 * 256 * 256 * 2);
  p.WtOutO = (bfr*)take((size_t)1024 * 1024 * 2);
  p.WtXq = (bfr*)take((size_t)2 * 1024 * 1024 * 2);
  p.WtXk = (bfr*)take((size_t)2 * 1024 * 1024 * 2);
  p.WtXv = (bfr*)take((size_t)2 * 1024 * 1024 * 2);
  p.WtXo = (bfr*)take((size_t)2 * 1024 * 1024 * 2);
  p.WN = (uint4*)take((size_t)1024 * 1024 * 16);
  p.QD = (uint4*)take((size_t)1024 * 1024 * 16);
  p.KD = (uint4*)take((size_t)1024 * 1024 * 16);
  p.QKF = (uint4*)take((size_t)1024 * 512 * 16);
  p.bar = (unsigned*)take((size_t)XCD_BAR_WORDS * 4);
  if (off > ws_size) {
    fprintf(stderr, "kernel_launch: workspace too small: need %zu have %zu\n", off, ws_size);
    return;
  }
  p.phase_lo = 0;
  p.phase_hi = 20;
  if (hipMemsetAsync(p.bar, 0, (size_t)XCD_BAR_WORDS * 4, stream) != hipSuccess) { fprintf(stderr, "memset failed\n"); return; }
  void* args[] = {&p};
  hipError_t e = hipLaunchCooperativeKernel((void*)mega, dim3(grid_blocks), dim3(256), args, 0, stream);
  if (e != hipSuccess) fprintf(stderr, "cooperative launch failed: %s (grid %d)\n", hipGetErrorString(e), grid_blocks);
}
```

```cpp
#include <hip/hip_runtime.h>
#include <hip/hip_cooperative_groups.h>
#include <cstdio>
namespace cg = cooperative_groups;

#define DI __device__ __forceinline__
typedef unsigned short bfr;
using bf16x8 = __attribute__((ext_vector_type(8))) short;
using f32x16 = __attribute__((ext_vector_type(16))) float;
typedef __bf16 bf2_t __attribute__((ext_vector_type(2)));
typedef float fl2_t __attribute__((ext_vector_type(2)));
typedef unsigned u32x4 __attribute__((ext_vector_type(4)));
#define MFMA32(a, b, c) __builtin_amdgcn_mfma_f32_32x32x16_bf16((a), (b), (c), 0, 0, 0)

constexpr int NROW = 16512;
constexpr int NPR = 16384;
constexpr int DM = 1024;
constexpr int EIN = 3592, EINP = 3584;
constexpr float EPSF = 1e-6f;

constexpr size_t O_Y = 0;
constexpr size_t O_CONVP = 16777216 + 131072;
constexpr size_t O_QKVP = O_CONVP + 122880;
constexpr size_t O_DELTAP = O_QKVP + 36864;
constexpr size_t O_POOLP = O_DELTAP + 524288;
constexpr size_t O_MEMK = O_POOLP + 122880;
constexpr size_t O_MEMV = O_MEMK + 4194304;
constexpr size_t O_CONVS = O_MEMV + 4194304;
constexpr size_t O_QKVS = O_CONVS + 1966080;
constexpr size_t O_DELTAS = O_QKVS + 589824;
constexpr size_t O_POOLS = O_DELTAS + 8388608;

struct Params {
  const float *x_prompt, *x_sample, *state_conv_a, *state_qkv_conv, *state_delta, *state_pool, *cache_k, *cache_v, *mem_prompt;
  const float *norm_mix, *norm_xattn, *norm_final, *w_in_even, *w_out_even, *dw_w, *dw_b, *ln_a_g, *ln_a_b, *sc_w, *a_log,
      *dt_bias, *dn_norm_g, *w_in_odd, *w_pool, *b_pool, *pool_scale, *w_out_odd, *w_xq, *w_xk, *w_xv, *w_xo;
  float* out;
  float *X, *QKV, *BGR, *BG, *CONV, *ODN, *U, *GL, *SS;
  bfr *H, *PB, *MIX, *ACT2, *ACT3, *KB, *VT, *MPB;
  bfr *WtInE, *WtOutE, *WtInO, *WtPool, *WtOutO, *WtXq, *WtXk, *WtXv, *WtXo;
  uint4 *WN, *QD, *KD, *QKF;
  unsigned* bar;
  int phase_lo, phase_hi;
};

DI int opaque_tid() { int t = threadIdx.x; asm volatile("" : "+v"(t)); return t; }
DI unsigned pack2(float a, float b) {
  fl2_t f = {a, b};
  bf2_t r = __builtin_convertvector(f, bf2_t);
  return __builtin_bit_cast(unsigned, r);
}
DI bfr f2bf(float a) { return (bfr)(pack2(a, 0.f) & 0xffffu); }
DI float bf2f(bfr u) { return __uint_as_float(((unsigned)u) << 16); }
DI float bflo(unsigned u) { return __uint_as_float(u << 16); }
DI float bfhi(unsigned u) { return __uint_as_float(u & 0xffff0000u); }
DI float sigmoidf_(float x) { return 1.0f / (1.0f + __expf(-x)); }
DI float siluf_(float x) { return x / (1.0f + __expf(-x)); }
#define DPPF(v, ctrl, rmask) __builtin_bit_cast(float, __builtin_amdgcn_update_dpp(0, __builtin_bit_cast(int, (v)), (ctrl), (rmask), 0xf, false))
DI float row16_sum(float v) {
  v += DPPF(v, 0xB1, 0xf);
  v += DPPF(v, 0x4E, 0xf);
  v += DPPF(v, 0x141, 0xf);
  v += DPPF(v, 0x140, 0xf);
  return v;
}
DI float half32_sum_hi(float v) {
  v = row16_sum(v);
  v += DPPF(v, 0x142, 0xa);
  return v;
}
DI float wave_sum(float v) {
  v = row16_sum(v);
  v += DPPF(v, 0x142, 0xa);
  v += DPPF(v, 0x143, 0xc);
  return __builtin_bit_cast(float, __builtin_amdgcn_readlane(__builtin_bit_cast(int, v), 63));
}
DI float wave_max(float v) {
#pragma unroll
  for (int o = 32; o >= 1; o >>= 1) v = fmaxf(v, __shfl_xor(v, o));
  return v;
}
DI int crow(int reg, int h) { return (reg & 3) + 8 * (reg >> 2) + 4 * h; }
DI bf16x8 pack8(const f32x16& x, int s) {
  uint4 p;
  p.x = pack2(x[8 * s + 0], x[8 * s + 1]);
  p.y = pack2(x[8 * s + 2], x[8 * s + 3]);
  p.z = pack2(x[8 * s + 4], x[8 * s + 5]);
  p.w = pack2(x[8 * s + 6], x[8 * s + 7]);
  return __builtin_bit_cast(bf16x8, p);
}
DI bf16x8 ldfrag(const uint4* p) { uint4 v = *p; return __builtin_bit_cast(bf16x8, v); }


#define XB_TMO      128
#define XB_XCNT(j)  (256  + 64 * (j))
#define XB_XSUB(j)  (1280 + 64 * (j))
#define XB_XGEN(j)  (2304 + 64 * (j))
#define XB_TOP      3328
#define XB_TOPGEN   3392
#define XCD_BAR_WORDS 3456
#define XB_SPIN_CAP (1u << 18)
#define LAS __attribute__((address_space(3)))
DI unsigned xb_ld(unsigned* p) { return __hip_atomic_load(p, __ATOMIC_RELAXED, __HIP_MEMORY_SCOPE_AGENT); }
DI unsigned xb_add(unsigned* p, unsigned v) { return __hip_atomic_fetch_add(p, v, __ATOMIC_RELAXED, __HIP_MEMORY_SCOPE_AGENT); }
DI unsigned xb_xcc_id() { return (unsigned)__builtin_amdgcn_s_getreg((3 << 11) | 20) & 0xFu; }
#define XB_SPIN(cond, bar) do { unsigned _sp = 0; while (cond) { __builtin_amdgcn_s_sleep(1); \
    if ((++_sp & 255u) == 0u) { if (xb_ld(&(bar)[XB_TMO])) break; if (_sp > XB_SPIN_CAP) { atomicAdd(&(bar)[XB_TMO], 1u); break; } } } } while (0)
struct XcdBarrier { unsigned* bar; unsigned x; volatile LAS unsigned* st; };
DI XcdBarrier xcd_barrier_post(unsigned* bar, volatile LAS unsigned* st) {
  XcdBarrier b; b.bar = bar; b.x = xb_xcc_id(); b.st = st;
  if (threadIdx.x == 0) (void)xb_add(&bar[XB_XCNT(b.x)], 1u);
  return b;
}
DI void xcd_barrier_complete(unsigned* bar, unsigned x, unsigned& nloc, unsigned& nx) {
  const unsigned G = gridDim.x * gridDim.y * gridDim.z;
  unsigned sum, cnt, mine, sp = 0u;
  for (;;) {
    sum = 0u; cnt = 0u; mine = 0u;
#pragma unroll
    for (unsigned j = 0; j < 16; ++j) { const unsigned c = xb_ld(&bar[XB_XCNT(j)]); sum += c; cnt += (c > 0u) ? 1u : 0u; mine = (j == x) ? c : mine; }
    if (sum == G) break;
    __builtin_amdgcn_s_sleep(1);
    if ((++sp & 255u) == 0u) { if (xb_ld(&bar[XB_TMO])) break; if (sp > XB_SPIN_CAP) { atomicAdd(&bar[XB_TMO], 1u); break; } }
  }
  nloc = mine > 0u ? mine : 1u; nx = cnt > 0u ? cnt : 1u;
}
DI void xcd_barrier(const XcdBarrier& b) {
  asm volatile("s_waitcnt vmcnt(0)" ::: "memory");
  __syncthreads();
  if (threadIdx.x == 0) {
    unsigned* bar = b.bar;
    __builtin_amdgcn_s_waitcnt(0);
    unsigned nloc = b.st[0], nx = b.st[1];
    if (nloc == 0u) { xcd_barrier_complete(bar, b.x, nloc, nx); b.st[0] = nloc; b.st[1] = nx; }
    const unsigned old = xb_add(&bar[XB_XSUB(b.x)], 1u);
    const unsigned gen = old / nloc;
    if (old + 1u == (gen + 1u) * nloc) {
      __builtin_amdgcn_fence(__ATOMIC_RELEASE, "agent");
      asm volatile("s_waitcnt vmcnt(0)" ::: "memory");
      const unsigned og = xb_add(&bar[XB_TOP], 1u);
      const unsigned tg = og / nx;
      if (og + 1u == (tg + 1u) * nx) xb_add(&bar[XB_TOPGEN], 1u);
      else XB_SPIN(xb_ld(&bar[XB_TOPGEN]) == tg, bar);
      __builtin_amdgcn_fence(__ATOMIC_ACQUIRE, "agent");
      xb_add(&bar[XB_XGEN(b.x)], 1u);
      asm volatile("s_waitcnt vmcnt(0)" ::: "memory");
    } else {
      XB_SPIN(xb_ld(&bar[XB_XGEN(b.x)]) == gen, bar);
      __builtin_amdgcn_fence(__ATOMIC_ACQUIRE, "agent");
      asm volatile("s_waitcnt vmcnt(0)" ::: "memory");
    }
  }
  __syncthreads();
}

constexpr int GSTAGE = (128 + 256) * 40;
template <int lda>
DI void gemm_mainloop(const bfr* __restrict__ A, const bfr* __restrict__ Bt, int NB, int K, int m0, int n0, char* smem, f32x16 (&acc)[2][4]) {
  bfr* S0 = (bfr*)smem;
  int tid = threadIdx.x;
  asm volatile("" : "+v"(tid));
  const int lane = tid & 63, wid = tid >> 6, wr = wid >> 1, wc = wid & 1;
  const int r = lane & 31, hl = lane >> 5;
#pragma unroll
  for (int i = 0; i < 2; ++i)
#pragma unroll
    for (int j = 0; j < 4; ++j)
#pragma unroll
      for (int q = 0; q < 16; ++q) acc[i][j][q] = 0.f;
  u32x4 ra[4], rb[4];
  const int nk = K >> 5;
  const int arow = tid >> 3, ac8 = tid & 7, apar = ac8 >> 2;
  const bfr* Ab = A + (m0 + arow) * lda + ac8 * 8;
  const int asoff = arow * 40 + (ac8 & 3) * 8;
  const int brow = tid >> 2, bc4 = tid & 3;
  const bfr* Bb = Bt + (n0 + brow) * 32 + bc4 * 8;
  const int bsoff = brow * 40 + bc4 * 8;
#define GA_LOAD(pr_) do { _Pragma("unroll") for (int i = 0; i < 4; ++i) ra[i] = *(const u32x4*)(Ab + (i * 32) * lda + (pr_) * 64); } while (0)
#define GB_LOAD(kt_) do { const bfr* bk_ = Bb + (kt_) * NB * 32; \
    _Pragma("unroll") for (int i = 0; i < 4; ++i) rb[i] = *(const u32x4*)(bk_ + (i * 64) * 32); } while (0)
#define G_STORE(kt_) do { bfr* as_ = S0 + ((kt_) & 1) * GSTAGE; bfr* bs_ = as_ + 128 * 40; \
    if (apar == ((kt_) & 1)) { _Pragma("unroll") for (int i = 0; i < 4; ++i) *(u32x4*)(as_ + asoff + i * 32 * 40) = ra[i]; } \
    _Pragma("unroll") for (int i = 0; i < 4; ++i) *(u32x4*)(bs_ + bsoff + i * 64 * 40) = rb[i]; } while (0)
  GA_LOAD(0);
  GB_LOAD(0);
  G_STORE(0);
  GB_LOAD(1);
  __syncthreads();
  for (int kt = 0; kt < nk; ++kt) {
    if (kt + 1 < nk) G_STORE(kt + 1);
    if (kt + 2 < nk) {
      GB_LOAD(kt + 2);
      if ((kt & 1) == 0) GA_LOAD((kt >> 1) + 1);
    }
    const bfr* As = S0 + (kt & 1) * GSTAGE;
    const bfr* Bs = As + 128 * 40;
#pragma unroll
    for (int ks = 0; ks < 2; ++ks) {
      bf16x8 af[2], bfg[4];
#pragma unroll
      for (int i = 0; i < 2; ++i) af[i] = *(const bf16x8*)(As + (wr * 64 + i * 32 + r) * 40 + ks * 16 + hl * 8);
#pragma unroll
      for (int j = 0; j < 4; ++j) bfg[j] = *(const bf16x8*)(Bs + (wc * 128 + j * 32 + r) * 40 + ks * 16 + hl * 8);
#pragma unroll
      for (int i = 0; i < 2; ++i)
#pragma unroll
        for (int j = 0; j < 4; ++j) acc[i][j] = MFMA32(af[i], bfg[j], acc[i][j]);
    }
    __syncthreads();
  }
#undef GA_LOAD
#undef GB_LOAD
#undef G_STORE
}

template <int lda, class Epi>
DI void gemm_tile(const bfr* __restrict__ A, const bfr* __restrict__ Bt, int NB, int K, int m0, int n0, char* smem, Epi epi) {
  f32x16 acc[2][4];
  gemm_mainloop<lda>(A, Bt, NB, K, m0, n0, smem, acc);
  int tid3 = threadIdx.x;
  asm volatile("" : "+v"(tid3));
  const int lane = tid3 & 63, wid = tid3 >> 6, wr = wid >> 1, wc = wid & 1, r = lane & 31, hl = lane >> 5;
#pragma unroll
  for (int i = 0; i < 2; ++i)
#pragma unroll
    for (int j = 0; j < 4; ++j)
#pragma unroll
      for (int q = 0; q < 16; ++q) {
        int row = m0 + wr * 64 + i * 32 + crow(q, hl);
        int col = n0 + wc * 128 + j * 32 + r;
        epi(row, col, acc[i][j][q]);
      }
}

template <bool RS, class Epi, class RowF>
DI void gemm_sample(const bfr* __restrict__ A, int lda, const bfr* __restrict__ Bt, int ldb, int K, int N, char* smem, Epi epi, RowF rowf) {
  const int tid = threadIdx.x, lane = tid & 63, wid = tid >> 6, r = lane & 31, hl = lane >> 5;
  float* red = (float*)smem;
  const int nun = 4 * (N >> 5);
  for (int u = blockIdx.x; u < nun; u += gridDim.x) {
    const int mu = u & 3, nu = u >> 2;
    const int kq = K >> 2, k0 = wid * kq;
    const bfr* ap = A + (size_t)(NPR + mu * 32 + r) * lda + k0 + hl * 8;
    const bfr* bp = Bt + ((size_t)(k0 >> 5) * ldb + nu * 32 + r) * 32 + hl * 8;
    f32x16 acc;
#pragma unroll
    for (int q = 0; q < 16; ++q) acc[q] = 0.f;
    if (K == 1024) {
#pragma unroll
      for (int ks = 0; ks < 16; ++ks) {
        bf16x8 af = *(const bf16x8*)(ap + ks * 16);
        bf16x8 bf = *(const bf16x8*)(bp + (size_t)(ks >> 1) * ldb * 32 + (ks & 1) * 16);
        acc = MFMA32(af, bf, acc);
      }
    } else {
      for (int ks = 0; ks < (kq >> 4); ++ks) {
        bf16x8 af = *(const bf16x8*)(ap + ks * 16);
        bf16x8 bf = *(const bf16x8*)(bp + (size_t)(ks >> 1) * ldb * 32 + (ks & 1) * 16);
        acc = MFMA32(af, bf, acc);
      }
    }
#pragma unroll
    for (int q = 0; q < 16; ++q) red[(wid * 16 + q) * 64 + lane] = acc[q];
    __syncthreads();
#pragma unroll
    for (int e = 0; e < 4; ++e) {
      const int q = wid + e * 4;
      const float v = red[q * 64 + lane] + red[(16 + q) * 64 + lane] + red[(32 + q) * 64 + lane] + red[(48 + q) * 64 + lane];
      const int row = NPR + mu * 32 + crow(q, hl), col = nu * 32 + r;
      float x = epi(row, col, v);
      if (RS) {
        float s2 = half32_sum_hi(x * x);
        if (r == 31) rowf(row, s2);
      }
    }
    __syncthreads();
  }
}

DI int xcd_tile(int t, int ntn) {
  const int x = t & 7, li = t >> 3;
  return (x * 16 + li / ntn) * ntn + (li % ntn);
}

DI void transpose_tile(const float* __restrict__ W, int ldw, bfr* __restrict__ Wt, int NB, int k0, int n0, float* sm, int nvalid = 1 << 30) {
  const int tid = threadIdx.x;
#pragma unroll
  for (int i = 0; i < 16; ++i) {
    int idx = tid + i * 256, kk = idx >> 6, nn = idx & 63;
    sm[kk * 65 + nn] = (n0 + nn < nvalid) ? W[(size_t)(k0 + kk) * ldw + n0 + nn] : 0.f;
  }
  __syncthreads();
#pragma unroll
  for (int i = 0; i < 8; ++i) {
    int idx = tid + i * 256, nn = idx >> 5, kp = idx & 31;
    float a = sm[(2 * kp) * 65 + nn], b = sm[(2 * kp + 1) * 65 + nn];
    { const int k = k0 + 2 * kp; *(unsigned*)(Wt + ((size_t)(k >> 5) * NB + n0 + nn) * 32 + (k & 31)) = pack2(a, b); }
  }
  __syncthreads();
}

DI void transpose_item(const Params& p, int tt, float* sm) {
  const int t = tt - 32;
  if (tt < 928) {
    int kt = tt / 58, nt = tt % 58;
    transpose_tile(p.w_in_even, EIN, p.WtInE, 3712, kt * 64, nt * 64, sm, EIN);
  } else if (t < 1152) {
    int u = t - 896;
    transpose_tile(p.w_out_even, 1024, p.WtOutE, 1024, (u >> 4) * 64, (u & 15) * 64, sm);
  } else if (t < 1664) {
    int u = t - 1152;
    transpose_tile(p.w_in_odd, 2048, p.WtInO, 2048, (u >> 5) * 64, (u & 31) * 64, sm);
  } else if (t < 1728) {
    int u = t - 1664, g = u >> 4, v = u & 15;
    transpose_tile(p.w_pool + (size_t)g * 65536, 256, p.WtPool + (size_t)g * 65536, 256, (v >> 2) * 64, (v & 3) * 64, sm);
  } else if (t < 1984) {
    int u = t - 1728;
    transpose_tile(p.w_out_odd, 1024, p.WtOutO, 1024, (u >> 4) * 64, (u & 15) * 64, sm);
  } else {
    int u = t - 1984, m = u >> 8, v = u & 255;
    int which = m >> 1, l = m & 1;
    const float* src = (which == 0 ? p.w_xq : which == 1 ? p.w_xk : which == 2 ? p.w_xv : p.w_xo) + (size_t)l * 1048576;
    bfr* dst = (which == 0 ? p.WtXq : which == 1 ? p.WtXk : which == 2 ? p.WtXv : p.WtXo) + (size_t)l * 1048576;
    transpose_tile(src, 1024, dst, 1024, (v >> 4) * 64, (v & 15) * 64, sm);
  }
}
DI int transpose_early(int i) { return i < 928 ? i : (2016 + 512) + (i - 928); }
DI int transpose_late(int i) { return i < 1600 ? 928 + i : (2016 + 1536) + (i - 1600); }

DI void phase_prep(const Params& p, char* smem) {
  float* sm = (float*)smem;
  for (int i = blockIdx.x; i < 1952; i += gridDim.x) transpose_item(p, transpose_early(i), sm);
  {
    for (int i = blockIdx.x * 256 + threadIdx.x; i < 4 * NROW; i += gridDim.x * 256) p.SS[i] = 0.f;
    const int n4 = 2048 * 1024 / 4;
    for (int i = blockIdx.x * 256 + threadIdx.x; i < n4; i += gridDim.x * 256) {
      float4 v = ((const float4*)p.mem_prompt)[i];
      uint2 o;
      o.x = pack2(v.x, v.y);
      o.y = pack2(v.z, v.w);
      ((uint2*)p.MPB)[i] = o;
    }
  }
  {
    const int lane = threadIdx.x & 63, wid = threadIdx.x >> 6;
    float* wT = (float*)smem;
    for (int i = opaque_tid(); i < 2048; i += 256) {
      const int k = i >> 1, hf = i & 1;
      float4 w = *(const float4*)(p.w_in_even + (size_t)k * EIN + EINP + hf * 4);
      wT[(hf * 4 + 0) * 1024 + k] = w.x; wT[(hf * 4 + 1) * 1024 + k] = w.y;
      wT[(hf * 4 + 2) * 1024 + k] = w.z; wT[(hf * 4 + 3) * 1024 + k] = w.w;
    }
    __syncthreads();
    for (int row = blockIdx.x * 4 + wid; row < NROW; row += gridDim.x * 4) {
      const float* xr = row < NPR ? p.x_prompt + (size_t)row * DM : p.x_sample + (size_t)(row - NPR) * DM;
      float4 v[4];
      float ss = 0.f;
#pragma unroll
      for (int j = 0; j < 4; ++j) {
        v[j] = ((const float4*)xr)[j * 64 + lane];
        ss += v[j].x * v[j].x + v[j].y * v[j].y + v[j].z * v[j].z + v[j].w * v[j].w;
      }
      ss = wave_sum(ss);
      float inv = rsqrtf(ss * (1.0f / 1024.0f) + EPSF);
      float part[8];
#pragma unroll
      for (int c = 0; c < 8; ++c) part[c] = 0.f;
#pragma unroll
      for (int j = 0; j < 4; ++j) {
        float4 g = ((const float4*)p.norm_mix)[j * 64 + lane];
        uint2 o;
        const float h0 = v[j].x * inv * g.x, h1 = v[j].y * inv * g.y, h2 = v[j].z * inv * g.z, h3 = v[j].w * inv * g.w;
        o.x = pack2(h0, h1);
        o.y = pack2(h2, h3);
        ((uint2*)(p.H + (size_t)row * DM))[j * 64 + lane] = o;
#pragma unroll
        for (int c = 0; c < 8; ++c) {
          float4 w = ((const float4*)(wT + c * 1024))[j * 64 + lane];
          part[c] += h0 * w.x + h1 * w.y + h2 * w.z + h3 * w.w;
        }
      }
#pragma unroll
      for (int c = 0; c < 8; ++c) part[c] = wave_sum(part[c]);
      if (lane == 0) {
        float4 a = {part[0], part[1], part[2], part[3]}, b = {part[4], part[5], part[6], part[7]};
        ((float4*)(p.BGR + (size_t)row * 8))[0] = a;
        ((float4*)(p.BGR + (size_t)row * 8))[1] = b;
      }
    }
    __syncthreads();
  }
}

DI void phase_rmsnorm(const Params& p, const float* g) {
  const int lane = threadIdx.x & 63, wid = threadIdx.x >> 6;
  for (int row = blockIdx.x * 4 + wid; row < NROW; row += gridDim.x * 4) {
    const float* xr = p.X + (size_t)row * DM;
    float4 v[4];
    float ss = 0.f;
#pragma unroll
    for (int j = 0; j < 4; ++j) {
      v[j] = ((const float4*)xr)[j * 64 + lane];
      ss += v[j].x * v[j].x + v[j].y * v[j].y + v[j].z * v[j].z + v[j].w * v[j].w;
    }
    ss = wave_sum(ss);
    float inv = rsqrtf(ss * (1.0f / 1024.0f) + EPSF);
#pragma unroll
    for (int j = 0; j < 4; ++j) {
      float4 gg = ((const float4*)g)[j * 64 + lane];
      uint2 o;
      o.x = pack2(v[j].x * inv * gg.x, v[j].y * inv * gg.y);
      o.y = pack2(v[j].z * inv * gg.z, v[j].w * inv * gg.w);
      ((uint2*)(p.H + (size_t)row * DM))[j * 64 + lane] = o;
    }
  }
}

DI void phase_final_norm(const Params& p) {
  const float* ss = p.SS + 3 * NROW;
  for (int i = blockIdx.x * 256 + threadIdx.x; i < NROW * 256; i += gridDim.x * 256) {
    const int row = i >> 8, c4 = i & 255;
    float4 v = ((const float4*)p.X)[i];
    float4 g = ((const float4*)p.norm_final)[c4];
    const float inv = rsqrtf(ss[row] * (1.0f / 1024.0f) + EPSF);
    float4 o = {v.x * inv * g.x, v.y * inv * g.y, v.z * inv * g.z, v.w * inv * g.w};
    ((float4*)(p.out + O_Y))[i] = o;
  }
}

DI void phase_gemm_in_even(const Params& p, char* smem) {
  const int NT1 = 128 * 14, NT2 = 4 * 64;
  {
    bfr* PB = p.PB;
    gemm_sample<false>(p.H, 1024, p.WtInE, 3712, 1024, EINP, smem,
                       [=](int row, int col, float v) -> float { PB[(size_t)row * EINP + col] = f2bf(v); return 0.f; },
                       [=](int, float) {});
  }
  for (int t0 = blockIdx.x; t0 < NT1 + NT2; t0 += gridDim.x) {
    const int t = (t0 < NT1 && (gridDim.x & 7) == 0) ? xcd_tile(t0, 14) : t0;
    if (t < NT1) {
      int mt = t / 14, nt = t % 14;
      bfr* PB = p.PB;
      gemm_tile<1024>(p.H, p.WtInE, 3712, 1024, mt * 128, nt * 256, smem,
                [=](int row, int col, float v) { PB[(size_t)row * EINP + col] = f2bf(v); });
    } else {
      int u = t - NT1, gsel = u >> 6, v = u & 63, mt = v >> 2, nt = v & 3;
      int isv = gsel >> 1, l = gsel & 1;
      if (!isv) {
        float* o = p.out + O_MEMK + (size_t)l * 2097152;
        bfr* kb = p.KB + (size_t)l * 2097152;
        gemm_tile<1024>(p.MPB, p.WtXk + (size_t)l * 1048576, 1024, 1024, mt * 128, nt * 256, smem,
                  [=](int row, int col, float v) {
                    o[(size_t)row * 1024 + col] = v;
                    kb[(size_t)row * 1024 + col] = f2bf(v);
                  });
      } else {
        float* o = p.out + O_MEMV + (size_t)l * 2097152;
        bfr* vt = p.VT + (size_t)l * 2097152;
        gemm_tile<1024>(p.MPB, p.WtXv + (size_t)l * 1048576, 1024, 1024, mt * 128, nt * 256, smem,
                  [=](int row, int col, float v) {
                    o[(size_t)row * 1024 + col] = v;
                    const int ml = row & 15;
                    const int rowpart = (row >> 8) * 262144 + ((row & 255) >> 4) * 512 + ((ml >> 2) & 1) * 256 + (((ml >> 3) << 2) | (ml & 3));
                    const int colpart = (col >> 8) * 65536 + ((col & 255) >> 5) * 8192 + (col & 31) * 8;
                    vt[rowpart + colpart] = f2bf(v);
                  });
      }
    }
  }
}

template <bool IS_P, bool EDGE>
DI void qkv_token(const Params& p, int row, int lane) {
  const int t = row & 2047, b = row >> 11, s = row - NPR;
#pragma unroll 6
  for (int grp = 0; grp < 12; ++grp) {
    const int ch = grp * 128 + lane * 2;
    float x0[4], x1[4];
    if (IS_P) {
      unsigned u[4];
#pragma unroll
      for (int j = 0; j < 4; ++j) {
        const int rc = (!EDGE || t - 3 + j >= 0) ? (row - 3 + j) : row;
        u[j] = *(const unsigned*)(p.PB + (size_t)rc * EINP + 1536 + ch);
      }
#pragma unroll
      for (int j = 0; j < 4; ++j) {
        const bool ok = (!EDGE || t - 3 + j >= 0);
        x0[j] = ok ? bflo(u[j]) : 0.f;
        x1[j] = ok ? bfhi(u[j]) : 0.f;
      }
    } else {
#pragma unroll
      for (int j = 0; j < 3; ++j) {
        float2 f = *(const float2*)(p.state_qkv_conv + ((size_t)s * 3 + j) * 1536 + ch);
        x0[j] = f.x; x1[j] = f.y;
      }
      unsigned u = *(const unsigned*)(p.PB + (size_t)row * EINP + 1536 + ch);
      x0[3] = bflo(u); x1[3] = bfhi(u);
    }
    float a0 = 0.f, a1 = 0.f;
#pragma unroll
    for (int j = 0; j < 4; ++j) {
      float2 w = *(const float2*)(p.sc_w + (size_t)j * 1536 + ch);
      a0 += w.x * x0[j]; a1 += w.y * x1[j];
    }
    float y0 = siluf_(a0), y1 = siluf_(a1);
    if (grp < 8) {
      float ss = wave_sum(y0 * y0 + y1 * y1);
      float inv = rsqrtf(ss + EPSF);
      if (grp < 4) inv *= 0.08838834764831845f;
      y0 *= inv; y1 *= inv;
    }
    float2 o = {y0, y1};
    *(float2*)(p.QKV + (size_t)row * 1536 + ch) = o;
    if (IS_P) {
      if (t >= 2045) {
        float2 c = {x0[3], x1[3]};
        *(float2*)(p.out + O_QKVP + ((size_t)b * 3 + (t - 2045)) * 1536 + ch) = c;
      }
    } else {
      float2 c0 = {x0[1], x1[1]}, c1 = {x0[2], x1[2]}, c2 = {x0[3], x1[3]};
      *(float2*)(p.out + O_QKVS + ((size_t)s * 3 + 0) * 1536 + ch) = c0;
      *(float2*)(p.out + O_QKVS + ((size_t)s * 3 + 1) * 1536 + ch) = c1;
      *(float2*)(p.out + O_QKVS + ((size_t)s * 3 + 2) * 1536 + ch) = c2;
    }
  }
  if (lane < 4) {
    float bl = p.BGR[(size_t)row * 8 + lane], al = p.BGR[(size_t)row * 8 + 4 + lane];
    float beta = sigmoidf_(bl);
    float xx = al + p.dt_bias[lane];
    float sp = xx > 20.f ? xx : log1pf(__expf(xx));
    float g = -__expf(p.a_log[lane]) * sp;
    p.BG[(size_t)row * 8 + lane] = beta;
    p.BG[(size_t)row * 8 + 4 + lane] = g;
  }
}

template <int G0>
DI void qkv_run4_half(const Params& p, int row0, int lane) {
  const int t0 = row0 & 2047, b = row0 >> 11;
  unsigned u[4][7];
  float2 w[4][4];
#pragma unroll
  for (int i = 0; i < 7; ++i) {
    const int rr = (i >= 3 || t0 > 0) ? (row0 - 3 + i) : row0;
    const bfr* rp = p.PB + (size_t)rr * EINP + 1536 + G0 * 128 + lane * 2;
#pragma unroll
    for (int g = 0; g < 4; ++g) u[g][i] = *(const unsigned*)(rp + g * 128);
  }
#pragma unroll
  for (int j = 0; j < 4; ++j) {
    const float* wp = p.sc_w + (size_t)j * 1536 + G0 * 128 + lane * 2;
#pragma unroll
    for (int g = 0; g < 4; ++g) w[g][j] = *(const float2*)(wp + g * 128);
  }
  const float hm = (t0 > 0) ? 1.f : 0.f;
#pragma unroll
  for (int k = 0; k < 4; ++k) {
    const int row = row0 + k;
#pragma unroll
    for (int g = 0; g < 4; ++g) {
      const int grp = G0 + g;
      const int ch = grp * 128 + lane * 2;
      float a0 = 0.f, a1 = 0.f;
#pragma unroll
      for (int j = 0; j < 4; ++j) {
        const int i = k + j;
        const float m = (i >= 3) ? 1.f : hm;
        a0 += w[g][j].x * (bflo(u[g][i]) * m);
        a1 += w[g][j].y * (bfhi(u[g][i]) * m);
      }
      float y0 = siluf_(a0), y1 = siluf_(a1);
      if (grp < 8) {
        float ss = wave_sum(y0 * y0 + y1 * y1);
        float inv = rsqrtf(ss + EPSF);
        if (grp < 4) inv *= 0.08838834764831845f;
        y0 *= inv; y1 *= inv;
      }
      float2 o = {y0, y1};
      *(float2*)(p.QKV + (size_t)row * 1536 + ch) = o;
      if (t0 == 2044 && k >= 1) {
        float2 c = {bflo(u[g][k + 3]), bfhi(u[g][k + 3])};
        *(float2*)(p.out + O_QKVP + ((size_t)b * 3 + (k - 1)) * 1536 + ch) = c;
      }
    }
  }
}
DI void qkv_run4(const Params& p, int row0, int lane) {
  qkv_run4_half<0>(p, row0, lane);
  qkv_run4_half<4>(p, row0, lane);
  qkv_run4_half<8>(p, row0, lane);
  if (lane < 16) {
    const int row = row0 + (lane >> 2), hd = lane & 3;
    float bl = p.BGR[(size_t)row * 8 + hd], al = p.BGR[(size_t)row * 8 + 4 + hd];
    float beta = sigmoidf_(bl);
    float xx = al + p.dt_bias[hd];
    float sp = xx > 20.f ? xx : log1pf(__expf(xx));
    float g = -__expf(p.a_log[hd]) * sp;
    p.BG[(size_t)row * 8 + hd] = beta;
    p.BG[(size_t)row * 8 + 4 + hd] = g;
  }
}

DI void conv_a_prompt_item(const Params& p, int item, float* sm) {
  const int half = item & 1, tile = (item >> 1) & 63, b = item >> 7;
  int tid = threadIdx.x;
  asm volatile("" : "+v"(tid));
  const int c = half * 256 + tid, t0 = tile * 32;
  {
    const int tg = tid >> 5, c8 = tid & 31;
    u32x4 vv[8], gg[8];
#pragma unroll
    for (int ps = 0; ps < 8; ++ps) {
      const int i = tg + 8 * ps;
      const int tt = t0 - 30 + i;
      const size_t row = (size_t)b * 2048 + ((tt >= 0 && i < 62) ? tt : t0);
      vv[ps] = *(const u32x4*)(p.PB + row * EINP + half * 256 + c8 * 8);
      gg[ps] = *(const u32x4*)(p.PB + row * EINP + 512 + half * 256 + c8 * 8);
    }
#pragma unroll
    for (int ps = 0; ps < 8; ++ps) {
      const int i = tg + 8 * ps;
      const int tt = t0 - 30 + i;
      const float msk = (tt >= 0) ? 1.f : 0.f;
      float o8[8];
#pragma unroll
      for (int e = 0; e < 4; ++e) {
        o8[2 * e] = bflo(vv[ps][e]) * sigmoidf_(bflo(gg[ps][e])) * msk;
        o8[2 * e + 1] = bfhi(vv[ps][e]) * sigmoidf_(bfhi(gg[ps][e])) * msk;
      }
      if (i < 62) {
        float4 a0 = {o8[0], o8[1], o8[2], o8[3]}, a1 = {o8[4], o8[5], o8[6], o8[7]};
        *(float4*)(sm + i * 256 + c8 * 8) = a0;
        *(float4*)(sm + i * 256 + c8 * 8 + 4) = a1;
      }
    }
    __syncthreads();
  }
  float w[31];
#pragma unroll
  for (int j = 0; j < 31; ++j) w[j] = p.dw_w[j * 512 + c];
  const float bias = p.dw_b[c];
#pragma unroll 1
  for (int o = 0; o < 32; ++o) {
    float acc = bias;
#pragma unroll
    for (int j = 0; j < 31; ++j) acc += w[j] * sm[(o + j) * 256 + tid];
    p.CONV[((size_t)b * 2048 + t0 + o) * 512 + c] = acc;
  }
  if (tile == 63) {
#pragma unroll 1
    for (int j = 0; j < 30; ++j) p.out[O_CONVP + ((size_t)b * 30 + j) * 512 + c] = sm[(32 + j) * 256 + tid];
  }
  __syncthreads();
}

DI void conv_a_sample_item(const Params& p, int s) {
  const int tid = threadIdx.x;
  const size_t row = NPR + s;
#pragma unroll
  for (int cc = 0; cc < 2; ++cc) {
    int c = tid + cc * 256;
    float val = bf2f(p.PB[row * EINP + c]);
    float gate = bf2f(p.PB[row * EINP + 512 + c]);
    float gl = val * sigmoidf_(gate);
    float acc = p.dw_b[c] + p.dw_w[30 * 512 + c] * gl;
#pragma unroll 6
    for (int j = 0; j < 30; ++j) {
      float st = p.state_conv_a[((size_t)s * 30 + j) * 512 + c];
      acc += p.dw_w[j * 512 + c] * st;
      if (j >= 1) p.out[O_CONVS + ((size_t)s * 30 + j - 1) * 512 + c] = st;
    }
    p.out[O_CONVS + ((size_t)s * 30 + 29) * 512 + c] = gl;
    p.CONV[row * 512 + c] = acc;
  }
}

DI void phase_even_pw_conv(const Params& p, char* smem) {
  for (int it = blockIdx.x; it < 1024 + 128; it += gridDim.x) {
    if (it < 1024) conv_a_prompt_item(p, it, (float*)smem);
    else conv_a_sample_item(p, it - 1024);
  }
}
DI void phase_even_pw_qkv(const Params& p) {
  const int lane = threadIdx.x & 63, wid = threadIdx.x >> 6;
  for (int run = blockIdx.x * 4 + wid; run < NPR / 4; run += gridDim.x * 4) qkv_run4(p, run * 4, lane);
  for (int row = NPR + blockIdx.x * 4 + wid; row < NROW; row += gridDim.x * 4) qkv_token<false, false>(p, row, lane);
}
DI void phase_even_pointwise(const Params& p, char* smem) {
  phase_even_pw_qkv(p);
}

DI void chunk_prep(const Params& p, int item, char* smem) {
  const int tid = threadIdx.x, lane = tid & 63, wid = tid >> 6, r = lane & 31, hl = lane >> 5;
  const int n = item & 31, hh = (item >> 5) & 3, b = item >> 7;
  const size_t row0 = (size_t)b * 2048 + n * 64;
  float* gcs = (float*)smem;
  float* betas = gcs + 64;
  float* egs = betas + 64;
  float* kscale = egs + 64;
  bfr* qs = (bfr*)(smem + 1024);
  bfr* ks_ = qs + 64 * 136;
  float* Am = (float*)(smem + 1024 + 2 * 64 * 136 * 2);
  bfr* wsb = qs;
  float rraw[64];
  {
    const int cofs = (tid < 128) ? (1024 + hh * 128 + tid) : (512 + hh * 128 + (tid - 128));
    const float* srcp = p.QKV + row0 * 1536 + cofs;
#pragma unroll
    for (int i = 0; i < 64; ++i) rraw[i] = srcp[i * 1536];
  }
  if (tid < 64) {
    float beta = p.BG[(row0 + tid) * 8 + hh];
    float g = p.BG[(row0 + tid) * 8 + 4 + hh];
    float v = g;
#pragma unroll
    for (int off = 1; off < 64; off <<= 1) {
      float t = __shfl_up(v, off);
      if (lane >= off) v += t;
    }
    float gl = __shfl(v, 63);
    gcs[tid] = v;
    betas[tid] = beta;
    egs[tid] = __expf(v);
    kscale[tid] = __expf(gl - v);
    if (tid == 63) p.GL[item] = __expf(gl);
  }
#pragma unroll
  for (int i = 0; i < 8; ++i) {
    int idx = tid + i * 256, row = idx >> 5, c4 = idx & 31;
    float4 q = *(const float4*)(p.QKV + (row0 + row) * 1536 + hh * 128 + c4 * 4);
    float4 k = *(const float4*)(p.QKV + (row0 + row) * 1536 + 512 + hh * 128 + c4 * 4);
    uint2 qo, ko;
    qo.x = pack2(q.x, q.y); qo.y = pack2(q.z, q.w);
    ko.x = pack2(k.x, k.y); ko.y = pack2(k.z, k.w);
    *(uint2*)(qs + row * 136 + c4 * 4) = qo;
    *(uint2*)(ks_ + row * 136 + c4 * 4) = ko;
  }
  __syncthreads();
  {
    const int mi = wid >> 1, ni = wid & 1;
    f32x16 akk, aqk;
#pragma unroll
    for (int q = 0; q < 16; ++q) { akk[q] = 0.f; aqk[q] = 0.f; }
#pragma unroll
    for (int ks = 0; ks < 8; ++ks) {
      bf16x8 ka = *(const bf16x8*)(ks_ + (mi * 32 + r) * 136 + ks * 16 + hl * 8);
      bf16x8 qa = *(const bf16x8*)(qs + (mi * 32 + r) * 136 + ks * 16 + hl * 8);
      bf16x8 kb = *(const bf16x8*)(ks_ + (ni * 32 + r) * 136 + ks * 16 + hl * 8);
      akk = MFMA32(ka, kb, akk);
      aqk = MFMA32(qa, kb, aqk);
    }
    bfr* qkf = (bfr*)(p.QKF + (size_t)item * 512);
#pragma unroll
    for (int q = 0; q < 16; ++q) {
      int i = mi * 32 + crow(q, hl), j = ni * 32 + r;
      float dec = (i >= j) ? __expf(gcs[i] - gcs[j]) : 0.f;
      Am[i * 68 + j] = (i > j) ? akk[q] * betas[i] * dec : 0.f;
      float qv = (i >= j) ? aqk[q] * dec : 0.f;
      int ksj = j >> 4, jl = j & 15, h2 = (jl >> 2) & 1, jj = ((jl >> 3) << 2) | (jl & 3);
      qkf[((mi * 4 + ksj) * 64 + h2 * 32 + (i & 31)) * 8 + jj] = f2bf(qv);
    }
  }
  {
    uint4* QD = p.QD + (size_t)item * 1024;
#pragma unroll
    for (int i = 0; i < 4; ++i) {
      int idx = tid + i * 256, f = idx >> 6, ln = idx & 63, mt = f >> 3, ks = f & 7, m = ln & 31, h2 = ln >> 5;
      int ri = mt * 32 + m, d0 = ks * 16 + h2 * 4;
      float sc = egs[ri];
      const float* src = p.QKV + (row0 + ri) * 1536 + hh * 128 + d0;
      float4 a = *(const float4*)src, c = *(const float4*)(src + 8);
      uint4 o;
      o.x = pack2(a.x * sc, a.y * sc); o.y = pack2(a.z * sc, a.w * sc);
      o.z = pack2(c.x * sc, c.y * sc); o.w = pack2(c.z * sc, c.w * sc);
      QD[f * 64 + ln] = o;
    }
    uint4* KD = p.KD + (size_t)item * 1024;
#pragma unroll
    for (int i = 0; i < 4; ++i) {
      int idx = tid + i * 256, f = idx >> 6, ln = idx & 63, mt = f >> 2, ks = f & 3, m = ln & 31, h2 = ln >> 5;
      int d = mt * 32 + m;
      float vals[8];
#pragma unroll
      for (int j = 0; j < 8; ++j) {
        int c = ks * 16 + 8 * (j >> 2) + 4 * h2 + (j & 3);
        vals[j] = p.QKV[(row0 + c) * 1536 + 512 + hh * 128 + d] * kscale[c];
      }
      uint4 o;
      o.x = pack2(vals[0], vals[1]); o.y = pack2(vals[2], vals[3]);
      o.z = pack2(vals[4], vals[5]); o.w = pack2(vals[6], vals[7]);
      KD[f * 64 + ln] = o;
    }
  }
  __syncthreads();
  {
    const int c = tid;
    float sol[64];
#pragma unroll
    for (int i = 0; i < 64; ++i) {
      float rhs = rraw[i] * betas[i];
      if (c >= 128) rhs *= egs[i];
      float acc = rhs, acc1 = 0.f;
#pragma unroll
      for (int j = 0; j < i; ++j) {
        if (j & 1) acc1 -= Am[i * 68 + j] * sol[j];
        else acc -= Am[i * 68 + j] * sol[j];
      }
      sol[i] = acc + acc1;
    }
    if (c < 128) {
      float* U = p.U + (size_t)item * 8192;
#pragma unroll
      for (int i = 0; i < 64; ++i) U[i * 128 + c] = sol[i];
    } else {
#pragma unroll
      for (int i = 0; i < 64; ++i) wsb[i * 136 + (c - 128)] = f2bf(-sol[i]);
    }
  }
  __syncthreads();
  {
    uint4* WN = p.WN + (size_t)item * 1024;
#pragma unroll
    for (int i = 0; i < 4; ++i) {
      int idx = tid + i * 256, f = idx >> 6, ln = idx & 63, mt = f >> 3, ks = f & 7, m = ln & 31, h2 = ln >> 5;
      int ri = mt * 32 + m, d0 = ks * 16 + h2 * 4;
      uint2 a = *(const uint2*)(wsb + ri * 136 + d0), c = *(const uint2*)(wsb + ri * 136 + d0 + 8);
      uint4 o = {a.x, a.y, c.x, c.y};
      WN[f * 64 + ln] = o;
    }
  }
  __syncthreads();
}

DI void branch_a_final_row(const Params& p, int row, int lane) {
  const float* cr = p.CONV + (size_t)row * 512;
  float4 v[2];
  float s = 0.f;
#pragma unroll
  for (int j = 0; j < 2; ++j) {
    v[j] = ((const float4*)cr)[j * 64 + lane];
    s += v[j].x + v[j].y + v[j].z + v[j].w;
  }
  float mean = wave_sum(s) * (1.0f / 512.0f);
  float vs = 0.f;
#pragma unroll
  for (int j = 0; j < 2; ++j) {
    v[j].x -= mean; v[j].y -= mean; v[j].z -= mean; v[j].w -= mean;
    vs += v[j].x * v[j].x + v[j].y * v[j].y + v[j].z * v[j].z + v[j].w * v[j].w;
  }
  float inv = rsqrtf(wave_sum(vs) * (1.0f / 512.0f) + EPSF);
#pragma unroll
  for (int j = 0; j < 2; ++j) {
    int c = (j * 64 + lane) * 4;
    float4 g = *(const float4*)(p.ln_a_g + c), bb = *(const float4*)(p.ln_a_b + c);
    uint2 gu = *(const uint2*)(p.PB + (size_t)row * EINP + 1024 + c);
    float y0 = siluf_(v[j].x * inv * g.x + bb.x) * siluf_(bflo(gu.x));
    float y1 = siluf_(v[j].y * inv * g.y + bb.y) * siluf_(bfhi(gu.x));
    float y2 = siluf_(v[j].z * inv * g.z + bb.z) * siluf_(bflo(gu.y));
    float y3 = siluf_(v[j].w * inv * g.w + bb.w) * siluf_(bfhi(gu.y));
    uint2 o;
    o.x = pack2(y0, y1); o.y = pack2(y2, y3);
    *(uint2*)(p.MIX + (size_t)row * 1024 + c) = o;
  }
}

DI void delta_sample_item(const Params& p, int item, char* smem) {
  const int s = item >> 2, hh = item & 3, tid = threadIdx.x;
  const size_t row = NPR + s;
  float* ksm = (float*)smem;
  float* qsm = ksm + 128;
  float* part = qsm + 128;
  if (tid < 128) ksm[tid] = p.QKV[row * 1536 + 512 + hh * 128 + tid];
  else qsm[tid - 128] = p.QKV[row * 1536 + hh * 128 + (tid - 128)];
  const float beta = p.BG[row * 8 + hh], a = __expf(p.BG[row * 8 + 4 + hh]);
  __syncthreads();
  const int e = tid & 127, half = tid >> 7, d0 = half * 64;
  const float* S0 = p.state_delta + (((size_t)s * 4 + hh) * 128 + d0) * 128 + e;
  float* So = p.out + O_DELTAS + (((size_t)s * 4 + hh) * 128 + d0) * 128 + e;
  float Sr[64];
  float ksum = 0.f;
#pragma unroll
  for (int i = 0; i < 64; ++i) {
    Sr[i] = S0[(size_t)i * 128] * a;
    ksum += ksm[d0 + i] * Sr[i];
  }
  part[half * 128 + e] = ksum;
  __syncthreads();
  const float kS = part[e] + part[128 + e];
  const float v = p.QKV[row * 1536 + 1024 + hh * 128 + e];
  const float vnew = (v - kS) * beta;
  float oo = 0.f;
#pragma unroll
  for (int i = 0; i < 64; ++i) {
    Sr[i] += ksm[d0 + i] * vnew;
    So[(size_t)i * 128] = Sr[i];
    oo += qsm[d0 + i] * Sr[i];
  }
  __syncthreads();
  part[half * 128 + e] = oo;
  __syncthreads();
  if (half == 0) p.ODN[row * 512 + hh * 128 + e] = part[e] + part[128 + e];
  __syncthreads();
}

DI void phase_chunk_prep(const Params& p, char* smem) {
  for (int it = blockIdx.x; it < 1024; it += gridDim.x) chunk_prep(p, it, smem);
}

DI void scan_item(const Params& p, int item, char* smem) {
  const int tid = threadIdx.x, lane = tid & 63, es = tid >> 6, r = lane & 31, hl = lane >> 5;
  const int b = item >> 2, hh = item & 3;
  u32x4* bufA = (u32x4*)smem;
  u32x4* bufB = (u32x4*)(smem + 32768);
  const u32x4* gWN = (const u32x4*)p.WN + (size_t)item * 32 * 1024;
  const u32x4* gQD = (const u32x4*)p.QD + (size_t)item * 32 * 1024;
  const u32x4* gKD = (const u32x4*)p.KD + (size_t)item * 32 * 1024;
  const u32x4* gQK = (const u32x4*)p.QKF + (size_t)item * 32 * 512;
  const float* gU = p.U + (size_t)item * 32 * 8192;
  const int uo = hl * 4 * 128 + es * 32 + r;
  const int oo = hl * 4 * 512 + es * 32 + r;
#define GLDS(gp, lp) __builtin_amdgcn_global_load_lds((const unsigned*)(gp), (unsigned*)(lp), 16, 0, 0)
  f32x16 S[4];
#pragma unroll
  for (int d = 0; d < 4; ++d)
#pragma unroll
    for (int q = 0; q < 16; ++q) S[d][q] = 0.f;
  f32x16 vn[2], o[2], op[2];
#pragma unroll
  for (int i = 0; i < 4; ++i) {
    GLDS(gWN + tid + i * 256, bufA + tid + i * 256);
    GLDS(gQD + tid + i * 256, bufA + 1024 + tid + i * 256);
  }
#pragma unroll
  for (int ct = 0; ct < 2; ++ct)
#pragma unroll
    for (int q = 0; q < 16; ++q) vn[ct][q] = gU[(ct * 32 + crow(q, 0)) * 128 + uo];
  asm volatile("s_waitcnt vmcnt(0)" ::: "memory");
  __syncthreads();
#pragma unroll 1
  for (int n = 0; n < 32; ++n) {
    const int chunk = item * 32 + n;
    const float gl = p.GL[chunk];
    const int n1 = (n + 1 < 32) ? n + 1 : 31;
    if (n > 0) {
      float* odp = p.ODN + ((size_t)b * 2048 + (n - 1) * 64) * 512 + hh * 128;
#pragma unroll
      for (int ct = 0; ct < 2; ++ct)
#pragma unroll
        for (int q = 0; q < 16; ++q) odp[(ct * 32 + crow(q, 0)) * 512 + oo] = op[ct][q];
    }
    {
      const u32x4* k0 = gQK + n * 512;
      const u32x4* d0 = gKD + n * 1024;
#pragma unroll
      for (int i = 0; i < 2; ++i) GLDS(k0 + tid + i * 256, bufB + tid + i * 256);
#pragma unroll
      for (int i = 0; i < 4; ++i) GLDS(d0 + tid + i * 256, bufB + 512 + tid + i * 256);
    }
    {
      bf16x8 Sb[4][2];
#pragma unroll
      for (int d = 0; d < 4; ++d) { Sb[d][0] = pack8(S[d], 0); Sb[d][1] = pack8(S[d], 1); }
#pragma unroll
      for (int ct = 0; ct < 2; ++ct)
#pragma unroll
        for (int q = 0; q < 16; ++q) o[ct][q] = 0.f;
#pragma unroll
      for (int ct = 0; ct < 2; ++ct)
#pragma unroll
        for (int ks = 0; ks < 8; ++ks) {
          bf16x8 aw = __builtin_bit_cast(bf16x8, bufA[(ct * 8 + ks) * 64 + lane]);
          bf16x8 aq = __builtin_bit_cast(bf16x8, bufA[1024 + (ct * 8 + ks) * 64 + lane]);
          vn[ct] = MFMA32(aw, Sb[ks >> 1][ks & 1], vn[ct]);
          o[ct] = MFMA32(aq, Sb[ks >> 1][ks & 1], o[ct]);
        }
    }
    bf16x8 Vb[2][2];
#pragma unroll
    for (int ct = 0; ct < 2; ++ct) { Vb[ct][0] = pack8(vn[ct], 0); Vb[ct][1] = pack8(vn[ct], 1); }
    asm volatile("s_waitcnt vmcnt(0)" ::: "memory");
    __syncthreads();
    {
      const u32x4* w1 = gWN + n1 * 1024;
      const u32x4* q1 = gQD + n1 * 1024;
#pragma unroll
      for (int i = 0; i < 4; ++i) {
        GLDS(w1 + tid + i * 256, bufA + tid + i * 256);
        GLDS(q1 + tid + i * 256, bufA + 1024 + tid + i * 256);
      }
      const float* u1 = gU + n1 * 8192;
#pragma unroll
      for (int ct = 0; ct < 2; ++ct)
#pragma unroll
        for (int q = 0; q < 16; ++q) vn[ct][q] = u1[(ct * 32 + crow(q, 0)) * 128 + uo];
    }
#pragma unroll
    for (int ct = 0; ct < 2; ++ct)
#pragma unroll
      for (int ks = 0; ks < 4; ++ks) {
        bf16x8 a = __builtin_bit_cast(bf16x8, bufB[(ct * 4 + ks) * 64 + lane]);
        o[ct] = MFMA32(a, Vb[ks >> 1][ks & 1], o[ct]);
      }
#pragma unroll
    for (int d = 0; d < 4; ++d) {
#pragma unroll
      for (int q = 0; q < 16; ++q) S[d][q] *= gl;
#pragma unroll
      for (int ks = 0; ks < 4; ++ks) {
        bf16x8 a = __builtin_bit_cast(bf16x8, bufB[512 + (d * 4 + ks) * 64 + lane]);
        S[d] = MFMA32(a, Vb[ks >> 1][ks & 1], S[d]);
      }
    }
#pragma unroll
    for (int ct = 0; ct < 2; ++ct) op[ct] = o[ct];
    asm volatile("s_waitcnt vmcnt(0)" ::: "memory");
    __syncthreads();
  }
  {
    float* odp = p.ODN + ((size_t)b * 2048 + 31 * 64) * 512 + hh * 128;
#pragma unroll
    for (int ct = 0; ct < 2; ++ct)
#pragma unroll
      for (int q = 0; q < 16; ++q) odp[(ct * 32 + crow(q, 0)) * 512 + oo] = op[ct][q];
  }
#undef GLDS
  float* so = p.out + O_DELTAP + ((size_t)(b * 4 + hh) * 128) * 128;
#pragma unroll
  for (int d = 0; d < 4; ++d)
#pragma unroll
    for (int q = 0; q < 16; ++q) so[(d * 32 + crow(q, 0)) * 128 + uo] = S[d][q];
  __syncthreads();
}

DI void branch_a_unit(const Params& p, int u, char* smem) {
  int tidu = threadIdx.x;
  asm volatile("" : "+v"(tidu));
  const int lane = tidu & 63, wid = tidu >> 6;
  if (u < 512) {
    conv_a_prompt_item(p, u * 2, (float*)smem);
    conv_a_prompt_item(p, u * 2 + 1, (float*)smem);
    __syncthreads();
    const int row0 = (u >> 6) * 2048 + (u & 63) * 32;
    for (int k = wid; k < 32; k += 4) branch_a_final_row(p, row0 + k, lane);
  } else {
    conv_a_sample_item(p, u - 512);
    __syncthreads();
    if (wid == 0) branch_a_final_row(p, NPR + (u - 512), lane);
  }
  __syncthreads();
}

DI void phase_scan(const Params& p, char* smem) {
  const int lane = threadIdx.x & 63, wid = threadIdx.x >> 6;
  if (gridDim.x >= 64) {
    if (blockIdx.x < 32) {
      __builtin_amdgcn_s_setprio(3);
      scan_item(p, blockIdx.x, smem);
      __builtin_amdgcn_s_setprio(0);
    } else {
      const int nb = gridDim.x - 32, bi = blockIdx.x - 32;
      for (int w = bi; w < 640 + 512 + 2112; w += nb) {
        if (w < 640) branch_a_unit(p, w, smem);
        else if (w < 1152) delta_sample_item(p, w - 640, smem);
        else transpose_item(p, transpose_late(w - 1152), (float*)smem);
      }
    }
  } else {
    for (int it = blockIdx.x; it < 32; it += gridDim.x) scan_item(p, it, smem);
    for (int it = blockIdx.x; it < 512; it += gridDim.x) delta_sample_item(p, it, smem);
    for (int u = blockIdx.x; u < 640; u += gridDim.x) branch_a_unit(p, u, smem);
    for (int i = blockIdx.x; i < 2112; i += gridDim.x) transpose_item(p, transpose_late(i), (float*)smem);
  }
}

DI void phase_delta_post(const Params& p) {
  const int lane = threadIdx.x & 63, wid = threadIdx.x >> 6;
  const int stride = gridDim.x * 4;
  const float2 g = *(const float2*)(p.dn_norm_g + lane * 2);
  for (int row = blockIdx.x * 4 + wid; row < NROW; row += 2 * stride) {
    const int r1 = row + stride;
    const bool has1 = r1 < NROW;
    const int rows[2] = {row, has1 ? r1 : row};
    float2 o[2][4];
    unsigned zu[2][4];
#pragma unroll
    for (int k = 0; k < 2; ++k)
#pragma unroll
      for (int hh = 0; hh < 4; ++hh) {
        const int ch = hh * 128 + lane * 2;
        o[k][hh] = *(const float2*)(p.ODN + (size_t)rows[k] * 512 + ch);
        zu[k][hh] = *(const unsigned*)(p.PB + (size_t)rows[k] * EINP + 3072 + ch);
      }
#pragma unroll
    for (int k = 0; k < 2; ++k)
#pragma unroll
      for (int hh = 0; hh < 4; ++hh) {
        const int ch = hh * 128 + lane * 2;
        float ss = wave_sum(o[k][hh].x * o[k][hh].x + o[k][hh].y * o[k][hh].y);
        float inv = rsqrtf(ss * (1.0f / 128.0f) + EPSF);
        float y0 = o[k][hh].x * inv * g.x * siluf_(bflo(zu[k][hh]));
        float y1 = o[k][hh].y * inv * g.y * siluf_(bfhi(zu[k][hh]));
        if (k == 0 || has1) *(unsigned*)(p.MIX + (size_t)rows[k] * 1024 + 512 + ch) = pack2(y0, y1);
      }
  }
}

template <bool FIRST, bool HAS_H>
DI void phase_gemm_resid(const Params& p, const bfr* A, const bfr* Wt, const float* gnext, float* ss, char* smem) {
  float* X = p.X;
  bfr* Hn = p.H;
  {
    const float* xs = p.x_sample - (size_t)NPR * 1024;
    gemm_sample<true>(A, 1024, Wt, 1024, 1024, 1024, smem,
                      [=](int row, int col, float v) -> float {
                        const size_t o = (size_t)row * 1024 + col;
                        const float xn = (FIRST ? xs[o] : X[o]) + v;
                        X[o] = xn;
                        if (HAS_H) Hn[o] = f2bf(xn * gnext[col]);
                        return xn;
                      },
                      [=](int row, float s2) { unsafeAtomicAdd(ss + row, s2); });
  }
  for (int t0 = blockIdx.x; t0 < 128 * 4; t0 += gridDim.x) {
    const int t = ((gridDim.x & 7) == 0) ? xcd_tile(t0, 4) : t0;
    const int mt = t >> 2, nt = t & 3, m0 = mt * 128, n0 = nt * 256;
    f32x16 acc[2][4];
    gemm_mainloop<1024>(A, Wt, 1024, 1024, m0, n0, smem, acc);
    int tid2 = threadIdx.x;
    asm volatile("" : "+v"(tid2));
    const int lane = tid2 & 63, wid = tid2 >> 6, wr = wid >> 1, wc = wid & 1, r = lane & 31, hl = lane >> 5;
    const float* xsrc = FIRST ? p.x_prompt : X;
    const int rbase = m0 + wr * 64 + 4 * hl, cbase = n0 + wc * 128 + r;
#pragma unroll
    for (int i = 0; i < 2; ++i) {
#pragma unroll
      for (int qh = 0; qh < 2; ++qh) {
        float rs[8];
#pragma unroll
        for (int q = 0; q < 8; ++q) rs[q] = 0.f;
#pragma unroll
        for (int jh = 0; jh < 2; ++jh) {
          float xo[2][8];
#pragma unroll
          for (int jj = 0; jj < 2; ++jj)
#pragma unroll
            for (int q = 0; q < 8; ++q)
              xo[jj][q] = xsrc[(rbase + i * 32 + crow(qh * 8 + q, 0)) * 1024 + cbase + (jh * 2 + jj) * 32];
#pragma unroll
          for (int q = 0; q < 8; ++q) {
            const int o = (rbase + i * 32 + crow(qh * 8 + q, 0)) * 1024 + cbase;
#pragma unroll
            for (int jj = 0; jj < 2; ++jj) {
              const int j = jh * 2 + jj;
              const float xn = xo[jj][q] + acc[i][j][qh * 8 + q];
              X[o + j * 32] = xn;
              if (HAS_H) Hn[o + j * 32] = f2bf(xn * gnext[cbase + j * 32]);
              rs[q] += xn * xn;
            }
          }
        }
#pragma unroll
        for (int q = 0; q < 8; ++q) rs[q] = half32_sum_hi(rs[q]);
        if (r == 31) {
#pragma unroll
          for (int q = 0; q < 8; ++q) unsafeAtomicAdd(ss + rbase + i * 32 + crow(qh * 8 + q, 0), rs[q]);
        }
      }
    }
  }
}
DI void phase_gemm_bf16out(const Params& p, const bfr* A, const bfr* Wt, bfr* C, int N, const float* ss, char* smem) {
  const int ntn = N >> 8;
  gemm_sample<false>(A, 1024, Wt, N, 1024, N, smem,
                     [=](int row, int col, float v) -> float {
                       float inv = rsqrtf(ss[row] * (1.0f / 1024.0f) + EPSF);
                       C[(size_t)row * N + col] = f2bf(v * inv);
                       return 0.f;
                     },
                     [=](int, float) {});
  for (int t0 = blockIdx.x; t0 < 128 * ntn; t0 += gridDim.x) {
    const int t = ((gridDim.x & 7) == 0) ? xcd_tile(t0, ntn) : t0;
    int mt = t / ntn, nt = t % ntn;
    gemm_tile<1024>(A, Wt, N, 1024, mt * 128, nt * 256, smem,
              [=](int row, int col, float v) {
                float inv = rsqrtf(ss[row] * (1.0f / 1024.0f) + EPSF);
                C[(size_t)row * N + col] = f2bf(v * inv);
              });
  }
}

DI void attn_prompt_wave(const Params& p, int l, int b, int hh, int tt, bfr* Obuf) {
  const int lane = threadIdx.x & 63, r = lane & 31, hl = lane >> 5;
  const size_t row0 = (size_t)b * 2048 + tt * 32;
  const bfr* Qp = p.ACT2 + (row0 + r) * 1024 + hh * 256 + hl * 8;
  const bfr* Kp = p.KB + (size_t)l * 2097152 + ((size_t)b * 256 + r) * 1024 + hh * 256 + hl * 8;
  f32x16 st[8];
#pragma unroll
  for (int m = 0; m < 8; ++m)
#pragma unroll
    for (int q = 0; q < 16; ++q) st[m][q] = 0.f;
#pragma unroll 2
  for (int ks = 0; ks < 16; ++ks) {
    bf16x8 qf = *(const bf16x8*)(Qp + ks * 16);
#pragma unroll
    for (int m = 0; m < 8; ++m) {
      bf16x8 kf = *(const bf16x8*)(Kp + (size_t)m * 32 * 1024 + ks * 16);
      st[m] = MFMA32(kf, qf, st[m]);
    }
  }
  float mx = -3.0e38f;
#pragma unroll
  for (int m = 0; m < 8; ++m)
#pragma unroll
    for (int q = 0; q < 16; ++q) mx = fmaxf(mx, st[m][q]);
  mx = fmaxf(mx, __shfl_xor(mx, 32));
  float sum = 0.f;
#pragma unroll
  for (int m = 0; m < 8; ++m)
#pragma unroll
    for (int q = 0; q < 16; ++q) {
      float e = __expf((st[m][q] - mx) * 0.0625f);
      st[m][q] = e;
      sum += e;
    }
  sum += __shfl_xor(sum, 32);
  const float inv = 1.0f / sum;
  bf16x8 pb[8][2];
#pragma unroll
  for (int m = 0; m < 8; ++m) { pb[m][0] = pack8(st[m], 0); pb[m][1] = pack8(st[m], 1); }
  const uint4* VT = (const uint4*)(p.VT + (size_t)l * 2097152) + ((size_t)(b * 4 + hh) * 8) * 16 * 64 + lane;
  bfr* Op = Obuf + (row0 + r) * 1024 + hh * 256;
#pragma unroll 1
  for (int half = 0; half < 2; ++half) {
    f32x16 o[4];
#pragma unroll
    for (int d = 0; d < 4; ++d)
#pragma unroll
      for (int q = 0; q < 16; ++q) o[d][q] = 0.f;
#pragma unroll
    for (int ks = 0; ks < 16; ++ks) {
#pragma unroll
      for (int d = 0; d < 4; ++d) {
        bf16x8 vf = ldfrag(VT + ((size_t)(half * 4 + d) * 16 + ks) * 64);
        o[d] = MFMA32(vf, pb[ks >> 1][ks & 1], o[d]);
      }
    }
#pragma unroll
    for (int d = 0; d < 4; ++d)
#pragma unroll
      for (int g4 = 0; g4 < 4; ++g4) {
        int dim = (half * 4 + d) * 32 + 8 * g4 + 4 * hl;
        uint2 ov;
        ov.x = pack2(o[d][g4 * 4 + 0] * inv, o[d][g4 * 4 + 1] * inv);
        ov.y = pack2(o[d][g4 * 4 + 2] * inv, o[d][g4 * 4 + 3] * inv);
        *(uint2*)(Op + dim) = ov;
      }
  }
}

DI void attn_prompt_block(const Params& p, int l, int b, int hh, int tt4, char* smem, bfr* Obuf) {
  int tid = threadIdx.x;
  asm volatile("" : "+v"(tid));
  const int lane = tid & 63, wid = tid >> 6, r = lane & 31, hl = lane >> 5;
  const int row0 = b * 2048 + (tt4 * 4 + wid) * 32;
  const int qoff = (row0 + r) * 1024 + hh * 256 + hl * 8;
  const bfr* Kg = p.KB + (size_t)l * 2097152 + (size_t)(b * 256) * 1024 + hh * 256;
  const u32x4* VTg = (const u32x4*)(p.VT + (size_t)l * 2097152) + (size_t)((b * 4 + hh) * 8) * 16 * 64;
  bfr* kbuf = (bfr*)smem;
  u32x4* vbuf = (u32x4*)smem;
  u32x4 sr[8];
#define LOADK(c_) do { _Pragma("unroll") for (int i = 0; i < 4; ++i) { const int ch = tid + i * 256; \
    sr[i] = *(const u32x4*)(Kg + (ch >> 2) * 1024 + (c_) * 32 + (ch & 3) * 8); } } while (0)
#define STOREK() do { _Pragma("unroll") for (int i = 0; i < 4; ++i) { const int ch = tid + i * 256; \
    *(u32x4*)(kbuf + (ch >> 2) * 40 + (ch & 3) * 8) = sr[i]; } } while (0)
#define LOADV(v_, tid) do { _Pragma("unroll") for (int i = 0; i < 8; ++i) { const int idx = tid + i * 256, f = idx >> 6; \
    sr[i] = VTg[(((v_) >> 1) * 4 + (f >> 3)) * 1024 + (((v_) & 1) * 8 + (f & 7)) * 64 + (idx & 63)]; } } while (0)
#define STOREV(tid) do { _Pragma("unroll") for (int i = 0; i < 8; ++i) vbuf[tid + i * 256] = sr[i]; } while (0)
  f32x16 st[8];
#pragma unroll
  for (int m = 0; m < 8; ++m)
#pragma unroll
    for (int q = 0; q < 16; ++q) st[m][q] = 0.f;
  LOADK(0);
  STOREK();
  __syncthreads();
#pragma unroll
  for (int c = 0; c < 8; ++c) {
    if (c < 7) LOADK(c + 1); else LOADV(0, tid);
    bf16x8 qf[2];
#pragma unroll
    for (int ksl = 0; ksl < 2; ++ksl) qf[ksl] = *(const bf16x8*)(p.ACT2 + qoff + (c * 2 + ksl) * 16);
#pragma unroll
    for (int ksl = 0; ksl < 2; ++ksl)
#pragma unroll
      for (int m = 0; m < 8; ++m) {
        bf16x8 kf = *(const bf16x8*)(kbuf + (m * 32 + r) * 40 + ksl * 16 + hl * 8);
        st[m] = MFMA32(kf, qf[ksl], st[m]);
      }
    __syncthreads();
    if (c < 7) STOREK(); else STOREV(tid);
    __syncthreads();
  }
  float mx = -3.0e38f;
#pragma unroll
  for (int m = 0; m < 8; ++m)
#pragma unroll
    for (int q = 0; q < 16; ++q) mx = fmaxf(mx, st[m][q]);
  mx = fmaxf(mx, __shfl_xor(mx, 32));
  float sum = 0.f;
#pragma unroll
  for (int m = 0; m < 8; ++m)
#pragma unroll
    for (int q = 0; q < 16; ++q) {
      float e = __expf((st[m][q] - mx) * 0.0625f);
      st[m][q] = e;
      sum += e;
    }
  sum += __shfl_xor(sum, 32);
  const float inv = 1.0f / sum;
  bf16x8 pb[8][2];
#pragma unroll
  for (int m = 0; m < 8; ++m) { pb[m][0] = pack8(st[m], 0); pb[m][1] = pack8(st[m], 1); }
  int tidv = threadIdx.x;
  asm volatile("" : "+v"(tidv));
  const int lanev = tidv & 63, rv = lanev & 31, hlv = lanev >> 5;
  const int ooff = (b * 2048 + (tt4 * 4 + (tidv >> 6)) * 32 + rv) * 1024 + hh * 256;
  f32x16 o[4];
#pragma unroll
  for (int v = 0; v < 4; ++v) {
    if (v < 3) LOADV(v + 1, tidv);
    if ((v & 1) == 0) {
#pragma unroll
      for (int d = 0; d < 4; ++d)
#pragma unroll
        for (int q = 0; q < 16; ++q) o[d][q] = 0.f;
    }
#pragma unroll
    for (int kk = 0; kk < 8; ++kk)
#pragma unroll
      for (int d = 0; d < 4; ++d) {
        bf16x8 vf = __builtin_bit_cast(bf16x8, vbuf[(d * 8 + kk) * 64 + lanev]);
        o[d] = MFMA32(vf, pb[((v & 1) * 8 + kk) >> 1][kk & 1], o[d]);
        if (d == 3) __builtin_amdgcn_sched_barrier(0);
      }
    if (v & 1) {
#pragma unroll
      for (int d = 0; d < 4; ++d)
#pragma unroll
        for (int g4 = 0; g4 < 4; ++g4) {
          int dim = ((v >> 1) * 4 + d) * 32 + 8 * g4 + 4 * hlv;
          uint2 ov;
          ov.x = pack2(o[d][g4 * 4 + 0] * inv, o[d][g4 * 4 + 1] * inv);
          ov.y = pack2(o[d][g4 * 4 + 2] * inv, o[d][g4 * 4 + 3] * inv);
          *(uint2*)(Obuf + ooff + dim) = ov;
        }
    }
    __syncthreads();
    if (v < 3) { STOREV(tidv); __syncthreads(); }
  }
#undef LOADK
#undef STOREK
#undef LOADV
#undef STOREV
}

DI void attn_sample_item(const Params& p, int l, int item, char* smem, bfr* Obuf) {
  const int s = item >> 2, hh = item & 3, tid = threadIdx.x, lane = tid & 63, wid = tid >> 6;
  float* qsm = (float*)smem;
  float* sc = qsm + 256;
  float* red = sc + 256;
  const size_t row = NPR + s;
  qsm[tid] = bf2f(p.ACT2[row * 1024 + hh * 256 + tid]);
  __syncthreads();
  const int grp = lane >> 4, l16 = lane & 15;
  float4 q4[4];
#pragma unroll
  for (int j = 0; j < 4; ++j) q4[j] = ((const float4*)qsm)[j * 16 + l16];
  const float* Kb = p.cache_k + ((((size_t)l * 128 + s) * 256) * 4 + hh) * 256;
  const float* Vb = p.cache_v + ((((size_t)l * 128 + s) * 256) * 4 + hh) * 256;
#pragma unroll 8
  for (int ps = 0; ps < 16; ++ps) {
    int mem = wid * 64 + ps * 4 + grp;
    const float4* kr = (const float4*)(Kb + (size_t)mem * 1024);
    float d = 0.f;
#pragma unroll
    for (int j = 0; j < 4; ++j) {
      float4 k4 = kr[j * 16 + l16];
      d += k4.x * q4[j].x + k4.y * q4[j].y + k4.z * q4[j].z + k4.w * q4[j].w;
    }
    d += __shfl_xor(d, 8);
    d += __shfl_xor(d, 4);
    d += __shfl_xor(d, 2);
    d += __shfl_xor(d, 1);
    if (l16 == 0) sc[mem] = d * 0.0625f;
  }
  __syncthreads();
  float sv = sc[tid];
  float m = wave_max(sv);
  if (lane == 0) red[wid] = m;
  __syncthreads();
  m = fmaxf(fmaxf(red[0], red[1]), fmaxf(red[2], red[3]));
  float e = __expf(sv - m);
  float sm_ = wave_sum(e);
  if (lane == 0) red[4 + wid] = sm_;
  sc[tid] = e;
  __syncthreads();
  const float inv = 1.0f / (red[4] + red[5] + red[6] + red[7]);
  float4 acc = {0.f, 0.f, 0.f, 0.f};
  float* partial = (float*)smem + 1024;
#pragma unroll 16
  for (int i = 0; i < 64; ++i) {
    const int mem = wid * 64 + i;
    float4 v4 = *(const float4*)(Vb + (size_t)mem * 1024 + lane * 4);
    const float pm = sc[mem];
    acc.x += pm * v4.x; acc.y += pm * v4.y; acc.z += pm * v4.z; acc.w += pm * v4.w;
  }
  *(float4*)(partial + wid * 256 + lane * 4) = acc;
  __syncthreads();
  const float ov = partial[tid] + partial[256 + tid] + partial[512 + tid] + partial[768 + tid];
  Obuf[row * 1024 + hh * 256 + tid] = f2bf(ov * inv);
  __syncthreads();
}

DI void phase_attn(const Params& p, int l, char* smem) {
  bfr* Obuf = p.ACT3;
  const int half = gridDim.x >> 1;
  const bool upper = (int)blockIdx.x >= half;
  const int bi = upper ? (int)blockIdx.x - half : (int)blockIdx.x;
  const int nb = upper ? (int)gridDim.x - half : half;
  for (int pass = 0; pass < 2; ++pass) {
    const bool do_sample = (pass == 0) != upper;
    if (do_sample) {
      for (int k = bi; k < 256; k += nb) attn_sample_item(p, l, 2 * k + (upper ? 1 : 0), smem, Obuf);
    } else {
      for (int k = bi; k < 256; k += nb) {
        const int u = 2 * k + (upper ? 1 : 0), tt4 = u & 15, hh = (u >> 4) & 3, b = u >> 6;
        attn_prompt_block(p, l, b, hh, tt4, smem, Obuf);
      }
    }
  }
}

template <int WIN>
DI void pool_elem(const Params& p, int row, int c) {
  const bfr* P2 = p.PB;
  unsigned uu = *(const unsigned*)(P2 + (size_t)row * 2048 + c);
  const float u0 = bflo(uu), u1 = bfhi(uu);
  float s0 = u0, s1 = u1, cnt;
  if (row < NPR) {
    const int t = row & 2047, b = row >> 11;
    if (t >= WIN - 1) {
      cnt = (float)WIN;
      unsigned w[WIN - 1];
#pragma unroll
      for (int j = 1; j < WIN; ++j) w[j - 1] = *(const unsigned*)(P2 + (size_t)(row - j) * 2048 + c);
#pragma unroll
      for (int j = 1; j < WIN; ++j) { s0 += bflo(w[j - 1]); s1 += bfhi(w[j - 1]); }
    } else {
      cnt = (float)(t + 1);
      for (int j = 1; j <= t; ++j) {
        unsigned w = *(const unsigned*)(P2 + (size_t)(row - j) * 2048 + c);
        s0 += bflo(w); s1 += bfhi(w);
      }
    }
    if (t >= 2033) {
      float2 o = {u0, u1};
      *(float2*)(p.out + O_POOLP + ((size_t)b * 15 + (t - 2033)) * 1024 + c) = o;
    }
  } else {
    const int s = row - NPR;
    cnt = (float)WIN;
    const float* sp = p.state_pool + (size_t)s * 15 * 1024 + c;
    float2 st[15];
#pragma unroll
    for (int j = 0; j < 15; ++j) st[j] = *(const float2*)(sp + (size_t)j * 1024);
#pragma unroll
    for (int j = 1; j < WIN; ++j) { s0 += st[15 - j].x; s1 += st[15 - j].y; }
    float* op = p.out + O_POOLS + (size_t)s * 15 * 1024 + c;
#pragma unroll
    for (int j = 0; j < 14; ++j) *(float2*)(op + (size_t)j * 1024) = st[j + 1];
    float2 o = {u0, u1};
    *(float2*)(op + (size_t)14 * 1024) = o;
  }
  *(unsigned*)(p.MIX + (size_t)row * 1024 + c) = pack2(s0 / cnt - u0, s1 / cnt - u1);
}
DI void phase_pool(const Params& p) {
  for (int idx = blockIdx.x * 256 + threadIdx.x; idx < NROW * 512; idx += gridDim.x * 256) {
    const int row = idx >> 9, c = (idx & 511) * 2;
    const int gi = c >> 8;
    if (gi == 0) pool_elem<2>(p, row, c);
    else if (gi == 1) pool_elem<4>(p, row, c);
    else if (gi == 2) pool_elem<8>(p, row, c);
    else pool_elem<16>(p, row, c);
  }
}

DI void phase_gemm_pool(const Params& p, char* smem) {
  const bfr* P2 = p.PB;
  bfr* Z = p.ACT3;
  for (int g = 0; g < 4; ++g) {
    const float* bp = p.b_pool + g * 256;
    const float* sc = p.pool_scale + g * 256;
    gemm_sample<false>(p.MIX + g * 256, 1024, p.WtPool + (size_t)g * 65536, 256, 256, 256, smem,
                       [=](int row, int col, float v) -> float {
                         float gate = bf2f(P2[(size_t)row * 2048 + 1024 + g * 256 + col]);
                         float z = (v + bp[col]) * sc[col] * siluf_(gate);
                         Z[(size_t)row * 1024 + g * 256 + col] = f2bf(z);
                         return 0.f;
                       },
                       [=](int, float) {});
  }
  for (int t0 = blockIdx.x; t0 < 128 * 4; t0 += gridDim.x) {
    const int t = ((gridDim.x & 7) == 0) ? xcd_tile(t0, 4) : t0;
    int mt = t >> 2, g = t & 3, nt = 0;
    const float* bp = p.b_pool + g * 256;
    const float* sc = p.pool_scale + g * 256;
    gemm_tile<1024>(p.MIX + g * 256, p.WtPool + (size_t)g * 65536, 256, 256, mt * 128, nt * 256, smem,
              [=](int row, int col, float v) {
                float gate = bf2f(P2[(size_t)row * 2048 + 1024 + g * 256 + col]);
                float z = (v + bp[col]) * sc[col] * siluf_(gate);
                Z[(size_t)row * 1024 + g * 256 + col] = f2bf(z);
              });
  }
}

#ifndef ONLY_PHASE
#define ONLY_PHASE -1
#endif
#define PON(n) (ONLY_PHASE < 0 || ONLY_PHASE == (n))
__global__ void __launch_bounds__(256, 2) mega(Params p) {
  __shared__ __attribute__((aligned(16))) char smem[65536];
  cg::grid_group grid = cg::this_grid();
  if (p.phase_lo < -1000) grid.sync();
  volatile LAS unsigned* xst = (volatile LAS unsigned*)(smem + 65520);
  if (threadIdx.x < 4) xst[threadIdx.x] = 0u;
  __syncthreads();
  (void)xcd_barrier_post(p.bar, xst);
#define XB_NOW() do { XcdBarrier b_; b_.bar = p.bar; b_.x = xb_xcc_id(); b_.st = (volatile LAS unsigned*)(smem + 65520); xcd_barrier(b_); } while (0)
#ifndef DUPMASK
#define DUPMASK 0
#endif
#define RUN(n, call) do { if (PON(n) && p.phase_lo <= (n) && (n) <= p.phase_hi) { call; if ((DUPMASK >> (n)) & 1) { XB_NOW(); call; } } if (p.phase_lo <= (n) && (n) < p.phase_hi) XB_NOW(); } while (0)
  RUN(0, phase_prep(p, smem));
  RUN(1, phase_gemm_in_even(p, smem));
  RUN(2, phase_even_pointwise(p, smem));
  RUN(3, phase_chunk_prep(p, smem));
  RUN(4, phase_scan(p, smem));
  RUN(5, phase_delta_post(p));
  RUN(6, (phase_gemm_resid<true, true>(p, p.MIX, p.WtOutE, p.norm_xattn, p.SS, smem)));
  RUN(8, phase_gemm_bf16out(p, p.H, p.WtXq, p.ACT2, 1024, p.SS, smem));
  RUN(9, phase_attn(p, 0, smem));
  RUN(10, (phase_gemm_resid<false, true>(p, p.ACT3, p.WtXo, p.norm_mix + 1024, p.SS + NROW, smem)));
  RUN(12, phase_gemm_bf16out(p, p.H, p.WtInO, p.PB, 2048, p.SS + NROW, smem));
  RUN(13, phase_pool(p));
  RUN(14, phase_gemm_pool(p, smem));
  RUN(15, (phase_gemm_resid<false, true>(p, p.ACT3, p.WtOutO, p.norm_xattn + 1024, p.SS + 2 * NROW, smem)));
  RUN(17, phase_gemm_bf16out(p, p.H, p.WtXq + 1048576, p.ACT2, 1024, p.SS + 2 * NROW, smem));
  RUN(18, phase_attn(p, 1, smem));
  RUN(19, (phase_gemm_resid<false, false>(p, p.ACT3, p.WtXo + 1048576, p.norm_final, p.SS + 3 * NROW, smem)));
  RUN(20, phase_final_norm(p));
}

extern "C" void kernel_launch(void* const* d_in, const int* in_sizes, int n_in, void* d_out, int out_size, void* d_ws,
                              size_t ws_size, hipStream_t stream) {
  static int grid_blocks = 0;
  if (!grid_blocks) {
    int dev = 0, cus = 0, per_cu = 0;
    (void)hipGetDevice(&dev);
    (void)hipDeviceGetAttribute(&cus, hipDeviceAttributeMultiprocessorCount, dev);
    (void)hipOccupancyMaxActiveBlocksPerMultiprocessor(&per_cu, mega, 256, 0);
    if (per_cu < 1) per_cu = 1;
    if (per_cu > 2) per_cu = 2;
    grid_blocks = cus * per_cu;
  }
  Params p{};
  const float** ins = (const float**)&p.x_prompt;
  for (int i = 0; i < 31; ++i) ins[i] = (const float*)d_in[i];
  p.out = (float*)d_out;
  char* w = (char*)d_ws;
  size_t off = 0;
  auto take = [&](size_t bytes) { char* r = w + off; off += (bytes + 255) & ~(size_t)255; return r; };
  p.X = (float*)take((size_t)NROW * 1024 * 4);
  p.QKV = (float*)take((size_t)NROW * 1536 * 4);
  p.BGR = (float*)take((size_t)NROW * 8 * 4);
  p.BG = (float*)take((size_t)NROW * 8 * 4);
  p.CONV = (float*)take((size_t)NROW * 512 * 4);
  p.ODN = (float*)take((size_t)NROW * 512 * 4);
  p.U = (float*)take((size_t)1024 * 8192 * 4);
  p.GL = (float*)take(4096);
  p.SS = (float*)take((size_t)4 * NROW * 4);
  p.H = (bfr*)take((size_t)NROW * 1024 * 2);
  p.PB = (bfr*)take((size_t)NROW * 3584 * 2);
  p.MIX = (bfr*)take((size_t)NROW * 1024 * 2);
  p.ACT2 = (bfr*)take((size_t)NROW * 1024 * 2);
  p.ACT3 = (bfr*)take((size_t)NROW * 1024 * 2);
  p.KB = (bfr*)take((size_t)2 * 2048 * 1024 * 2);
  p.VT = (bfr*)take((size_t)2 * 2048 * 1024 * 2);
  p.MPB = (bfr*)take((size_t)2048 * 1024 * 2);
  p.WtInE = (bfr*)take((size_t)3712 * 1024 * 2);
  p.WtOutE = (bfr*)take((size_t)1024 * 1024 * 2);
  p.WtInO = (bfr*)take((size_t)2048 * 1024 * 2);
  p.WtPool = (bfr*)take((size_t)4 * 256 * 256 * 2);
  p.WtOutO = (bfr*)take((size_t)1024 * 1024 * 2);
  p.WtXq = (bfr*)take((size_t)2 * 1024 * 1024 * 2);
  p.WtXk = (bfr*)take((size_t)2 * 1024 * 1024 * 2);
  p.WtXv = (bfr*)take((size_t)2 * 1024 * 1024 * 2);
  p.WtXo = (bfr*)take((size_t)2 * 1024 * 1024 * 2);
  p.WN = (uint4*)take((size_t)1024 * 1024 * 16);
  p.QD = (uint4*)take((size_t)1024 * 1024 * 16);
  p.KD = (uint4*)take((size_t)1024 * 1024 * 16);
  p.QKF = (uint4*)take((size_t)1024 * 512 * 16);
  p.bar = (unsigned*)take((size_t)XCD_BAR_WORDS * 4);
  if (off > ws_size) {
    fprintf(stderr, "kernel_launch: workspace too small: need %zu have %zu\n", off, ws_size);
    return;
  }
  p.phase_lo = 0;
  p.phase_hi = 20;
  if (hipMemsetAsync(p.bar, 0, (size_t)XCD_BAR_WORDS * 4, stream) != hipSuccess) { fprintf(stderr, "memset failed\n"); return; }
  void* args[] = {&p};
  hipError_t e = hipLaunchCooperativeKernel((void*)mega, dim3(grid_blocks), dim3(256), args, 0, stream);
  if (e != hipSuccess) fprintf(stderr, "cooperative launch failed: %s (grid %d)\n", hipGetErrorString(e), grid_blocks);
}
```
